# Optimizing an MI355X kernel written in HIP

```python
import jax, jax.numpy as jnp
from jax import lax
import numpy as np

D_MODEL = 1024
BATCH = 8
SEQ = 2048
DEPTH = 2
DEC_BATCH = 128
DEC_SEQ = 4
PAST_LEN = 16384
PAGE_SIZE = 128

EXPAND = 2
E_A = EXPAND * D_MODEL
HEAD_K = 128
N_HEADS_A = E_A // HEAD_K
HEAD_V = E_A // N_HEADS_A
CHUNK_A = 64
E_B = EXPAND * D_MODEL
CHUNK_B = 128
GROUP_B = 128
N_GROUPS_B = E_B // GROUP_B
N_A_LAYERS = (DEPTH + 1) // 2
N_B_LAYERS = DEPTH // 2
ALPHA = (2 * DEPTH) ** 0.25
BETA = (8 * DEPTH) ** -0.25
LN_EPS = 1e-5

kernel_name = "hgrn2_chunk_gmlp_hybrid_step"


def layer_norm(x, g, b):
    xf = x.astype(jnp.float32)
    mu = jnp.mean(xf, axis=-1, keepdims=True)
    var = jnp.mean(jnp.square(xf - mu), axis=-1, keepdims=True)
    y = (xf - mu) * lax.rsqrt(var + LN_EPS) * g.astype(jnp.float32) + b.astype(jnp.float32)
    return y.astype(x.dtype)


def hgrn2_recurrence(q, log_f, v, s0):
    bsz, seq_len, n_heads, _ = q.shape
    pad = (-seq_len) % CHUNK_A
    n_chunks = (seq_len + pad) // CHUNK_A

    def to_chunks(t):
        t = jnp.pad(t.astype(jnp.float32), ((0, 0), (0, pad), (0, 0), (0, 0)))
        return t.reshape(bsz, n_chunks, CHUNK_A, n_heads, t.shape[-1]).transpose(1, 0, 3, 2, 4)

    qc, lfc, vc = to_chunks(q), to_chunks(log_f), to_chunks(v)
    causal = jnp.tril(jnp.ones((CHUNK_A, CHUNK_A), dtype=bool))

    def step(s, inp):
        qn, lfn, vn = inp
        kn = -jnp.expm1(lfn)
        cum = jnp.cumsum(lfn, axis=2)
        cum_last = cum[:, :, -1:, :]
        q_dec = qn * jnp.exp(cum)
        k_inv = kn * jnp.exp(-cum)
        scores = jnp.where(causal, jnp.einsum('bhtk,bhsk->bhts', q_dec, k_inv), 0.0)
        o = jnp.einsum('bhts,bhsv->bhtv', scores, vn) + jnp.einsum('bhtk,bhkv->bhtv', q_dec, s)
        k_end = kn * jnp.exp(cum_last - cum)
        s_new = jnp.exp(cum_last[:, :, 0, :])[..., None] * s + jnp.einsum('bhsk,bhsv->bhkv', k_end, vn)
        return s_new, o

    s_final, o = lax.scan(step, s0.astype(jnp.float32), (qc, lfc, vc))
    o = o.transpose(1, 0, 3, 2, 4).reshape(bsz, n_chunks * CHUNK_A, n_heads, -1)[:, :seq_len]
    return o, s_final


def hgrn2_branch(x, s0, w_in, lb, gnorm, w_out):
    bsz, seq_len, _ = x.shape
    proj = x @ w_in
    q, f_logit, i_in, gate = jnp.split(proj, 4, axis=-1)
    q = jax.nn.silu(q).reshape(bsz, seq_len, N_HEADS_A, HEAD_K)
    log_f = jnp.logaddexp(jnp.log(lb), jnp.log1p(-lb) + jax.nn.log_sigmoid(f_logit.astype(jnp.float32)))
    log_f = log_f.reshape(bsz, seq_len, N_HEADS_A, HEAD_K)
    v = i_in.reshape(bsz, seq_len, N_HEADS_A, HEAD_V)
    o, s_new = hgrn2_recurrence(q, log_f, v, s0)
    o = o * lax.rsqrt(jnp.mean(jnp.square(o), axis=-1, keepdims=True) + LN_EPS)
    o = o * gnorm.astype(jnp.float32).reshape(N_HEADS_A, HEAD_V)
    o = o.reshape(bsz, seq_len, E_A).astype(x.dtype) * jax.nn.silu(gate)
    return o @ w_out, s_new.astype(s0.dtype)


def chunk_gmlp_branch(x, w_in, lnv_g, lnv_b, w_s, b_s, w_out):
    bsz, seq_len, _ = x.shape
    proj = x @ w_in
    u, v = jnp.split(jax.nn.gelu(proj[..., :2 * E_B]), 2, axis=-1)
    z = proj[..., 2 * E_B:]
    v = layer_norm(v, lnv_g, lnv_b)
    pad = (-seq_len) % CHUNK_B
    n_chunks = (seq_len + pad) // CHUNK_B
    vc = jnp.pad(v, ((0, 0), (0, pad), (0, 0))).reshape(bsz, n_chunks, CHUNK_B, N_GROUPS_B, GROUP_B)
    w_causal = jnp.where(jnp.tril(jnp.ones((CHUNK_B, CHUNK_B), dtype=bool)), w_s, 0.0)
    mixed = jnp.einsum('gts,bnsgc->bntgc', w_causal, vc) + b_s.T[None, None, :, :, None]
    mixed = mixed.reshape(bsz, n_chunks * CHUNK_B, E_B)[:, :seq_len]
    out = u * mixed * jax.nn.silu(z)
    return out @ w_out, v


def setup_inputs(seed: int = 0) -> dict:
    key = jax.random.key(seed)
    ks = jax.random.split(key, 16)
    nrm = jax.random.normal
    f32 = jnp.float32
    return {
        "x_prompt": nrm(ks[0], (BATCH, SEQ, D_MODEL), f32),
        "x_sample": nrm(ks[1], (DEC_BATCH, DEC_SEQ, D_MODEL), f32),
        "state_hgrn": 0.5 * nrm(ks[2], (N_A_LAYERS, DEC_BATCH, N_HEADS_A, HEAD_K, HEAD_V), f32),
        "w_in_a": nrm(ks[3], (N_A_LAYERS, D_MODEL, 4 * E_A), f32) * D_MODEL ** -0.5,
        "lb_logits_a": 0.1 * nrm(ks[4], (N_A_LAYERS + 1, N_HEADS_A * HEAD_K), f32),
        "gnorm_a": 1.0 + 0.02 * nrm(ks[5], (N_A_LAYERS, E_A), f32),
        "w_out_a": nrm(ks[6], (N_A_LAYERS, E_A, D_MODEL), f32) * (E_A ** -0.5 * BETA),
        "w_in_b": nrm(ks[7], (N_B_LAYERS, D_MODEL, 3 * E_B), f32) * D_MODEL ** -0.5,
        "lnv_g_b": 1.0 + 0.02 * nrm(ks[8], (N_B_LAYERS, E_B), f32),
        "lnv_b_b": 0.02 * nrm(ks[9], (N_B_LAYERS, E_B), f32),
        "w_s_b": nrm(ks[10], (N_B_LAYERS, N_GROUPS_B, CHUNK_B, CHUNK_B), f32) * CHUNK_B ** -0.5,
        "b_s_b": 1.0 + 0.02 * nrm(ks[11], (N_B_LAYERS, N_GROUPS_B, CHUNK_B), f32),
        "w_out_b": nrm(ks[12], (N_B_LAYERS, E_B, D_MODEL), f32) * (E_B ** -0.5 * BETA),
        "ln_g": 1.0 + 0.02 * nrm(ks[13], (DEPTH, D_MODEL), f32),
        "ln_b": 0.02 * nrm(ks[14], (DEPTH, D_MODEL), f32),
    }


def reference(x_prompt, x_sample, state_hgrn, w_in_a, lb_logits_a, gnorm_a, w_out_a, w_in_b, lnv_g_b,
              lnv_b_b, w_s_b, b_s_b, w_out_b, ln_g, ln_b):
    lb_all = jnp.cumsum(jax.nn.softmax(lb_logits_a.astype(jnp.float32), axis=0), axis=0)
    hp, hs = x_prompt, x_sample
    hgrn_prompt, hgrn_sample, chunk_v_sample = [], [], []
    for layer in range(DEPTH):
        j = layer // 2
        if layer % 2 == 0:
            s_zero = jnp.zeros((hp.shape[0], N_HEADS_A, HEAD_K, HEAD_V), state_hgrn.dtype)
            dp, sp = hgrn2_branch(hp, s_zero, w_in_a[j], lb_all[j], gnorm_a[j], w_out_a[j])
            ds, ss = hgrn2_branch(hs, state_hgrn[j], w_in_a[j], lb_all[j], gnorm_a[j], w_out_a[j])
            hgrn_prompt.append(sp)
            hgrn_sample.append(ss)
        else:
            dp, _ = chunk_gmlp_branch(hp, w_in_b[j], lnv_g_b[j], lnv_b_b[j], w_s_b[j], b_s_b[j], w_out_b[j])
            ds, vs = chunk_gmlp_branch(hs, w_in_b[j], lnv_g_b[j], lnv_b_b[j], w_s_b[j], b_s_b[j], w_out_b[j])
            chunk_v_sample.append(vs)
        hp = layer_norm(ALPHA * hp + dp, ln_g[layer], ln_b[layer])
        hs = layer_norm(ALPHA * hs + ds, ln_g[layer], ln_b[layer])
    return (hp, hs, jnp.stack(hgrn_prompt), jnp.stack(hgrn_sample), jnp.stack(chunk_v_sample))
```

```cpp
#include <hip/hip_runtime.h>
#include <hip/hip_cooperative_groups.h>
#include <cstdio>
#include <cstdint>
namespace cg = cooperative_groups;
#define MK_MULTI 0
namespace pg8 {
#define PG8_LAS __attribute__((address_space(3)))
typedef unsigned short bf16_t;
typedef short bf16x8 __attribute__((ext_vector_type(8)));
typedef float f32x4 __attribute__((ext_vector_type(4)));
typedef unsigned u32x4 __attribute__((ext_vector_type(4)));
constexpr int BM = 256, BK = 64, HALF = 128, HTB = HALF * BK * 2  , STAGE_BYTES = 8 * HTB, NXCD = 8, WGM = 8;

__host__ __device__ __forceinline__ int lds_byte(int r, int c) { const int st = (r >> 4) * 2 + (c >> 5), rr = r & 15, cc = c & 31, ob = rr * 64 + cc * 2; return st * 1024 + (ob ^ (((ob >> 9) & 1) << 5)); }
__host__ __device__ __forceinline__ void stage_rc(int b, int& R, int& C) { const int st = b / 1024, sb = b % 1024, swz = sb ^ (((sb >> 9) & 1) << 5); R = (st >> 1) * 16 + swz / 64; C = (st & 1) * 32 + (swz % 64) / 2; }
__host__ __device__ __forceinline__ int perm32(int rho) { const int n = rho >> 4, i = rho & 15; return 8 * (i >> 2) + 4 * n + (i & 3); }

struct Unit { int pm, pn; };
struct Gemm { const bf16_t* A; const bf16_t* Bt; int M, N, K; int nt = 0; };

struct StaticOrder {
    int nM, nN, nwg, G, c;
    __host__ __device__ void init(int M, int N, int G_, int c_) { nM = M / BM; nN = N / BM; nwg = nM * nN; G = G_; c = c_; }
    __host__ __device__ bool next(int i, Unit& u) const {
        const long L = (long)i * G + c; if (L >= nwg) return false;
        int wgid = (int)L; { const int q = nwg / NXCD, r = nwg % NXCD, xcd = wgid % NXCD, off = wgid / NXCD; wgid = (xcd < r ? xcd * (q + 1) : r * (q + 1) + (xcd - r) * q) + off; }
        const int nig = WGM * nN, gid = wgid / nig, fm = gid * WGM, gsz = (nM - fm) < WGM ? (nM - fm) : WGM;
        u.pm = fm + ((wgid % nig) % gsz); u.pn = (wgid % nig) / gsz; return true;
    }
    __device__ __forceinline__ void a_ready(const Unit&) const {}
    __device__ __forceinline__ void done(const Unit&) const {}
};

typedef float cvt_f32x2 __attribute__((ext_vector_type(2)));
typedef __bf16 cvt_bf16x2 __attribute__((ext_vector_type(2)));
__device__ __forceinline__ unsigned cvt_pk_bf16(float lo, float hi) { cvt_f32x2 v; v.x = lo; v.y = hi; const cvt_bf16x2 b = __builtin_convertvector(v, cvt_bf16x2); return __builtin_bit_cast(unsigned, b); }
typedef unsigned u32x2 __attribute__((ext_vector_type(2)));
constexpr size_t MROWS = 16896;
constexpr size_t SEC_STRIDE = (size_t)16896 * 2048;
typedef float f32x2 __attribute__((ext_vector_type(2)));
typedef _Float16 f16x2 __attribute__((ext_vector_type(2)));
__device__ __forceinline__ float silu_f(float x) { return x * __builtin_amdgcn_rcpf(1.0f + __expf(-x)); }
__device__ __forceinline__ float gelu_tanh_f(float x) { const float u = 1.5957691216057308f * (x + 0.044715f * x * x * x); return x * __builtin_amdgcn_rcpf(1.0f + __expf(-u)); }
__device__ __forceinline__ unsigned pk_f16(float lo, float hi) { f16x2 p; p.x = (_Float16)lo; p.y = (_Float16)hi; return __builtin_bit_cast(unsigned, p); }

struct EpiHgrnIn {
    static constexpr bool PERM = true, AFTER_DRAIN = false;
    bf16_t* B0; const float* lb;
    __device__ __forceinline__ void operator()(const f32x4 (&acc)[2][2][4][2], const Unit& u, int wr, int wc, int fr, int fq) const {
        const int sec = u.pn >> 3;
        const int row0 = u.pm * BM + wr * 64 + fr, col0 = (u.pn & 7) * BM + wc * 32 + 8 * fq;
        bf16_t* base = B0 + (size_t)sec * SEC_STRIDE;
        f32x4 l0[2], l1[2];
#pragma unroll
        for (int bj = 0; bj < 2; ++bj) { l0[bj] = (f32x4){0.f, 0.f, 0.f, 0.f}; l1[bj] = l0[bj]; }
        if (sec == 1) {
#pragma unroll
            for (int bj = 0; bj < 2; ++bj) { l0[bj] = *(const f32x4*)(lb + col0 + bj * HALF); l1[bj] = *(const f32x4*)(lb + col0 + bj * HALF + 4); }
        }
#pragma unroll
        for (int ai = 0; ai < 2; ++ai)
#pragma unroll
            for (int m = 0; m < 4; ++m) { bf16_t* rowp = base + ((size_t)((u.pn & 7) * 2) * MROWS + (size_t)(row0 + ai * HALF + m * 16)) * 128 + wc * 32 + 8 * fq;
#pragma unroll
                for (int bj = 0; bj < 2; ++bj) { f32x4 v0 = acc[ai][bj][m][0], v1 = acc[ai][bj][m][1]; u32x4 w;
                    if (sec == 1) {
#pragma unroll
                        for (int j = 0; j < 4; ++j) { const float s0 = __builtin_amdgcn_rcpf(1.0f + __expf(-v0[j])), s1 = __builtin_amdgcn_rcpf(1.0f + __expf(-v1[j]));
                            v0[j] = __logf(l0[bj][j] + (1.0f - l0[bj][j]) * s0); v1[j] = __logf(l1[bj][j] + (1.0f - l1[bj][j]) * s1); }
                        w.x = pk_f16(v0[0], v0[1]); w.y = pk_f16(v0[2], v0[3]); w.z = pk_f16(v1[0], v1[1]); w.w = pk_f16(v1[2], v1[3]);
                    } else {
                        if (sec != 2) {
#pragma unroll
                            for (int j = 0; j < 4; ++j) { v0[j] = silu_f(v0[j]); v1[j] = silu_f(v1[j]); } }
                        w.x = cvt_pk_bf16(v0[0], v0[1]); w.y = cvt_pk_bf16(v0[2], v0[3]); w.z = cvt_pk_bf16(v1[0], v1[1]); w.w = cvt_pk_bf16(v1[2], v1[3]);
                    }
                    *(u32x4*)(rowp + (size_t)bj * MROWS * 128) = w; } }
    }
};
struct EpiGmlpIn {
    static constexpr bool PERM = true, AFTER_DRAIN = false;
    bf16_t* B0; float* part;
    __device__ __forceinline__ void operator()(const f32x4 (&acc)[2][2][4][2], const Unit& u, int wr, int wc, int fr, int fq) const {
        const int row0 = u.pm * BM + wr * 64 + fr;
        if (u.pn < 16) {
#pragma unroll
            for (int ai = 0; ai < 2; ++ai)
#pragma unroll
                for (int m = 0; m < 4; ++m) { const int row = row0 + ai * HALF + m * 16; bf16_t* rowp = B0 + ((size_t)u.pn * MROWS + (size_t)row) * 128 + wc * 32 + 8 * fq;
                    f32x4 v0 = acc[ai][0][m][0], v1 = acc[ai][0][m][1]; const f32x4 z0 = acc[ai][1][m][0], z1 = acc[ai][1][m][1]; u32x4 w;
#pragma unroll
                    for (int j = 0; j < 4; ++j) { v0[j] = gelu_tanh_f(v0[j]) * silu_f(z0[j]); v1[j] = gelu_tanh_f(v1[j]) * silu_f(z1[j]); }
                    w.x = cvt_pk_bf16(v0[0], v0[1]); w.y = cvt_pk_bf16(v0[2], v0[3]); w.z = cvt_pk_bf16(v1[0], v1[1]); w.w = cvt_pk_bf16(v1[2], v1[3]);
                    *(u32x4*)rowp = w; }
        } else {
            const int g0 = (u.pn - 16) * 2;
#pragma unroll
            for (int ai = 0; ai < 2; ++ai)
#pragma unroll
                for (int m = 0; m < 4; ++m) { const int row = row0 + ai * HALF + m * 16; bf16_t* rowp = B0 + SEC_STRIDE + ((size_t)g0 * MROWS + (size_t)row) * 128 + wc * 32 + 8 * fq; float s = 0.f, ss = 0.f;
#pragma unroll
                    for (int bj = 0; bj < 2; ++bj) { f32x4 v0 = acc[ai][bj][m][0], v1 = acc[ai][bj][m][1]; u32x4 w;
#pragma unroll
                        for (int j = 0; j < 4; ++j) { v0[j] = gelu_tanh_f(v0[j]); v1[j] = gelu_tanh_f(v1[j]); s += v0[j] + v1[j]; ss += v0[j] * v0[j] + v1[j] * v1[j]; }
                        w.x = cvt_pk_bf16(v0[0], v0[1]); w.y = cvt_pk_bf16(v0[2], v0[3]); w.z = cvt_pk_bf16(v1[0], v1[1]); w.w = cvt_pk_bf16(v1[2], v1[3]);
                        *(u32x4*)(rowp + (size_t)bj * MROWS * 128) = w; }
                    s += __shfl_xor(s, 16); s += __shfl_xor(s, 32); ss += __shfl_xor(ss, 16); ss += __shfl_xor(ss, 32);
                    if (fq == 0) { f32x2 o; o.x = s; o.y = ss; *(f32x2*)(part + (size_t)row * 64 + ((u.pn - 16) * 4 + wc) * 2) = o; } }
        }
    }
};
struct EpiF32 {
    static constexpr bool PERM = false, AFTER_DRAIN = false;
    float* C; int ldc;
    __device__ __forceinline__ void operator()(const f32x4 (&acc)[2][2][4][2], const Unit& u, int wr, int wc, int fr, int fq) const {
        const int row0 = u.pm * BM + wr * 64 + fr, col0 = u.pn * BM + wc * 32 + 4 * fq;
#pragma unroll
        for (int ai = 0; ai < 2; ++ai)
#pragma unroll
            for (int m = 0; m < 4; ++m) { float* rowp = C + (size_t)(row0 + ai * HALF + m * 16) * ldc + col0;
#pragma unroll
                for (int bj = 0; bj < 2; ++bj)
#pragma unroll
                    for (int n = 0; n < 2; ++n) *(f32x4*)(rowp + bj * HALF + n * 16) = acc[ai][bj][m][n]; }
    }
};
struct EpiBf16Plain {
    static constexpr bool PERM = true, AFTER_DRAIN = false;
    bf16_t* C; int ldc;
    __device__ __forceinline__ void operator()(const f32x4 (&acc)[2][2][4][2], const Unit& u, int wr, int wc, int fr, int fq) const {
        const int row0 = u.pm * BM + wr * 64 + fr, col0 = u.pn * BM + wc * 32 + 8 * fq;
#pragma unroll
        for (int ai = 0; ai < 2; ++ai)
#pragma unroll
            for (int m = 0; m < 4; ++m) { bf16_t* rowp = C + (size_t)(row0 + ai * HALF + m * 16) * ldc + col0;
#pragma unroll
                for (int bj = 0; bj < 2; ++bj) { const f32x4 v0 = acc[ai][bj][m][0], v1 = acc[ai][bj][m][1]; u32x4 w;
                    w.x = cvt_pk_bf16(v0[0], v0[1]); w.y = cvt_pk_bf16(v0[2], v0[3]); w.z = cvt_pk_bf16(v1[0], v1[1]); w.w = cvt_pk_bf16(v1[2], v1[3]);
                    *(u32x4*)(rowp + bj * HALF) = w; } }
    }
};
template <class Epi, class Sched, bool ALIGN_EPI = false, bool SP2 = false>
__device__ __forceinline__ void gemm_phase(PG8_LAS unsigned char* lds, const Gemm g, const Sched& S, const Epi& E) {
    const int tid = threadIdx.x, wid = __builtin_amdgcn_readfirstlane(tid >> 6), lane = tid & 63, wr = wid >> 2, wc = wid & 3, fr = lane & 15, fq = lane >> 4;
    const int K = g.K, nt = g.nt ? g.nt : K / BK;
    unsigned voffA[2], voffB[2];
#pragma unroll
    for (int i = 0; i < 2; ++i) { int R, C; stage_rc(tid * 16 + i * 8192, R, C); const int Rb = Epi::PERM ? ((R & ~31) + perm32(R & 31)) : R;
        voffA[i] = (unsigned)(R * K + C) * 2u; voffB[i] = (unsigned)(Rb * K + C) * 2u; }
    const size_t kstep = (size_t)(BK * 2);
    const size_t hstep = (size_t)HALF * K * 2;
    const size_t tstep = 2 * hstep;
    const unsigned ldsw = (unsigned)wid * 1024u;
    const int aoff = lds_byte(wr * 64 + fr, fq * 8), boff = lds_byte(wc * 32 + fr, fq * 8);
#define PG8_SA(b, h) (((b) * 2 + (h)) * HTB)
#define PG8_SB(b, h) ((4 + (b) * 2 + (h)) * HTB)
#define PG8_STAGE(bufoff, gbase, voff) do { _Pragma("unroll") for (int _i = 0; _i < 2; ++_i) \
        __builtin_amdgcn_global_load_lds((const unsigned*)((const char*)(gbase) + (voff)[_i]), (PG8_LAS unsigned*)(lds + (bufoff) + ldsw + _i * 8192), 16, 0, 0); } while (0)
#define PG8_LDA(dst, b, h) do { _Pragma("unroll") for (int m = 0; m < 4; ++m) _Pragma("unroll") for (int k = 0; k < 2; ++k) dst[m][k] = *(const PG8_LAS bf16x8*)(lds + PG8_SA(b, h) + aoff + m * 2048 + k * 1024); } while (0)
#define PG8_LDB(dst, b, h) do { _Pragma("unroll") for (int n = 0; n < 2; ++n) _Pragma("unroll") for (int k = 0; k < 2; ++k) dst[n][k] = *(const PG8_LAS bf16x8*)(lds + PG8_SB(b, h) + boff + n * 2048 + k * 1024); } while (0)
#define PG8_MMA(ai, bj, At, Bt) do { __builtin_amdgcn_s_setprio(1); _Pragma("unroll") for (int m = 0; m < 4; ++m) _Pragma("unroll") for (int n = 0; n < 2; ++n) _Pragma("unroll") for (int k = 0; k < 2; ++k) \
        acc[ai][bj][m][n] = __builtin_amdgcn_mfma_f32_16x16x32_bf16(Bt[n][k], At[m][k], acc[ai][bj][m][n], 0, 0, 0); __builtin_amdgcn_s_setprio(0); } while (0)
#define PG8_WAIT_V(n) asm volatile("s_waitcnt vmcnt(" #n ")" ::: "memory")
#define PG8_WAIT_L(n) asm volatile("s_waitcnt lgkmcnt(" #n ")" ::: "memory")
#define PG8_BAR __builtin_amdgcn_s_barrier()
#define PG8_SCHED __builtin_amdgcn_sched_barrier(0)
    Unit cur, nxt; int ui = 0;
    if (!S.next(0, cur)) return;
    f32x4 acc[2][2][4][2];
#pragma unroll
    for (int a = 0; a < 2; ++a)
#pragma unroll
        for (int b = 0; b < 2; ++b)
#pragma unroll
            for (int m = 0; m < 4; ++m)
#pragma unroll
                for (int n = 0; n < 2; ++n) acc[a][b][m][n] = (f32x4){0.f, 0.f, 0.f, 0.f};
    bf16x8 At[4][2], B0[2][2], B1[2][2];
    const char* cA = (const char*)g.A + (size_t)cur.pm * tstep; const char* cB = (const char*)g.Bt + (size_t)cur.pn * tstep;
    S.a_ready(cur);
    if constexpr (SP2) {
        PG8_STAGE(PG8_SB(0, 0), cB, voffB); PG8_STAGE(PG8_SB(0, 1), cB + hstep, voffB); PG8_STAGE(PG8_SA(0, 0), cA, voffA); PG8_STAGE(PG8_SA(0, 1), cA + hstep, voffA);
        if (wr == 1) PG8_BAR;
        PG8_WAIT_V(2); PG8_BAR;
        PG8_STAGE(PG8_SB(1, 0), cB + kstep, voffB); PG8_STAGE(PG8_SA(1, 0), cA + kstep, voffA); PG8_STAGE(PG8_SB(1, 1), cB + hstep + kstep, voffB);
        PG8_WAIT_V(6); PG8_BAR;
    } else {
        PG8_STAGE(PG8_SB(0, 0), cB, voffB); PG8_STAGE(PG8_SA(0, 0), cA, voffA); PG8_STAGE(PG8_SB(0, 1), cB + hstep, voffB); PG8_STAGE(PG8_SA(0, 1), cA + hstep, voffA);
        if (wr == 1) PG8_BAR;
        PG8_WAIT_V(4); PG8_BAR;
        PG8_STAGE(PG8_SB(1, 0), cB + kstep, voffB); PG8_STAGE(PG8_SA(1, 0), cA + kstep, voffA); PG8_STAGE(PG8_SB(1, 1), cB + hstep + kstep, voffB);
        PG8_WAIT_V(6); PG8_BAR;
    }
    for (;;) {
        const bool has_next = S.next(ui + 1, nxt);
        const char* nA = has_next ? (const char*)g.A + (size_t)nxt.pm * tstep : cA; const char* nB = has_next ? (const char*)g.Bt + (size_t)nxt.pn * tstep : cB;
        for (int t = 0; t < nt; t += 2) {
            const bool last = (t == nt - 2);
            const char* a1 = cA + (size_t)(t + 1) * kstep;
            const char* a2 = last ? nA : cA + (size_t)(t + 2) * kstep; const char* b2 = last ? nB : cB + (size_t)(t + 2) * kstep;
            const char* a3 = a2 + kstep; const char* b3 = b2 + kstep;
            if (last && has_next) S.a_ready(nxt);
            if constexpr (SP2) {
            PG8_LDB(B0, 0, 0); PG8_LDB(B1, 0, 1); PG8_SCHED; PG8_LDA(At, 0, 0); PG8_STAGE(PG8_SA(1, 1), a1 + hstep, voffA);
            PG8_WAIT_V(8); PG8_WAIT_L(0); PG8_BAR; PG8_MMA(0, 0, At, B0); PG8_MMA(0, 1, At, B1); PG8_BAR; PG8_SCHED;
            PG8_LDA(At, 0, 1); PG8_STAGE(PG8_SB(0, 0), b2, voffB); PG8_STAGE(PG8_SB(0, 1), b2 + hstep, voffB); PG8_STAGE(PG8_SA(0, 0), a2, voffA);
            PG8_WAIT_V(8); PG8_WAIT_L(0); PG8_BAR; PG8_MMA(1, 0, At, B0); PG8_MMA(1, 1, At, B1); PG8_BAR; PG8_SCHED;
            PG8_LDB(B0, 1, 0); PG8_LDB(B1, 1, 1); PG8_SCHED; PG8_LDA(At, 1, 0); PG8_STAGE(PG8_SA(0, 1), a2 + hstep, voffA);
            PG8_WAIT_V(8); PG8_WAIT_L(0); PG8_BAR; PG8_MMA(0, 0, At, B0); PG8_MMA(0, 1, At, B1); PG8_BAR; PG8_SCHED;
            PG8_LDA(At, 1, 1); PG8_STAGE(PG8_SB(1, 0), b3, voffB); PG8_STAGE(PG8_SB(1, 1), b3 + hstep, voffB); PG8_STAGE(PG8_SA(1, 0), a3, voffA);
            PG8_WAIT_V(8); PG8_WAIT_L(0); PG8_BAR; PG8_MMA(1, 0, At, B0); PG8_MMA(1, 1, At, B1); PG8_BAR; PG8_SCHED;
            } else {
            PG8_LDB(B0, 0, 0); PG8_SCHED; PG8_LDA(At, 0, 0); PG8_STAGE(PG8_SA(1, 1), a1 + hstep, voffA);
            PG8_WAIT_L(8); PG8_BAR; PG8_WAIT_L(0); PG8_MMA(0, 0, At, B0); PG8_BAR; PG8_SCHED;
            PG8_LDB(B1, 0, 1); PG8_STAGE(PG8_SB(0, 0), b2, voffB);
            PG8_BAR; PG8_WAIT_L(0); PG8_MMA(0, 1, At, B1); PG8_BAR;
            PG8_LDA(At, 0, 1); PG8_STAGE(PG8_SA(0, 0), a2, voffA);
            PG8_BAR; PG8_WAIT_L(0); PG8_MMA(1, 0, At, B0); PG8_BAR; PG8_SCHED;
            PG8_STAGE(PG8_SB(0, 1), b2 + hstep, voffB);
            PG8_WAIT_V(6); PG8_BAR; PG8_MMA(1, 1, At, B1); PG8_BAR;
            PG8_LDB(B0, 1, 0); PG8_SCHED; PG8_LDA(At, 1, 0); PG8_STAGE(PG8_SA(0, 1), a2 + hstep, voffA);
            PG8_WAIT_L(8); PG8_BAR; PG8_WAIT_L(0); PG8_MMA(0, 0, At, B0); PG8_BAR; PG8_SCHED;
            PG8_LDB(B1, 1, 1); PG8_STAGE(PG8_SB(1, 0), b3, voffB);
            PG8_BAR; PG8_WAIT_L(0); PG8_MMA(0, 1, At, B1); PG8_BAR;
            PG8_LDA(At, 1, 1); PG8_STAGE(PG8_SA(1, 0), a3, voffA);
            PG8_BAR; PG8_WAIT_L(0); PG8_MMA(1, 0, At, B0); PG8_BAR; PG8_SCHED;
            PG8_STAGE(PG8_SB(1, 1), b3 + hstep, voffB);
            PG8_WAIT_V(6); PG8_BAR; PG8_MMA(1, 1, At, B1); PG8_BAR;
            }
        }
        if constexpr (ALIGN_EPI) { if (wr == 0) PG8_BAR; }
        if constexpr (!Epi::AFTER_DRAIN) { E(acc, cur, wr, wc, fr, fq); S.done(cur); }
        if (!has_next) break;
#pragma unroll
        for (int a = 0; a < 2; ++a)
#pragma unroll
            for (int b = 0; b < 2; ++b)
#pragma unroll
                for (int m = 0; m < 4; ++m)
#pragma unroll
                    for (int n = 0; n < 2; ++n) acc[a][b][m][n] = (f32x4){0.f, 0.f, 0.f, 0.f};
        cur = nxt; cA = nA; cB = nB; ++ui;
        if constexpr (ALIGN_EPI) { if (wr == 1) PG8_BAR; }
    }
    PG8_WAIT_V(0);
    if constexpr (!ALIGN_EPI) { if (wr == 0) PG8_BAR; }
    PG8_BAR;
    if constexpr (Epi::AFTER_DRAIN) { E.fused(acc, cur, wr, wc, fr, fq, lds, wid, lane); S.done(cur); }
#undef PG8_SA
#undef PG8_SB
#undef PG8_STAGE
#undef PG8_LDA
#undef PG8_LDB
#undef PG8_MMA
#undef PG8_WAIT_V
#undef PG8_WAIT_L
#undef PG8_BAR
#undef PG8_SCHED
}
}

#define GAS __attribute__((address_space(1)))
#define LAS __attribute__((address_space(3)))
typedef unsigned short bf16;
typedef unsigned v4u __attribute__((ext_vector_type(4)));
typedef unsigned v2u __attribute__((ext_vector_type(2)));
typedef float f32x4 __attribute__((ext_vector_type(4)));
typedef float f32x2 __attribute__((ext_vector_type(2)));
typedef short bf16x8 __attribute__((ext_vector_type(8)));
typedef _Float16 f16x2 __attribute__((ext_vector_type(2)));

#ifndef MK_MULTI
#define MK_MULTI 0
#endif
constexpr int NPHASE = 9;
constexpr int MP = 16384, MS = 512, MT = MP + MS, DM = 1024, EA = 2048;
constexpr float LN_EPS = 1e-5f, ALPHA = 1.4142135623730951f;
constexpr size_t MiB = 1u << 20;
constexpr size_t WS_CTL = 0, WS_LB = 64 * 1024, WS_WSB = 1 * MiB, WS_WINA = 2 * MiB, WS_WOUTA = 18 * MiB, WS_WINB = 22 * MiB, WS_WOUTB = 34 * MiB, WS_PART = 38 * MiB;
constexpr size_t WS_XB = 44 * MiB;
constexpr size_t WS_Q = 78 * MiB, WS_LF = 144 * MiB, WS_V = 210 * MiB, WS_G = 276 * MiB, WS_O = 342 * MiB, WS_D = 408 * MiB, WS_DP = 474 * MiB, WS_END = 482 * MiB;
constexpr size_t WS_U = WS_Q, WS_VB = WS_LF, WS_Z = WS_V, WS_H1F = WS_G;
static_assert(WS_LF - WS_Q == pg8::SEC_STRIDE * 2 && WS_V - WS_LF == pg8::SEC_STRIDE * 2 && WS_G - WS_V == pg8::SEC_STRIDE * 2 && WS_O - WS_G == pg8::SEC_STRIDE * 2, "section stride");
constexpr size_t OUT_Y = 0, OUT_HP = 17301504, OUT_HS = 19398656, OUT_CV = 52953088;
constexpr int LDS_BYTES = 131072 + 1024;
constexpr size_t WS_BAR = 32 * 1024;

__device__ __forceinline__ unsigned pkbf(float lo, float hi) { return pg8::cvt_pk_bf16(lo, hi); }
__device__ __forceinline__ float bf_lo(unsigned w) { return __builtin_bit_cast(float, w << 16); }
__device__ __forceinline__ float bf_hi(unsigned w) { return __builtin_bit_cast(float, w & 0xffff0000u); }
__device__ __forceinline__ float wave_sum(float v) {
#pragma unroll
    for (int o = 1; o < 64; o <<= 1) v += __shfl_xor(v, o);
    return v;
}
#define LDS_WAIT() asm volatile("s_waitcnt lgkmcnt(0)" ::: "memory")

__device__ __forceinline__ void p0_transpose_item(const float* W, int K, int N, bf16* WT, LAS float* scr, int item, int lane, bool gmlp = false) {
    const int nblk = N / 32, kb = item / nblk, nb = item % nblk, k0 = 64 * kb, nd = 32 * nb;
    int n0 = nd;
    if (gmlp) { if (nd < 4096) { const int tile = nd >> 8, half = (nd >> 7) & 1, cc = nd & 127; n0 = (half ? 4096 : 0) + tile * 128 + cc; } else n0 = 2048 + (nd - 4096); }
    float wv[32];
#pragma unroll
    for (int i = 0; i < 32; ++i) { const int kk = 2 * i + (lane >> 5); wv[i] = __builtin_nontemporal_load(W + (size_t)(k0 + kk) * N + n0 + (lane & 31)); }
#pragma unroll
    for (int i = 0; i < 32; ++i) { const int kk = 2 * i + (lane >> 5); scr[kk * 33 + (lane & 31)] = wv[i]; }
    LDS_WAIT(); asm volatile("" ::: "memory");
    const int c = lane & 7;
#pragma unroll
    for (int j = 0; j < 4; ++j) { const int n = (lane >> 3) + 8 * j; const LAS float* s = scr + (8 * c) * 33 + n;
        v4u o; o.x = pkbf(s[0 * 33], s[1 * 33]); o.y = pkbf(s[2 * 33], s[3 * 33]); o.z = pkbf(s[4 * 33], s[5 * 33]); o.w = pkbf(s[6 * 33], s[7 * 33]);
        *(v4u*)(WT + (size_t)(nd + n) * K + k0 + 8 * c) = o; }
    LDS_WAIT(); asm volatile("" ::: "memory");
}

typedef GAS unsigned gu32;
#define XB_TMO      128
#define XB_XCNT(j)  (256  + 64 * (j))
#define XB_XSUB(j)  (1280 + 64 * (j))
#define XB_XGEN(j)  (2304 + 64 * (j))
#define XB_TOP      3328
#define XB_TOPGEN   3392
#define XCD_BAR_WORDS 3456
#define XB_SPIN_CAP (1u << 18)

__device__ __forceinline__ unsigned xb_ld(unsigned* p)              { return __hip_atomic_load(p, __ATOMIC_RELAXED, __HIP_MEMORY_SCOPE_AGENT); }
__device__ __forceinline__ unsigned xb_add(unsigned* p, unsigned v) { return __hip_atomic_fetch_add(p, v, __ATOMIC_RELAXED, __HIP_MEMORY_SCOPE_AGENT); }
__device__ __forceinline__ unsigned xb_xcc_id() { return (unsigned)__builtin_amdgcn_s_getreg((3 << 11) | 20) & 0xFu; }
#define XB_SPIN(cond, bar) do { unsigned _sp = 0; while (cond) { __builtin_amdgcn_s_sleep(1); \
    if ((++_sp & 255u) == 0u) { if (xb_ld(&(bar)[XB_TMO])) break; if (_sp > XB_SPIN_CAP) { atomicAdd(&(bar)[XB_TMO], 1u); break; } } } } while (0)

struct XcdBarrier {
    unsigned* bar; unsigned x;
    volatile LAS unsigned* st;
};

__device__ __forceinline__ XcdBarrier xcd_barrier_post(unsigned* bar, volatile LAS unsigned* st) {
    XcdBarrier b; b.bar = bar; b.x = xb_xcc_id(); b.st = st;
    if (threadIdx.x == 0) (void)xb_add(&bar[XB_XCNT(b.x)], 1u);
    return b;
}
__device__ __forceinline__ void xcd_barrier_complete(unsigned* bar, unsigned x, unsigned& nloc, unsigned& nx) {
    const unsigned G = gridDim.x * gridDim.y * gridDim.z;
    unsigned sum, cnt, mine, sp = 0u;
    for (;;) {
        sum = 0u; cnt = 0u; mine = 0u;
#pragma unroll
        for (unsigned j = 0; j < 16; ++j) { const unsigned c = xb_ld(&bar[XB_XCNT(j)]); sum += c; cnt += (c > 0u) ? 1u : 0u; mine = (j == x) ? c : mine; }
        if (sum == G) break;
        __builtin_amdgcn_s_sleep(1);
        if ((++sp & 255u) == 0u) { if (xb_ld(&bar[XB_TMO])) break; if (sp > XB_SPIN_CAP) { atomicAdd(&bar[XB_TMO], 1u); break; } }
    }
    nloc = mine > 0u ? mine : 1u; nx = cnt > 0u ? cnt : 1u;
}

__device__ __forceinline__ void xcd_barrier(const XcdBarrier& b) {
    asm volatile("s_waitcnt vmcnt(0)" ::: "memory");
    __syncthreads();
    if (threadIdx.x == 0) {
        unsigned* bar = b.bar;
        __builtin_amdgcn_s_waitcnt(0);
        unsigned nloc = b.st[0], nx = b.st[1];
        if (nloc == 0u) { xcd_barrier_complete(bar, b.x, nloc, nx); b.st[0] = nloc; b.st[1] = nx; }
        const unsigned old = xb_add(&bar[XB_XSUB(b.x)], 1u);
        const unsigned gen = old / nloc;
        if (old + 1u == (gen + 1u) * nloc) {
            __builtin_amdgcn_fence(__ATOMIC_RELEASE, "agent");
            asm volatile("s_waitcnt vmcnt(0)" ::: "memory");
            const unsigned og = xb_add(&bar[XB_TOP], 1u);
            const unsigned tg = og / nx;
            if (og + 1u == (tg + 1u) * nx) xb_add(&bar[XB_TOPGEN], 1u);
            else XB_SPIN(xb_ld(&bar[XB_TOPGEN]) == tg, bar);
            __builtin_amdgcn_fence(__ATOMIC_ACQUIRE, "agent");
            xb_add(&bar[XB_XGEN(b.x)], 1u);
            asm volatile("s_waitcnt vmcnt(0)" ::: "memory");
        } else {
            XB_SPIN(xb_ld(&bar[XB_XGEN(b.x)]) == gen, bar);
            __builtin_amdgcn_fence(__ATOMIC_ACQUIRE, "agent");
            asm volatile("s_waitcnt vmcnt(0)" ::: "memory");
        }
    }
    __syncthreads();
}

struct Ptrs {
    const float *xp, *xs, *state, *w_in_a, *lb_logits, *gnorm, *w_out_a, *w_in_b, *lnv_g, *lnv_b, *w_s, *b_s, *w_out_b, *ln_g, *ln_b;
    float* out; unsigned char* ws;
};

__device__ __forceinline__ void p0_prologue(const Ptrs& P, LAS unsigned char* lds) {
    const int tid = threadIdx.x, lane = tid & 63, wave = __builtin_amdgcn_readfirstlane(tid >> 6);
    LAS float* scr = (LAS float*)(lds + wave * 16384);
    const int gw = blockIdx.x * 8 + wave, NGW = gridDim.x * 8;
    constexpr int I_A = (DM / 64) * (4 * EA / 32), I_OA = (EA / 64) * (DM / 32), I_B = (DM / 64) * (3 * EA / 32), I_OB = I_OA, NITEMS = I_A + I_OA + I_B + I_OB;
    for (int it = gw; it < NITEMS; it += NGW) {
        int r = it;
        if (r < I_A) { p0_transpose_item(P.w_in_a, DM, 4 * EA, (bf16*)(P.ws + WS_WINA), scr, r, lane); continue; } r -= I_A;
        if (r < I_OA) { p0_transpose_item(P.w_out_a, EA, DM, (bf16*)(P.ws + WS_WOUTA), scr, r, lane); continue; } r -= I_OA;
        if (r < I_B) { p0_transpose_item(P.w_in_b, DM, 3 * EA, (bf16*)(P.ws + WS_WINB), scr, r, lane, true); continue; } r -= I_B;
        p0_transpose_item(P.w_out_b, EA, DM, (bf16*)(P.ws + WS_WOUTB), scr, r, lane);
    }
    const size_t gtid = (size_t)blockIdx.x * 512 + tid, GT = (size_t)gridDim.x * 512;
    {
        const f32x4* xp4 = (const f32x4*)P.xp; const f32x4* xs4 = (const f32x4*)P.xs; v2u* xb = (v2u*)(P.ws + WS_XB);
        constexpr size_t NP4 = (size_t)MP * DM / 4, NT4 = (size_t)MT * DM / 4;
        for (size_t q = gtid; q < NT4; q += 4 * GT) { f32x4 v[4];
#pragma unroll
            for (int k = 0; k < 4; ++k) { size_t qq = q + k * GT; qq = qq < NT4 ? qq : NT4 - 1; v[k] = __builtin_nontemporal_load(qq < NP4 ? xp4 + qq : xs4 + (qq - NP4)); }
#pragma unroll
            for (int k = 0; k < 4; ++k) { const size_t qq = q + k * GT; if (qq < NT4) { v2u o; o.x = pkbf(v[k].x, v[k].y); o.y = pkbf(v[k].z, v[k].w); xb[qq] = o; } } }
    }
    {
        const f32x4* w4 = (const f32x4*)P.w_s; v2u* wb = (v2u*)(P.ws + WS_WSB);
        for (size_t q = gtid; q < (size_t)16 * 128 * 128 / 4; q += GT) { const int e = (int)(q * 4), s = e & 127, t = (e >> 7) & 127; const f32x4 v = w4[q];
            v2u o; o.x = pkbf(s <= t ? v.x : 0.f, s + 1 <= t ? v.y : 0.f); o.y = pkbf(s + 2 <= t ? v.z : 0.f, s + 3 <= t ? v.w : 0.f); wb[q] = o; }
    }
    if (gtid < 2048) { float* lb = (float*)(P.ws + WS_LB); lb[gtid] = 1.0f / (1.0f + expf(P.lb_logits[2048 + gtid] - P.lb_logits[gtid])); }
    if (gtid < 4) { ((unsigned*)(P.ws + WS_CTL))[64 * gtid] = 0u; }
}

struct OneUnit {
    pg8::Unit u0;
    __device__ __forceinline__ bool next(int i, pg8::Unit& u) const { if (i != 0) return false; u = u0; return true; }
    __device__ __forceinline__ void a_ready(const pg8::Unit&) const {}
    __device__ __forceinline__ void done(const pg8::Unit&) const {}
};
template <bool FINAL, int NR, bool PARTS = false>
__device__ __forceinline__ void ln_rows(const Ptrs& P, const f32x4* g4, const f32x4* b4, int mbase, int mstride, int mend, int lane) {
    const bf16* D = (const bf16*)(P.ws + WS_D); bf16* H1B = (bf16*)(P.ws + WS_XB);
    f32x4 v[NR][4]; float s[NR];
#pragma unroll
    for (int k = 0; k < NR; ++k) { int m = mbase + k * mstride; m = m < mend ? m : mend - 1;
        f32x4 x[4];
        if (FINAL) { const v2u* h4 = (const v2u*)(H1B + (size_t)m * DM);
#pragma unroll
            for (int j = 0; j < 4; ++j) { const v2u r = __builtin_nontemporal_load(h4 + 64 * j + lane); x[j].x = bf_lo(r.x); x[j].y = bf_hi(r.x); x[j].z = bf_lo(r.y); x[j].w = bf_hi(r.y); } }
        else { const f32x4* x4 = (const f32x4*)(m < MP ? P.xp + (size_t)m * DM : P.xs + (size_t)(m - MP) * DM);
#pragma unroll
            for (int j = 0; j < 4; ++j) x[j] = __builtin_nontemporal_load(x4 + 64 * j + lane); }
        if (PARTS) { const f32x4* d4 = (const f32x4*)(P.ws + WS_DP) + (size_t)(m - MP) * (DM / 4);
#pragma unroll
            for (int j = 0; j < 4; ++j) v[k][j] = x[j] * ALPHA + ((d4[64 * j + lane] + d4[64 * j + lane + 512 * DM / 4]) + (d4[64 * j + lane + 2 * 512 * DM / 4] + d4[64 * j + lane + 3 * 512 * DM / 4])); }
        else { const v2u* d4 = (const v2u*)(D + (size_t)m * DM);
#pragma unroll
            for (int j = 0; j < 4; ++j) { const v2u r = __builtin_nontemporal_load(d4 + 64 * j + lane); f32x4 d; d.x = bf_lo(r.x); d.y = bf_hi(r.x); d.z = bf_lo(r.y); d.w = bf_hi(r.y); v[k][j] = x[j] * ALPHA + d; } } }
#pragma unroll
    for (int k = 0; k < NR; ++k) { s[k] = 0.f;
#pragma unroll
        for (int j = 0; j < 4; ++j) s[k] += (v[k][j].x + v[k][j].y) + (v[k][j].z + v[k][j].w); }
#pragma unroll
    for (int o = 1; o < 64; o <<= 1) {
#pragma unroll
        for (int k = 0; k < NR; ++k) s[k] += __shfl_xor(s[k], o); }
#pragma unroll
    for (int k = 0; k < NR; ++k) { const float mean = s[k] * (1.0f / DM); s[k] = 0.f;
#pragma unroll
        for (int j = 0; j < 4; ++j) { v[k][j] = v[k][j] - mean; s[k] += (v[k][j].x * v[k][j].x + v[k][j].y * v[k][j].y) + (v[k][j].z * v[k][j].z + v[k][j].w * v[k][j].w); } }
#pragma unroll
    for (int o = 1; o < 64; o <<= 1) {
#pragma unroll
        for (int k = 0; k < NR; ++k) s[k] += __shfl_xor(s[k], o); }
#pragma unroll
    for (int j = 0; j < 4; ++j) { const f32x4 gg = g4[64 * j + lane], bb = b4[64 * j + lane];
#pragma unroll
        for (int k = 0; k < NR; ++k) { const int m = mbase + k * mstride; if (m < mend) { const float rstd = __builtin_amdgcn_rsqf(s[k] * (1.0f / DM) + LN_EPS); const f32x4 y = v[k][j] * rstd * gg + bb;
            if (FINAL) { __builtin_nontemporal_store(y, (f32x4*)(P.out + OUT_Y + (size_t)m * DM) + 64 * j + lane); }
            else { v2u o; o.x = pkbf(y.x, y.y); o.y = pkbf(y.z, y.w); ((v2u*)(H1B + (size_t)m * DM))[64 * j + lane] = o; } } } }
}
template <bool FINAL>
__device__ __forceinline__ void ln_phase(const Ptrs& P, LAS unsigned char* lds, int layer) {
    const int tid = threadIdx.x, lane = tid & 63, wave = tid >> 6;
    const int G = (int)gridDim.x, bx = (int)blockIdx.x;
    const f32x4* g4 = (const f32x4*)(P.ln_g + layer * DM); const f32x4* b4 = (const f32x4*)(P.ln_b + layer * DM);
    if (G <= 32) {
        for (int m = bx * 8 + wave; m < MT; m += G * 8) ln_rows<FINAL, 1>(P, g4, b4, m, 0, MT, lane);
        return;
    }
    if (bx < 32) {
        unsigned* cnt = (unsigned*)(P.ws + WS_CTL) + 64 * (2 + layer);
        const int unit = bx >> 2, ks = bx & 3;
        pg8::Gemm g{(const bf16*)(P.ws + WS_O) + ks * 512, (const bf16*)(P.ws + (FINAL ? WS_WOUTB : WS_WOUTA)) + ks * 512, MT, DM, EA, 8};
        OneUnit S; S.u0.pm = MP / 256 + (unit >> 2); S.u0.pn = unit & 3;
        pg8::EpiF32 E{(float*)(P.ws + WS_DP) + (size_t)ks * 512 * DM - (size_t)MP * DM, DM};
        pg8::gemm_phase<pg8::EpiF32, OneUnit, true, true>(lds, g, S, E);
        asm volatile("s_waitcnt vmcnt(0)" ::: "memory");
        __syncthreads();
        if (tid == 0) {
            __builtin_amdgcn_fence(__ATOMIC_RELEASE, "agent"); asm volatile("s_waitcnt vmcnt(0)" ::: "memory");
            __hip_atomic_fetch_add(cnt, 1u, __ATOMIC_RELAXED, __HIP_MEMORY_SCOPE_AGENT);
            while (__hip_atomic_load(cnt, __ATOMIC_RELAXED, __HIP_MEMORY_SCOPE_AGENT) < 32u) __builtin_amdgcn_s_sleep(4);
            __builtin_amdgcn_fence(__ATOMIC_ACQUIRE, "agent"); asm volatile("s_waitcnt vmcnt(0)" ::: "memory");
        }
        __syncthreads();
        __builtin_amdgcn_fence(__ATOMIC_ACQUIRE, "agent");
        ln_rows<FINAL, 2, true>(P, g4, b4, MP + bx * 16 + wave * 2, 1, MT, lane);
    } else {
        const int nw = (G - 32) * 8;
        for (int m = (bx - 32) * 8 + wave; m < MP; m += 3 * nw) ln_rows<FINAL, 3>(P, g4, b4, m, nw, MP, lane);
    }
}

#define MFMA16(a, b, c) __builtin_amdgcn_mfma_f32_16x16x32_bf16((a), (b), (c), 0, 0, 0)
__device__ __forceinline__ void hgrn_unit(LAS unsigned char* lds, const bf16* Q, const bf16* LF, const bf16* V, const bf16* G, bf16* O, const float* gnorm,
                                          int m0, int h, float* s_out) {
    const int tid = threadIdx.x, lane = tid & 63, wid = __builtin_amdgcn_readfirstlane(tid >> 6);
    const int i = lane & 15, g = lane >> 4, wq = wid & 3, hc = h * 128;
    constexpr int SQ = 136, SK = 72, nch = 32;
    LAS unsigned char* QD = lds; LAS unsigned char* KI = lds + 17408; LAS unsigned char* KET = lds + 34816; LAS unsigned char* VT = lds + 53248; LAS unsigned char* ST = lds + 71680;
    LAS float* DEC = (LAS float*)(lds + 106496); LAS float* GN = (LAS float*)(lds + 111104);
    if (tid < 128) GN[tid] = gnorm[hc + tid];
    if (wid < 4) {
        const int t0 = 16 * wid;
        v2u gq_n[8], gq_c[8], po[8];
        const bf16* gp = G + ((size_t)h * MT + (size_t)(m0 + t0 + i)) * 128 + 4 * g;
        bf16* orow = O + (size_t)(m0 + t0 + i) * 2048 + hc + 4 * g;
        bf16* prow = orow;
#define LOAD_GATE(nn) do { const int nc_ = (nn) < nch ? (nn) : nch - 1; const bf16* gb_ = gp + (size_t)nc_ * 8192; \
        _Pragma("unroll") for (int vt = 0; vt < 8; ++vt) gq_n[vt] = __builtin_nontemporal_load((const v2u*)(gb_ + 16 * vt)); } while (0)
#define STORE_PREV() do { _Pragma("unroll") for (int vt = 0; vt < 8; ++vt) *(v2u*)(prow + 16 * vt) = po[vt]; } while (0)
        LOAD_GATE(0);
        const size_t pfo = ((size_t)h * MT + (size_t)(m0 + t0 + (lane >> 4))) * 128 + 8 * (lane & 15);
        const bf16* pfq = Q + pfo; const bf16* pfl = LF + pfo; const bf16* pfv = V + pfo;
        v4u pf[12]; unsigned pfx = 0u;
#pragma unroll
        for (int j = 0; j < 12; ++j) pf[j] = (v4u){0u, 0u, 0u, 0u};
        for (int n = 0; n < nch; ++n) {
            int i_ = i, g_ = g; asm volatile("" : "+v"(i_), "+v"(g_));
#pragma unroll
            for (int vt = 0; vt < 8; ++vt) gq_c[vt] = gq_n[vt];
#pragma unroll
            for (int j = 0; j < 12; ++j) pfx ^= (pf[j].x ^ pf[j].y) ^ (pf[j].z ^ pf[j].w);
            { const int nc_ = (n + 2) < nch ? (n + 2) : nch - 1; const size_t co_ = (size_t)nc_ * 8192;
#pragma unroll
              for (int j = 0; j < 4; ++j) { pf[j] = *(const v4u*)(pfq + co_ + (size_t)j * 4 * 128); pf[4 + j] = *(const v4u*)(pfl + co_ + (size_t)j * 4 * 128); pf[8 + j] = *(const v4u*)(pfv + co_ + (size_t)j * 4 * 128); } }
            if (n > 0) STORE_PREV();
            LOAD_GATE(n + 1);
            __syncthreads();
            {
                bf16x8 bq[4];
#pragma unroll
                for (int kk = 0; kk < 4; ++kk) bq[kk] = *(const LAS bf16x8*)(QD + ((t0 + i_) * SQ + 32 * kk + 8 * g_) * 2);
                bf16x8 pc[2];
                {
                    f32x4 sT[4];
#pragma unroll
                    for (int st = 0; st < 4; ++st) {
                        f32x4 a4 = (f32x4){0.f, 0.f, 0.f, 0.f};
#pragma unroll
                        for (int kk = 0; kk < 4; ++kk) { const bf16x8 a = *(const LAS bf16x8*)(KI + ((16 * st + i_) * SQ + 32 * kk + 8 * g_) * 2); a4 = MFMA16(a, bq[kk], a4); }
#pragma unroll
                        for (int r = 0; r < 4; ++r) if (16 * st + 4 * g_ + r > t0 + i_) a4[r] = 0.f;
                        sT[st] = a4;
                    }
#pragma unroll
                    for (int c = 0; c < 2; ++c) { v4u w; w.x = pkbf(sT[2 * c][0], sT[2 * c][1]); w.y = pkbf(sT[2 * c][2], sT[2 * c][3]); w.z = pkbf(sT[2 * c + 1][0], sT[2 * c + 1][1]); w.w = pkbf(sT[2 * c + 1][2], sT[2 * c + 1][3]);
                        pc[c] = __builtin_bit_cast(bf16x8, w); }
                }
                f32x4 oa[8]; float ss = 0.f;
#pragma unroll
                for (int vt = 0; vt < 8; ++vt) {
                    f32x4 acc = (f32x4){0.f, 0.f, 0.f, 0.f};
#pragma unroll
                    for (int c = 0; c < 2; ++c) {
                        const v2u lo = *(const LAS v2u*)(VT + ((16 * vt + i_) * SK + 32 * c + 4 * g_) * 2), hi = *(const LAS v2u*)(VT + ((16 * vt + i_) * SK + 32 * c + 16 + 4 * g_) * 2);
                        v4u w; w.x = lo.x; w.y = lo.y; w.z = hi.x; w.w = hi.y; acc = MFMA16(__builtin_bit_cast(bf16x8, w), pc[c], acc); }
#pragma unroll
                    for (int kk = 0; kk < 4; ++kk) { const bf16x8 a = *(const LAS bf16x8*)(ST + ((16 * vt + i_) * SQ + 32 * kk + 8 * g_) * 2); acc = MFMA16(a, bq[kk], acc); }
                    oa[vt] = acc; ss += (acc[0] * acc[0] + acc[1] * acc[1]) + (acc[2] * acc[2] + acc[3] * acc[3]);
                }
                ss += __shfl_xor(ss, 16); ss += __shfl_xor(ss, 32);
                const float sc = __builtin_amdgcn_rsqf(ss * (1.0f / 128.0f) + LN_EPS);
#pragma unroll
                for (int vt = 0; vt < 8; ++vt) { const v2u gg = gq_c[vt]; const f32x4 gn = *(const LAS f32x4*)(GN + 16 * vt + 4 * g_) * sc;
                    po[vt].x = pkbf(oa[vt][0] * gn[0] * bf_lo(gg.x), oa[vt][1] * gn[1] * bf_hi(gg.x)); po[vt].y = pkbf(oa[vt][2] * gn[2] * bf_lo(gg.y), oa[vt][3] * gn[3] * bf_hi(gg.y)); }
                prow = orow + (size_t)n * (64 * 2048);
            }
            __syncthreads();
        }
        STORE_PREV();
        if (pfx == 0x9e3779b9u && lane == 77) *(unsigned*)(O) = pfx;
#undef STORE_PREV
#undef LOAD_GATE
    } else {
        const int cp = i, rg = g, c0 = 32 * wq + 2 * cp;
        const size_t pofs = ((size_t)h * MT + (size_t)(m0 + 16 * rg)) * 128 + c0;
        const bf16* qp = Q + pofs; const bf16* lp = LF + pofs; const bf16* vp = V + pofs;
        unsigned rq[16], rl[16], rv[16];
        unsigned sq[16], sk[16], ske0[8], ske1[8]; float det0, det1;
#define LOAD_RAW(nn) do { const int nc_ = (nn) < nch ? (nn) : nch - 1; const bf16* qb_ = qp + (size_t)nc_ * 8192; const bf16* lb_ = lp + (size_t)nc_ * 8192; const bf16* vb_ = vp + (size_t)nc_ * 8192; \
        _Pragma("unroll") for (int r = 0; r < 16; ++r) { rl[r] = *(const unsigned*)(lb_ + r * 128); rq[r] = *(const unsigned*)(qb_ + r * 128); } (void)vb_; } while (0)
#define LOAD_V(nn) do { const int nc_ = (nn) < nch ? (nn) : nch - 1; const bf16* vb_ = vp + (size_t)nc_ * 8192; _Pragma("unroll") for (int r = 0; r < 16; ++r) rv[r] = *(const unsigned*)(vb_ + r * 128); } while (0)
#define PREP_REGS() do { \
        float su0 = 0.f, su1 = 0.f; \
        _Pragma("unroll") for (int r = 0; r < 16; ++r) { const f16x2 hh = __builtin_bit_cast(f16x2, rl[r]); su0 += (float)hh.x; su1 += (float)hh.y; } \
        float off0 = 0.f, off1 = 0.f, tot0 = 0.f, tot1 = 0.f; \
        _Pragma("unroll") for (int j = 0; j < 4; ++j) { const float a_ = __shfl(su0, cpx + 16 * j), b_ = __shfl(su1, cpx + 16 * j); if (j < rgx) { off0 += a_; off1 += b_; } tot0 += a_; tot1 += b_; } \
        const float et0 = __expf(tot0), et1 = __expf(tot1); float p0 = __expf(off0), p1 = __expf(off1); det0 = et0; det1 = et1; \
        float kp0 = 0.f, kp1 = 0.f; \
        _Pragma("unroll") for (int r = 0; r < 16; ++r) { const f16x2 hh = __builtin_bit_cast(f16x2, rl[r]); const float f0 = __expf((float)hh.x), f1 = __expf((float)hh.y); \
            p0 *= f0; p1 *= f1; \
            const float ki0 = (1.0f - f0) * __builtin_amdgcn_rcpf(p0), ki1 = (1.0f - f1) * __builtin_amdgcn_rcpf(p1); const float ke0 = ki0 * et0, ke1 = ki1 * et1; \
            sq[r] = pkbf(bf_lo(rq[r]) * p0, bf_hi(rq[r]) * p1); sk[r] = pkbf(ki0, ki1); \
            if (r & 1) { ske0[r >> 1] = pkbf(kp0, ke0); ske1[r >> 1] = pkbf(kp1, ke1); } \
            kp0 = ke0; kp1 = ke1; } } while (0)
#define DUMP_REGS() do { \
        _Pragma("unroll") for (int r = 0; r < 16; ++r) { *(LAS unsigned*)(QD + ((16 * rgx + r) * SQ + c0x) * 2) = sq[r]; *(LAS unsigned*)(KI + ((16 * rgx + r) * SQ + c0x) * 2) = sk[r]; } \
        { v4u w_; w_.x = ske0[0]; w_.y = ske0[1]; w_.z = ske0[2]; w_.w = ske0[3]; *(LAS v4u*)(KET + (c0x * SK + 16 * rgx) * 2) = w_; w_.x = ske0[4]; w_.y = ske0[5]; w_.z = ske0[6]; w_.w = ske0[7]; *(LAS v4u*)(KET + (c0x * SK + 16 * rgx + 8) * 2) = w_; \
          w_.x = ske1[0]; w_.y = ske1[1]; w_.z = ske1[2]; w_.w = ske1[3]; *(LAS v4u*)(KET + ((c0x + 1) * SK + 16 * rgx) * 2) = w_; w_.x = ske1[4]; w_.y = ske1[5]; w_.z = ske1[6]; w_.w = ske1[7]; *(LAS v4u*)(KET + ((c0x + 1) * SK + 16 * rgx + 8) * 2) = w_; \
          _Pragma("unroll") for (int hh_ = 0; hh_ < 2; ++hh_) { \
            w_.x = (rv[8 * hh_ + 0] & 0xffffu) | (rv[8 * hh_ + 1] << 16); w_.y = (rv[8 * hh_ + 2] & 0xffffu) | (rv[8 * hh_ + 3] << 16); w_.z = (rv[8 * hh_ + 4] & 0xffffu) | (rv[8 * hh_ + 5] << 16); w_.w = (rv[8 * hh_ + 6] & 0xffffu) | (rv[8 * hh_ + 7] << 16); \
            *(LAS v4u*)(VT + (c0x * SK + 16 * rgx + 8 * hh_) * 2) = w_; \
            w_.x = (rv[8 * hh_ + 0] >> 16) | (rv[8 * hh_ + 1] & 0xffff0000u); w_.y = (rv[8 * hh_ + 2] >> 16) | (rv[8 * hh_ + 3] & 0xffff0000u); w_.z = (rv[8 * hh_ + 4] >> 16) | (rv[8 * hh_ + 5] & 0xffff0000u); w_.w = (rv[8 * hh_ + 6] >> 16) | (rv[8 * hh_ + 7] & 0xffff0000u); \
            *(LAS v4u*)(VT + ((c0x + 1) * SK + 16 * rgx + 8 * hh_) * 2) = w_; } } \
        if (rgx == 0) { f32x2 p_; p_.x = det0; p_.y = det1; *(LAS f32x2*)(DEC + c0x) = p_; } } while (0)
        f32x4 S[8][2];
#define WRITE_ST() do { _Pragma("unroll") for (int kt = 0; kt < 8; ++kt) _Pragma("unroll") for (int j = 0; j < 2; ++j) { v2u w_; w_.x = pkbf(S[kt][j][0], S[kt][j][1]); w_.y = pkbf(S[kt][j][2], S[kt][j][3]); \
        *(LAS v2u*)(ST + ((16 * (2 * wq + j) + i) * SQ + 16 * kt + 4 * g) * 2) = w_; } } while (0)
#pragma unroll
        for (int kt = 0; kt < 8; ++kt)
#pragma unroll
            for (int j = 0; j < 2; ++j) S[kt][j] = (f32x4){0.f, 0.f, 0.f, 0.f};
        LOAD_RAW(0); LOAD_V(0);
        WRITE_ST();
        { const int cpx = cp, rgx = rg, c0x = c0; PREP_REGS(); (void)c0x; }
        LOAD_RAW(1);
        for (int n = 0; n < nch; ++n) {
            int i_ = i, g_ = g; asm volatile("" : "+v"(i_), "+v"(g_));
            const int cpx = i_, rgx = g_, c0x = 32 * wq + 2 * i_;
            DUMP_REGS();
            asm volatile("" ::: "memory");
            LOAD_V(n + 1);
            __syncthreads();
            {
                bf16x8 bv[2][2];
#pragma unroll
                for (int j = 0; j < 2; ++j)
#pragma unroll
                    for (int c = 0; c < 2; ++c) bv[j][c] = *(const LAS bf16x8*)(VT + ((16 * (2 * wq + j) + i_) * SK + 32 * c + 8 * g_) * 2);
#pragma unroll
                for (int kt = 0; kt < 8; ++kt) {
                    const f32x4 d = *(const LAS f32x4*)(DEC + 16 * kt + 4 * g_);
                    const bf16x8 a0 = *(const LAS bf16x8*)(KET + ((16 * kt + i_) * SK + 8 * g_) * 2), a1 = *(const LAS bf16x8*)(KET + ((16 * kt + i_) * SK + 32 + 8 * g_) * 2);
#pragma unroll
                    for (int j = 0; j < 2; ++j) { f32x4 acc = S[kt][j] * d; acc = MFMA16(a0, bv[j][0], acc); acc = MFMA16(a1, bv[j][1], acc); S[kt][j] = acc; }
                }
            }
            PREP_REGS();
            LOAD_RAW(n + 2);
            __syncthreads();
            WRITE_ST();
        }
        {
            float* op = s_out + (4 * g) * 128 + 32 * wq + i;
#pragma unroll
            for (int kt = 0; kt < 8; ++kt) {
#pragma unroll
                for (int j = 0; j < 2; ++j)
#pragma unroll
                    for (int r = 0; r < 4; ++r) __builtin_nontemporal_store(S[kt][j][r], op + r * 128 + 16 * j);
                op += 2048; asm volatile("" : "+v"(op));
            }
        }
#undef WRITE_ST
#undef DUMP_REGS
#undef PREP_REGS
#undef LOAD_RAW
#undef LOAD_V
    }
}

__device__ __forceinline__ void hgrn_sample_units(LAS unsigned char* lds, const bf16* Q, const bf16* LF, const bf16* V, const bf16* G, bf16* O, const float* gnorm,
                                                  const float* state, float* out_hs, int su0, int stride) {
    const int tid = threadIdx.x, lane = tid & 63, wid = tid >> 6, kr = tid >> 5, vc = tid & 31;
    LAS float* SQv = (LAS float*)lds; LAS float* SFv = SQv + 512; LAS float* SKv = SQv + 1024; LAS float* SVv = SQv + 1536; LAS float* RED = SQv + 2048;
    if (su0 >= 2048) return;
    f32x4 S[8], Sn[8]; unsigned short nq, nl, nv;
    const int tt = tid >> 7, tk = tid & 127;
#define SU_LOAD(su_) do { const int b_ = (su_) >> 4, h_ = (su_) & 15; const f32x4* sp_ = (const f32x4*)(state + (size_t)(su_) * 16384 + kr * 128 + 4 * vc); \
        _Pragma("unroll") for (int p = 0; p < 8; ++p) Sn[p] = __builtin_nontemporal_load(sp_ + p * 512); \
        const size_t idx_ = ((size_t)h_ * MT + (size_t)(MP + 4 * b_ + tt)) * 128 + tk; nq = Q[idx_]; nl = LF[idx_]; nv = V[idx_]; } while (0)
    SU_LOAD(su0);
    for (int su = su0; su < 2048; su += stride) {
        const int b = su >> 4, h = su & 15;
#pragma unroll
        for (int p = 0; p < 8; ++p) S[p] = Sn[p];
        { const float q = __builtin_bit_cast(float, (unsigned)nq << 16), v = __builtin_bit_cast(float, (unsigned)nv << 16);
          const float f = __expf((float)__builtin_bit_cast(_Float16, nl));
          SQv[tid] = q; SFv[tid] = f; SKv[tid] = 1.0f - f; SVv[tid] = v; }
        { const int sn = (su + stride) < 2048 ? (su + stride) : su; SU_LOAD(sn); }
        __syncthreads();
        f32x4 o[4];
#pragma unroll
        for (int t = 0; t < 4; ++t) {
            const f32x4 vv = *(const LAS f32x4*)(SVv + t * 128 + 4 * vc); f32x4 acc = (f32x4){0.f, 0.f, 0.f, 0.f};
#pragma unroll
            for (int p = 0; p < 8; ++p) { const int k = t * 128 + kr + 16 * p; const float f = SFv[k], kn = SKv[k], q = SQv[k]; S[p] = S[p] * f + vv * kn; acc += S[p] * q; }
            o[t] = acc;
        }
        { f32x4* op = (f32x4*)(out_hs + (size_t)su * 16384 + kr * 128 + 4 * vc);
#pragma unroll
          for (int p = 0; p < 8; ++p) __builtin_nontemporal_store(S[p], op + p * 512); }
#pragma unroll
        for (int t = 0; t < 4; ++t) { o[t].x += __shfl_xor(o[t].x, 32); o[t].y += __shfl_xor(o[t].y, 32); o[t].z += __shfl_xor(o[t].z, 32); o[t].w += __shfl_xor(o[t].w, 32); }
        if (lane < 32) {
#pragma unroll
            for (int t = 0; t < 4; ++t) *(LAS f32x4*)(RED + (wid * 4 + t) * 128 + 4 * vc) = o[t];
        }
        __syncthreads();
        if (wid < 4) {
            const int t = wid; float a0 = 0.f, a1 = 0.f;
#pragma unroll
            for (int w2 = 0; w2 < 8; ++w2) { a0 += RED[(w2 * 4 + t) * 128 + lane]; a1 += RED[(w2 * 4 + t) * 128 + lane + 64]; }
            const float ss = wave_sum(a0 * a0 + a1 * a1); const float sc = __builtin_amdgcn_rsqf(ss * (1.0f / 128.0f) + LN_EPS);
            const int row = MP + 4 * b + t; const size_t gi = ((size_t)h * MT + (size_t)row) * 128;
            const float g0 = __builtin_bit_cast(float, (unsigned)G[gi + lane] << 16), g1 = __builtin_bit_cast(float, (unsigned)G[gi + lane + 64] << 16);
            bf16* orow = O + (size_t)row * 2048 + h * 128;
            orow[lane] = (bf16)(pkbf(a0 * sc * gnorm[h * 128 + lane] * g0, 0.f) & 0xffffu); orow[lane + 64] = (bf16)(pkbf(a1 * sc * gnorm[h * 128 + lane + 64] * g1, 0.f) & 0xffffu);
        }
        __syncthreads();
    }
#undef SU_LOAD
}

__device__ __forceinline__ void hgrn_phase(const Ptrs& P, LAS unsigned char* lds, int ctr_idx) {
    const bf16* Q = (const bf16*)(P.ws + WS_Q); const bf16* LF = (const bf16*)(P.ws + WS_LF); const bf16* V = (const bf16*)(P.ws + WS_V); const bf16* G = (const bf16*)(P.ws + WS_G);
    bf16* O = (bf16*)(P.ws + WS_O);
    const int Gd = (int)gridDim.x, bx = (int)blockIdx.x;
    const bool split = Gd > 128;
    if (!split || bx < 128) {
        for (int pu = bx; pu < 128; pu += (split ? 128 : Gd)) {
#ifdef PROBE_P2MODE
            if (ctr_idx == 1 && PROBE_P2MODE == 2) break;
#endif
            hgrn_unit(lds, Q, LF, V, G, O, P.gnorm, (pu >> 4) * 2048, pu & 15, P.out + OUT_HP + (size_t)pu * 16384); }
    }
    if (!split || bx >= 128) {
        const int sid = split ? bx - 128 : bx, ns = split ? Gd - 128 : Gd;
        if (split) {
            if (sid < 64 && Gd >= 192) {
                pg8::Gemm g{(const bf16*)(P.ws + WS_XB), (const bf16*)(P.ws + WS_WINA), MT, 4 * EA, DM};
                OneUnit S; S.u0.pm = MP / 256 + (sid >> 5); S.u0.pn = sid & 31;
                pg8::EpiHgrnIn E{(bf16*)(P.ws + WS_Q), (const float*)(P.ws + WS_LB)};
                pg8::gemm_phase<pg8::EpiHgrnIn, OneUnit, true, true>(lds, g, S, E);
            }
            unsigned* cnt = (unsigned*)(P.ws + WS_CTL) + 64;
            asm volatile("s_waitcnt vmcnt(0)" ::: "memory");
            __syncthreads();
            if (threadIdx.x == 0) {
                __builtin_amdgcn_fence(__ATOMIC_RELEASE, "agent"); asm volatile("s_waitcnt vmcnt(0)" ::: "memory");
                __hip_atomic_fetch_add(cnt, 1u, __ATOMIC_RELAXED, __HIP_MEMORY_SCOPE_AGENT);
                while (__hip_atomic_load(cnt, __ATOMIC_RELAXED, __HIP_MEMORY_SCOPE_AGENT) < (unsigned)ns) __builtin_amdgcn_s_sleep(4);
                __builtin_amdgcn_fence(__ATOMIC_ACQUIRE, "agent"); asm volatile("s_waitcnt vmcnt(0)" ::: "memory");
            }
            __syncthreads();
            __builtin_amdgcn_fence(__ATOMIC_ACQUIRE, "agent");
        }
        hgrn_sample_units(lds, Q, LF, V, G, O, P.gnorm, P.state, P.out + OUT_HS, sid, ns);
    }
    (void)ctr_idx;
}

__device__ __forceinline__ void gate_phase(const Ptrs& P, LAS unsigned char* lds) {
    const int tid = threadIdx.x, lane = tid & 63, wid = __builtin_amdgcn_readfirstlane(tid >> 6);
    const int i = lane & 15, g = lane >> 4;
    constexpr int SW = 136;
    const bf16* U = (const bf16*)(P.ws + WS_U); const bf16* Vb = (const bf16*)(P.ws + WS_VB); bf16* GT = (bf16*)(P.ws + WS_O);
    const float* part = (const float*)(P.ws + WS_PART); const bf16* WSB = (const bf16*)(P.ws + WS_WSB);
    LAS unsigned char* WT = lds; LAS unsigned char* VNT = lds + 34816; LAS f32x2* STT = (LAS f32x2*)(lds + 69632);
    int cur_grp = -1;
    for (int u = blockIdx.x; u < 2048; u += gridDim.x) {
        const int grp = u & 15, m0 = (u >> 4) * 128;
        v2u uq[8]; float bq_[8];
        { const size_t og0 = ((size_t)grp * MT + (size_t)(m0 + i)) * 128 + 16 * wid + 4 * g;
#pragma unroll
          for (int tt = 0; tt < 8; ++tt) { uq[tt] = __builtin_nontemporal_load((const v2u*)(U + og0 + (size_t)tt * 16 * 128)); bq_[tt] = P.b_s[grp * 128 + 16 * tt + i]; } }
        __syncthreads();
        if (grp != cur_grp) {
#pragma unroll
            for (int it = 0; it < 4; ++it) { const int idx = tid + 512 * it, row = idx >> 4, c16 = idx & 15;
                *(LAS v4u*)(WT + (row * SW) * 2 + c16 * 16) = *(const v4u*)(WSB + (size_t)grp * 16384 + row * 128 + c16 * 8); }
            cur_grp = grp;
        }
        unsigned vraw[16];
#pragma unroll
        for (int r = 0; r < 16; ++r) vraw[r] = __builtin_nontemporal_load((const unsigned*)(Vb + ((size_t)grp * MT + (size_t)(m0 + 16 * wid + r)) * 128 + 2 * lane));
        if (tid < 128) { const f32x2* pr = (const f32x2*)(part + (size_t)(m0 + tid) * 64); float s = 0.f, ss = 0.f;
#pragma unroll
            for (int j = 0; j < 32; ++j) { const f32x2 p = pr[j]; s += p.x; ss += p.y; }
            const float mean = s * (1.0f / 2048.0f), var = ss * (1.0f / 2048.0f) - mean * mean; f32x2 o; o.x = mean; o.y = 1.0f / sqrtf(var + LN_EPS); STT[tid] = o; }
        __syncthreads();
        {
            const int c0 = grp * 128 + 2 * lane; const float g0 = P.lnv_g[c0], g1 = P.lnv_g[c0 + 1], b0 = P.lnv_b[c0], b1 = P.lnv_b[c0 + 1];
            float y0[16], y1[16];
#pragma unroll
            for (int r = 0; r < 16; ++r) { const int row = 16 * wid + r; const unsigned raw = vraw[r]; const f32x2 st = STT[row];
                y0[r] = (bf_lo(raw) - st.x) * st.y * g0 + b0; y1[r] = (bf_hi(raw) - st.x) * st.y * g1 + b1; }
#pragma unroll
            for (int hh = 0; hh < 2; ++hh) { v4u w0, w1;
                w0.x = pkbf(y0[8 * hh + 0], y0[8 * hh + 1]); w0.y = pkbf(y0[8 * hh + 2], y0[8 * hh + 3]); w0.z = pkbf(y0[8 * hh + 4], y0[8 * hh + 5]); w0.w = pkbf(y0[8 * hh + 6], y0[8 * hh + 7]);
                w1.x = pkbf(y1[8 * hh + 0], y1[8 * hh + 1]); w1.y = pkbf(y1[8 * hh + 2], y1[8 * hh + 3]); w1.z = pkbf(y1[8 * hh + 4], y1[8 * hh + 5]); w1.w = pkbf(y1[8 * hh + 6], y1[8 * hh + 7]);
                *(LAS v4u*)(VNT + ((2 * lane) * SW + 16 * wid + 8 * hh) * 2) = w0; *(LAS v4u*)(VNT + ((2 * lane + 1) * SW + 16 * wid + 8 * hh) * 2) = w1; }
        }
        __syncthreads();
        {
            bf16x8 av[4];
#pragma unroll
            for (int kk = 0; kk < 4; ++kk) av[kk] = *(const LAS bf16x8*)(VNT + ((16 * wid + i) * SW + 32 * kk + 8 * g) * 2);
#pragma unroll
            for (int tt = 0; tt < 8; ++tt) {
                f32x4 acc = (f32x4){0.f, 0.f, 0.f, 0.f};
#pragma unroll
                for (int kk = 0; kk < 4; ++kk) if (kk <= (tt >> 1)) { const bf16x8 b = *(const LAS bf16x8*)(WT + ((16 * tt + i) * SW + 32 * kk + 8 * g) * 2); acc = MFMA16(av[kk], b, acc); }
                const int t = 16 * tt + i; const float bias = bq_[tt];
                const size_t off = (size_t)(m0 + t) * 2048 + grp * 128 + 16 * wid + 4 * g;
                const v2u uu = uq[tt];
                v2u w; w.x = pkbf(bf_lo(uu.x) * (acc[0] + bias), bf_hi(uu.x) * (acc[1] + bias));
                w.y = pkbf(bf_lo(uu.y) * (acc[2] + bias), bf_hi(uu.y) * (acc[3] + bias));
                *(v2u*)(GT + off) = w;
            }
        }
    }
    for (int sb = (int)gridDim.x - 1 - (int)blockIdx.x; sb < 128; sb += gridDim.x) {
        __syncthreads();
        const int mrow = MP + 4 * sb;
        if (tid < 4) { const f32x2* pr = (const f32x2*)(part + (size_t)(mrow + tid) * 64); float s = 0.f, ss = 0.f;
            for (int j = 0; j < 32; ++j) { const f32x2 p = pr[j]; s += p.x; ss += p.y; }
            const float mean = s * (1.0f / 2048.0f), var = ss * (1.0f / 2048.0f) - mean * mean; f32x2 o; o.x = mean; o.y = 1.0f / sqrtf(var + LN_EPS); STT[tid] = o; }
        __syncthreads();
        const int c = 4 * tid, grp = c >> 7;
        const f32x4 lg = *(const f32x4*)(P.lnv_g + c), lb = *(const f32x4*)(P.lnv_b + c);
        f32x4 vn[4];
#pragma unroll
        for (int t = 0; t < 4; ++t) { const v2u raw = *(const v2u*)(Vb + ((size_t)grp * MT + (size_t)(mrow + t)) * 128 + (c & 127)); const f32x2 st = STT[t];
            f32x4 x; x.x = bf_lo(raw.x); x.y = bf_hi(raw.x); x.z = bf_lo(raw.y); x.w = bf_hi(raw.y);
            vn[t] = (x - st.x) * st.y * lg + lb;
            __builtin_nontemporal_store(vn[t], (f32x4*)(P.out + OUT_CV + (size_t)(4 * sb + t) * 2048 + c)); }
#pragma unroll
        for (int t = 0; t < 4; ++t) { const float bias = P.b_s[grp * 128 + t]; f32x4 mx = (f32x4){bias, bias, bias, bias};
#pragma unroll
            for (int s = 0; s < 4; ++s) if (s <= t) mx += vn[s] * P.w_s[(size_t)grp * 16384 + t * 128 + s];
            const size_t off = (size_t)(mrow + t) * 2048 + c; const size_t offg = ((size_t)grp * MT + (size_t)(mrow + t)) * 128 + (c & 127); const v2u uu = *(const v2u*)(U + offg);
            v2u w; w.x = pkbf(bf_lo(uu.x) * mx.x, bf_hi(uu.x) * mx.y); w.y = pkbf(bf_lo(uu.y) * mx.z, bf_hi(uu.y) * mx.w);
            *(v2u*)(GT + off) = w; }
    }
}

struct Args { const float* in[15]; float* out; unsigned char* ws; int ph_lo, ph_hi; };
__global__ void __launch_bounds__(512, 2) mk_fwd(Args a) {
    extern __shared__ __attribute__((aligned(16))) unsigned char lds_raw[];
    LAS unsigned char* lds = (LAS unsigned char*)lds_raw;
    Ptrs P;
    P.xp = a.in[0]; P.xs = a.in[1]; P.state = a.in[2]; P.w_in_a = a.in[3]; P.lb_logits = a.in[4]; P.gnorm = a.in[5]; P.w_out_a = a.in[6]; P.w_in_b = a.in[7];
    P.lnv_g = a.in[8]; P.lnv_b = a.in[9]; P.w_s = a.in[10]; P.b_s = a.in[11]; P.w_out_b = a.in[12]; P.ln_g = a.in[13]; P.ln_b = a.in[14]; P.out = a.out; P.ws = a.ws;
    const int lo = a.ph_lo, hi = a.ph_hi;
    volatile LAS unsigned* bst = (volatile LAS unsigned*)(lds + 131072 + 64);
    if (threadIdx.x == 0) { bst[0] = 0u; bst[1] = 0u; }
    __syncthreads();
    XcdBarrier bar = xcd_barrier_post((unsigned*)(P.ws + WS_BAR), bst);
    if (lo < 0) cg::this_grid().sync();
#define IN(k) (lo <= (k) && (k) < hi)
#define SEAM(k) do { if (IN(k) && IN((k) + 1)) { xcd_barrier(bar); } } while (0)
#ifndef PROBE_REP
#define PROBE_REP -1
#endif
#define REP(k) for (int rep_ = 0; rep_ < ((PROBE_REP == (k)) ? 2 : 1); ++rep_, (void)((PROBE_REP == (k) && rep_ == 1) ? (cg::this_grid().sync(), 0) : 0))
    const int G = (int)gridDim.x, c = (int)blockIdx.x;
    if (IN(0)) REP(0) { p0_prologue(P, lds); }
    SEAM(0);
    if (IN(1)) REP(1) {
        const int M1 = G >= 192 ? MP : MT;
        pg8::Gemm g{(const bf16*)(P.ws + WS_XB), (const bf16*)(P.ws + WS_WINA), M1, 4 * EA, DM}; pg8::StaticOrder S; S.init(M1, 4 * EA, G, c);
        pg8::EpiHgrnIn E{(bf16*)(P.ws + WS_Q), (const float*)(P.ws + WS_LB)};
        pg8::gemm_phase<pg8::EpiHgrnIn, pg8::StaticOrder, true, true>(lds, g, S, E);
    }
    SEAM(1);
    if (IN(2)) REP(2) { hgrn_phase(P, lds, rep_); }
    SEAM(2);
    if (IN(3)) REP(3) {
        const int Mo = G > 32 ? MP : MT;
        pg8::Gemm g{(const bf16*)(P.ws + WS_O), (const bf16*)(P.ws + WS_WOUTA), Mo, DM, EA}; pg8::StaticOrder S; S.init(Mo, DM, G, c);
        pg8::EpiBf16Plain E{(bf16*)(P.ws + WS_D), DM};
        pg8::gemm_phase<pg8::EpiBf16Plain, pg8::StaticOrder, true, true>(lds, g, S, E);
    }
    SEAM(3);
    if (IN(4)) REP(4) { ln_phase<false>(P, lds, 0); }
    SEAM(4);
    if (IN(5)) REP(5) {
        pg8::Gemm g{(const bf16*)(P.ws + WS_XB), (const bf16*)(P.ws + WS_WINB), MT, 3 * EA, DM}; pg8::StaticOrder S; S.init(MT, 3 * EA, G, c);
        pg8::EpiGmlpIn E{(bf16*)(P.ws + WS_U), (float*)(P.ws + WS_PART)};
        pg8::gemm_phase<pg8::EpiGmlpIn, pg8::StaticOrder, true, true>(lds, g, S, E);
    }
    SEAM(5);
    if (IN(6)) REP(6) { gate_phase(P, lds); }
    SEAM(6);
    if (IN(7)) REP(7) {
        const int Mo = G > 32 ? MP : MT;
        pg8::Gemm g{(const bf16*)(P.ws + WS_O), (const bf16*)(P.ws + WS_WOUTB), Mo, DM, EA}; pg8::StaticOrder S; S.init(Mo, DM, G, c);
        pg8::EpiBf16Plain E{(bf16*)(P.ws + WS_D), DM};
        pg8::gemm_phase<pg8::EpiBf16Plain, pg8::StaticOrder, true, true>(lds, g, S, E);
    }
    SEAM(7);
    if (IN(8)) REP(8) { ln_phase<true>(P, lds, 1); }
#undef IN
#undef SEAM
}

extern "C" void kernel_launch(void* const* d_in, const int* in_sizes, int n_in, void* d_out, int out_size, void* d_ws, size_t ws_size, hipStream_t stream) {
    static int grid = 0;
    if (grid == 0) {
        if (n_in != 15 || ws_size < WS_END || out_size != 54001664) { fprintf(stderr, "kernel_launch: unexpected problem (n_in %d, out %d, ws %zu)\n", n_in, out_size, ws_size); grid = -1; return; }
        int dev = 0, cus = 0, per_cu = 0;
        if (hipGetDevice(&dev) != hipSuccess || hipDeviceGetAttribute(&cus, hipDeviceAttributeMultiprocessorCount, dev) != hipSuccess) { grid = -1; return; }
        if (hipFuncSetAttribute((const void*)mk_fwd, hipFuncAttributeMaxDynamicSharedMemorySize, LDS_BYTES) != hipSuccess) { fprintf(stderr, "kernel_launch: hipFuncSetAttribute failed\n"); grid = -1; return; }
        if (hipOccupancyMaxActiveBlocksPerMultiprocessor(&per_cu, (const void*)mk_fwd, 512, LDS_BYTES) != hipSuccess || per_cu < 1) { fprintf(stderr, "kernel_launch: occupancy query gave %d\n", per_cu); (void)hipGetLastError(); per_cu = 1; }
        grid = cus * 1;
        (void)in_sizes;
    }
    if (grid < 0) return;
    Args a{};
    for (int i = 0; i < 15; ++i) a.in[i] = (const float*)d_in[i];
    a.out = (float*)d_out; a.ws = (unsigned char*)d_ws;
#if MK_MULTI
    for (int p = 0; p < NPHASE; ++p) { a.ph_lo = p; a.ph_hi = p + 1; hipLaunchKernelGGL(mk_fwd, dim3(grid), dim3(512), LDS_BYTES, stream, a); }
#else
    a.ph_lo = 0; a.ph_hi = NPHASE;
    if (hipMemsetAsync((char*)d_ws + WS_BAR, 0, XCD_BAR_WORDS * 4, stream) != hipSuccess) { fprintf(stderr, "kernel_launch: memset of the barrier words failed\n"); return; }
    void* args[] = {&a};
    hipError_t e = hipLaunchCooperativeKernel((const void*)mk_fwd, dim3(grid), dim3(512), args, LDS_BYTES, stream);
    if (e != hipSuccess) fprintf(stderr, "kernel_launch: cooperative launch failed: %s (grid %d)\n", hipGetErrorString(e), grid);
#endif
}
```

```cpp
#include <hip/hip_runtime.h>
#include <hip/hip_cooperative_groups.h>
#include <cstdio>
#include <cstdint>
namespace cg = cooperative_groups;
#define MK_MULTI 0
namespace pg8 {
#define PG8_LAS __attribute__((address_space(3)))
typedef unsigned short bf16_t;
typedef short bf16x8 __attribute__((ext_vector_type(8)));
typedef float f32x4 __attribute__((ext_vector_type(4)));
typedef unsigned u32x4 __attribute__((ext_vector_type(4)));
constexpr int BM = 256, BK = 64, HALF = 128, HTB = HALF * BK * 2  , STAGE_BYTES = 8 * HTB, NXCD = 8, WGM = 8;

__host__ __device__ __forceinline__ int lds_byte(int r, int c) { const int st = (r >> 4) * 2 + (c >> 5), rr = r & 15, cc = c & 31, ob = rr * 64 + cc * 2; return st * 1024 + (ob ^ (((ob >> 9) & 1) << 5)); }
__host__ __device__ __forceinline__ void stage_rc(int b, int& R, int& C) { const int st = b / 1024, sb = b % 1024, swz = sb ^ (((sb >> 9) & 1) << 5); R = (st >> 1) * 16 + swz / 64; C = (st & 1) * 32 + (swz % 64) / 2; }
__host__ __device__ __forceinline__ int perm32(int rho) { const int n = rho >> 4, i = rho & 15; return 8 * (i >> 2) + 4 * n + (i & 3); }

struct Unit { int pm, pn; };
struct Gemm { const bf16_t* A; const bf16_t* Bt; int M, N, K; int nt = 0; };

struct StaticOrder {
    int nM, nN, nwg, G, c;
    __host__ __device__ void init(int M, int N, int G_, int c_) { nM = M / BM; nN = N / BM; nwg = nM * nN; G = G_; c = c_; }
    __host__ __device__ bool next(int i, Unit& u) const {
        const long L = (long)i * G + c; if (L >= nwg) return false;
        int wgid = (int)L; { const int q = nwg / NXCD, r = nwg % NXCD, xcd = wgid % NXCD, off = wgid / NXCD; wgid = (xcd < r ? xcd * (q + 1) : r * (q + 1) + (xcd - r) * q) + off; }
        const int nig = WGM * nN, gid = wgid / nig, fm = gid * WGM, gsz = (nM - fm) < WGM ? (nM - fm) : WGM;
        u.pm = fm + ((wgid % nig) % gsz); u.pn = (wgid % nig) / gsz; return true;
    }
    __device__ __forceinline__ void a_ready(const Unit&) const {}
    __device__ __forceinline__ void done(const Unit&) const {}
};

typedef float cvt_f32x2 __attribute__((ext_vector_type(2)));
typedef __bf16 cvt_bf16x2 __attribute__((ext_vector_type(2)));
__device__ __forceinline__ unsigned cvt_pk_bf16(float lo, float hi) { cvt_f32x2 v; v.x = lo; v.y = hi; const cvt_bf16x2 b = __builtin_convertvector(v, cvt_bf16x2); return __builtin_bit_cast(unsigned, b); }
typedef unsigned u32x2 __attribute__((ext_vector_type(2)));
constexpr size_t MROWS = 16896;
constexpr size_t SEC_STRIDE = (size_t)16896 * 2048;
typedef float f32x2 __attribute__((ext_vector_type(2)));
typedef _Float16 f16x2 __attribute__((ext_vector_type(2)));
__device__ __forceinline__ float silu_f(float x) { return x * __builtin_amdgcn_rcpf(1.0f + __expf(-x)); }
__device__ __forceinline__ float gelu_tanh_f(float x) { const float u = 1.5957691216057308f * (x + 0.044715f * x * x * x); return x * __builtin_amdgcn_rcpf(1.0f + __expf(-u)); }
__device__ __forceinline__ unsigned pk_f16(float lo, float hi) { f16x2 p; p.x = (_Float16)lo; p.y = (_Float16)hi; return __builtin_bit_cast(unsigned, p); }

struct EpiHgrnIn {
    static constexpr bool PERM = true, AFTER_DRAIN = false;
    bf16_t* B0; const float* lb;
    __device__ __forceinline__ void operator()(const f32x4 (&acc)[2][2][4][2], const Unit& u, int wr, int wc, int fr, int fq) const {
        const int sec = u.pn >> 3;
        const int row0 = u.pm * BM + wr * 64 + fr, col0 = (u.pn & 7) * BM + wc * 32 + 8 * fq;
        bf16_t* base = B0 + (size_t)sec * SEC_STRIDE;
        f32x4 l0[2], l1[2];
#pragma unroll
        for (int bj = 0; bj < 2; ++bj) { l0[bj] = (f32x4){0.f, 0.f, 0.f, 0.f}; l1[bj] = l0[bj]; }
        if (sec == 1) {
#pragma unroll
            for (int bj = 0; bj < 2; ++bj) { l0[bj] = *(const f32x4*)(lb + col0 + bj * HALF); l1[bj] = *(const f32x4*)(lb + col0 + bj * HALF + 4); }
        }
#pragma unroll
        for (int ai = 0; ai < 2; ++ai)
#pragma unroll
            for (int m = 0; m < 4; ++m) { bf16_t* rowp = base + ((size_t)((u.pn & 7) * 2) * MROWS + (size_t)(row0 + ai * HALF + m * 16)) * 128 + wc * 32 + 8 * fq;
#pragma unroll
                for (int bj = 0; bj < 2; ++bj) { f32x4 v0 = acc[ai][bj][m][0], v1 = acc[ai][bj][m][1]; u32x4 w;
                    if (sec == 1) {
#pragma unroll
                        for (int j = 0; j < 4; ++j) { const float s0 = __builtin_amdgcn_rcpf(1.0f + __expf(-v0[j])), s1 = __builtin_amdgcn_rcpf(1.0f + __expf(-v1[j]));
                            v0[j] = __logf(l0[bj][j] + (1.0f - l0[bj][j]) * s0); v1[j] = __logf(l1[bj][j] + (1.0f - l1[bj][j]) * s1); }
                        w.x = pk_f16(v0[0], v0[1]); w.y = pk_f16(v0[2], v0[3]); w.z = pk_f16(v1[0], v1[1]); w.w = pk_f16(v1[2], v1[3]);
                    } else {
                        if (sec != 2) {
#pragma unroll
                            for (int j = 0; j < 4; ++j) { v0[j] = silu_f(v0[j]); v1[j] = silu_f(v1[j]); } }
                        w.x = cvt_pk_bf16(v0[0], v0[1]); w.y = cvt_pk_bf16(v0[2], v0[3]); w.z = cvt_pk_bf16(v1[0], v1[1]); w.w = cvt_pk_bf16(v1[2], v1[3]);
                    }
                    *(u32x4*)(rowp + (size_t)bj * MROWS * 128) = w; } }
    }
};
struct EpiGmlpIn {
    static constexpr bool PERM = true, AFTER_DRAIN = false;
    bf16_t* B0; float* part;
    __device__ __forceinline__ void operator()(const f32x4 (&acc)[2][2][4][2], const Unit& u, int wr, int wc, int fr, int fq) const {
        const int row0 = u.pm * BM + wr * 64 + fr;
        if (u.pn < 16) {
#pragma unroll
            for (int ai = 0; ai < 2; ++ai)
#pragma unroll
                for (int m = 0; m < 4; ++m) { const int row = row0 + ai * HALF + m * 16; bf16_t* rowp = B0 + ((size_t)u.pn * MROWS + (size_t)row) * 128 + wc * 32 + 8 * fq;
                    f32x4 v0 = acc[ai][0][m][0], v1 = acc[ai][0][m][1]; const f32x4 z0 = acc[ai][1][m][0], z1 = acc[ai][1][m][1]; u32x4 w;
#pragma unroll
                    for (int j = 0; j < 4; ++j) { v0[j] = gelu_tanh_f(v0[j]) * silu_f(z0[j]); v1[j] = gelu_tanh_f(v1[j]) * silu_f(z1[j]); }
                    w.x = cvt_pk_bf16(v0[0], v0[1]); w.y = cvt_pk_bf16(v0[2], v0[3]); w.z = cvt_pk_bf16(v1[0], v1[1]); w.w = cvt_pk_bf16(v1[2], v1[3]);
                    *(u32x4*)rowp = w; }
        } else {
            const int g0 = (u.pn - 16) * 2;
#pragma unroll
            for (int ai = 0; ai < 2; ++ai)
#pragma unroll
                for (int m = 0; m < 4; ++m) { const int row = row0 + ai * HALF + m * 16; bf16_t* rowp = B0 + SEC_STRIDE + ((size_t)g0 * MROWS + (size_t)row) * 128 + wc * 32 + 8 * fq; float s = 0.f, ss = 0.f;
#pragma unroll
                    for (int bj = 0; bj < 2; ++bj) { f32x4 v0 = acc[ai][bj][m][0], v1 = acc[ai][bj][m][1]; u32x4 w;
#pragma unroll
                        for (int j = 0; j < 4; ++j) { v0[j] = gelu_tanh_f(v0[j]); v1[j] = gelu_tanh_f(v1[j]); s += v0[j] + v1[j]; ss += v0[j] * v0[j] + v1[j] * v1[j]; }
                        w.x = cvt_pk_bf16(v0[0], v0[1]); w.y = cvt_pk_bf16(v0[2], v0[3]); w.z = cvt_pk_bf16(v1[0], v1[1]); w.w = cvt_pk_bf16(v1[2], v1[3]);
                        *(u32x4*)(rowp + (size_t)bj * MROWS * 128) = w; }
                    s += __shfl_xor(s, 16); s += __shfl_xor(s, 32); ss += __shfl_xor(ss, 16); ss += __shfl_xor(ss, 32);
                    if (fq == 0) { f32x2 o; o.x = s; o.y = ss; *(f32x2*)(part + (size_t)row * 64 + ((u.pn - 16) * 4 + wc) * 2) = o; } }
        }
    }
};
struct EpiF32 {
    static constexpr bool PERM = false, AFTER_DRAIN = false;
    float* C; int ldc;
    __device__ __forceinline__ void operator()(const f32x4 (&acc)[2][2][4][2], const Unit& u, int wr, int wc, int fr, int fq) const {
        const int row0 = u.pm * BM + wr * 64 + fr, col0 = u.pn * BM + wc * 32 + 4 * fq;
#pragma unroll
        for (int ai = 0; ai < 2; ++ai)
#pragma unroll
            for (int m = 0; m < 4; ++m) { float* rowp = C + (size_t)(row0 + ai * HALF + m * 16) * ldc + col0;
#pragma unroll
                for (int bj = 0; bj < 2; ++bj)
#pragma unroll
                    for (int n = 0; n < 2; ++n) *(f32x4*)(rowp + bj * HALF + n * 16) = acc[ai][bj][m][n]; }
    }
};
struct EpiBf16Plain {
    static constexpr bool PERM = true, AFTER_DRAIN = false;
    bf16_t* C; int ldc;
    __device__ __forceinline__ void operator()(const f32x4 (&acc)[2][2][4][2], const Unit& u, int wr, int wc, int fr, int fq) const {
        const int row0 = u.pm * BM + wr * 64 + fr, col0 = u.pn * BM + wc * 32 + 8 * fq;
#pragma unroll
        for (int ai = 0; ai < 2; ++ai)
#pragma unroll
            for (int m = 0; m < 4; ++m) { bf16_t* rowp = C + (size_t)(row0 + ai * HALF + m * 16) * ldc + col0;
#pragma unroll
                for (int bj = 0; bj < 2; ++bj) { const f32x4 v0 = acc[ai][bj][m][0], v1 = acc[ai][bj][m][1]; u32x4 w;
                    w.x = cvt_pk_bf16(v0[0], v0[1]); w.y = cvt_pk_bf16(v0[2], v0[3]); w.z = cvt_pk_bf16(v1[0], v1[1]); w.w = cvt_pk_bf16(v1[2], v1[3]);
                    *(u32x4*)(rowp + bj * HALF) = w; } }
    }
};
template <class Epi, class Sched, bool ALIGN_EPI = false, bool SP2 = false>
__device__ __forceinline__ void gemm_phase(PG8_LAS unsigned char* lds, const Gemm g, const Sched& S, const Epi& E) {
    const int tid = threadIdx.x, wid = __builtin_amdgcn_readfirstlane(tid >> 6), lane = tid & 63, wr = wid >> 2, wc = wid & 3, fr = lane & 15, fq = lane >> 4;
    const int K = g.K, nt = g.nt ? g.nt : K / BK;
    unsigned voffA[2], voffB[2];
#pragma unroll
    for (int i = 0; i < 2; ++i) { int R, C; stage_rc(tid * 16 + i * 8192, R, C); const int Rb = Epi::PERM ? ((R & ~31) + perm32(R & 31)) : R;
        voffA[i] = (unsigned)(R * K + C) * 2u; voffB[i] = (unsigned)(Rb * K + C) * 2u; }
    const size_t kstep = (size_t)(BK * 2);
    const size_t hstep = (size_t)HALF * K * 2;
    const size_t tstep = 2 * hstep;
    const unsigned ldsw = (unsigned)wid * 1024u;
    const int aoff = lds_byte(wr * 64 + fr, fq * 8), boff = lds_byte(wc * 32 + fr, fq * 8);
#define PG8_SA(b, h) (((b) * 2 + (h)) * HTB)
#define PG8_SB(b, h) ((4 + (b) * 2 + (h)) * HTB)
#define PG8_STAGE(bufoff, gbase, voff) do { _Pragma("unroll") for (int _i = 0; _i < 2; ++_i) \
        __builtin_amdgcn_global_load_lds((const unsigned*)((const char*)(gbase) + (voff)[_i]), (PG8_LAS unsigned*)(lds + (bufoff) + ldsw + _i * 8192), 16, 0, 0); } while (0)
#define PG8_LDA(dst, b, h) do { _Pragma("unroll") for (int m = 0; m < 4; ++m) _Pragma("unroll") for (int k = 0; k < 2; ++k) dst[m][k] = *(const PG8_LAS bf16x8*)(lds + PG8_SA(b, h) + aoff + m * 2048 + k * 1024); } while (0)
#define PG8_LDB(dst, b, h) do { _Pragma("unroll") for (int n = 0; n < 2; ++n) _Pragma("unroll") for (int k = 0; k < 2; ++k) dst[n][k] = *(const PG8_LAS bf16x8*)(lds + PG8_SB(b, h) + boff + n * 2048 + k * 1024); } while (0)
#define PG8_MMA(ai, bj, At, Bt) do { __builtin_amdgcn_s_setprio(1); _Pragma("unroll") for (int m = 0; m < 4; ++m) _Pragma("unroll") for (int n = 0; n < 2; ++n) _Pragma("unroll") for (int k = 0; k < 2; ++k) \
        acc[ai][bj][m][n] = __builtin_amdgcn_mfma_f32_16x16x32_bf16(Bt[n][k], At[m][k], acc[ai][bj][m][n], 0, 0, 0); __builtin_amdgcn_s_setprio(0); } while (0)
#define PG8_WAIT_V(n) asm volatile("s_waitcnt vmcnt(" #n ")" ::: "memory")
#define PG8_WAIT_L(n) asm volatile("s_waitcnt lgkmcnt(" #n ")" ::: "memory")
#define PG8_BAR __builtin_amdgcn_s_barrier()
#define PG8_SCHED __builtin_amdgcn_sched_barrier(0)
    Unit cur, nxt; int ui = 0;
    if (!S.next(0, cur)) return;
    f32x4 acc[2][2][4][2];
#pragma unroll
    for (int a = 0; a < 2; ++a)
#pragma unroll
        for (int b = 0; b < 2; ++b)
#pragma unroll
            for (int m = 0; m < 4; ++m)
#pragma unroll
                for (int n = 0; n < 2; ++n) acc[a][b][m][n] = (f32x4){0.f, 0.f, 0.f, 0.f};
    bf16x8 At[4][2], B0[2][2], B1[2][2];
    const char* cA = (const char*)g.A + (size_t)cur.pm * tstep; const char* cB = (const char*)g.Bt + (size_t)cur.pn * tstep;
    S.a_ready(cur);
    if constexpr (SP2) {
        PG8_STAGE(PG8_SB(0, 0), cB, voffB); PG8_STAGE(PG8_SB(0, 1), cB + hstep, voffB); PG8_STAGE(PG8_SA(0, 0), cA, voffA); PG8_STAGE(PG8_SA(0, 1), cA + hstep, voffA);
        if (wr == 1) PG8_BAR;
        PG8_WAIT_V(2); PG8_BAR;
        PG8_STAGE(PG8_SB(1, 0), cB + kstep, voffB); PG8_STAGE(PG8_SA(1, 0), cA + kstep, voffA); PG8_STAGE(PG8_SB(1, 1), cB + hstep + kstep, voffB);
        PG8_WAIT_V(6); PG8_BAR;
    } else {
        PG8_STAGE(PG8_SB(0, 0), cB, voffB); PG8_STAGE(PG8_SA(0, 0), cA, voffA); PG8_STAGE(PG8_SB(0, 1), cB + hstep, voffB); PG8_STAGE(PG8_SA(0, 1), cA + hstep, voffA);
        if (wr == 1) PG8_BAR;
        PG8_WAIT_V(4); PG8_BAR;
        PG8_STAGE(PG8_SB(1, 0), cB + kstep, voffB); PG8_STAGE(PG8_SA(1, 0), cA + kstep, voffA); PG8_STAGE(PG8_SB(1, 1), cB + hstep + kstep, voffB);
        PG8_WAIT_V(6); PG8_BAR;
    }
    for (;;) {
        const bool has_next = S.next(ui + 1, nxt);
        const char* nA = has_next ? (const char*)g.A + (size_t)nxt.pm * tstep : cA; const char* nB = has_next ? (const char*)g.Bt + (size_t)nxt.pn * tstep : cB;
        for (int t = 0; t < nt; t += 2) {
            const bool last = (t == nt - 2);
            const char* a1 = cA + (size_t)(t + 1) * kstep;
            const char* a2 = last ? nA : cA + (size_t)(t + 2) * kstep; const char* b2 = last ? nB : cB + (size_t)(t + 2) * kstep;
            const char* a3 = a2 + kstep; const char* b3 = b2 + kstep;
            if (last && has_next) S.a_ready(nxt);
            if constexpr (SP2) {
            PG8_LDB(B0, 0, 0); PG8_LDB(B1, 0, 1); PG8_SCHED; PG8_LDA(At, 0, 0); PG8_STAGE(PG8_SA(1, 1), a1 + hstep, voffA);
            PG8_WAIT_V(8); PG8_WAIT_L(0); PG8_BAR; PG8_MMA(0, 0, At, B0); PG8_MMA(0, 1, At, B1); PG8_BAR; PG8_SCHED;
            PG8_LDA(At, 0, 1); PG8_STAGE(PG8_SB(0, 0), b2, voffB); PG8_STAGE(PG8_SB(0, 1), b2 + hstep, voffB); PG8_STAGE(PG8_SA(0, 0), a2, voffA);
            PG8_WAIT_V(8); PG8_WAIT_L(0); PG8_BAR; PG8_MMA(1, 0, At, B0); PG8_MMA(1, 1, At, B1); PG8_BAR; PG8_SCHED;
            PG8_LDB(B0, 1, 0); PG8_LDB(B1, 1, 1); PG8_SCHED; PG8_LDA(At, 1, 0); PG8_STAGE(PG8_SA(0, 1), a2 + hstep, voffA);
            PG8_WAIT_V(8); PG8_WAIT_L(0); PG8_BAR; PG8_MMA(0, 0, At, B0); PG8_MMA(0, 1, At, B1); PG8_BAR; PG8_SCHED;
            PG8_LDA(At, 1, 1); PG8_STAGE(PG8_SB(1, 0), b3, voffB); PG8_STAGE(PG8_SB(1, 1), b3 + hstep, voffB); PG8_STAGE(PG8_SA(1, 0), a3, voffA);
            PG8_WAIT_V(8); PG8_WAIT_L(0); PG8_BAR; PG8_MMA(1, 0, At, B0); PG8_MMA(1, 1, At, B1); PG8_BAR; PG8_SCHED;
            } else {
            PG8_LDB(B0, 0, 0); PG8_SCHED; PG8_LDA(At, 0, 0); PG8_STAGE(PG8_SA(1, 1), a1 + hstep, voffA);
            PG8_WAIT_L(8); PG8_BAR; PG8_WAIT_L(0); PG8_MMA(0, 0, At, B0); PG8_BAR; PG8_SCHED;
            PG8_LDB(B1, 0, 1); PG8_STAGE(PG8_SB(0, 0), b2, voffB);
            PG8_BAR; PG8_WAIT_L(0); PG8_MMA(0, 1, At, B1); PG8_BAR;
            PG8_LDA(At, 0, 1); PG8_STAGE(PG8_SA(0, 0), a2, voffA);
            PG8_BAR; PG8_WAIT_L(0); PG8_MMA(1, 0, At, B0); PG8_BAR; PG8_SCHED;
            PG8_STAGE(PG8_SB(0, 1), b2 + hstep, voffB);
            PG8_WAIT_V(6); PG8_BAR; PG8_MMA(1, 1, At, B1); PG8_BAR;
            PG8_LDB(B0, 1, 0); PG8_SCHED; PG8_LDA(At, 1, 0); PG8_STAGE(PG8_SA(0, 1), a2 + hstep, voffA);
            PG8_WAIT_L(8); PG8_BAR; PG8_WAIT_L(0); PG8_MMA(0, 0, At, B0); PG8_BAR; PG8_SCHED;
            PG8_LDB(B1, 1, 1); PG8_STAGE(PG8_SB(1, 0), b3, voffB);
            PG8_BAR; PG8_WAIT_L(0); PG8_MMA(0, 1, At, B1); PG8_BAR;
            PG8_LDA(At, 1, 1); PG8_STAGE(PG8_SA(1, 0), a3, voffA);
            PG8_BAR; PG8_WAIT_L(0); PG8_MMA(1, 0, At, B0); PG8_BAR; PG8_SCHED;
            PG8_STAGE(PG8_SB(1, 1), b3 + hstep, voffB);
            PG8_WAIT_V(6); PG8_BAR; PG8_MMA(1, 1, At, B1); PG8_BAR;
            }
        }
        if constexpr (ALIGN_EPI) { if (wr == 0) PG8_BAR; }
        if constexpr (!Epi::AFTER_DRAIN) { E(acc, cur, wr, wc, fr, fq); S.done(cur); }
        if (!has_next) break;
#pragma unroll
        for (int a = 0; a < 2; ++a)
#pragma unroll
            for (int b = 0; b < 2; ++b)
#pragma unroll
                for (int m = 0; m < 4; ++m)
#pragma unroll
                    for (int n = 0; n < 2; ++n) acc[a][b][m][n] = (f32x4){0.f, 0.f, 0.f, 0.f};
        cur = nxt; cA = nA; cB = nB; ++ui;
        if constexpr (ALIGN_EPI) { if (wr == 1) PG8_BAR; }
    }
    PG8_WAIT_V(0);
    if constexpr (!ALIGN_EPI) { if (wr == 0) PG8_BAR; }
    PG8_BAR;
    if constexpr (Epi::AFTER_DRAIN) { E.fused(acc, cur, wr, wc, fr, fq, lds, wid, lane); S.done(cur); }
#undef PG8_SA
#undef PG8_SB
#undef PG8_STAGE
#undef PG8_LDA
#undef PG8_LDB
#undef PG8_MMA
#undef PG8_WAIT_V
#undef PG8_WAIT_L
#undef PG8_BAR
#undef PG8_SCHED
}
}

#define GAS __attribute__((address_space(1)))
#define LAS __attribute__((address_space(3)))
typedef unsigned short bf16;
typedef unsigned v4u __attribute__((ext_vector_type(4)));
typedef unsigned v2u __attribute__((ext_vector_type(2)));
typedef float f32x4 __attribute__((ext_vector_type(4)));
typedef float f32x2 __attribute__((ext_vector_type(2)));
typedef short bf16x8 __attribute__((ext_vector_type(8)));
typedef _Float16 f16x2 __attribute__((ext_vector_type(2)));

#ifndef MK_MULTI
#define MK_MULTI 0
#endif
constexpr int NPHASE = 9;
constexpr int MP = 16384, MS = 512, MT = MP + MS, DM = 1024, EA = 2048;
constexpr float LN_EPS = 1e-5f, ALPHA = 1.4142135623730951f;
constexpr size_t MiB = 1u << 20;
constexpr size_t WS_CTL = 0, WS_LB = 64 * 1024, WS_WSB = 1 * MiB, WS_WINA = 2 * MiB, WS_WOUTA = 18 * MiB, WS_WINB = 22 * MiB, WS_WOUTB = 34 * MiB, WS_PART = 38 * MiB;
constexpr size_t WS_XB = 44 * MiB;
constexpr size_t WS_Q = 78 * MiB, WS_LF = 144 * MiB, WS_V = 210 * MiB, WS_G = 276 * MiB, WS_O = 342 * MiB, WS_D = 408 * MiB, WS_DP = 474 * MiB, WS_END = 482 * MiB;
constexpr size_t WS_U = WS_Q, WS_VB = WS_LF, WS_Z = WS_V, WS_H1F = WS_G;
static_assert(WS_LF - WS_Q == pg8::SEC_STRIDE * 2 && WS_V - WS_LF == pg8::SEC_STRIDE * 2 && WS_G - WS_V == pg8::SEC_STRIDE * 2 && WS_O - WS_G == pg8::SEC_STRIDE * 2, "section stride");
constexpr size_t OUT_Y = 0, OUT_HP = 17301504, OUT_HS = 19398656, OUT_CV = 52953088;
constexpr int LDS_BYTES = 131072 + 1024;
constexpr size_t WS_BAR = 32 * 1024;

__device__ __forceinline__ unsigned pkbf(float lo, float hi) { return pg8::cvt_pk_bf16(lo, hi); }
__device__ __forceinline__ float bf_lo(unsigned w) { return __builtin_bit_cast(float, w << 16); }
__device__ __forceinline__ float bf_hi(unsigned w) { return __builtin_bit_cast(float, w & 0xffff0000u); }
__device__ __forceinline__ float wave_sum(float v) {
#pragma unroll
    for (int o = 1; o < 64; o <<= 1) v += __shfl_xor(v, o);
    return v;
}
#define LDS_WAIT() asm volatile("s_waitcnt lgkmcnt(0)" ::: "memory")

__device__ __forceinline__ void p0_transpose_item(const float* W, int K, int N, bf16* WT, LAS float* scr, int item, int lane, bool gmlp = false) {
    const int nblk = N / 32, kb = item / nblk, nb = item % nblk, k0 = 64 * kb, nd = 32 * nb;
    int n0 = nd;
    if (gmlp) { if (nd < 4096) { const int tile = nd >> 8, half = (nd >> 7) & 1, cc = nd & 127; n0 = (half ? 4096 : 0) + tile * 128 + cc; } else n0 = 2048 + (nd - 4096); }
    float wv[32];
#pragma unroll
    for (int i = 0; i < 32; ++i) { const int kk = 2 * i + (lane >> 5); wv[i] = __builtin_nontemporal_load(W + (size_t)(k0 + kk) * N + n0 + (lane & 31)); }
#pragma unroll
    for (int i = 0; i < 32; ++i) { const int kk = 2 * i + (lane >> 5); scr[kk * 33 + (lane & 31)] = wv[i]; }
    LDS_WAIT(); asm volatile("" ::: "memory");
    const int c = lane & 7;
#pragma unroll
    for (int j = 0; j < 4; ++j) { const int n = (lane >> 3) + 8 * j; const LAS float* s = scr + (8 * c) * 33 + n;
        v4u o; o.x = pkbf(s[0 * 33], s[1 * 33]); o.y = pkbf(s[2 * 33], s[3 * 33]); o.z = pkbf(s[4 * 33], s[5 * 33]); o.w = pkbf(s[6 * 33], s[7 * 33]);
        *(v4u*)(WT + (size_t)(nd + n) * K + k0 + 8 * c) = o; }
    LDS_WAIT(); asm volatile("" ::: "memory");
}

typedef GAS unsigned gu32;
#define XB_TMO      128
#define XB_XCNT(j)  (256  + 64 * (j))
#define XB_XSUB(j)  (1280 + 64 * (j))
#define XB_XGEN(j)  (2304 + 64 * (j))
#define XB_TOP      3328
#define XB_TOPGEN   3392
#define XCD_BAR_WORDS 3456
#define XB_SPIN_CAP (1u << 18)

__device__ __forceinline__ unsigned xb_ld(unsigned* p)              { return __hip_atomic_load(p, __ATOMIC_RELAXED, __HIP_MEMORY_SCOPE_AGENT); }
__device__ __forceinline__ unsigned xb_add(unsigned* p, unsigned v) { return __hip_atomic_fetch_add(p, v, __ATOMIC_RELAXED, __HIP_MEMORY_SCOPE_AGENT); }
__device__ __forceinline__ unsigned xb_xcc_id() { return (unsigned)__builtin_amdgcn_s_getreg((3 << 11) | 20) & 0xFu; }
#define XB_SPIN(cond, bar) do { unsigned _sp = 0; while (cond) { __builtin_amdgcn_s_sleep(1); \
    if ((++_sp & 255u) == 0u) { if (xb_ld(&(bar)[XB_TMO])) break; if (_sp > XB_SPIN_CAP) { atomicAdd(&(bar)[XB_TMO], 1u); break; } } } } while (0)

struct XcdBarrier {
    unsigned* bar; unsigned x;
    volatile LAS unsigned* st;
};

__device__ __forceinline__ XcdBarrier xcd_barrier_post(unsigned* bar, volatile LAS unsigned* st) {
    XcdBarrier b; b.bar = bar; b.x = xb_xcc_id(); b.st = st;
    if (threadIdx.x == 0) (void)xb_add(&bar[XB_XCNT(b.x)], 1u);
    return b;
}
__device__ __forceinline__ void xcd_barrier_complete(unsigned* bar, unsigned x, unsigned& nloc, unsigned& nx) {
    const unsigned G = gridDim.x * gridDim.y * gridDim.z;
    unsigned sum, cnt, mine, sp = 0u;
    for (;;) {
        sum = 0u; cnt = 0u; mine = 0u;
#pragma unroll
        for (unsigned j = 0; j < 16; ++j) { const unsigned c = xb_ld(&bar[XB_XCNT(j)]); sum += c; cnt += (c > 0u) ? 1u : 0u; mine = (j == x) ? c : mine; }
        if (sum == G) break;
        __builtin_amdgcn_s_sleep(1);
        if ((++sp & 255u) == 0u) { if (xb_ld(&bar[XB_TMO])) break; if (sp > XB_SPIN_CAP) { atomicAdd(&bar[XB_TMO], 1u); break; } }
    }
    nloc = mine > 0u ? mine : 1u; nx = cnt > 0u ? cnt : 1u;
}

__device__ __forceinline__ void xcd_barrier(const XcdBarrier& b) {
    asm volatile("s_waitcnt vmcnt(0)" ::: "memory");
    __syncthreads();
    if (threadIdx.x == 0) {
        unsigned* bar = b.bar;
        __builtin_amdgcn_s_waitcnt(0);
        unsigned nloc = b.st[0], nx = b.st[1];
        if (nloc == 0u) { xcd_barrier_complete(bar, b.x, nloc, nx); b.st[0] = nloc; b.st[1] = nx; }
        const unsigned old = xb_add(&bar[XB_XSUB(b.x)], 1u);
        const unsigned gen = old / nloc;
        if (old + 1u == (gen + 1u) * nloc) {
            __builtin_amdgcn_fence(__ATOMIC_RELEASE, "agent");
            asm volatile("s_waitcnt vmcnt(0)" ::: "memory");
            const unsigned og = xb_add(&bar[XB_TOP], 1u);
            const unsigned tg = og / nx;
            if (og + 1u == (tg + 1u) * nx) xb_add(&bar[XB_TOPGEN], 1u);
            else XB_SPIN(xb_ld(&bar[XB_TOPGEN]) == tg, bar);
            __builtin_amdgcn_fence(__ATOMIC_ACQUIRE, "agent");
            xb_add(&bar[XB_XGEN(b.x)], 1u);
            asm volatile("s_waitcnt vmcnt(0)" ::: "memory");
        } else {
            XB_SPIN(xb_ld(&bar[XB_XGEN(b.x)]) == gen, bar);
            __builtin_amdgcn_fence(__ATOMIC_ACQUIRE, "agent");
            asm volatile("s_waitcnt vmcnt(0)" ::: "memory");
        }
    }
    __syncthreads();
}

struct Ptrs {
    const float *xp, *xs, *state, *w_in_a, *lb_logits, *gnorm, *w_out_a, *w_in_b, *lnv_g, *lnv_b, *w_s, *b_s, *w_out_b, *ln_g, *ln_b;
    float* out; unsigned char* ws;
};

__device__ __forceinline__ void p0_prologue(const Ptrs& P, LAS unsigned char* lds) {
    const int tid = threadIdx.x, lane = tid & 63, wave = __builtin_amdgcn_readfirstlane(tid >> 6);
    LAS float* scr = (LAS float*)(lds + wave * 16384);
    const int gw = blockIdx.x * 8 + wave, NGW = gridDim.x * 8;
    constexpr int I_A = (DM / 64) * (4 * EA / 32), I_OA = (EA / 64) * (DM / 32), I_B = (DM / 64) * (3 * EA / 32), I_OB = I_OA, NITEMS = I_A + I_OA + I_B + I_OB;
    for (int it = gw; it < NITEMS; it += NGW) {
        int r = it;
        if (r < I_A) { p0_transpose_item(P.w_in_a, DM, 4 * EA, (bf16*)(P.ws + WS_WINA), scr, r, lane); continue; } r -= I_A;
        if (r < I_OA) { p0_transpose_item(P.w_out_a, EA, DM, (bf16*)(P.ws + WS_WOUTA), scr, r, lane); continue; } r -= I_OA;
        if (r < I_B) { p0_transpose_item(P.w_in_b, DM, 3 * EA, (bf16*)(P.ws + WS_WINB), scr, r, lane, true); continue; } r -= I_B;
        p0_transpose_item(P.w_out_b, EA, DM, (bf16*)(P.ws + WS_WOUTB), scr, r, lane);
    }
    const size_t gtid = (size_t)blockIdx.x * 512 + tid, GT = (size_t)gridDim.x * 512;
    {
        const f32x4* xp4 = (const f32x4*)P.xp; const f32x4* xs4 = (const f32x4*)P.xs; v2u* xb = (v2u*)(P.ws + WS_XB);
        constexpr size_t NP4 = (size_t)MP * DM / 4, NT4 = (size_t)MT * DM / 4;
        for (size_t q = gtid; q < NT4; q += 4 * GT) { f32x4 v[4];
#pragma unroll
            for (int k = 0; k < 4; ++k) { size_t qq = q + k * GT; qq = qq < NT4 ? qq : NT4 - 1; v[k] = __builtin_nontemporal_load(qq < NP4 ? xp4 + qq : xs4 + (qq - NP4)); }
#pragma unroll
            for (int k = 0; k < 4; ++k) { const size_t qq = q + k * GT; if (qq < NT4) { v2u o; o.x = pkbf(v[k].x, v[k].y); o.y = pkbf(v[k].z, v[k].w); xb[qq] = o; } } }
    }
    {
        const f32x4* w4 = (const f32x4*)P.w_s; v2u* wb = (v2u*)(P.ws + WS_WSB);
        for (size_t q = gtid; q < (size_t)16 * 128 * 128 / 4; q += GT) { const int e = (int)(q * 4), s = e & 127, t = (e >> 7) & 127; const f32x4 v = w4[q];
            v2u o; o.x = pkbf(s <= t ? v.x : 0.f, s + 1 <= t ? v.y : 0.f); o.y = pkbf(s + 2 <= t ? v.z : 0.f, s + 3 <= t ? v.w : 0.f); wb[q] = o; }
    }
    if (gtid < 2048) { float* lb = (float*)(P.ws + WS_LB); lb[gtid] = 1.0f / (1.0f + expf(P.lb_logits[2048 + gtid] - P.lb_logits[gtid])); }
    if (gtid < 4) { ((unsigned*)(P.ws + WS_CTL))[64 * gtid] = 0u; }
}

struct OneUnit {
    pg8::Unit u0;
    __device__ __forceinline__ bool next(int i, pg8::Unit& u) const { if (i != 0) return false; u = u0; return true; }
    __device__ __forceinline__ void a_ready(const pg8::Unit&) const {}
    __device__ __forceinline__ void done(const pg8::Unit&) const {}
};
template <bool FINAL, int NR, bool PARTS = false>
__device__ __forceinline__ void ln_rows(const Ptrs& P, const f32x4* g4, const f32x4* b4, int mbase, int mstride, int mend, int lane) {
    const bf16* D = (const bf16*)(P.ws + WS_D); bf16* H1B = (bf16*)(P.ws + WS_XB);
    f32x4 v[NR][4]; float s[NR];
#pragma unroll
    for (int k = 0; k < NR; ++k) { int m = mbase + k * mstride; m = m < mend ? m : mend - 1;
        f32x4 x[4];
        if (FINAL) { const v2u* h4 = (const v2u*)(H1B + (size_t)m * DM);
#pragma unroll
            for (int j = 0; j < 4; ++j) { const v2u r = __builtin_nontemporal_load(h4 + 64 * j + lane); x[j].x = bf_lo(r.x); x[j].y = bf_hi(r.x); x[j].z = bf_lo(r.y); x[j].w = bf_hi(r.y); } }
        else { const f32x4* x4 = (const f32x4*)(m < MP ? P.xp + (size_t)m * DM : P.xs + (size_t)(m - MP) * DM);
#pragma unroll
            for (int j = 0; j < 4; ++j) x[j] = __builtin_nontemporal_load(x4 + 64 * j + lane); }
        if (PARTS) { const f32x4* d4 = (const f32x4*)(P.ws + WS_DP) + (size_t)(m - MP) * (DM / 4);
#pragma unroll
            for (int j = 0; j < 4; ++j) v[k][j] = x[j] * ALPHA + ((d4[64 * j + lane] + d4[64 * j + lane + 512 * DM / 4]) + (d4[64 * j + lane + 2 * 512 * DM / 4] + d4[64 * j + lane + 3 * 512 * DM / 4])); }
        else { const v2u* d4 = (const v2u*)(D + (size_t)m * DM);
#pragma unroll
            for (int j = 0; j < 4; ++j) { const v2u r = __builtin_nontemporal_load(d4 + 64 * j + lane); f32x4 d; d.x = bf_lo(r.x); d.y = bf_hi(r.x); d.z = bf_lo(r.y); d.w = bf_hi(r.y); v[k][j] = x[j] * ALPHA + d; } } }
#pragma unroll
    for (int k = 0; k < NR; ++k) { s[k] = 0.f;
#pragma unroll
        for (int j = 0; j < 4; ++j) s[k] += (v[k][j].x + v[k][j].y) + (v[k][j].z + v[k][j].w); }
#pragma unroll
    for (int o = 1; o < 64; o <<= 1) {
#pragma unroll
        for (int k = 0; k < NR; ++k) s[k] += __shfl_xor(s[k], o); }
#pragma unroll
    for (int k = 0; k < NR; ++k) { const float mean = s[k] * (1.0f / DM); s[k] = 0.f;
#pragma unroll
        for (int j = 0; j < 4; ++j) { v[k][j] = v[k][j] - mean; s[k] += (v[k][j].x * v[k][j].x + v[k][j].y * v[k][j].y) + (v[k][j].z * v[k][j].z + v[k][j].w * v[k][j].w); } }
#pragma unroll
    for (int o = 1; o < 64; o <<= 1) {
#pragma unroll
        for (int k = 0; k < NR; ++k) s[k] += __shfl_xor(s[k], o); }
#pragma unroll
    for (int j = 0; j < 4; ++j) { const f32x4 gg = g4[64 * j + lane], bb = b4[64 * j + lane];
#pragma unroll
        for (int k = 0; k < NR; ++k) { const int m = mbase + k * mstride; if (m < mend) { const float rstd = __builtin_amdgcn_rsqf(s[k] * (1.0f / DM) + LN_EPS); const f32x4 y = v[k][j] * rstd * gg + bb;
            if (FINAL) { __builtin_nontemporal_store(y, (f32x4*)(P.out + OUT_Y + (size_t)m * DM) + 64 * j + lane); }
            else { v2u o; o.x = pkbf(y.x, y.y); o.y = pkbf(y.z, y.w); ((v2u*)(H1B + (size_t)m * DM))[64 * j + lane] = o; } } } }
}
template <bool FINAL>
__device__ __forceinline__ void ln_phase(const Ptrs& P, LAS unsigned char* lds, int layer) {
    const int tid = threadIdx.x, lane = tid & 63, wave = tid >> 6;
    const int G = (int)gridDim.x, bx = (int)blockIdx.x;
    const f32x4* g4 = (const f32x4*)(P.ln_g + layer * DM); const f32x4* b4 = (const f32x4*)(P.ln_b + layer * DM);
    if (G <= 32) {
        for (int m = bx * 8 + wave; m < MT; m += G * 8) ln_rows<FINAL, 1>(P, g4, b4, m, 0, MT, lane);
        return;
    }
    if (bx < 32) {
        unsigned* cnt = (unsigned*)(P.ws + WS_CTL) + 64 * (2 + layer);
        const int unit = bx >> 2, ks = bx & 3;
        pg8::Gemm g{(const bf16*)(P.ws + WS_O) + ks * 512, (const bf16*)(P.ws + (FINAL ? WS_WOUTB : WS_WOUTA)) + ks * 512, MT, DM, EA, 8};
        OneUnit S; S.u0.pm = MP / 256 + (unit >> 2); S.u0.pn = unit & 3;
        pg8::EpiF32 E{(float*)(P.ws + WS_DP) + (size_t)ks * 512 * DM - (size_t)MP * DM, DM};
        pg8::gemm_phase<pg8::EpiF32, OneUnit, true, true>(lds, g, S, E);
        asm volatile("s_waitcnt vmcnt(0)" ::: "memory");
        __syncthreads();
        if (tid == 0) {
            __builtin_amdgcn_fence(__ATOMIC_RELEASE, "agent"); asm volatile("s_waitcnt vmcnt(0)" ::: "memory");
            __hip_atomic_fetch_add(cnt, 1u, __ATOMIC_RELAXED, __HIP_MEMORY_SCOPE_AGENT);
            while (__hip_atomic_load(cnt, __ATOMIC_RELAXED, __HIP_MEMORY_SCOPE_AGENT) < 32u) __builtin_amdgcn_s_sleep(4);
            __builtin_amdgcn_fence(__ATOMIC_ACQUIRE, "agent"); asm volatile("s_waitcnt vmcnt(0)" ::: "memory");
        }
        __syncthreads();
        __builtin_amdgcn_fence(__ATOMIC_ACQUIRE, "agent");
        ln_rows<FINAL, 2, true>(P, g4, b4, MP + bx * 16 + wave * 2, 1, MT, lane);
    } else {
        const int nw = (G - 32) * 8;
        for (int m = (bx - 32) * 8 + wave; m < MP; m += 3 * nw) ln_rows<FINAL, 3>(P, g4, b4, m, nw, MP, lane);
    }
}

#define MFMA16(a, b, c) __builtin_amdgcn_mfma_f32_16x16x32_bf16((a), (b), (c), 0, 0, 0)
__device__ __forceinline__ void hgrn_unit(LAS unsigned char* lds, const bf16* Q, const bf16* LF, const bf16* V, const bf16* G, bf16* O, const float* gnorm,
                                          int m0, int h, float* s_out, int nb, int ne, bool store_state) {
    const int tid = threadIdx.x, lane = tid & 63, wid = __builtin_amdgcn_readfirstlane(tid >> 6);
    const int i = lane & 15, g = lane >> 4, wq = wid & 3, hc = h * 128;
    constexpr int SQ = 136, SK = 72, nch = 32;
    LAS unsigned char* QD = lds; LAS unsigned char* KI = lds + 17408; LAS unsigned char* KET = lds + 34816; LAS unsigned char* VT = lds + 53248; LAS unsigned char* ST = lds + 71680;
    LAS float* DEC = (LAS float*)(lds + 106496); LAS float* GN = (LAS float*)(lds + 111104);
    if (tid < 128) GN[tid] = gnorm[hc + tid];
    if (wid < 4) {
        const int t0 = 16 * wid;
        v2u gq_n[8], gq_c[8], po[8];
        const bf16* gp = G + ((size_t)h * MT + (size_t)(m0 + t0 + i)) * 128 + 4 * g;
        bf16* orow = O + (size_t)(m0 + t0 + i) * 2048 + hc + 4 * g;
        bf16* prow = orow;
#define LOAD_GATE(nn) do { const int nc_ = (nn) < nch ? (nn) : nch - 1; const bf16* gb_ = gp + (size_t)nc_ * 8192; \
        _Pragma("unroll") for (int vt = 0; vt < 8; ++vt) gq_n[vt] = __builtin_nontemporal_load((const v2u*)(gb_ + 16 * vt)); } while (0)
#define STORE_PREV() do { _Pragma("unroll") for (int vt = 0; vt < 8; ++vt) *(v2u*)(prow + 16 * vt) = po[vt]; } while (0)
        LOAD_GATE(nb);
        for (int n = 0; n < ne; ++n) {
            if (n < nb) { __syncthreads(); __syncthreads(); continue; }
            int i_ = i, g_ = g; asm volatile("" : "+v"(i_), "+v"(g_));
#pragma unroll
            for (int vt = 0; vt < 8; ++vt) gq_c[vt] = gq_n[vt];
            if (n > nb) STORE_PREV();
            LOAD_GATE(n + 1);
            __syncthreads();
            {
                bf16x8 bq[4];
#pragma unroll
                for (int kk = 0; kk < 4; ++kk) bq[kk] = *(const LAS bf16x8*)(QD + ((t0 + i_) * SQ + 32 * kk + 8 * g_) * 2);
                bf16x8 pc[2];
                {
                    f32x4 sT[4];
#pragma unroll
                    for (int st = 0; st < 4; ++st) {
                        f32x4 a4 = (f32x4){0.f, 0.f, 0.f, 0.f};
#pragma unroll
                        for (int kk = 0; kk < 4; ++kk) { const bf16x8 a = *(const LAS bf16x8*)(KI + ((16 * st + i_) * SQ + 32 * kk + 8 * g_) * 2); a4 = MFMA16(a, bq[kk], a4); }
#pragma unroll
                        for (int r = 0; r < 4; ++r) if (16 * st + 4 * g_ + r > t0 + i_) a4[r] = 0.f;
                        sT[st] = a4;
                    }
#pragma unroll
                    for (int c = 0; c < 2; ++c) { v4u w; w.x = pkbf(sT[2 * c][0], sT[2 * c][1]); w.y = pkbf(sT[2 * c][2], sT[2 * c][3]); w.z = pkbf(sT[2 * c + 1][0], sT[2 * c + 1][1]); w.w = pkbf(sT[2 * c + 1][2], sT[2 * c + 1][3]);
                        pc[c] = __builtin_bit_cast(bf16x8, w); }
                }
                f32x4 oa[8]; float ss = 0.f;
#pragma unroll
                for (int vt = 0; vt < 8; ++vt) {
                    f32x4 acc = (f32x4){0.f, 0.f, 0.f, 0.f};
#pragma unroll
                    for (int c = 0; c < 2; ++c) {
                        const v2u lo = *(const LAS v2u*)(VT + ((16 * vt + i_) * SK + 32 * c + 4 * g_) * 2), hi = *(const LAS v2u*)(VT + ((16 * vt + i_) * SK + 32 * c + 16 + 4 * g_) * 2);
                        v4u w; w.x = lo.x; w.y = lo.y; w.z = hi.x; w.w = hi.y; acc = MFMA16(__builtin_bit_cast(bf16x8, w), pc[c], acc); }
#pragma unroll
                    for (int kk = 0; kk < 4; ++kk) { const bf16x8 a = *(const LAS bf16x8*)(ST + ((16 * vt + i_) * SQ + 32 * kk + 8 * g_) * 2); acc = MFMA16(a, bq[kk], acc); }
                    oa[vt] = acc; ss += (acc[0] * acc[0] + acc[1] * acc[1]) + (acc[2] * acc[2] + acc[3] * acc[3]);
                }
                ss += __shfl_xor(ss, 16); ss += __shfl_xor(ss, 32);
                const float sc = __builtin_amdgcn_rsqf(ss * (1.0f / 128.0f) + LN_EPS);
#pragma unroll
                for (int vt = 0; vt < 8; ++vt) { const v2u gg = gq_c[vt]; const f32x4 gn = *(const LAS f32x4*)(GN + 16 * vt + 4 * g_) * sc;
                    po[vt].x = pkbf(oa[vt][0] * gn[0] * bf_lo(gg.x), oa[vt][1] * gn[1] * bf_hi(gg.x)); po[vt].y = pkbf(oa[vt][2] * gn[2] * bf_lo(gg.y), oa[vt][3] * gn[3] * bf_hi(gg.y)); }
                prow = orow + (size_t)n * (64 * 2048);
            }
            __syncthreads();
        }
        STORE_PREV();
#undef STORE_PREV
#undef LOAD_GATE
    } else {
        const int cp = i, rg = g, c0 = 32 * wq + 2 * cp;
        const size_t pofs = ((size_t)h * MT + (size_t)(m0 + 16 * rg)) * 128 + c0;
        const bf16* qp = Q + pofs; const bf16* lp = LF + pofs; const bf16* vp = V + pofs;
        unsigned rq[16], rl[16], rv[16];
        unsigned sq[16], sk[16], ske0[8], ske1[8]; float det0, det1;
#define LOAD_RAW(nn) do { const int nc_ = (nn) < nch ? (nn) : nch - 1; const bf16* qb_ = qp + (size_t)nc_ * 8192; const bf16* lb_ = lp + (size_t)nc_ * 8192; const bf16* vb_ = vp + (size_t)nc_ * 8192; \
        _Pragma("unroll") for (int r = 0; r < 16; ++r) { rl[r] = *(const unsigned*)(lb_ + r * 128); rq[r] = *(const unsigned*)(qb_ + r * 128); } (void)vb_; } while (0)
#define LOAD_V(nn) do { const int nc_ = (nn) < nch ? (nn) : nch - 1; const bf16* vb_ = vp + (size_t)nc_ * 8192; _Pragma("unroll") for (int r = 0; r < 16; ++r) rv[r] = *(const unsigned*)(vb_ + r * 128); } while (0)
#define PREP_REGS() do { \
        float su0 = 0.f, su1 = 0.f; \
        _Pragma("unroll") for (int r = 0; r < 16; ++r) { const f16x2 hh = __builtin_bit_cast(f16x2, rl[r]); su0 += (float)hh.x; su1 += (float)hh.y; } \
        float off0 = 0.f, off1 = 0.f, tot0 = 0.f, tot1 = 0.f; \
        _Pragma("unroll") for (int j = 0; j < 4; ++j) { const float a_ = __shfl(su0, cpx + 16 * j), b_ = __shfl(su1, cpx + 16 * j); if (j < rgx) { off0 += a_; off1 += b_; } tot0 += a_; tot1 += b_; } \
        const float et0 = __expf(tot0), et1 = __expf(tot1); float p0 = __expf(off0), p1 = __expf(off1); det0 = et0; det1 = et1; \
        float kp0 = 0.f, kp1 = 0.f; \
        _Pragma("unroll") for (int r = 0; r < 16; ++r) { const f16x2 hh = __builtin_bit_cast(f16x2, rl[r]); const float f0 = __expf((float)hh.x), f1 = __expf((float)hh.y); \
            p0 *= f0; p1 *= f1; \
            const float ki0 = (1.0f - f0) * __builtin_amdgcn_rcpf(p0), ki1 = (1.0f - f1) * __builtin_amdgcn_rcpf(p1); const float ke0 = ki0 * et0, ke1 = ki1 * et1; \
            sq[r] = pkbf(bf_lo(rq[r]) * p0, bf_hi(rq[r]) * p1); sk[r] = pkbf(ki0, ki1); \
            if (r & 1) { ske0[r >> 1] = pkbf(kp0, ke0); ske1[r >> 1] = pkbf(kp1, ke1); } \
            kp0 = ke0; kp1 = ke1; } } while (0)
#define DUMP_REGS() do { \
        _Pragma("unroll") for (int r = 0; r < 16; ++r) { *(LAS unsigned*)(QD + ((16 * rgx + r) * SQ + c0x) * 2) = sq[r]; *(LAS unsigned*)(KI + ((16 * rgx + r) * SQ + c0x) * 2) = sk[r]; } \
        { v4u w_; w_.x = ske0[0]; w_.y = ske0[1]; w_.z = ske0[2]; w_.w = ske0[3]; *(LAS v4u*)(KET + (c0x * SK + 16 * rgx) * 2) = w_; w_.x = ske0[4]; w_.y = ske0[5]; w_.z = ske0[6]; w_.w = ske0[7]; *(LAS v4u*)(KET + (c0x * SK + 16 * rgx + 8) * 2) = w_; \
          w_.x = ske1[0]; w_.y = ske1[1]; w_.z = ske1[2]; w_.w = ske1[3]; *(LAS v4u*)(KET + ((c0x + 1) * SK + 16 * rgx) * 2) = w_; w_.x = ske1[4]; w_.y = ske1[5]; w_.z = ske1[6]; w_.w = ske1[7]; *(LAS v4u*)(KET + ((c0x + 1) * SK + 16 * rgx + 8) * 2) = w_; \
          _Pragma("unroll") for (int hh_ = 0; hh_ < 2; ++hh_) { \
            w_.x = (rv[8 * hh_ + 0] & 0xffffu) | (rv[8 * hh_ + 1] << 16); w_.y = (rv[8 * hh_ + 2] & 0xffffu) | (rv[8 * hh_ + 3] << 16); w_.z = (rv[8 * hh_ + 4] & 0xffffu) | (rv[8 * hh_ + 5] << 16); w_.w = (rv[8 * hh_ + 6] & 0xffffu) | (rv[8 * hh_ + 7] << 16); \
            *(LAS v4u*)(VT + (c0x * SK + 16 * rgx + 8 * hh_) * 2) = w_; \
            w_.x = (rv[8 * hh_ + 0] >> 16) | (rv[8 * hh_ + 1] & 0xffff0000u); w_.y = (rv[8 * hh_ + 2] >> 16) | (rv[8 * hh_ + 3] & 0xffff0000u); w_.z = (rv[8 * hh_ + 4] >> 16) | (rv[8 * hh_ + 5] & 0xffff0000u); w_.w = (rv[8 * hh_ + 6] >> 16) | (rv[8 * hh_ + 7] & 0xffff0000u); \
            *(LAS v4u*)(VT + ((c0x + 1) * SK + 16 * rgx + 8 * hh_) * 2) = w_; } } \
        if (rgx == 0) { f32x2 p_; p_.x = det0; p_.y = det1; *(LAS f32x2*)(DEC + c0x) = p_; } } while (0)
        f32x4 S[8][2];
#define WRITE_ST() do { _Pragma("unroll") for (int kt = 0; kt < 8; ++kt) _Pragma("unroll") for (int j = 0; j < 2; ++j) { v2u w_; w_.x = pkbf(S[kt][j][0], S[kt][j][1]); w_.y = pkbf(S[kt][j][2], S[kt][j][3]); \
        *(LAS v2u*)(ST + ((16 * (2 * wq + j) + i) * SQ + 16 * kt + 4 * g) * 2) = w_; } } while (0)
#pragma unroll
        for (int kt = 0; kt < 8; ++kt)
#pragma unroll
            for (int j = 0; j < 2; ++j) S[kt][j] = (f32x4){0.f, 0.f, 0.f, 0.f};
        LOAD_RAW(0); LOAD_V(0);
        WRITE_ST();
        { const int cpx = cp, rgx = rg, c0x = c0; PREP_REGS(); (void)c0x; }
        LOAD_RAW(1);
        for (int n = 0; n < ne; ++n) {
            int i_ = i, g_ = g; asm volatile("" : "+v"(i_), "+v"(g_));
            const int cpx = i_, rgx = g_, c0x = 32 * wq + 2 * i_;
            DUMP_REGS();
            asm volatile("" ::: "memory");
            LOAD_V(n + 1);
            __syncthreads();
            {
                bf16x8 bv[2][2];
#pragma unroll
                for (int j = 0; j < 2; ++j)
#pragma unroll
                    for (int c = 0; c < 2; ++c) bv[j][c] = *(const LAS bf16x8*)(VT + ((16 * (2 * wq + j) + i_) * SK + 32 * c + 8 * g_) * 2);
#pragma unroll
                for (int kt = 0; kt < 8; ++kt) {
                    const f32x4 d = *(const LAS f32x4*)(DEC + 16 * kt + 4 * g_);
                    const bf16x8 a0 = *(const LAS bf16x8*)(KET + ((16 * kt + i_) * SK + 8 * g_) * 2), a1 = *(const LAS bf16x8*)(KET + ((16 * kt + i_) * SK + 32 + 8 * g_) * 2);
#pragma unroll
                    for (int j = 0; j < 2; ++j) { f32x4 acc = S[kt][j] * d; acc = MFMA16(a0, bv[j][0], acc); acc = MFMA16(a1, bv[j][1], acc); S[kt][j] = acc; }
                }
            }
            PREP_REGS();
            LOAD_RAW(n + 2);
            __syncthreads();
            WRITE_ST();
        }
        if (store_state) {
            float* op = s_out + (4 * g) * 128 + 32 * wq + i;
#pragma unroll
            for (int kt = 0; kt < 8; ++kt) {
#pragma unroll
                for (int j = 0; j < 2; ++j)
#pragma unroll
                    for (int r = 0; r < 4; ++r) __builtin_nontemporal_store(S[kt][j][r], op + r * 128 + 16 * j);
                op += 2048; asm volatile("" : "+v"(op));
            }
        }
#undef WRITE_ST
#undef DUMP_REGS
#undef PREP_REGS
#undef LOAD_RAW
#undef LOAD_V
    }
}

__device__ __forceinline__ void hgrn_sample_units(LAS unsigned char* lds, const bf16* Q, const bf16* LF, const bf16* V, const bf16* G, bf16* O, const float* gnorm,
                                                  const float* state, float* out_hs, int su0, int stride) {
    int tid_ = threadIdx.x; asm volatile("" : "+v"(tid_));
    const int tid = tid_, lane = tid & 63, wid = tid >> 6, kr = tid >> 5, vc = tid & 31;
    LAS float* SQv = (LAS float*)lds; LAS float* SFv = SQv + 512; LAS float* SKv = SQv + 1024; LAS float* SVv = SQv + 1536; LAS float* RED = SQv + 2048;
    if (su0 >= 2048) return;
    f32x4 S[8], Sn[8]; unsigned short nq, nl, nv;
    const int tt = tid >> 7, tk = tid & 127;
#define SU_LOAD(su_) do { const int b_ = (su_) >> 4, h_ = (su_) & 15; const f32x4* sp_ = (const f32x4*)(state + (size_t)(su_) * 16384 + kr * 128 + 4 * vc); \
        _Pragma("unroll") for (int p = 0; p < 8; ++p) Sn[p] = __builtin_nontemporal_load(sp_ + p * 512); \
        const size_t idx_ = ((size_t)h_ * MT + (size_t)(MP + 4 * b_ + tt)) * 128 + tk; nq = Q[idx_]; nl = LF[idx_]; nv = V[idx_]; } while (0)
    SU_LOAD(su0);
    for (int su = su0; su < 2048; su += stride) {
        const int b = su >> 4, h = su & 15;
#pragma unroll
        for (int p = 0; p < 8; ++p) S[p] = Sn[p];
        { const float q = __builtin_bit_cast(float, (unsigned)nq << 16), v = __builtin_bit_cast(float, (unsigned)nv << 16);
          const float f = __expf((float)__builtin_bit_cast(_Float16, nl));
          SQv[tid] = q; SFv[tid] = f; SKv[tid] = 1.0f - f; SVv[tid] = v; }
        { const int sn = (su + stride) < 2048 ? (su + stride) : su; SU_LOAD(sn); }
        __syncthreads();
        f32x4 o[4];
#pragma unroll
        for (int t = 0; t < 4; ++t) {
            const f32x4 vv = *(const LAS f32x4*)(SVv + t * 128 + 4 * vc); f32x4 acc = (f32x4){0.f, 0.f, 0.f, 0.f};
#pragma unroll
            for (int p = 0; p < 8; ++p) { const int k = t * 128 + kr + 16 * p; const float f = SFv[k], kn = SKv[k], q = SQv[k]; S[p] = S[p] * f + vv * kn; acc += S[p] * q; }
            o[t] = acc;
        }
        { f32x4* op = (f32x4*)(out_hs + (size_t)su * 16384 + kr * 128 + 4 * vc);
#pragma unroll
          for (int p = 0; p < 8; ++p) __builtin_nontemporal_store(S[p], op + p * 512); }
#pragma unroll
        for (int t = 0; t < 4; ++t) { o[t].x += __shfl_xor(o[t].x, 32); o[t].y += __shfl_xor(o[t].y, 32); o[t].z += __shfl_xor(o[t].z, 32); o[t].w += __shfl_xor(o[t].w, 32); }
        if (lane < 32) {
#pragma unroll
            for (int t = 0; t < 4; ++t) *(LAS f32x4*)(RED + (wid * 4 + t) * 128 + 4 * vc) = o[t];
        }
        __syncthreads();
        if (wid < 4) {
            const int t = wid; float a0 = 0.f, a1 = 0.f;
#pragma unroll
            for (int w2 = 0; w2 < 8; ++w2) { a0 += RED[(w2 * 4 + t) * 128 + lane]; a1 += RED[(w2 * 4 + t) * 128 + lane + 64]; }
            const float ss = wave_sum(a0 * a0 + a1 * a1); const float sc = __builtin_amdgcn_rsqf(ss * (1.0f / 128.0f) + LN_EPS);
            const int row = MP + 4 * b + t; const size_t gi = ((size_t)h * MT + (size_t)row) * 128;
            const float g0 = __builtin_bit_cast(float, (unsigned)G[gi + lane] << 16), g1 = __builtin_bit_cast(float, (unsigned)G[gi + lane + 64] << 16);
            bf16* orow = O + (size_t)row * 2048 + h * 128;
            orow[lane] = (bf16)(pkbf(a0 * sc * gnorm[h * 128 + lane] * g0, 0.f) & 0xffffu); orow[lane + 64] = (bf16)(pkbf(a1 * sc * gnorm[h * 128 + lane + 64] * g1, 0.f) & 0xffffu);
        }
        __syncthreads();
    }
#undef SU_LOAD
}

__device__ __forceinline__ void hgrn_phase(const Ptrs& P, LAS unsigned char* lds, int ctr_idx) {
    const bf16* Q = (const bf16*)(P.ws + WS_Q); const bf16* LF = (const bf16*)(P.ws + WS_LF); const bf16* V = (const bf16*)(P.ws + WS_V); const bf16* G = (const bf16*)(P.ws + WS_G);
    bf16* O = (bf16*)(P.ws + WS_O);
    const int Gd = (int)gridDim.x, bx = (int)blockIdx.x;
    if (Gd >= 256) {
        constexpr int SPLIT = 12;
        if (bx < 256) { const int pu = bx & 127; const bool late = bx >= 128;
            hgrn_unit(lds, Q, LF, V, G, O, P.gnorm, (pu >> 4) * 2048, pu & 15, P.out + OUT_HP + (size_t)pu * 16384, late ? SPLIT : 0, late ? 32 : SPLIT, late); }
        if (bx < 128) hgrn_sample_units(lds, Q, LF, V, G, O, P.gnorm, P.state, P.out + OUT_HS, bx, 128);
    } else {
        const bool split = Gd > 128;
        if (!split || bx < 128) {
            for (int pu = bx; pu < 128; pu += (split ? 128 : Gd)) hgrn_unit(lds, Q, LF, V, G, O, P.gnorm, (pu >> 4) * 2048, pu & 15, P.out + OUT_HP + (size_t)pu * 16384, 0, 32, true);
        }
        if (!split || bx >= 128) { const int sid = split ? bx - 128 : bx, ns = split ? Gd - 128 : Gd; __syncthreads(); hgrn_sample_units(lds, Q, LF, V, G, O, P.gnorm, P.state, P.out + OUT_HS, sid, ns); }
    }
    (void)ctr_idx;
}

__device__ __forceinline__ void gate_phase(const Ptrs& P, LAS unsigned char* lds) {
    const int tid = threadIdx.x, lane = tid & 63, wid = __builtin_amdgcn_readfirstlane(tid >> 6);
    const int i = lane & 15, g = lane >> 4;
    constexpr int SW = 136;
    const bf16* U = (const bf16*)(P.ws + WS_U); const bf16* Vb = (const bf16*)(P.ws + WS_VB); bf16* GT = (bf16*)(P.ws + WS_O);
    const float* part = (const float*)(P.ws + WS_PART); const bf16* WSB = (const bf16*)(P.ws + WS_WSB);
    LAS unsigned char* WT = lds; LAS unsigned char* VNT = lds + 34816; LAS f32x2* STT = (LAS f32x2*)(lds + 69632);
    int cur_grp = -1;
    for (int u = blockIdx.x; u < 2048; u += gridDim.x) {
        const int grp = u & 15, m0 = (u >> 4) * 128;
        v2u uq[8]; float bq_[8];
        { const size_t og0 = ((size_t)grp * MT + (size_t)(m0 + i)) * 128 + 16 * wid + 4 * g;
#pragma unroll
          for (int tt = 0; tt < 8; ++tt) { uq[tt] = __builtin_nontemporal_load((const v2u*)(U + og0 + (size_t)tt * 16 * 128)); bq_[tt] = P.b_s[grp * 128 + 16 * tt + i]; } }
        __syncthreads();
        if (grp != cur_grp) {
#pragma unroll
            for (int it = 0; it < 4; ++it) { const int idx = tid + 512 * it, row = idx >> 4, c16 = idx & 15;
                *(LAS v4u*)(WT + (row * SW) * 2 + c16 * 16) = *(const v4u*)(WSB + (size_t)grp * 16384 + row * 128 + c16 * 8); }
            cur_grp = grp;
        }
        unsigned vraw[16];
#pragma unroll
        for (int r = 0; r < 16; ++r) vraw[r] = __builtin_nontemporal_load((const unsigned*)(Vb + ((size_t)grp * MT + (size_t)(m0 + 16 * wid + r)) * 128 + 2 * lane));
        if (tid < 128) { const f32x2* pr = (const f32x2*)(part + (size_t)(m0 + tid) * 64); float s = 0.f, ss = 0.f;
#pragma unroll
            for (int j = 0; j < 32; ++j) { const f32x2 p = pr[j]; s += p.x; ss += p.y; }
            const float mean = s * (1.0f / 2048.0f), var = ss * (1.0f / 2048.0f) - mean * mean; f32x2 o; o.x = mean; o.y = 1.0f / sqrtf(var + LN_EPS); STT[tid] = o; }
        __syncthreads();
        {
            const int c0 = grp * 128 + 2 * lane; const float g0 = P.lnv_g[c0], g1 = P.lnv_g[c0 + 1], b0 = P.lnv_b[c0], b1 = P.lnv_b[c0 + 1];
            float y0[16], y1[16];
#pragma unroll
            for (int r = 0; r < 16; ++r) { const int row = 16 * wid + r; const unsigned raw = vraw[r]; const f32x2 st = STT[row];
                y0[r] = (bf_lo(raw) - st.x) * st.y * g0 + b0; y1[r] = (bf_hi(raw) - st.x) * st.y * g1 + b1; }
#pragma unroll
            for (int hh = 0; hh < 2; ++hh) { v4u w0, w1;
                w0.x = pkbf(y0[8 * hh + 0], y0[8 * hh + 1]); w0.y = pkbf(y0[8 * hh + 2], y0[8 * hh + 3]); w0.z = pkbf(y0[8 * hh + 4], y0[8 * hh + 5]); w0.w = pkbf(y0[8 * hh + 6], y0[8 * hh + 7]);
                w1.x = pkbf(y1[8 * hh + 0], y1[8 * hh + 1]); w1.y = pkbf(y1[8 * hh + 2], y1[8 * hh + 3]); w1.z = pkbf(y1[8 * hh + 4], y1[8 * hh + 5]); w1.w = pkbf(y1[8 * hh + 6], y1[8 * hh + 7]);
                *(LAS v4u*)(VNT + ((2 * lane) * SW + 16 * wid + 8 * hh) * 2) = w0; *(LAS v4u*)(VNT + ((2 * lane + 1) * SW + 16 * wid + 8 * hh) * 2) = w1; }
        }
        __syncthreads();
        {
            bf16x8 av[4];
#pragma unroll
            for (int kk = 0; kk < 4; ++kk) av[kk] = *(const LAS bf16x8*)(VNT + ((16 * wid + i) * SW + 32 * kk + 8 * g) * 2);
#pragma unroll
            for (int tt = 0; tt < 8; ++tt) {
                f32x4 acc = (f32x4){0.f, 0.f, 0.f, 0.f};
#pragma unroll
                for (int kk = 0; kk < 4; ++kk) if (kk <= (tt >> 1)) { const bf16x8 b = *(const LAS bf16x8*)(WT + ((16 * tt + i) * SW + 32 * kk + 8 * g) * 2); acc = MFMA16(av[kk], b, acc); }
                const int t = 16 * tt + i; const float bias = bq_[tt];
                const size_t off = (size_t)(m0 + t) * 2048 + grp * 128 + 16 * wid + 4 * g;
                const v2u uu = uq[tt];
                v2u w; w.x = pkbf(bf_lo(uu.x) * (acc[0] + bias), bf_hi(uu.x) * (acc[1] + bias));
                w.y = pkbf(bf_lo(uu.y) * (acc[2] + bias), bf_hi(uu.y) * (acc[3] + bias));
                *(v2u*)(GT + off) = w;
            }
        }
    }
    for (int sb = (int)gridDim.x - 1 - (int)blockIdx.x; sb < 128; sb += gridDim.x) {
        __syncthreads();
        const int mrow = MP + 4 * sb;
        if (tid < 4) { const f32x2* pr = (const f32x2*)(part + (size_t)(mrow + tid) * 64); float s = 0.f, ss = 0.f;
            for (int j = 0; j < 32; ++j) { const f32x2 p = pr[j]; s += p.x; ss += p.y; }
            const float mean = s * (1.0f / 2048.0f), var = ss * (1.0f / 2048.0f) - mean * mean; f32x2 o; o.x = mean; o.y = 1.0f / sqrtf(var + LN_EPS); STT[tid] = o; }
        __syncthreads();
        const int c = 4 * tid, grp = c >> 7;
        const f32x4 lg = *(const f32x4*)(P.lnv_g + c), lb = *(const f32x4*)(P.lnv_b + c);
        f32x4 vn[4];
#pragma unroll
        for (int t = 0; t < 4; ++t) { const v2u raw = *(const v2u*)(Vb + ((size_t)grp * MT + (size_t)(mrow + t)) * 128 + (c & 127)); const f32x2 st = STT[t];
            f32x4 x; x.x = bf_lo(raw.x); x.y = bf_hi(raw.x); x.z = bf_lo(raw.y); x.w = bf_hi(raw.y);
            vn[t] = (x - st.x) * st.y * lg + lb;
            __builtin_nontemporal_store(vn[t], (f32x4*)(P.out + OUT_CV + (size_t)(4 * sb + t) * 2048 + c)); }
#pragma unroll
        for (int t = 0; t < 4; ++t) { const float bias = P.b_s[grp * 128 + t]; f32x4 mx = (f32x4){bias, bias, bias, bias};
#pragma unroll
            for (int s = 0; s < 4; ++s) if (s <= t) mx += vn[s] * P.w_s[(size_t)grp * 16384 + t * 128 + s];
            const size_t off = (size_t)(mrow + t) * 2048 + c; const size_t offg = ((size_t)grp * MT + (size_t)(mrow + t)) * 128 + (c & 127); const v2u uu = *(const v2u*)(U + offg);
            v2u w; w.x = pkbf(bf_lo(uu.x) * mx.x, bf_hi(uu.x) * mx.y); w.y = pkbf(bf_lo(uu.y) * mx.z, bf_hi(uu.y) * mx.w);
            *(v2u*)(GT + off) = w; }
    }
}

struct Args { const float* in[15]; float* out; unsigned char* ws; int ph_lo, ph_hi; };
__global__ void __launch_bounds__(512, 2) mk_fwd(Args a) {
    extern __shared__ __attribute__((aligned(16))) unsigned char lds_raw[];
    LAS unsigned char* lds = (LAS unsigned char*)lds_raw;
    Ptrs P;
    P.xp = a.in[0]; P.xs = a.in[1]; P.state = a.in[2]; P.w_in_a = a.in[3]; P.lb_logits = a.in[4]; P.gnorm = a.in[5]; P.w_out_a = a.in[6]; P.w_in_b = a.in[7];
    P.lnv_g = a.in[8]; P.lnv_b = a.in[9]; P.w_s = a.in[10]; P.b_s = a.in[11]; P.w_out_b = a.in[12]; P.ln_g = a.in[13]; P.ln_b = a.in[14]; P.out = a.out; P.ws = a.ws;
    const int lo = a.ph_lo, hi = a.ph_hi;
    volatile LAS unsigned* bst = (volatile LAS unsigned*)(lds + 131072 + 64);
    if (threadIdx.x == 0) { bst[0] = 0u; bst[1] = 0u; }
    __syncthreads();
    XcdBarrier bar = xcd_barrier_post((unsigned*)(P.ws + WS_BAR), bst);
    if (lo < 0) cg::this_grid().sync();
#define IN(k) (lo <= (k) && (k) < hi)
#define SEAM(k) do { if (IN(k) && IN((k) + 1)) { xcd_barrier(bar); } } while (0)
#ifndef PROBE_REP
#define PROBE_REP -1
#endif
#define REP(k) for (int rep_ = 0; rep_ < ((PROBE_REP == (k)) ? 2 : 1); ++rep_, (void)((PROBE_REP == (k) && rep_ == 1) ? (cg::this_grid().sync(), 0) : 0))
    const int G = (int)gridDim.x, c = (int)blockIdx.x;
    if (IN(0)) REP(0) { p0_prologue(P, lds); }
    SEAM(0);
    if (IN(1)) REP(1) {
        pg8::Gemm g{(const bf16*)(P.ws + WS_XB), (const bf16*)(P.ws + WS_WINA), MT, 4 * EA, DM}; pg8::StaticOrder S; S.init(MT, 4 * EA, G, c);
        pg8::EpiHgrnIn E{(bf16*)(P.ws + WS_Q), (const float*)(P.ws + WS_LB)};
        pg8::gemm_phase<pg8::EpiHgrnIn, pg8::StaticOrder, true, true>(lds, g, S, E);
    }
    SEAM(1);
    if (IN(2)) REP(2) { hgrn_phase(P, lds, rep_); }
    SEAM(2);
    if (IN(3)) REP(3) {
        const int Mo = G > 32 ? MP : MT;
        pg8::Gemm g{(const bf16*)(P.ws + WS_O), (const bf16*)(P.ws + WS_WOUTA), Mo, DM, EA}; pg8::StaticOrder S; S.init(Mo, DM, G, c);
        pg8::EpiBf16Plain E{(bf16*)(P.ws + WS_D), DM};
        pg8::gemm_phase<pg8::EpiBf16Plain, pg8::StaticOrder, true, true>(lds, g, S, E);
    }
    SEAM(3);
    if (IN(4)) REP(4) { ln_phase<false>(P, lds, 0); }
    SEAM(4);
    if (IN(5)) REP(5) {
        pg8::Gemm g{(const bf16*)(P.ws + WS_XB), (const bf16*)(P.ws + WS_WINB), MT, 3 * EA, DM}; pg8::StaticOrder S; S.init(MT, 3 * EA, G, c);
        pg8::EpiGmlpIn E{(bf16*)(P.ws + WS_U), (float*)(P.ws + WS_PART)};
        pg8::gemm_phase<pg8::EpiGmlpIn, pg8::StaticOrder, true, true>(lds, g, S, E);
    }
    SEAM(5);
    if (IN(6)) REP(6) { gate_phase(P, lds); }
    SEAM(6);
    if (IN(7)) REP(7) {
        const int Mo = G > 32 ? MP : MT;
        pg8::Gemm g{(const bf16*)(P.ws + WS_O), (const bf16*)(P.ws + WS_WOUTB), Mo, DM, EA}; pg8::StaticOrder S; S.init(Mo, DM, G, c);
        pg8::EpiBf16Plain E{(bf16*)(P.ws + WS_D), DM};
        pg8::gemm_phase<pg8::EpiBf16Plain, pg8::StaticOrder, true, true>(lds, g, S, E);
    }
    SEAM(7);
    if (IN(8)) REP(8) { ln_phase<true>(P, lds, 1); }
#undef IN
#undef SEAM
}

extern "C" void kernel_launch(void* const* d_in, const int* in_sizes, int n_in, void* d_out, int out_size, void* d_ws, size_t ws_size, hipStream_t stream) {
    static int grid = 0;
    if (grid == 0) {
        if (n_in != 15 || ws_size < WS_END || out_size != 54001664) { fprintf(stderr, "kernel_launch: unexpected problem (n_in %d, out %d, ws %zu)\n", n_in, out_size, ws_size); grid = -1; return; }
        int dev = 0, cus = 0, per_cu = 0;
        if (hipGetDevice(&dev) != hipSuccess || hipDeviceGetAttribute(&cus, hipDeviceAttributeMultiprocessorCount, dev) != hipSuccess) { grid = -1; return; }
        if (hipFuncSetAttribute((const void*)mk_fwd, hipFuncAttributeMaxDynamicSharedMemorySize, LDS_BYTES) != hipSuccess) { fprintf(stderr, "kernel_launch: hipFuncSetAttribute failed\n"); grid = -1; return; }
        if (hipOccupancyMaxActiveBlocksPerMultiprocessor(&per_cu, (const void*)mk_fwd, 512, LDS_BYTES) != hipSuccess || per_cu < 1) { fprintf(stderr, "kernel_launch: occupancy query gave %d\n", per_cu); (void)hipGetLastError(); per_cu = 1; }
        grid = cus * 1;
        (void)in_sizes;
    }
    if (grid < 0) return;
    Args a{};
    for (int i = 0; i < 15; ++i) a.in[i] = (const float*)d_in[i];
    a.out = (float*)d_out; a.ws = (unsigned char*)d_ws;
#if MK_MULTI
    for (int p = 0; p < NPHASE; ++p) { a.ph_lo = p; a.ph_hi = p + 1; hipLaunchKernelGGL(mk_fwd, dim3(grid), dim3(512), LDS_BYTES, stream, a); }
#else
    a.ph_lo = 0; a.ph_hi = NPHASE;
    if (hipMemsetAsync((char*)d_ws + WS_BAR, 0, XCD_BAR_WORDS * 4, stream) != hipSuccess) { fprintf(stderr, "kernel_launch: memset of the barrier words failed\n"); return; }
    void* args[] = {&a};
    hipError_t e = hipLaunchCooperativeKernel((const void*)mk_fwd, dim3(grid), dim3(512), args, LDS_BYTES, stream);
    if (e != hipSuccess) fprintf(stderr, "kernel_launch: cooperative launch failed: %s (grid %d)\n", hipGetErrorString(e), grid);
#endif
}
```

```cpp
#include <hip/hip_runtime.h>
#include <hip/hip_cooperative_groups.h>
#include <cstdio>
#include <cstdint>
namespace cg = cooperative_groups;
#define MK_MULTI 0
namespace pg8 {
#define PG8_LAS __attribute__((address_space(3)))
typedef unsigned short bf16_t;
typedef short bf16x8 __attribute__((ext_vector_type(8)));
typedef float f32x4 __attribute__((ext_vector_type(4)));
typedef unsigned u32x4 __attribute__((ext_vector_type(4)));
constexpr int BM = 256, BK = 64, HALF = 128, HTB = HALF * BK * 2  , STAGE_BYTES = 8 * HTB, NXCD = 8, WGM = 8;

__host__ __device__ __forceinline__ int lds_byte(int r, int c) { const int st = (r >> 4) * 2 + (c >> 5), rr = r & 15, cc = c & 31, ob = rr * 64 + cc * 2; return st * 1024 + (ob ^ (((ob >> 9) & 1) << 5)); }
__host__ __device__ __forceinline__ void stage_rc(int b, int& R, int& C) { const int st = b / 1024, sb = b % 1024, swz = sb ^ (((sb >> 9) & 1) << 5); R = (st >> 1) * 16 + swz / 64; C = (st & 1) * 32 + (swz % 64) / 2; }
__host__ __device__ __forceinline__ int perm32(int rho) { const int n = rho >> 4, i = rho & 15; return 8 * (i >> 2) + 4 * n + (i & 3); }

struct Unit { int pm, pn; };
struct Gemm { const bf16_t* A; const bf16_t* Bt; int M, N, K; int nt = 0; };

struct StaticOrder {
    int nM, nN, nwg, G, c;
    __host__ __device__ void init(int M, int N, int G_, int c_) { nM = M / BM; nN = N / BM; nwg = nM * nN; G = G_; c = c_; }
    __host__ __device__ bool next(int i, Unit& u) const {
        const long L = (long)i * G + c; if (L >= nwg) return false;
        int wgid = (int)L; { const int q = nwg / NXCD, r = nwg % NXCD, xcd = wgid % NXCD, off = wgid / NXCD; wgid = (xcd < r ? xcd * (q + 1) : r * (q + 1) + (xcd - r) * q) + off; }
        const int nig = WGM * nN, gid = wgid / nig, fm = gid * WGM, gsz = (nM - fm) < WGM ? (nM - fm) : WGM;
        u.pm = fm + ((wgid % nig) % gsz); u.pn = (wgid % nig) / gsz; return true;
    }
    __device__ __forceinline__ void a_ready(const Unit&) const {}
    __device__ __forceinline__ void done(const Unit&) const {}
};

typedef float cvt_f32x2 __attribute__((ext_vector_type(2)));
typedef __bf16 cvt_bf16x2 __attribute__((ext_vector_type(2)));
__device__ __forceinline__ unsigned cvt_pk_bf16(float lo, float hi) { cvt_f32x2 v; v.x = lo; v.y = hi; const cvt_bf16x2 b = __builtin_convertvector(v, cvt_bf16x2); return __builtin_bit_cast(unsigned, b); }
typedef unsigned u32x2 __attribute__((ext_vector_type(2)));
constexpr size_t MROWS = 16896;
constexpr size_t SEC_STRIDE = (size_t)16896 * 2048;
typedef float f32x2 __attribute__((ext_vector_type(2)));
typedef _Float16 f16x2 __attribute__((ext_vector_type(2)));
__device__ __forceinline__ float silu_f(float x) { return x * __builtin_amdgcn_rcpf(1.0f + __expf(-x)); }
__device__ __forceinline__ float gelu_tanh_f(float x) { const float u = 1.5957691216057308f * (x + 0.044715f * x * x * x); return x * __builtin_amdgcn_rcpf(1.0f + __expf(-u)); }
__device__ __forceinline__ unsigned pk_f16(float lo, float hi) { f16x2 p; p.x = (_Float16)lo; p.y = (_Float16)hi; return __builtin_bit_cast(unsigned, p); }

struct EpiHgrnIn {
    static constexpr bool PERM = true, AFTER_DRAIN = false;
    bf16_t* B0; const float* lb;
    __device__ __forceinline__ void operator()(const f32x4 (&acc)[2][2][4][2], const Unit& u, int wr, int wc, int fr, int fq) const {
        const int sec = u.pn >> 3;
        const int row0 = u.pm * BM + wr * 64 + fr, col0 = (u.pn & 7) * BM + wc * 32 + 8 * fq;
        bf16_t* base = B0 + (size_t)sec * SEC_STRIDE;
        f32x4 l0[2], l1[2];
#pragma unroll
        for (int bj = 0; bj < 2; ++bj) { l0[bj] = (f32x4){0.f, 0.f, 0.f, 0.f}; l1[bj] = l0[bj]; }
        if (sec == 1) {
#pragma unroll
            for (int bj = 0; bj < 2; ++bj) { l0[bj] = *(const f32x4*)(lb + col0 + bj * HALF); l1[bj] = *(const f32x4*)(lb + col0 + bj * HALF + 4); }
        }
#pragma unroll
        for (int ai = 0; ai < 2; ++ai)
#pragma unroll
            for (int m = 0; m < 4; ++m) { bf16_t* rowp = base + ((size_t)((u.pn & 7) * 2) * MROWS + (size_t)(row0 + ai * HALF + m * 16)) * 128 + wc * 32 + 8 * fq;
#pragma unroll
                for (int bj = 0; bj < 2; ++bj) { f32x4 v0 = acc[ai][bj][m][0], v1 = acc[ai][bj][m][1]; u32x4 w;
                    if (sec == 1) {
#pragma unroll
                        for (int j = 0; j < 4; ++j) { const float s0 = __builtin_amdgcn_rcpf(1.0f + __expf(-v0[j])), s1 = __builtin_amdgcn_rcpf(1.0f + __expf(-v1[j]));
                            v0[j] = __logf(l0[bj][j] + (1.0f - l0[bj][j]) * s0); v1[j] = __logf(l1[bj][j] + (1.0f - l1[bj][j]) * s1); }
                        w.x = pk_f16(v0[0], v0[1]); w.y = pk_f16(v0[2], v0[3]); w.z = pk_f16(v1[0], v1[1]); w.w = pk_f16(v1[2], v1[3]);
                    } else {
                        if (sec != 2) {
#pragma unroll
                            for (int j = 0; j < 4; ++j) { v0[j] = silu_f(v0[j]); v1[j] = silu_f(v1[j]); } }
                        w.x = cvt_pk_bf16(v0[0], v0[1]); w.y = cvt_pk_bf16(v0[2], v0[3]); w.z = cvt_pk_bf16(v1[0], v1[1]); w.w = cvt_pk_bf16(v1[2], v1[3]);
                    }
                    *(u32x4*)(rowp + (size_t)bj * MROWS * 128) = w; } }
    }
};
struct EpiGmlpIn {
    static constexpr bool PERM = true, AFTER_DRAIN = false;
    bf16_t* B0; float* part;
    __device__ __forceinline__ void operator()(const f32x4 (&acc)[2][2][4][2], const Unit& u, int wr, int wc, int fr, int fq) const {
        const int row0 = u.pm * BM + wr * 64 + fr;
        if (u.pn < 16) {
#pragma unroll
            for (int ai = 0; ai < 2; ++ai)
#pragma unroll
                for (int m = 0; m < 4; ++m) { const int row = row0 + ai * HALF + m * 16; bf16_t* rowp = B0 + ((size_t)u.pn * MROWS + (size_t)row) * 128 + wc * 32 + 8 * fq;
                    f32x4 v0 = acc[ai][0][m][0], v1 = acc[ai][0][m][1]; const f32x4 z0 = acc[ai][1][m][0], z1 = acc[ai][1][m][1]; u32x4 w;
#pragma unroll
                    for (int j = 0; j < 4; ++j) { v0[j] = gelu_tanh_f(v0[j]) * silu_f(z0[j]); v1[j] = gelu_tanh_f(v1[j]) * silu_f(z1[j]); }
                    w.x = cvt_pk_bf16(v0[0], v0[1]); w.y = cvt_pk_bf16(v0[2], v0[3]); w.z = cvt_pk_bf16(v1[0], v1[1]); w.w = cvt_pk_bf16(v1[2], v1[3]);
                    *(u32x4*)rowp = w; }
        } else {
            const int g0 = (u.pn - 16) * 2;
#pragma unroll
            for (int ai = 0; ai < 2; ++ai)
#pragma unroll
                for (int m = 0; m < 4; ++m) { const int row = row0 + ai * HALF + m * 16; bf16_t* rowp = B0 + SEC_STRIDE + ((size_t)g0 * MROWS + (size_t)row) * 128 + wc * 32 + 8 * fq; float s = 0.f, ss = 0.f;
#pragma unroll
                    for (int bj = 0; bj < 2; ++bj) { f32x4 v0 = acc[ai][bj][m][0], v1 = acc[ai][bj][m][1]; u32x4 w;
#pragma unroll
                        for (int j = 0; j < 4; ++j) { v0[j] = gelu_tanh_f(v0[j]); v1[j] = gelu_tanh_f(v1[j]); s += v0[j] + v1[j]; ss += v0[j] * v0[j] + v1[j] * v1[j]; }
                        w.x = cvt_pk_bf16(v0[0], v0[1]); w.y = cvt_pk_bf16(v0[2], v0[3]); w.z = cvt_pk_bf16(v1[0], v1[1]); w.w = cvt_pk_bf16(v1[2], v1[3]);
                        *(u32x4*)(rowp + (size_t)bj * MROWS * 128) = w; }
                    s += __shfl_xor(s, 16); s += __shfl_xor(s, 32); ss += __shfl_xor(ss, 16); ss += __shfl_xor(ss, 32);
                    if (fq == 0) { f32x2 o; o.x = s; o.y = ss; *(f32x2*)(part + (size_t)row * 64 + ((u.pn - 16) * 4 + wc) * 2) = o; } }
        }
    }
};
struct EpiF32 {
    static constexpr bool PERM = false, AFTER_DRAIN = false;
    float* C; int ldc;
    __device__ __forceinline__ void operator()(const f32x4 (&acc)[2][2][4][2], const Unit& u, int wr, int wc, int fr, int fq) const {
        const int row0 = u.pm * BM + wr * 64 + fr, col0 = u.pn * BM + wc * 32 + 4 * fq;
#pragma unroll
        for (int ai = 0; ai < 2; ++ai)
#pragma unroll
            for (int m = 0; m < 4; ++m) { float* rowp = C + (size_t)(row0 + ai * HALF + m * 16) * ldc + col0;
#pragma unroll
                for (int bj = 0; bj < 2; ++bj)
#pragma unroll
                    for (int n = 0; n < 2; ++n) *(f32x4*)(rowp + bj * HALF + n * 16) = acc[ai][bj][m][n]; }
    }
};
struct EpiBf16Plain {
    static constexpr bool PERM = true, AFTER_DRAIN = false;
    bf16_t* C; int ldc;
    __device__ __forceinline__ void operator()(const f32x4 (&acc)[2][2][4][2], const Unit& u, int wr, int wc, int fr, int fq) const {
        const int row0 = u.pm * BM + wr * 64 + fr, col0 = u.pn * BM + wc * 32 + 8 * fq;
#pragma unroll
        for (int ai = 0; ai < 2; ++ai)
#pragma unroll
            for (int m = 0; m < 4; ++m) { bf16_t* rowp = C + (size_t)(row0 + ai * HALF + m * 16) * ldc + col0;
#pragma unroll
                for (int bj = 0; bj < 2; ++bj) { const f32x4 v0 = acc[ai][bj][m][0], v1 = acc[ai][bj][m][1]; u32x4 w;
                    w.x = cvt_pk_bf16(v0[0], v0[1]); w.y = cvt_pk_bf16(v0[2], v0[3]); w.z = cvt_pk_bf16(v1[0], v1[1]); w.w = cvt_pk_bf16(v1[2], v1[3]);
                    *(u32x4*)(rowp + bj * HALF) = w; } }
    }
};
template <class Epi, class Sched, bool ALIGN_EPI = false, bool SP2 = false>
__device__ __forceinline__ void gemm_phase(PG8_LAS unsigned char* lds, const Gemm g, const Sched& S, const Epi& E) {
    const int tid = threadIdx.x, wid = __builtin_amdgcn_readfirstlane(tid >> 6), lane = tid & 63, wr = wid >> 2, wc = wid & 3, fr = lane & 15, fq = lane >> 4;
    const int K = g.K, nt = g.nt ? g.nt : K / BK;
    unsigned voffA[2], voffB[2];
#pragma unroll
    for (int i = 0; i < 2; ++i) { int R, C; stage_rc(tid * 16 + i * 8192, R, C); const int Rb = Epi::PERM ? ((R & ~31) + perm32(R & 31)) : R;
        voffA[i] = (unsigned)(R * K + C) * 2u; voffB[i] = (unsigned)(Rb * K + C) * 2u; }
    const size_t kstep = (size_t)(BK * 2);
    const size_t hstep = (size_t)HALF * K * 2;
    const size_t tstep = 2 * hstep;
    const unsigned ldsw = (unsigned)wid * 1024u;
    const int aoff = lds_byte(wr * 64 + fr, fq * 8), boff = lds_byte(wc * 32 + fr, fq * 8);
#define PG8_SA(b, h) (((b) * 2 + (h)) * HTB)
#define PG8_SB(b, h) ((4 + (b) * 2 + (h)) * HTB)
#define PG8_STAGE(bufoff, gbase, voff) do { _Pragma("unroll") for (int _i = 0; _i < 2; ++_i) \
        __builtin_amdgcn_global_load_lds((const unsigned*)((const char*)(gbase) + (voff)[_i]), (PG8_LAS unsigned*)(lds + (bufoff) + ldsw + _i * 8192), 16, 0, 0); } while (0)
#define PG8_LDA(dst, b, h) do { _Pragma("unroll") for (int m = 0; m < 4; ++m) _Pragma("unroll") for (int k = 0; k < 2; ++k) dst[m][k] = *(const PG8_LAS bf16x8*)(lds + PG8_SA(b, h) + aoff + m * 2048 + k * 1024); } while (0)
#define PG8_LDB(dst, b, h) do { _Pragma("unroll") for (int n = 0; n < 2; ++n) _Pragma("unroll") for (int k = 0; k < 2; ++k) dst[n][k] = *(const PG8_LAS bf16x8*)(lds + PG8_SB(b, h) + boff + n * 2048 + k * 1024); } while (0)
#define PG8_MMA(ai, bj, At, Bt) do { __builtin_amdgcn_s_setprio(1); _Pragma("unroll") for (int m = 0; m < 4; ++m) _Pragma("unroll") for (int n = 0; n < 2; ++n) _Pragma("unroll") for (int k = 0; k < 2; ++k) \
        acc[ai][bj][m][n] = __builtin_amdgcn_mfma_f32_16x16x32_bf16(Bt[n][k], At[m][k], acc[ai][bj][m][n], 0, 0, 0); __builtin_amdgcn_s_setprio(0); } while (0)
#define PG8_WAIT_V(n) asm volatile("s_waitcnt vmcnt(" #n ")" ::: "memory")
#define PG8_WAIT_L(n) asm volatile("s_waitcnt lgkmcnt(" #n ")" ::: "memory")
#define PG8_BAR __builtin_amdgcn_s_barrier()
#define PG8_SCHED __builtin_amdgcn_sched_barrier(0)
    Unit cur, nxt; int ui = 0;
    if (!S.next(0, cur)) return;
    f32x4 acc[2][2][4][2];
#pragma unroll
    for (int a = 0; a < 2; ++a)
#pragma unroll
        for (int b = 0; b < 2; ++b)
#pragma unroll
            for (int m = 0; m < 4; ++m)
#pragma unroll
                for (int n = 0; n < 2; ++n) acc[a][b][m][n] = (f32x4){0.f, 0.f, 0.f, 0.f};
    bf16x8 At[4][2], B0[2][2], B1[2][2];
    const char* cA = (const char*)g.A + (size_t)cur.pm * tstep; const char* cB = (const char*)g.Bt + (size_t)cur.pn * tstep;
    S.a_ready(cur);
    if constexpr (SP2) {
        PG8_STAGE(PG8_SB(0, 0), cB, voffB); PG8_STAGE(PG8_SB(0, 1), cB + hstep, voffB); PG8_STAGE(PG8_SA(0, 0), cA, voffA); PG8_STAGE(PG8_SA(0, 1), cA + hstep, voffA);
        if (wr == 1) PG8_BAR;
        PG8_WAIT_V(2); PG8_BAR;
        PG8_STAGE(PG8_SB(1, 0), cB + kstep, voffB); PG8_STAGE(PG8_SA(1, 0), cA + kstep, voffA); PG8_STAGE(PG8_SB(1, 1), cB + hstep + kstep, voffB);
        PG8_WAIT_V(6); PG8_BAR;
    } else {
        PG8_STAGE(PG8_SB(0, 0), cB, voffB); PG8_STAGE(PG8_SA(0, 0), cA, voffA); PG8_STAGE(PG8_SB(0, 1), cB + hstep, voffB); PG8_STAGE(PG8_SA(0, 1), cA + hstep, voffA);
        if (wr == 1) PG8_BAR;
        PG8_WAIT_V(4); PG8_BAR;
        PG8_STAGE(PG8_SB(1, 0), cB + kstep, voffB); PG8_STAGE(PG8_SA(1, 0), cA + kstep, voffA); PG8_STAGE(PG8_SB(1, 1), cB + hstep + kstep, voffB);
        PG8_WAIT_V(6); PG8_BAR;
    }
    for (;;) {
        const bool has_next = S.next(ui + 1, nxt);
        const char* nA = has_next ? (const char*)g.A + (size_t)nxt.pm * tstep : cA; const char* nB = has_next ? (const char*)g.Bt + (size_t)nxt.pn * tstep : cB;
        for (int t = 0; t < nt; t += 2) {
            const bool last = (t == nt - 2);
            const char* a1 = cA + (size_t)(t + 1) * kstep;
            const char* a2 = last ? nA : cA + (size_t)(t + 2) * kstep; const char* b2 = last ? nB : cB + (size_t)(t + 2) * kstep;
            const char* a3 = a2 + kstep; const char* b3 = b2 + kstep;
            if (last && has_next) S.a_ready(nxt);
            if constexpr (SP2) {
            PG8_LDB(B0, 0, 0); PG8_LDB(B1, 0, 1); PG8_SCHED; PG8_LDA(At, 0, 0); PG8_STAGE(PG8_SA(1, 1), a1 + hstep, voffA);
            PG8_WAIT_V(8); PG8_WAIT_L(0); PG8_BAR; PG8_MMA(0, 0, At, B0); PG8_MMA(0, 1, At, B1); PG8_BAR; PG8_SCHED;
            PG8_LDA(At, 0, 1); PG8_STAGE(PG8_SB(0, 0), b2, voffB); PG8_STAGE(PG8_SB(0, 1), b2 + hstep, voffB); PG8_STAGE(PG8_SA(0, 0), a2, voffA);
            PG8_WAIT_V(8); PG8_WAIT_L(0); PG8_BAR; PG8_MMA(1, 0, At, B0); PG8_MMA(1, 1, At, B1); PG8_BAR; PG8_SCHED;
            PG8_LDB(B0, 1, 0); PG8_LDB(B1, 1, 1); PG8_SCHED; PG8_LDA(At, 1, 0); PG8_STAGE(PG8_SA(0, 1), a2 + hstep, voffA);
            PG8_WAIT_V(8); PG8_WAIT_L(0); PG8_BAR; PG8_MMA(0, 0, At, B0); PG8_MMA(0, 1, At, B1); PG8_BAR; PG8_SCHED;
            PG8_LDA(At, 1, 1); PG8_STAGE(PG8_SB(1, 0), b3, voffB); PG8_STAGE(PG8_SB(1, 1), b3 + hstep, voffB); PG8_STAGE(PG8_SA(1, 0), a3, voffA);
            PG8_WAIT_V(8); PG8_WAIT_L(0); PG8_BAR; PG8_MMA(1, 0, At, B0); PG8_MMA(1, 1, At, B1); PG8_BAR; PG8_SCHED;
            } else {
            PG8_LDB(B0, 0, 0); PG8_SCHED; PG8_LDA(At, 0, 0); PG8_STAGE(PG8_SA(1, 1), a1 + hstep, voffA);
            PG8_WAIT_L(8); PG8_BAR; PG8_WAIT_L(0); PG8_MMA(0, 0, At, B0); PG8_BAR; PG8_SCHED;
            PG8_LDB(B1, 0, 1); PG8_STAGE(PG8_SB(0, 0), b2, voffB);
            PG8_BAR; PG8_WAIT_L(0); PG8_MMA(0, 1, At, B1); PG8_BAR;
            PG8_LDA(At, 0, 1); PG8_STAGE(PG8_SA(0, 0), a2, voffA);
            PG8_BAR; PG8_WAIT_L(0); PG8_MMA(1, 0, At, B0); PG8_BAR; PG8_SCHED;
            PG8_STAGE(PG8_SB(0, 1), b2 + hstep, voffB);
            PG8_WAIT_V(6); PG8_BAR; PG8_MMA(1, 1, At, B1); PG8_BAR;
            PG8_LDB(B0, 1, 0); PG8_SCHED; PG8_LDA(At, 1, 0); PG8_STAGE(PG8_SA(0, 1), a2 + hstep, voffA);
            PG8_WAIT_L(8); PG8_BAR; PG8_WAIT_L(0); PG8_MMA(0, 0, At, B0); PG8_BAR; PG8_SCHED;
            PG8_LDB(B1, 1, 1); PG8_STAGE(PG8_SB(1, 0), b3, voffB);
            PG8_BAR; PG8_WAIT_L(0); PG8_MMA(0, 1, At, B1); PG8_BAR;
            PG8_LDA(At, 1, 1); PG8_STAGE(PG8_SA(1, 0), a3, voffA);
            PG8_BAR; PG8_WAIT_L(0); PG8_MMA(1, 0, At, B0); PG8_BAR; PG8_SCHED;
            PG8_STAGE(PG8_SB(1, 1), b3 + hstep, voffB);
            PG8_WAIT_V(6); PG8_BAR; PG8_MMA(1, 1, At, B1); PG8_BAR;
            }
        }
        if constexpr (ALIGN_EPI) { if (wr == 0) PG8_BAR; }
        if constexpr (!Epi::AFTER_DRAIN) { E(acc, cur, wr, wc, fr, fq); S.done(cur); }
        if (!has_next) break;
#pragma unroll
        for (int a = 0; a < 2; ++a)
#pragma unroll
            for (int b = 0; b < 2; ++b)
#pragma unroll
                for (int m = 0; m < 4; ++m)
#pragma unroll
                    for (int n = 0; n < 2; ++n) acc[a][b][m][n] = (f32x4){0.f, 0.f, 0.f, 0.f};
        cur = nxt; cA = nA; cB = nB; ++ui;
        if constexpr (ALIGN_EPI) { if (wr == 1) PG8_BAR; }
    }
    PG8_WAIT_V(0);
    if constexpr (!ALIGN_EPI) { if (wr == 0) PG8_BAR; }
    PG8_BAR;
    if constexpr (Epi::AFTER_DRAIN) { E.fused(acc, cur, wr, wc, fr, fq, lds, wid, lane); S.done(cur); }
#undef PG8_SA
#undef PG8_SB
#undef PG8_STAGE
#undef PG8_LDA
#undef PG8_LDB
#undef PG8_MMA
#undef PG8_WAIT_V
#undef PG8_WAIT_L
#undef PG8_BAR
#undef PG8_SCHED
}
}

#define GAS __attribute__((address_space(1)))
#define LAS __attribute__((address_space(3)))
typedef unsigned short bf16;
typedef unsigned v4u __attribute__((ext_vector_type(4)));
typedef unsigned v2u __attribute__((ext_vector_type(2)));
typedef float f32x4 __attribute__((ext_vector_type(4)));
typedef float f32x2 __attribute__((ext_vector_type(2)));
typedef short bf16x8 __attribute__((ext_vector_type(8)));
typedef _Float16 f16x2 __attribute__((ext_vector_type(2)));

#ifndef MK_MULTI
#define MK_MULTI 0
#endif
constexpr int NPHASE = 9;
constexpr int MP = 16384, MS = 512, MT = MP + MS, DM = 1024, EA = 2048;
constexpr float LN_EPS = 1e-5f, ALPHA = 1.4142135623730951f;
constexpr size_t MiB = 1u << 20;
constexpr size_t WS_CTL = 0, WS_LB = 64 * 1024, WS_WSB = 1 * MiB, WS_WINA = 2 * MiB, WS_WOUTA = 18 * MiB, WS_WINB = 22 * MiB, WS_WOUTB = 34 * MiB, WS_PART = 38 * MiB;
constexpr size_t WS_XB = 44 * MiB;
constexpr size_t WS_Q = 78 * MiB, WS_LF = 144 * MiB, WS_V = 210 * MiB, WS_G = 276 * MiB, WS_O = 342 * MiB, WS_D = 408 * MiB, WS_DP = 474 * MiB, WS_END = 482 * MiB;
constexpr size_t WS_U = WS_Q, WS_VB = WS_LF, WS_Z = WS_V, WS_H1F = WS_G;
static_assert(WS_LF - WS_Q == pg8::SEC_STRIDE * 2 && WS_V - WS_LF == pg8::SEC_STRIDE * 2 && WS_G - WS_V == pg8::SEC_STRIDE * 2 && WS_O - WS_G == pg8::SEC_STRIDE * 2, "section stride");
constexpr size_t OUT_Y = 0, OUT_HP = 17301504, OUT_HS = 19398656, OUT_CV = 52953088;
constexpr int LDS_BYTES = 131072 + 1024;
constexpr size_t WS_BAR = 32 * 1024;

__device__ __forceinline__ unsigned pkbf(float lo, float hi) { return pg8::cvt_pk_bf16(lo, hi); }
__device__ __forceinline__ float bf_lo(unsigned w) { return __builtin_bit_cast(float, w << 16); }
__device__ __forceinline__ float bf_hi(unsigned w) { return __builtin_bit_cast(float, w & 0xffff0000u); }
__device__ __forceinline__ float wave_sum(float v) {
#pragma unroll
    for (int o = 1; o < 64; o <<= 1) v += __shfl_xor(v, o);
    return v;
}
#define LDS_WAIT() asm volatile("s_waitcnt lgkmcnt(0)" ::: "memory")

__device__ __forceinline__ void p0_transpose_item(const float* W, int K, int N, bf16* WT, LAS float* scr, int item, int lane, bool gmlp = false) {
    const int nblk = N / 32, kb = item / nblk, nb = item % nblk, k0 = 64 * kb, nd = 32 * nb;
    int n0 = nd;
    if (gmlp) { if (nd < 4096) { const int tile = nd >> 8, half = (nd >> 7) & 1, cc = nd & 127; n0 = (half ? 4096 : 0) + tile * 128 + cc; } else n0 = 2048 + (nd - 4096); }
    float wv[32];
#pragma unroll
    for (int i = 0; i < 32; ++i) { const int kk = 2 * i + (lane >> 5); wv[i] = __builtin_nontemporal_load(W + (size_t)(k0 + kk) * N + n0 + (lane & 31)); }
#pragma unroll
    for (int i = 0; i < 32; ++i) { const int kk = 2 * i + (lane >> 5); scr[kk * 33 + (lane & 31)] = wv[i]; }
    LDS_WAIT(); asm volatile("" ::: "memory");
    const int c = lane & 7;
#pragma unroll
    for (int j = 0; j < 4; ++j) { const int n = (lane >> 3) + 8 * j; const LAS float* s = scr + (8 * c) * 33 + n;
        v4u o; o.x = pkbf(s[0 * 33], s[1 * 33]); o.y = pkbf(s[2 * 33], s[3 * 33]); o.z = pkbf(s[4 * 33], s[5 * 33]); o.w = pkbf(s[6 * 33], s[7 * 33]);
        *(v4u*)(WT + (size_t)(nd + n) * K + k0 + 8 * c) = o; }
    LDS_WAIT(); asm volatile("" ::: "memory");
}

typedef GAS unsigned gu32;
#define XB_TMO      128
#define XB_XCNT(j)  (256  + 64 * (j))
#define XB_XSUB(j)  (1280 + 64 * (j))
#define XB_XGEN(j)  (2304 + 64 * (j))
#define XB_TOP      3328
#define XB_TOPGEN   3392
#define XCD_BAR_WORDS 3456
#define XB_SPIN_CAP (1u << 18)

__device__ __forceinline__ unsigned xb_ld(unsigned* p)              { return __hip_atomic_load(p, __ATOMIC_RELAXED, __HIP_MEMORY_SCOPE_AGENT); }
__device__ __forceinline__ unsigned xb_add(unsigned* p, unsigned v) { return __hip_atomic_fetch_add(p, v, __ATOMIC_RELAXED, __HIP_MEMORY_SCOPE_AGENT); }
__device__ __forceinline__ unsigned xb_xcc_id() { return (unsigned)__builtin_amdgcn_s_getreg((3 << 11) | 20) & 0xFu; }
#define XB_SPIN(cond, bar) do { unsigned _sp = 0; while (cond) { __builtin_amdgcn_s_sleep(1); \
    if ((++_sp & 255u) == 0u) { if (xb_ld(&(bar)[XB_TMO])) break; if (_sp > XB_SPIN_CAP) { atomicAdd(&(bar)[XB_TMO], 1u); break; } } } } while (0)

struct XcdBarrier {
    unsigned* bar; unsigned x;
    volatile LAS unsigned* st;
};

__device__ __forceinline__ XcdBarrier xcd_barrier_post(unsigned* bar, volatile LAS unsigned* st) {
    XcdBarrier b; b.bar = bar; b.x = xb_xcc_id(); b.st = st;
    if (threadIdx.x == 0) (void)xb_add(&bar[XB_XCNT(b.x)], 1u);
    return b;
}
__device__ __forceinline__ void xcd_barrier_complete(unsigned* bar, unsigned x, unsigned& nloc, unsigned& nx) {
    const unsigned G = gridDim.x * gridDim.y * gridDim.z;
    unsigned sum, cnt, mine, sp = 0u;
    for (;;) {
        sum = 0u; cnt = 0u; mine = 0u;
#pragma unroll
        for (unsigned j = 0; j < 16; ++j) { const unsigned c = xb_ld(&bar[XB_XCNT(j)]); sum += c; cnt += (c > 0u) ? 1u : 0u; mine = (j == x) ? c : mine; }
        if (sum == G) break;
        __builtin_amdgcn_s_sleep(1);
        if ((++sp & 255u) == 0u) { if (xb_ld(&bar[XB_TMO])) break; if (sp > XB_SPIN_CAP) { atomicAdd(&bar[XB_TMO], 1u); break; } }
    }
    nloc = mine > 0u ? mine : 1u; nx = cnt > 0u ? cnt : 1u;
}

__device__ __forceinline__ void xcd_barrier(const XcdBarrier& b) {
    asm volatile("s_waitcnt vmcnt(0)" ::: "memory");
    __syncthreads();
    if (threadIdx.x == 0) {
        unsigned* bar = b.bar;
        __builtin_amdgcn_s_waitcnt(0);
        unsigned nloc = b.st[0], nx = b.st[1];
        if (nloc == 0u) { xcd_barrier_complete(bar, b.x, nloc, nx); b.st[0] = nloc; b.st[1] = nx; }
        const unsigned old = xb_add(&bar[XB_XSUB(b.x)], 1u);
        const unsigned gen = old / nloc;
        if (old + 1u == (gen + 1u) * nloc) {
            __builtin_amdgcn_fence(__ATOMIC_RELEASE, "agent");
            asm volatile("s_waitcnt vmcnt(0)" ::: "memory");
            const unsigned og = xb_add(&bar[XB_TOP], 1u);
            const unsigned tg = og / nx;
            if (og + 1u == (tg + 1u) * nx) xb_add(&bar[XB_TOPGEN], 1u);
            else XB_SPIN(xb_ld(&bar[XB_TOPGEN]) == tg, bar);
            __builtin_amdgcn_fence(__ATOMIC_ACQUIRE, "agent");
            xb_add(&bar[XB_XGEN(b.x)], 1u);
            asm volatile("s_waitcnt vmcnt(0)" ::: "memory");
        } else {
            XB_SPIN(xb_ld(&bar[XB_XGEN(b.x)]) == gen, bar);
            __builtin_amdgcn_fence(__ATOMIC_ACQUIRE, "agent");
            asm volatile("s_waitcnt vmcnt(0)" ::: "memory");
        }
    }
    __syncthreads();
}

struct Ptrs {
    const float *xp, *xs, *state, *w_in_a, *lb_logits, *gnorm, *w_out_a, *w_in_b, *lnv_g, *lnv_b, *w_s, *b_s, *w_out_b, *ln_g, *ln_b;
    float* out; unsigned char* ws;
};

__device__ __forceinline__ void p0_prologue(const Ptrs& P, LAS unsigned char* lds) {
    const int tid = threadIdx.x, lane = tid & 63, wave = __builtin_amdgcn_readfirstlane(tid >> 6);
    LAS float* scr = (LAS float*)(lds + wave * 16384);
    const int gw = blockIdx.x * 8 + wave, NGW = gridDim.x * 8;
    constexpr int I_A = (DM / 64) * (4 * EA / 32), I_OA = (EA / 64) * (DM / 32), I_B = (DM / 64) * (3 * EA / 32), I_OB = I_OA, NITEMS = I_A + I_OA + I_B + I_OB;
    for (int it = gw; it < NITEMS; it += NGW) {
        int r = it;
        if (r < I_A) { p0_transpose_item(P.w_in_a, DM, 4 * EA, (bf16*)(P.ws + WS_WINA), scr, r, lane); continue; } r -= I_A;
        if (r < I_OA) { p0_transpose_item(P.w_out_a, EA, DM, (bf16*)(P.ws + WS_WOUTA), scr, r, lane); continue; } r -= I_OA;
        if (r < I_B) { p0_transpose_item(P.w_in_b, DM, 3 * EA, (bf16*)(P.ws + WS_WINB), scr, r, lane, true); continue; } r -= I_B;
        p0_transpose_item(P.w_out_b, EA, DM, (bf16*)(P.ws + WS_WOUTB), scr, r, lane);
    }
    const size_t gtid = (size_t)blockIdx.x * 512 + tid, GT = (size_t)gridDim.x * 512;
    {
        const f32x4* xp4 = (const f32x4*)P.xp; const f32x4* xs4 = (const f32x4*)P.xs; v2u* xb = (v2u*)(P.ws + WS_XB);
        constexpr size_t NP4 = (size_t)MP * DM / 4, NT4 = (size_t)MT * DM / 4;
        for (size_t q = gtid; q < NT4; q += 4 * GT) { f32x4 v[4];
#pragma unroll
            for (int k = 0; k < 4; ++k) { size_t qq = q + k * GT; qq = qq < NT4 ? qq : NT4 - 1; v[k] = __builtin_nontemporal_load(qq < NP4 ? xp4 + qq : xs4 + (qq - NP4)); }
#pragma unroll
            for (int k = 0; k < 4; ++k) { const size_t qq = q + k * GT; if (qq < NT4) { v2u o; o.x = pkbf(v[k].x, v[k].y); o.y = pkbf(v[k].z, v[k].w); xb[qq] = o; } } }
    }
    {
        const f32x4* w4 = (const f32x4*)P.w_s; v2u* wb = (v2u*)(P.ws + WS_WSB);
        for (size_t q = gtid; q < (size_t)16 * 128 * 128 / 4; q += GT) { const int e = (int)(q * 4), s = e & 127, t = (e >> 7) & 127; const f32x4 v = w4[q];
            v2u o; o.x = pkbf(s <= t ? v.x : 0.f, s + 1 <= t ? v.y : 0.f); o.y = pkbf(s + 2 <= t ? v.z : 0.f, s + 3 <= t ? v.w : 0.f); wb[q] = o; }
    }
    if (gtid < 2048) { float* lb = (float*)(P.ws + WS_LB); lb[gtid] = 1.0f / (1.0f + expf(P.lb_logits[2048 + gtid] - P.lb_logits[gtid])); }
    if (gtid < 4) { ((unsigned*)(P.ws + WS_CTL))[64 * gtid] = 0u; }
}

struct OneUnit {
    pg8::Unit u0;
    __device__ __forceinline__ bool next(int i, pg8::Unit& u) const { if (i != 0) return false; u = u0; return true; }
    __device__ __forceinline__ void a_ready(const pg8::Unit&) const {}
    __device__ __forceinline__ void done(const pg8::Unit&) const {}
};
template <bool FINAL, int NR, bool PARTS = false>
__device__ __forceinline__ void ln_rows(const Ptrs& P, const f32x4* g4, const f32x4* b4, int mbase, int mstride, int mend, int lane) {
    const bf16* D = (const bf16*)(P.ws + WS_D); bf16* H1B = (bf16*)(P.ws + WS_XB);
    f32x4 v[NR][4]; float s[NR];
#pragma unroll
    for (int k = 0; k < NR; ++k) { int m = mbase + k * mstride; m = m < mend ? m : mend - 1;
        f32x4 x[4];
        if (FINAL) { const v2u* h4 = (const v2u*)(H1B + (size_t)m * DM);
#pragma unroll
            for (int j = 0; j < 4; ++j) { const v2u r = __builtin_nontemporal_load(h4 + 64 * j + lane); x[j].x = bf_lo(r.x); x[j].y = bf_hi(r.x); x[j].z = bf_lo(r.y); x[j].w = bf_hi(r.y); } }
        else { const f32x4* x4 = (const f32x4*)(m < MP ? P.xp + (size_t)m * DM : P.xs + (size_t)(m - MP) * DM);
#pragma unroll
            for (int j = 0; j < 4; ++j) x[j] = __builtin_nontemporal_load(x4 + 64 * j + lane); }
        if (PARTS) { const f32x4* d4 = (const f32x4*)(P.ws + WS_DP) + (size_t)(m - MP) * (DM / 4);
#pragma unroll
            for (int j = 0; j < 4; ++j) v[k][j] = x[j] * ALPHA + ((d4[64 * j + lane] + d4[64 * j + lane + 512 * DM / 4]) + (d4[64 * j + lane + 2 * 512 * DM / 4] + d4[64 * j + lane + 3 * 512 * DM / 4])); }
        else { const v2u* d4 = (const v2u*)(D + (size_t)m * DM);
#pragma unroll
            for (int j = 0; j < 4; ++j) { const v2u r = __builtin_nontemporal_load(d4 + 64 * j + lane); f32x4 d; d.x = bf_lo(r.x); d.y = bf_hi(r.x); d.z = bf_lo(r.y); d.w = bf_hi(r.y); v[k][j] = x[j] * ALPHA + d; } } }
#pragma unroll
    for (int k = 0; k < NR; ++k) { s[k] = 0.f;
#pragma unroll
        for (int j = 0; j < 4; ++j) s[k] += (v[k][j].x + v[k][j].y) + (v[k][j].z + v[k][j].w); }
#pragma unroll
    for (int o = 1; o < 64; o <<= 1) {
#pragma unroll
        for (int k = 0; k < NR; ++k) s[k] += __shfl_xor(s[k], o); }
#pragma unroll
    for (int k = 0; k < NR; ++k) { const float mean = s[k] * (1.0f / DM); s[k] = 0.f;
#pragma unroll
        for (int j = 0; j < 4; ++j) { v[k][j] = v[k][j] - mean; s[k] += (v[k][j].x * v[k][j].x + v[k][j].y * v[k][j].y) + (v[k][j].z * v[k][j].z + v[k][j].w * v[k][j].w); } }
#pragma unroll
    for (int o = 1; o < 64; o <<= 1) {
#pragma unroll
        for (int k = 0; k < NR; ++k) s[k] += __shfl_xor(s[k], o); }
#pragma unroll
    for (int j = 0; j < 4; ++j) { const f32x4 gg = g4[64 * j + lane], bb = b4[64 * j + lane];
#pragma unroll
        for (int k = 0; k < NR; ++k) { const int m = mbase + k * mstride; if (m < mend) { const float rstd = __builtin_amdgcn_rsqf(s[k] * (1.0f / DM) + LN_EPS); const f32x4 y = v[k][j] * rstd * gg + bb;
            if (FINAL) { __builtin_nontemporal_store(y, (f32x4*)(P.out + OUT_Y + (size_t)m * DM) + 64 * j + lane); }
            else { v2u o; o.x = pkbf(y.x, y.y); o.y = pkbf(y.z, y.w); ((v2u*)(H1B + (size_t)m * DM))[64 * j + lane] = o; } } } }
}
template <bool FINAL>
__device__ __forceinline__ void ln_phase(const Ptrs& P, LAS unsigned char* lds, int layer) {
    const int tid = threadIdx.x, lane = tid & 63, wave = tid >> 6;
    const int G = (int)gridDim.x, bx = (int)blockIdx.x;
    const f32x4* g4 = (const f32x4*)(P.ln_g + layer * DM); const f32x4* b4 = (const f32x4*)(P.ln_b + layer * DM);
    if (G <= 32) {
        for (int m = bx * 8 + wave; m < MT; m += G * 8) ln_rows<FINAL, 1>(P, g4, b4, m, 0, MT, lane);
        return;
    }
    if (bx < 32) {
        unsigned* cnt = (unsigned*)(P.ws + WS_CTL) + 64 * (2 + layer);
        const int unit = bx >> 2, ks = bx & 3;
        pg8::Gemm g{(const bf16*)(P.ws + WS_O) + ks * 512, (const bf16*)(P.ws + (FINAL ? WS_WOUTB : WS_WOUTA)) + ks * 512, MT, DM, EA, 8};
        OneUnit S; S.u0.pm = MP / 256 + (unit >> 2); S.u0.pn = unit & 3;
        pg8::EpiF32 E{(float*)(P.ws + WS_DP) + (size_t)ks * 512 * DM - (size_t)MP * DM, DM};
        pg8::gemm_phase<pg8::EpiF32, OneUnit, true, true>(lds, g, S, E);
        asm volatile("s_waitcnt vmcnt(0)" ::: "memory");
        __syncthreads();
        if (tid == 0) {
            __builtin_amdgcn_fence(__ATOMIC_RELEASE, "agent"); asm volatile("s_waitcnt vmcnt(0)" ::: "memory");
            __hip_atomic_fetch_add(cnt, 1u, __ATOMIC_RELAXED, __HIP_MEMORY_SCOPE_AGENT);
            while (__hip_atomic_load(cnt, __ATOMIC_RELAXED, __HIP_MEMORY_SCOPE_AGENT) < 32u) __builtin_amdgcn_s_sleep(4);
            __builtin_amdgcn_fence(__ATOMIC_ACQUIRE, "agent"); asm volatile("s_waitcnt vmcnt(0)" ::: "memory");
        }
        __syncthreads();
        __builtin_amdgcn_fence(__ATOMIC_ACQUIRE, "agent");
        ln_rows<FINAL, 2, true>(P, g4, b4, MP + bx * 16 + wave * 2, 1, MT, lane);
    } else {
        const int nw = (G - 32) * 8;
        for (int m = (bx - 32) * 8 + wave; m < MP; m += 3 * nw) ln_rows<FINAL, 3>(P, g4, b4, m, nw, MP, lane);
    }
}

#define MFMA16(a, b, c) __builtin_amdgcn_mfma_f32_16x16x32_bf16((a), (b), (c), 0, 0, 0)
__device__ __forceinline__ void hgrn_unit(LAS unsigned char* lds, const bf16* Q, const bf16* LF, const bf16* V, const bf16* G, bf16* O, const float* gnorm,
                                          int m0, int h, float* s_out, int nb, int ne, bool store_state) {
    const int tid = threadIdx.x, lane = tid & 63, wid = __builtin_amdgcn_readfirstlane(tid >> 6);
    const int i = lane & 15, g = lane >> 4, wq = wid & 3, hc = h * 128;
    constexpr int SQ = 136, SK = 72, nch = 32;
    LAS unsigned char* QD = lds; LAS unsigned char* KI = lds + 17408; LAS unsigned char* KET = lds + 34816; LAS unsigned char* VT = lds + 53248; LAS unsigned char* ST = lds + 71680;
    LAS float* DEC = (LAS float*)(lds + 106496); LAS float* GN = (LAS float*)(lds + 111104);
    if (tid < 128) GN[tid] = gnorm[hc + tid];
    if (wid < 4) {
        const int t0 = 16 * wid;
        v2u gq_n[8], gq_c[8], po[8];
        const bf16* gp = G + ((size_t)h * MT + (size_t)(m0 + t0 + i)) * 128 + 4 * g;
        bf16* orow = O + (size_t)(m0 + t0 + i) * 2048 + hc + 4 * g;
        bf16* prow = orow;
#define LOAD_GATE(nn) do { const int nc_ = (nn) < nch ? (nn) : nch - 1; const bf16* gb_ = gp + (size_t)nc_ * 8192; \
        _Pragma("unroll") for (int vt = 0; vt < 8; ++vt) gq_n[vt] = __builtin_nontemporal_load((const v2u*)(gb_ + 16 * vt)); } while (0)
#define STORE_PREV() do { _Pragma("unroll") for (int vt = 0; vt < 8; ++vt) *(v2u*)(prow + 16 * vt) = po[vt]; } while (0)
        LOAD_GATE(nb);
        for (int n = 0; n < ne; ++n) {
            if (n < nb) { __syncthreads(); __syncthreads(); continue; }
            int i_ = i, g_ = g; asm volatile("" : "+v"(i_), "+v"(g_));
#pragma unroll
            for (int vt = 0; vt < 8; ++vt) gq_c[vt] = gq_n[vt];
            if (n > nb) STORE_PREV();
            LOAD_GATE(n + 1);
            __syncthreads();
            {
                bf16x8 bq[4];
#pragma unroll
                for (int kk = 0; kk < 4; ++kk) bq[kk] = *(const LAS bf16x8*)(QD + ((t0 + i_) * SQ + 32 * kk + 8 * g_) * 2);
                bf16x8 pc[2];
                {
                    f32x4 sT[4];
#pragma unroll
                    for (int st = 0; st < 4; ++st) {
                        f32x4 a4 = (f32x4){0.f, 0.f, 0.f, 0.f};
#pragma unroll
                        for (int kk = 0; kk < 4; ++kk) { const bf16x8 a = *(const LAS bf16x8*)(KI + ((16 * st + i_) * SQ + 32 * kk + 8 * g_) * 2); a4 = MFMA16(a, bq[kk], a4); }
#pragma unroll
                        for (int r = 0; r < 4; ++r) if (16 * st + 4 * g_ + r > t0 + i_) a4[r] = 0.f;
                        sT[st] = a4;
                    }
#pragma unroll
                    for (int c = 0; c < 2; ++c) { v4u w; w.x = pkbf(sT[2 * c][0], sT[2 * c][1]); w.y = pkbf(sT[2 * c][2], sT[2 * c][3]); w.z = pkbf(sT[2 * c + 1][0], sT[2 * c + 1][1]); w.w = pkbf(sT[2 * c + 1][2], sT[2 * c + 1][3]);
                        pc[c] = __builtin_bit_cast(bf16x8, w); }
                }
                f32x4 oa[8]; float ss = 0.f;
#pragma unroll
                for (int vt = 0; vt < 8; ++vt) {
                    f32x4 acc = (f32x4){0.f, 0.f, 0.f, 0.f};
#pragma unroll
                    for (int c = 0; c < 2; ++c) {
                        const v2u lo = *(const LAS v2u*)(VT + ((16 * vt + i_) * SK + 32 * c + 4 * g_) * 2), hi = *(const LAS v2u*)(VT + ((16 * vt + i_) * SK + 32 * c + 16 + 4 * g_) * 2);
                        v4u w; w.x = lo.x; w.y = lo.y; w.z = hi.x; w.w = hi.y; acc = MFMA16(__builtin_bit_cast(bf16x8, w), pc[c], acc); }
#pragma unroll
                    for (int kk = 0; kk < 4; ++kk) { const bf16x8 a = *(const LAS bf16x8*)(ST + ((16 * vt + i_) * SQ + 32 * kk + 8 * g_) * 2); acc = MFMA16(a, bq[kk], acc); }
                    oa[vt] = acc; ss += (acc[0] * acc[0] + acc[1] * acc[1]) + (acc[2] * acc[2] + acc[3] * acc[3]);
                }
                ss += __shfl_xor(ss, 16); ss += __shfl_xor(ss, 32);
                const float sc = __builtin_amdgcn_rsqf(ss * (1.0f / 128.0f) + LN_EPS);
#pragma unroll
                for (int vt = 0; vt < 8; ++vt) { const v2u gg = gq_c[vt]; const f32x4 gn = *(const LAS f32x4*)(GN + 16 * vt + 4 * g_) * sc;
                    po[vt].x = pkbf(oa[vt][0] * gn[0] * bf_lo(gg.x), oa[vt][1] * gn[1] * bf_hi(gg.x)); po[vt].y = pkbf(oa[vt][2] * gn[2] * bf_lo(gg.y), oa[vt][3] * gn[3] * bf_hi(gg.y)); }
                prow = orow + (size_t)n * (64 * 2048);
            }
            __syncthreads();
        }
        STORE_PREV();
#undef STORE_PREV
#undef LOAD_GATE
    } else {
        const int cp = i, rg = g, c0 = 32 * wq + 2 * cp;
        const size_t pofs = ((size_t)h * MT + (size_t)(m0 + 16 * rg)) * 128 + c0;
        const bf16* qp = Q + pofs; const bf16* lp = LF + pofs; const bf16* vp = V + pofs;
        unsigned rq[16], rl[16], rv[16];
        unsigned sq[16], sk[16], ske0[8], ske1[8]; float det0, det1;
#define LOAD_RAW(nn) do { const int nc_ = (nn) < nch ? (nn) : nch - 1; const bf16* qb_ = qp + (size_t)nc_ * 8192; const bf16* lb_ = lp + (size_t)nc_ * 8192; const bf16* vb_ = vp + (size_t)nc_ * 8192; \
        _Pragma("unroll") for (int r = 0; r < 16; ++r) { rl[r] = *(const unsigned*)(lb_ + r * 128); rq[r] = *(const unsigned*)(qb_ + r * 128); } (void)vb_; } while (0)
#define LOAD_V(nn) do { const int nc_ = (nn) < nch ? (nn) : nch - 1; const bf16* vb_ = vp + (size_t)nc_ * 8192; _Pragma("unroll") for (int r = 0; r < 16; ++r) rv[r] = *(const unsigned*)(vb_ + r * 128); } while (0)
#define PREP_REGS() do { \
        float su0 = 0.f, su1 = 0.f; \
        _Pragma("unroll") for (int r = 0; r < 16; ++r) { const f16x2 hh = __builtin_bit_cast(f16x2, rl[r]); su0 += (float)hh.x; su1 += (float)hh.y; } \
        float off0 = 0.f, off1 = 0.f, tot0 = 0.f, tot1 = 0.f; \
        _Pragma("unroll") for (int j = 0; j < 4; ++j) { const float a_ = __shfl(su0, cpx + 16 * j), b_ = __shfl(su1, cpx + 16 * j); if (j < rgx) { off0 += a_; off1 += b_; } tot0 += a_; tot1 += b_; } \
        const float et0 = __expf(tot0), et1 = __expf(tot1); float p0 = __expf(off0), p1 = __expf(off1); det0 = et0; det1 = et1; \
        float kp0 = 0.f, kp1 = 0.f; \
        _Pragma("unroll") for (int r = 0; r < 16; ++r) { const f16x2 hh = __builtin_bit_cast(f16x2, rl[r]); const float f0 = __expf((float)hh.x), f1 = __expf((float)hh.y); \
            p0 *= f0; p1 *= f1; \
            const float ki0 = (1.0f - f0) * __builtin_amdgcn_rcpf(p0), ki1 = (1.0f - f1) * __builtin_amdgcn_rcpf(p1); const float ke0 = ki0 * et0, ke1 = ki1 * et1; \
            sq[r] = pkbf(bf_lo(rq[r]) * p0, bf_hi(rq[r]) * p1); sk[r] = pkbf(ki0, ki1); \
            if (r & 1) { ske0[r >> 1] = pkbf(kp0, ke0); ske1[r >> 1] = pkbf(kp1, ke1); } \
            kp0 = ke0; kp1 = ke1; } } while (0)
#define DUMP_REGS() do { \
        _Pragma("unroll") for (int r = 0; r < 16; ++r) { *(LAS unsigned*)(QD + ((16 * rgx + r) * SQ + c0x) * 2) = sq[r]; *(LAS unsigned*)(KI + ((16 * rgx + r) * SQ + c0x) * 2) = sk[r]; } \
        { v4u w_; w_.x = ske0[0]; w_.y = ske0[1]; w_.z = ske0[2]; w_.w = ske0[3]; *(LAS v4u*)(KET + (c0x * SK + 16 * rgx) * 2) = w_; w_.x = ske0[4]; w_.y = ske0[5]; w_.z = ske0[6]; w_.w = ske0[7]; *(LAS v4u*)(KET + (c0x * SK + 16 * rgx + 8) * 2) = w_; \
          w_.x = ske1[0]; w_.y = ske1[1]; w_.z = ske1[2]; w_.w = ske1[3]; *(LAS v4u*)(KET + ((c0x + 1) * SK + 16 * rgx) * 2) = w_; w_.x = ske1[4]; w_.y = ske1[5]; w_.z = ske1[6]; w_.w = ske1[7]; *(LAS v4u*)(KET + ((c0x + 1) * SK + 16 * rgx + 8) * 2) = w_; \
          _Pragma("unroll") for (int hh_ = 0; hh_ < 2; ++hh_) { \
            w_.x = (rv[8 * hh_ + 0] & 0xffffu) | (rv[8 * hh_ + 1] << 16); w_.y = (rv[8 * hh_ + 2] & 0xffffu) | (rv[8 * hh_ + 3] << 16); w_.z = (rv[8 * hh_ + 4] & 0xffffu) | (rv[8 * hh_ + 5] << 16); w_.w = (rv[8 * hh_ + 6] & 0xffffu) | (rv[8 * hh_ + 7] << 16); \
            *(LAS v4u*)(VT + (c0x * SK + 16 * rgx + 8 * hh_) * 2) = w_; \
            w_.x = (rv[8 * hh_ + 0] >> 16) | (rv[8 * hh_ + 1] & 0xffff0000u); w_.y = (rv[8 * hh_ + 2] >> 16) | (rv[8 * hh_ + 3] & 0xffff0000u); w_.z = (rv[8 * hh_ + 4] >> 16) | (rv[8 * hh_ + 5] & 0xffff0000u); w_.w = (rv[8 * hh_ + 6] >> 16) | (rv[8 * hh_ + 7] & 0xffff0000u); \
            *(LAS v4u*)(VT + ((c0x + 1) * SK + 16 * rgx + 8 * hh_) * 2) = w_; } } \
        if (rgx == 0) { f32x2 p_; p_.x = det0; p_.y = det1; *(LAS f32x2*)(DEC + c0x) = p_; } } while (0)
        f32x4 S[8][2];
#define WRITE_ST() do { _Pragma("unroll") for (int kt = 0; kt < 8; ++kt) _Pragma("unroll") for (int j = 0; j < 2; ++j) { v2u w_; w_.x = pkbf(S[kt][j][0], S[kt][j][1]); w_.y = pkbf(S[kt][j][2], S[kt][j][3]); \
        *(LAS v2u*)(ST + ((16 * (2 * wq + j) + i) * SQ + 16 * kt + 4 * g) * 2) = w_; } } while (0)
#pragma unroll
        for (int kt = 0; kt < 8; ++kt)
#pragma unroll
            for (int j = 0; j < 2; ++j) S[kt][j] = (f32x4){0.f, 0.f, 0.f, 0.f};
        LOAD_RAW(0); LOAD_V(0);
        WRITE_ST();
        { const int cpx = cp, rgx = rg, c0x = c0; PREP_REGS(); (void)c0x; }
        LOAD_RAW(1);
        for (int n = 0; n < ne; ++n) {
            int i_ = i, g_ = g; asm volatile("" : "+v"(i_), "+v"(g_));
            const int cpx = i_, rgx = g_, c0x = 32 * wq + 2 * i_;
            DUMP_REGS();
            asm volatile("" ::: "memory");
            LOAD_V(n + 1);
            __syncthreads();
            {
                bf16x8 bv[2][2];
#pragma unroll
                for (int j = 0; j < 2; ++j)
#pragma unroll
                    for (int c = 0; c < 2; ++c) bv[j][c] = *(const LAS bf16x8*)(VT + ((16 * (2 * wq + j) + i_) * SK + 32 * c + 8 * g_) * 2);
#pragma unroll
                for (int kt = 0; kt < 8; ++kt) {
                    const f32x4 d = *(const LAS f32x4*)(DEC + 16 * kt + 4 * g_);
                    const bf16x8 a0 = *(const LAS bf16x8*)(KET + ((16 * kt + i_) * SK + 8 * g_) * 2), a1 = *(const LAS bf16x8*)(KET + ((16 * kt + i_) * SK + 32 + 8 * g_) * 2);
#pragma unroll
                    for (int j = 0; j < 2; ++j) { f32x4 acc = S[kt][j] * d; acc = MFMA16(a0, bv[j][0], acc); acc = MFMA16(a1, bv[j][1], acc); S[kt][j] = acc; }
                }
            }
            PREP_REGS();
            LOAD_RAW(n + 2);
            __syncthreads();
            WRITE_ST();
        }
        if (store_state) {
            float* op = s_out + (4 * g) * 128 + 32 * wq + i;
#pragma unroll
            for (int kt = 0; kt < 8; ++kt) {
#pragma unroll
                for (int j = 0; j < 2; ++j)
#pragma unroll
                    for (int r = 0; r < 4; ++r) __builtin_nontemporal_store(S[kt][j][r], op + r * 128 + 16 * j);
                op += 2048; asm volatile("" : "+v"(op));
            }
        }
#undef WRITE_ST
#undef DUMP_REGS
#undef PREP_REGS
#undef LOAD_RAW
#undef LOAD_V
    }
}

__device__ __forceinline__ void hgrn_sample_units(LAS unsigned char* lds, const bf16* Q, const bf16* LF, const bf16* V, const bf16* G, bf16* O, const float* gnorm,
                                                  const float* state, float* out_hs, int su0, int stride) {
    int tid_ = threadIdx.x; asm volatile("" : "+v"(tid_));
    const int tid = tid_, lane = tid & 63, wid = tid >> 6, kr = tid >> 5, vc = tid & 31;
    LAS float* SQv = (LAS float*)lds; LAS float* SFv = SQv + 512; LAS float* SKv = SQv + 1024; LAS float* SVv = SQv + 1536; LAS float* RED = SQv + 2048;
    if (su0 >= 2048) return;
    f32x4 S[8], Sn[8]; unsigned short nq, nl, nv;
    const int tt = tid >> 7, tk = tid & 127;
#define SU_LOAD(su_) do { const int b_ = (su_) >> 4, h_ = (su_) & 15; const f32x4* sp_ = (const f32x4*)(state + (size_t)(su_) * 16384 + kr * 128 + 4 * vc); \
        _Pragma("unroll") for (int p = 0; p < 8; ++p) Sn[p] = __builtin_nontemporal_load(sp_ + p * 512); \
        const size_t idx_ = ((size_t)h_ * MT + (size_t)(MP + 4 * b_ + tt)) * 128 + tk; nq = Q[idx_]; nl = LF[idx_]; nv = V[idx_]; } while (0)
    SU_LOAD(su0);
    for (int su = su0; su < 2048; su += stride) {
        const int b = su >> 4, h = su & 15;
#pragma unroll
        for (int p = 0; p < 8; ++p) S[p] = Sn[p];
        { const float q = __builtin_bit_cast(float, (unsigned)nq << 16), v = __builtin_bit_cast(float, (unsigned)nv << 16);
          const float f = __expf((float)__builtin_bit_cast(_Float16, nl));
          SQv[tid] = q; SFv[tid] = f; SKv[tid] = 1.0f - f; SVv[tid] = v; }
        { const int sn = (su + stride) < 2048 ? (su + stride) : su; SU_LOAD(sn); }
        __syncthreads();
        f32x4 o[4];
#pragma unroll
        for (int t = 0; t < 4; ++t) {
            const f32x4 vv = *(const LAS f32x4*)(SVv + t * 128 + 4 * vc); f32x4 acc = (f32x4){0.f, 0.f, 0.f, 0.f};
#pragma unroll
            for (int p = 0; p < 8; ++p) { const int k = t * 128 + kr + 16 * p; const float f = SFv[k], kn = SKv[k], q = SQv[k]; S[p] = S[p] * f + vv * kn; acc += S[p] * q; }
            o[t] = acc;
        }
        { f32x4* op = (f32x4*)(out_hs + (size_t)su * 16384 + kr * 128 + 4 * vc);
#pragma unroll
          for (int p = 0; p < 8; ++p) __builtin_nontemporal_store(S[p], op + p * 512); }
#pragma unroll
        for (int t = 0; t < 4; ++t) { o[t].x += __shfl_xor(o[t].x, 32); o[t].y += __shfl_xor(o[t].y, 32); o[t].z += __shfl_xor(o[t].z, 32); o[t].w += __shfl_xor(o[t].w, 32); }
        if (lane < 32) {
#pragma unroll
            for (int t = 0; t < 4; ++t) *(LAS f32x4*)(RED + (wid * 4 + t) * 128 + 4 * vc) = o[t];
        }
        __syncthreads();
        if (wid < 4) {
            const int t = wid; float a0 = 0.f, a1 = 0.f;
#pragma unroll
            for (int w2 = 0; w2 < 8; ++w2) { a0 += RED[(w2 * 4 + t) * 128 + lane]; a1 += RED[(w2 * 4 + t) * 128 + lane + 64]; }
            const float ss = wave_sum(a0 * a0 + a1 * a1); const float sc = __builtin_amdgcn_rsqf(ss * (1.0f / 128.0f) + LN_EPS);
            const int row = MP + 4 * b + t; const size_t gi = ((size_t)h * MT + (size_t)row) * 128;
            const float g0 = __builtin_bit_cast(float, (unsigned)G[gi + lane] << 16), g1 = __builtin_bit_cast(float, (unsigned)G[gi + lane + 64] << 16);
            bf16* orow = O + (size_t)row * 2048 + h * 128;
            orow[lane] = (bf16)(pkbf(a0 * sc * gnorm[h * 128 + lane] * g0, 0.f) & 0xffffu); orow[lane + 64] = (bf16)(pkbf(a1 * sc * gnorm[h * 128 + lane + 64] * g1, 0.f) & 0xffffu);
        }
        __syncthreads();
    }
#undef SU_LOAD
}

__device__ __forceinline__ void hgrn_phase(const Ptrs& P, LAS unsigned char* lds, int ctr_idx) {
    const bf16* Q = (const bf16*)(P.ws + WS_Q); const bf16* LF = (const bf16*)(P.ws + WS_LF); const bf16* V = (const bf16*)(P.ws + WS_V); const bf16* G = (const bf16*)(P.ws + WS_G);
    bf16* O = (bf16*)(P.ws + WS_O);
    const int Gd = (int)gridDim.x, bx = (int)blockIdx.x;
    if (Gd >= 256) {
        constexpr int SPLIT = 16;
        if (bx < 256) { const int pu = bx & 127; const bool late = bx >= 128;
            hgrn_unit(lds, Q, LF, V, G, O, P.gnorm, (pu >> 4) * 2048, pu & 15, P.out + OUT_HP + (size_t)pu * 16384, late ? SPLIT : 0, late ? 32 : SPLIT, late); }
        if (bx < 128) hgrn_sample_units(lds, Q, LF, V, G, O, P.gnorm, P.state, P.out + OUT_HS, bx, 128);
    } else {
        const bool split = Gd > 128;
        if (!split || bx < 128) {
            for (int pu = bx; pu < 128; pu += (split ? 128 : Gd)) hgrn_unit(lds, Q, LF, V, G, O, P.gnorm, (pu >> 4) * 2048, pu & 15, P.out + OUT_HP + (size_t)pu * 16384, 0, 32, true);
        }
        if (!split || bx >= 128) { const int sid = split ? bx - 128 : bx, ns = split ? Gd - 128 : Gd; __syncthreads(); hgrn_sample_units(lds, Q, LF, V, G, O, P.gnorm, P.state, P.out + OUT_HS, sid, ns); }
    }
    (void)ctr_idx;
}

__device__ __forceinline__ void gate_phase(const Ptrs& P, LAS unsigned char* lds) {
    const int tid = threadIdx.x, lane = tid & 63, wid = __builtin_amdgcn_readfirstlane(tid >> 6);
    const int i = lane & 15, g = lane >> 4;
    constexpr int SW = 136;
    const bf16* U = (const bf16*)(P.ws + WS_U); const bf16* Vb = (const bf16*)(P.ws + WS_VB); bf16* GT = (bf16*)(P.ws + WS_O);
    const float* part = (const float*)(P.ws + WS_PART); const bf16* WSB = (const bf16*)(P.ws + WS_WSB);
    LAS unsigned char* WT = lds; LAS unsigned char* VNT = lds + 34816; LAS f32x2* STT = (LAS f32x2*)(lds + 69632);
    int cur_grp = -1;
    for (int u = blockIdx.x; u < 2048; u += gridDim.x) {
        const int grp = u & 15, m0 = (u >> 4) * 128;
        v2u uq[8]; float bq_[8];
        { const size_t og0 = ((size_t)grp * MT + (size_t)(m0 + i)) * 128 + 16 * wid + 4 * g;
#pragma unroll
          for (int tt = 0; tt < 8; ++tt) { uq[tt] = __builtin_nontemporal_load((const v2u*)(U + og0 + (size_t)tt * 16 * 128)); bq_[tt] = P.b_s[grp * 128 + 16 * tt + i]; } }
        __syncthreads();
        if (grp != cur_grp) {
#pragma unroll
            for (int it = 0; it < 4; ++it) { const int idx = tid + 512 * it, row = idx >> 4, c16 = idx & 15;
                *(LAS v4u*)(WT + (row * SW) * 2 + c16 * 16) = *(const v4u*)(WSB + (size_t)grp * 16384 + row * 128 + c16 * 8); }
            cur_grp = grp;
        }
        unsigned vraw[16];
#pragma unroll
        for (int r = 0; r < 16; ++r) vraw[r] = __builtin_nontemporal_load((const unsigned*)(Vb + ((size_t)grp * MT + (size_t)(m0 + 16 * wid + r)) * 128 + 2 * lane));
        if (tid < 128) { const f32x2* pr = (const f32x2*)(part + (size_t)(m0 + tid) * 64); float s = 0.f, ss = 0.f;
#pragma unroll
            for (int j = 0; j < 32; ++j) { const f32x2 p = pr[j]; s += p.x; ss += p.y; }
            const float mean = s * (1.0f / 2048.0f), var = ss * (1.0f / 2048.0f) - mean * mean; f32x2 o; o.x = mean; o.y = 1.0f / sqrtf(var + LN_EPS); STT[tid] = o; }
        __syncthreads();
        {
            const int c0 = grp * 128 + 2 * lane; const float g0 = P.lnv_g[c0], g1 = P.lnv_g[c0 + 1], b0 = P.lnv_b[c0], b1 = P.lnv_b[c0 + 1];
            float y0[16], y1[16];
#pragma unroll
            for (int r = 0; r < 16; ++r) { const int row = 16 * wid + r; const unsigned raw = vraw[r]; const f32x2 st = STT[row];
                y0[r] = (bf_lo(raw) - st.x) * st.y * g0 + b0; y1[r] = (bf_hi(raw) - st.x) * st.y * g1 + b1; }
#pragma unroll
            for (int hh = 0; hh < 2; ++hh) { v4u w0, w1;
                w0.x = pkbf(y0[8 * hh + 0], y0[8 * hh + 1]); w0.y = pkbf(y0[8 * hh + 2], y0[8 * hh + 3]); w0.z = pkbf(y0[8 * hh + 4], y0[8 * hh + 5]); w0.w = pkbf(y0[8 * hh + 6], y0[8 * hh + 7]);
                w1.x = pkbf(y1[8 * hh + 0], y1[8 * hh + 1]); w1.y = pkbf(y1[8 * hh + 2], y1[8 * hh + 3]); w1.z = pkbf(y1[8 * hh + 4], y1[8 * hh + 5]); w1.w = pkbf(y1[8 * hh + 6], y1[8 * hh + 7]);
                *(LAS v4u*)(VNT + ((2 * lane) * SW + 16 * wid + 8 * hh) * 2) = w0; *(LAS v4u*)(VNT + ((2 * lane + 1) * SW + 16 * wid + 8 * hh) * 2) = w1; }
        }
        __syncthreads();
        {
            bf16x8 av[4];
#pragma unroll
            for (int kk = 0; kk < 4; ++kk) av[kk] = *(const LAS bf16x8*)(VNT + ((16 * wid + i) * SW + 32 * kk + 8 * g) * 2);
#pragma unroll
            for (int tt = 0; tt < 8; ++tt) {
                f32x4 acc = (f32x4){0.f, 0.f, 0.f, 0.f};
#pragma unroll
                for (int kk = 0; kk < 4; ++kk) if (kk <= (tt >> 1)) { const bf16x8 b = *(const LAS bf16x8*)(WT + ((16 * tt + i) * SW + 32 * kk + 8 * g) * 2); acc = MFMA16(av[kk], b, acc); }
                const int t = 16 * tt + i; const float bias = bq_[tt];
                const size_t off = (size_t)(m0 + t) * 2048 + grp * 128 + 16 * wid + 4 * g;
                const v2u uu = uq[tt];
                v2u w; w.x = pkbf(bf_lo(uu.x) * (acc[0] + bias), bf_hi(uu.x) * (acc[1] + bias));
                w.y = pkbf(bf_lo(uu.y) * (acc[2] + bias), bf_hi(uu.y) * (acc[3] + bias));
                *(v2u*)(GT + off) = w;
            }
        }
    }
    for (int sb = (int)gridDim.x - 1 - (int)blockIdx.x; sb < 128; sb += gridDim.x) {
        __syncthreads();
        const int mrow = MP + 4 * sb;
        if (tid < 4) { const f32x2* pr = (const f32x2*)(part + (size_t)(mrow + tid) * 64); float s = 0.f, ss = 0.f;
            for (int j = 0; j < 32; ++j) { const f32x2 p = pr[j]; s += p.x; ss += p.y; }
            const float mean = s * (1.0f / 2048.0f), var = ss * (1.0f / 2048.0f) - mean * mean; f32x2 o; o.x = mean; o.y = 1.0f / sqrtf(var + LN_EPS); STT[tid] = o; }
        __syncthreads();
        const int c = 4 * tid, grp = c >> 7;
        const f32x4 lg = *(const f32x4*)(P.lnv_g + c), lb = *(const f32x4*)(P.lnv_b + c);
        f32x4 vn[4];
#pragma unroll
        for (int t = 0; t < 4; ++t) { const v2u raw = *(const v2u*)(Vb + ((size_t)grp * MT + (size_t)(mrow + t)) * 128 + (c & 127)); const f32x2 st = STT[t];
            f32x4 x; x.x = bf_lo(raw.x); x.y = bf_hi(raw.x); x.z = bf_lo(raw.y); x.w = bf_hi(raw.y);
            vn[t] = (x - st.x) * st.y * lg + lb;
            __builtin_nontemporal_store(vn[t], (f32x4*)(P.out + OUT_CV + (size_t)(4 * sb + t) * 2048 + c)); }
#pragma unroll
        for (int t = 0; t < 4; ++t) { const float bias = P.b_s[grp * 128 + t]; f32x4 mx = (f32x4){bias, bias, bias, bias};
#pragma unroll
            for (int s = 0; s < 4; ++s) if (s <= t) mx += vn[s] * P.w_s[(size_t)grp * 16384 + t * 128 + s];
            const size_t off = (size_t)(mrow + t) * 2048 + c; const size_t offg = ((size_t)grp * MT + (size_t)(mrow + t)) * 128 + (c & 127); const v2u uu = *(const v2u*)(U + offg);
            v2u w; w.x = pkbf(bf_lo(uu.x) * mx.x, bf_hi(uu.x) * mx.y); w.y = pkbf(bf_lo(uu.y) * mx.z, bf_hi(uu.y) * mx.w);
            *(v2u*)(GT + off) = w; }
    }
}

struct Args { const float* in[15]; float* out; unsigned char* ws; int ph_lo, ph_hi; };
__global__ void __launch_bounds__(512, 2) mk_fwd(Args a) {
    extern __shared__ __attribute__((aligned(16))) unsigned char lds_raw[];
    LAS unsigned char* lds = (LAS unsigned char*)lds_raw;
    Ptrs P;
    P.xp = a.in[0]; P.xs = a.in[1]; P.state = a.in[2]; P.w_in_a = a.in[3]; P.lb_logits = a.in[4]; P.gnorm = a.in[5]; P.w_out_a = a.in[6]; P.w_in_b = a.in[7];
    P.lnv_g = a.in[8]; P.lnv_b = a.in[9]; P.w_s = a.in[10]; P.b_s = a.in[11]; P.w_out_b = a.in[12]; P.ln_g = a.in[13]; P.ln_b = a.in[14]; P.out = a.out; P.ws = a.ws;
    const int lo = a.ph_lo, hi = a.ph_hi;
    volatile LAS unsigned* bst = (volatile LAS unsigned*)(lds + 131072 + 64);
    if (threadIdx.x == 0) { bst[0] = 0u; bst[1] = 0u; }
    __syncthreads();
    XcdBarrier bar = xcd_barrier_post((unsigned*)(P.ws + WS_BAR), bst);
    if (lo < 0) cg::this_grid().sync();
#define IN(k) (lo <= (k) && (k) < hi)
#define SEAM(k) do { if (IN(k) && IN((k) + 1)) { xcd_barrier(bar); } } while (0)
#ifndef PROBE_REP
#define PROBE_REP -1
#endif
#define REP(k) for (int rep_ = 0; rep_ < ((PROBE_REP == (k)) ? 2 : 1); ++rep_, (void)((PROBE_REP == (k) && rep_ == 1) ? (cg::this_grid().sync(), 0) : 0))
    const int G = (int)gridDim.x, c = (int)blockIdx.x;
    if (IN(0)) REP(0) { p0_prologue(P, lds); }
    SEAM(0);
    if (IN(1)) REP(1) {
        pg8::Gemm g{(const bf16*)(P.ws + WS_XB), (const bf16*)(P.ws + WS_WINA), MT, 4 * EA, DM}; pg8::StaticOrder S; S.init(MT, 4 * EA, G, c);
        pg8::EpiHgrnIn E{(bf16*)(P.ws + WS_Q), (const float*)(P.ws + WS_LB)};
        pg8::gemm_phase<pg8::EpiHgrnIn, pg8::StaticOrder, true, true>(lds, g, S, E);
    }
    SEAM(1);
    if (IN(2)) REP(2) { hgrn_phase(P, lds, rep_); }
    SEAM(2);
    if (IN(3)) REP(3) {
        const int Mo = G > 32 ? MP : MT;
        pg8::Gemm g{(const bf16*)(P.ws + WS_O), (const bf16*)(P.ws + WS_WOUTA), Mo, DM, EA}; pg8::StaticOrder S; S.init(Mo, DM, G, c);
        pg8::EpiBf16Plain E{(bf16*)(P.ws + WS_D), DM};
        pg8::gemm_phase<pg8::EpiBf16Plain, pg8::StaticOrder, true, true>(lds, g, S, E);
    }
    SEAM(3);
    if (IN(4)) REP(4) { ln_phase<false>(P, lds, 0); }
    SEAM(4);
    if (IN(5)) REP(5) {
        pg8::Gemm g{(const bf16*)(P.ws + WS_XB), (const bf16*)(P.ws + WS_WINB), MT, 3 * EA, DM}; pg8::StaticOrder S; S.init(MT, 3 * EA, G, c);
        pg8::EpiGmlpIn E{(bf16*)(P.ws + WS_U), (float*)(P.ws + WS_PART)};
        pg8::gemm_phase<pg8::EpiGmlpIn, pg8::StaticOrder, true, true>(lds, g, S, E);
    }
    SEAM(5);
    if (IN(6)) REP(6) { gate_phase(P, lds); }
    SEAM(6);
    if (IN(7)) REP(7) {
        const int Mo = G > 32 ? MP : MT;
        pg8::Gemm g{(const bf16*)(P.ws + WS_O), (const bf16*)(P.ws + WS_WOUTB), Mo, DM, EA}; pg8::StaticOrder S; S.init(Mo, DM, G, c);
        pg8::EpiBf16Plain E{(bf16*)(P.ws + WS_D), DM};
        pg8::gemm_phase<pg8::EpiBf16Plain, pg8::StaticOrder, true, true>(lds, g, S, E);
    }
    SEAM(7);
    if (IN(8)) REP(8) { ln_phase<true>(P, lds, 1); }
#undef IN
#undef SEAM
}

extern "C" void kernel_launch(void* const* d_in, const int* in_sizes, int n_in, void* d_out, int out_size, void* d_ws, size_t ws_size, hipStream_t stream) {
    static int grid = 0;
    if (grid == 0) {
        if (n_in != 15 || ws_size < WS_END || out_size != 54001664) { fprintf(stderr, "kernel_launch: unexpected problem (n_in %d, out %d, ws %zu)\n", n_in, out_size, ws_size); grid = -1; return; }
        int dev = 0, cus = 0, per_cu = 0;
        if (hipGetDevice(&dev) != hipSuccess || hipDeviceGetAttribute(&cus, hipDeviceAttributeMultiprocessorCount, dev) != hipSuccess) { grid = -1; return; }
        if (hipFuncSetAttribute((const void*)mk_fwd, hipFuncAttributeMaxDynamicSharedMemorySize, LDS_BYTES) != hipSuccess) { fprintf(stderr, "kernel_launch: hipFuncSetAttribute failed\n"); grid = -1; return; }
        if (hipOccupancyMaxActiveBlocksPerMultiprocessor(&per_cu, (const void*)mk_fwd, 512, LDS_BYTES) != hipSuccess || per_cu < 1) { fprintf(stderr, "kernel_launch: occupancy query gave %d\n", per_cu); (void)hipGetLastError(); per_cu = 1; }
        grid = cus * 1;
        (void)in_sizes;
    }
    if (grid < 0) return;
    Args a{};
    for (int i = 0; i < 15; ++i) a.in[i] = (const float*)d_in[i];
    a.out = (float*)d_out; a.ws = (unsigned char*)d_ws;
#if MK_MULTI
    for (int p = 0; p < NPHASE; ++p) { a.ph_lo = p; a.ph_hi = p + 1; hipLaunchKernelGGL(mk_fwd, dim3(grid), dim3(512), LDS_BYTES, stream, a); }
#else
    a.ph_lo = 0; a.ph_hi = NPHASE;
    if (hipMemsetAsync((char*)d_ws + WS_BAR, 0, XCD_BAR_WORDS * 4, stream) != hipSuccess) { fprintf(stderr, "kernel_launch: memset of the barrier words failed\n"); return; }
    void* args[] = {&a};
    hipError_t e = hipLaunchCooperativeKernel((const void*)mk_fwd, dim3(grid), dim3(512), args, LDS_BYTES, stream);
    if (e != hipSuccess) fprintf(stderr, "kernel_launch: cooperative launch failed: %s (grid %d)\n", hipGetErrorString(e), grid);
#endif
}
```

```cpp
#include <hip/hip_runtime.h>
#include <hip/hip_cooperative_groups.h>
#include <cstdio>
#include <cstdint>
namespace cg = cooperative_groups;
#define MK_MULTI 0
namespace pg8 {
#define PG8_LAS __attribute__((address_space(3)))
typedef unsigned short bf16_t;
typedef short bf16x8 __attribute__((ext_vector_type(8)));
typedef float f32x4 __attribute__((ext_vector_type(4)));
typedef unsigned u32x4 __attribute__((ext_vector_type(4)));
constexpr int BM = 256, BK = 64, HALF = 128, HTB = HALF * BK * 2  , STAGE_BYTES = 8 * HTB, NXCD = 8, WGM = 8;

__host__ __device__ __forceinline__ int lds_byte(int r, int c) { const int st = (r >> 4) * 2 + (c >> 5), rr = r & 15, cc = c & 31, ob = rr * 64 + cc * 2; return st * 1024 + (ob ^ (((ob >> 9) & 1) << 5)); }
__host__ __device__ __forceinline__ void stage_rc(int b, int& R, int& C) { const int st = b / 1024, sb = b % 1024, swz = sb ^ (((sb >> 9) & 1) << 5); R = (st >> 1) * 16 + swz / 64; C = (st & 1) * 32 + (swz % 64) / 2; }
__host__ __device__ __forceinline__ int perm32(int rho) { const int n = rho >> 4, i = rho & 15; return 8 * (i >> 2) + 4 * n + (i & 3); }

struct Unit { int pm, pn; };
struct Gemm { const bf16_t* A; const bf16_t* Bt; int M, N, K; int nt = 0; };

struct StaticOrder {
    int nM, nN, nwg, G, c;
    __host__ __device__ void init(int M, int N, int G_, int c_) { nM = M / BM; nN = N / BM; nwg = nM * nN; G = G_; c = c_; }
    __host__ __device__ bool next(int i, Unit& u) const {
        const long L = (long)i * G + c; if (L >= nwg) return false;
        int wgid = (int)L; { const int q = nwg / NXCD, r = nwg % NXCD, xcd = wgid % NXCD, off = wgid / NXCD; wgid = (xcd < r ? xcd * (q + 1) : r * (q + 1) + (xcd - r) * q) + off; }
        const int nig = WGM * nN, gid = wgid / nig, fm = gid * WGM, gsz = (nM - fm) < WGM ? (nM - fm) : WGM;
        u.pm = fm + ((wgid % nig) % gsz); u.pn = (wgid % nig) / gsz; return true;
    }
    __device__ __forceinline__ void a_ready(const Unit&) const {}
    __device__ __forceinline__ void done(const Unit&) const {}
};

typedef float cvt_f32x2 __attribute__((ext_vector_type(2)));
typedef __bf16 cvt_bf16x2 __attribute__((ext_vector_type(2)));
__device__ __forceinline__ unsigned cvt_pk_bf16(float lo, float hi) { cvt_f32x2 v; v.x = lo; v.y = hi; const cvt_bf16x2 b = __builtin_convertvector(v, cvt_bf16x2); return __builtin_bit_cast(unsigned, b); }
typedef unsigned u32x2 __attribute__((ext_vector_type(2)));
constexpr size_t MROWS = 16896;
constexpr size_t SEC_STRIDE = (size_t)16896 * 2048;
typedef float f32x2 __attribute__((ext_vector_type(2)));
typedef _Float16 f16x2 __attribute__((ext_vector_type(2)));
__device__ __forceinline__ float silu_f(float x) { return x * __builtin_amdgcn_rcpf(1.0f + __expf(-x)); }
__device__ __forceinline__ float gelu_tanh_f(float x) { const float u = 1.5957691216057308f * (x + 0.044715f * x * x * x); return x * __builtin_amdgcn_rcpf(1.0f + __expf(-u)); }
__device__ __forceinline__ unsigned pk_f16(float lo, float hi) { f16x2 p; p.x = (_Float16)lo; p.y = (_Float16)hi; return __builtin_bit_cast(unsigned, p); }

struct EpiHgrnIn {
    static constexpr bool PERM = true, AFTER_DRAIN = false;
    bf16_t* B0; const float* lb;
    __device__ __forceinline__ void operator()(const f32x4 (&acc)[2][2][4][2], const Unit& u, int wr, int wc, int fr, int fq) const {
        const int sec = u.pn >> 3;
        const int row0 = u.pm * BM + wr * 64 + fr, col0 = (u.pn & 7) * BM + wc * 32 + 8 * fq;
        bf16_t* base = B0 + (size_t)sec * SEC_STRIDE;
        f32x4 l0[2], l1[2];
#pragma unroll
        for (int bj = 0; bj < 2; ++bj) { l0[bj] = (f32x4){0.f, 0.f, 0.f, 0.f}; l1[bj] = l0[bj]; }
        if (sec == 1) {
#pragma unroll
            for (int bj = 0; bj < 2; ++bj) { l0[bj] = *(const f32x4*)(lb + col0 + bj * HALF); l1[bj] = *(const f32x4*)(lb + col0 + bj * HALF + 4); }
        }
#pragma unroll
        for (int ai = 0; ai < 2; ++ai)
#pragma unroll
            for (int m = 0; m < 4; ++m) { bf16_t* rowp = base + ((size_t)((u.pn & 7) * 2) * MROWS + (size_t)(row0 + ai * HALF + m * 16)) * 128 + wc * 32 + 8 * fq;
#pragma unroll
                for (int bj = 0; bj < 2; ++bj) { f32x4 v0 = acc[ai][bj][m][0], v1 = acc[ai][bj][m][1]; u32x4 w;
                    if (sec == 1) {
#pragma unroll
                        for (int j = 0; j < 4; ++j) { const float s0 = __builtin_amdgcn_rcpf(1.0f + __expf(-v0[j])), s1 = __builtin_amdgcn_rcpf(1.0f + __expf(-v1[j]));
                            v0[j] = __logf(l0[bj][j] + (1.0f - l0[bj][j]) * s0); v1[j] = __logf(l1[bj][j] + (1.0f - l1[bj][j]) * s1); }
                        w.x = pk_f16(v0[0], v0[1]); w.y = pk_f16(v0[2], v0[3]); w.z = pk_f16(v1[0], v1[1]); w.w = pk_f16(v1[2], v1[3]);
                    } else {
                        if (sec != 2) {
#pragma unroll
                            for (int j = 0; j < 4; ++j) { v0[j] = silu_f(v0[j]); v1[j] = silu_f(v1[j]); } }
                        w.x = cvt_pk_bf16(v0[0], v0[1]); w.y = cvt_pk_bf16(v0[2], v0[3]); w.z = cvt_pk_bf16(v1[0], v1[1]); w.w = cvt_pk_bf16(v1[2], v1[3]);
                    }
                    *(u32x4*)(rowp + (size_t)bj * MROWS * 128) = w; } }
    }
};
struct EpiGmlpIn {
    static constexpr bool PERM = true, AFTER_DRAIN = false;
    bf16_t* B0; float* part;
    __device__ __forceinline__ void operator()(const f32x4 (&acc)[2][2][4][2], const Unit& u, int wr, int wc, int fr, int fq) const {
        const int row0 = u.pm * BM + wr * 64 + fr;
        if (u.pn < 16) {
#pragma unroll
            for (int ai = 0; ai < 2; ++ai)
#pragma unroll
                for (int m = 0; m < 4; ++m) { const int row = row0 + ai * HALF + m * 16; bf16_t* rowp = B0 + ((size_t)u.pn * MROWS + (size_t)row) * 128 + wc * 32 + 8 * fq;
                    f32x4 v0 = acc[ai][0][m][0], v1 = acc[ai][0][m][1]; const f32x4 z0 = acc[ai][1][m][0], z1 = acc[ai][1][m][1]; u32x4 w;
#pragma unroll
                    for (int j = 0; j < 4; ++j) { v0[j] = gelu_tanh_f(v0[j]) * silu_f(z0[j]); v1[j] = gelu_tanh_f(v1[j]) * silu_f(z1[j]); }
                    w.x = cvt_pk_bf16(v0[0], v0[1]); w.y = cvt_pk_bf16(v0[2], v0[3]); w.z = cvt_pk_bf16(v1[0], v1[1]); w.w = cvt_pk_bf16(v1[2], v1[3]);
                    *(u32x4*)rowp = w; }
        } else {
            const int g0 = (u.pn - 16) * 2;
#pragma unroll
            for (int ai = 0; ai < 2; ++ai)
#pragma unroll
                for (int m = 0; m < 4; ++m) { const int row = row0 + ai * HALF + m * 16; bf16_t* rowp = B0 + SEC_STRIDE + ((size_t)g0 * MROWS + (size_t)row) * 128 + wc * 32 + 8 * fq; float s = 0.f, ss = 0.f;
#pragma unroll
                    for (int bj = 0; bj < 2; ++bj) { f32x4 v0 = acc[ai][bj][m][0], v1 = acc[ai][bj][m][1]; u32x4 w;
#pragma unroll
                        for (int j = 0; j < 4; ++j) { v0[j] = gelu_tanh_f(v0[j]); v1[j] = gelu_tanh_f(v1[j]); s += v0[j] + v1[j]; ss += v0[j] * v0[j] + v1[j] * v1[j]; }
                        w.x = cvt_pk_bf16(v0[0], v0[1]); w.y = cvt_pk_bf16(v0[2], v0[3]); w.z = cvt_pk_bf16(v1[0], v1[1]); w.w = cvt_pk_bf16(v1[2], v1[3]);
                        *(u32x4*)(rowp + (size_t)bj * MROWS * 128) = w; }
                    s += __shfl_xor(s, 16); s += __shfl_xor(s, 32); ss += __shfl_xor(ss, 16); ss += __shfl_xor(ss, 32);
                    if (fq == 0) { f32x2 o; o.x = s; o.y = ss; *(f32x2*)(part + (size_t)row * 64 + ((u.pn - 16) * 4 + wc) * 2) = o; } }
        }
    }
};
struct EpiF32 {
    static constexpr bool PERM = false, AFTER_DRAIN = false;
    float* C; int ldc;
    __device__ __forceinline__ void operator()(const f32x4 (&acc)[2][2][4][2], const Unit& u, int wr, int wc, int fr, int fq) const {
        const int row0 = u.pm * BM + wr * 64 + fr, col0 = u.pn * BM + wc * 32 + 4 * fq;
#pragma unroll
        for (int ai = 0; ai < 2; ++ai)
#pragma unroll
            for (int m = 0; m < 4; ++m) { float* rowp = C + (size_t)(row0 + ai * HALF + m * 16) * ldc + col0;
#pragma unroll
                for (int bj = 0; bj < 2; ++bj)
#pragma unroll
                    for (int n = 0; n < 2; ++n) *(f32x4*)(rowp + bj * HALF + n * 16) = acc[ai][bj][m][n]; }
    }
};
struct EpiBf16Plain {
    static constexpr bool PERM = true, AFTER_DRAIN = false;
    bf16_t* C; int ldc;
    __device__ __forceinline__ void operator()(const f32x4 (&acc)[2][2][4][2], const Unit& u, int wr, int wc, int fr, int fq) const {
        const int row0 = u.pm * BM + wr * 64 + fr, col0 = u.pn * BM + wc * 32 + 8 * fq;
#pragma unroll
        for (int ai = 0; ai < 2; ++ai)
#pragma unroll
            for (int m = 0; m < 4; ++m) { bf16_t* rowp = C + (size_t)(row0 + ai * HALF + m * 16) * ldc + col0;
#pragma unroll
                for (int bj = 0; bj < 2; ++bj) { const f32x4 v0 = acc[ai][bj][m][0], v1 = acc[ai][bj][m][1]; u32x4 w;
                    w.x = cvt_pk_bf16(v0[0], v0[1]); w.y = cvt_pk_bf16(v0[2], v0[3]); w.z = cvt_pk_bf16(v1[0], v1[1]); w.w = cvt_pk_bf16(v1[2], v1[3]);
                    *(u32x4*)(rowp + bj * HALF) = w; } }
    }
};
template <class Epi, class Sched, bool ALIGN_EPI = false, bool SP2 = false>
__device__ __forceinline__ void gemm_phase(PG8_LAS unsigned char* lds, const Gemm g, const Sched& S, const Epi& E) {
    const int tid = threadIdx.x, wid = __builtin_amdgcn_readfirstlane(tid >> 6), lane = tid & 63, wr = wid >> 2, wc = wid & 3, fr = lane & 15, fq = lane >> 4;
    const int K = g.K, nt = g.nt ? g.nt : K / BK;
    unsigned voffA[2], voffB[2];
#pragma unroll
    for (int i = 0; i < 2; ++i) { int R, C; stage_rc(tid * 16 + i * 8192, R, C); const int Rb = Epi::PERM ? ((R & ~31) + perm32(R & 31)) : R;
        voffA[i] = (unsigned)(R * K + C) * 2u; voffB[i] = (unsigned)(Rb * K + C) * 2u; }
    const size_t kstep = (size_t)(BK * 2);
    const size_t hstep = (size_t)HALF * K * 2;
    const size_t tstep = 2 * hstep;
    const unsigned ldsw = (unsigned)wid * 1024u;
    const int aoff = lds_byte(wr * 64 + fr, fq * 8), boff = lds_byte(wc * 32 + fr, fq * 8);
#define PG8_SA(b, h) (((b) * 2 + (h)) * HTB)
#define PG8_SB(b, h) ((4 + (b) * 2 + (h)) * HTB)
#define PG8_STAGE(bufoff, gbase, voff) do { _Pragma("unroll") for (int _i = 0; _i < 2; ++_i) \
        __builtin_amdgcn_global_load_lds((const unsigned*)((const char*)(gbase) + (voff)[_i]), (PG8_LAS unsigned*)(lds + (bufoff) + ldsw + _i * 8192), 16, 0, 0); } while (0)
#define PG8_LDA(dst, b, h) do { _Pragma("unroll") for (int m = 0; m < 4; ++m) _Pragma("unroll") for (int k = 0; k < 2; ++k) dst[m][k] = *(const PG8_LAS bf16x8*)(lds + PG8_SA(b, h) + aoff + m * 2048 + k * 1024); } while (0)
#define PG8_LDB(dst, b, h) do { _Pragma("unroll") for (int n = 0; n < 2; ++n) _Pragma("unroll") for (int k = 0; k < 2; ++k) dst[n][k] = *(const PG8_LAS bf16x8*)(lds + PG8_SB(b, h) + boff + n * 2048 + k * 1024); } while (0)
#define PG8_MMA(ai, bj, At, Bt) do { __builtin_amdgcn_s_setprio(1); _Pragma("unroll") for (int m = 0; m < 4; ++m) _Pragma("unroll") for (int n = 0; n < 2; ++n) _Pragma("unroll") for (int k = 0; k < 2; ++k) \
        acc[ai][bj][m][n] = __builtin_amdgcn_mfma_f32_16x16x32_bf16(Bt[n][k], At[m][k], acc[ai][bj][m][n], 0, 0, 0); __builtin_amdgcn_s_setprio(0); } while (0)
#define PG8_WAIT_V(n) asm volatile("s_waitcnt vmcnt(" #n ")" ::: "memory")
#define PG8_WAIT_L(n) asm volatile("s_waitcnt lgkmcnt(" #n ")" ::: "memory")
#define PG8_BAR __builtin_amdgcn_s_barrier()
#define PG8_SCHED __builtin_amdgcn_sched_barrier(0)
    Unit cur, nxt; int ui = 0;
    if (!S.next(0, cur)) return;
    f32x4 acc[2][2][4][2];
#pragma unroll
    for (int a = 0; a < 2; ++a)
#pragma unroll
        for (int b = 0; b < 2; ++b)
#pragma unroll
            for (int m = 0; m < 4; ++m)
#pragma unroll
                for (int n = 0; n < 2; ++n) acc[a][b][m][n] = (f32x4){0.f, 0.f, 0.f, 0.f};
    bf16x8 At[4][2], B0[2][2], B1[2][2];
    const char* cA = (const char*)g.A + (size_t)cur.pm * tstep; const char* cB = (const char*)g.Bt + (size_t)cur.pn * tstep;
    S.a_ready(cur);
    if constexpr (SP2) {
        PG8_STAGE(PG8_SB(0, 0), cB, voffB); PG8_STAGE(PG8_SB(0, 1), cB + hstep, voffB); PG8_STAGE(PG8_SA(0, 0), cA, voffA); PG8_STAGE(PG8_SA(0, 1), cA + hstep, voffA);
        if (wr == 1) PG8_BAR;
        PG8_WAIT_V(2); PG8_BAR;
        PG8_STAGE(PG8_SB(1, 0), cB + kstep, voffB); PG8_STAGE(PG8_SA(1, 0), cA + kstep, voffA); PG8_STAGE(PG8_SB(1, 1), cB + hstep + kstep, voffB);
        PG8_WAIT_V(6); PG8_BAR;
    } else {
        PG8_STAGE(PG8_SB(0, 0), cB, voffB); PG8_STAGE(PG8_SA(0, 0), cA, voffA); PG8_STAGE(PG8_SB(0, 1), cB + hstep, voffB); PG8_STAGE(PG8_SA(0, 1), cA + hstep, voffA);
        if (wr == 1) PG8_BAR;
        PG8_WAIT_V(4); PG8_BAR;
        PG8_STAGE(PG8_SB(1, 0), cB + kstep, voffB); PG8_STAGE(PG8_SA(1, 0), cA + kstep, voffA); PG8_STAGE(PG8_SB(1, 1), cB + hstep + kstep, voffB);
        PG8_WAIT_V(6); PG8_BAR;
    }
    for (;;) {
        const bool has_next = S.next(ui + 1, nxt);
        const char* nA = has_next ? (const char*)g.A + (size_t)nxt.pm * tstep : cA; const char* nB = has_next ? (const char*)g.Bt + (size_t)nxt.pn * tstep : cB;
        for (int t = 0; t < nt; t += 2) {
            const bool last = (t == nt - 2);
            const char* a1 = cA + (size_t)(t + 1) * kstep;
            const char* a2 = last ? nA : cA + (size_t)(t + 2) * kstep; const char* b2 = last ? nB : cB + (size_t)(t + 2) * kstep;
            const char* a3 = a2 + kstep; const char* b3 = b2 + kstep;
            if (last && has_next) S.a_ready(nxt);
            if constexpr (SP2) {
            PG8_LDB(B0, 0, 0); PG8_LDB(B1, 0, 1); PG8_SCHED; PG8_LDA(At, 0, 0); PG8_STAGE(PG8_SA(1, 1), a1 + hstep, voffA);
            PG8_WAIT_V(8); PG8_WAIT_L(0); PG8_BAR; PG8_MMA(0, 0, At, B0); PG8_MMA(0, 1, At, B1); PG8_BAR; PG8_SCHED;
            PG8_LDA(At, 0, 1); PG8_STAGE(PG8_SB(0, 0), b2, voffB); PG8_STAGE(PG8_SB(0, 1), b2 + hstep, voffB); PG8_STAGE(PG8_SA(0, 0), a2, voffA);
            PG8_WAIT_V(8); PG8_WAIT_L(0); PG8_BAR; PG8_MMA(1, 0, At, B0); PG8_MMA(1, 1, At, B1); PG8_BAR; PG8_SCHED;
            PG8_LDB(B0, 1, 0); PG8_LDB(B1, 1, 1); PG8_SCHED; PG8_LDA(At, 1, 0); PG8_STAGE(PG8_SA(0, 1), a2 + hstep, voffA);
            PG8_WAIT_V(8); PG8_WAIT_L(0); PG8_BAR; PG8_MMA(0, 0, At, B0); PG8_MMA(0, 1, At, B1); PG8_BAR; PG8_SCHED;
            PG8_LDA(At, 1, 1); PG8_STAGE(PG8_SB(1, 0), b3, voffB); PG8_STAGE(PG8_SB(1, 1), b3 + hstep, voffB); PG8_STAGE(PG8_SA(1, 0), a3, voffA);
            PG8_WAIT_V(8); PG8_WAIT_L(0); PG8_BAR; PG8_MMA(1, 0, At, B0); PG8_MMA(1, 1, At, B1); PG8_BAR; PG8_SCHED;
            } else {
            PG8_LDB(B0, 0, 0); PG8_SCHED; PG8_LDA(At, 0, 0); PG8_STAGE(PG8_SA(1, 1), a1 + hstep, voffA);
            PG8_WAIT_L(8); PG8_BAR; PG8_WAIT_L(0); PG8_MMA(0, 0, At, B0); PG8_BAR; PG8_SCHED;
            PG8_LDB(B1, 0, 1); PG8_STAGE(PG8_SB(0, 0), b2, voffB);
            PG8_BAR; PG8_WAIT_L(0); PG8_MMA(0, 1, At, B1); PG8_BAR;
            PG8_LDA(At, 0, 1); PG8_STAGE(PG8_SA(0, 0), a2, voffA);
            PG8_BAR; PG8_WAIT_L(0); PG8_MMA(1, 0, At, B0); PG8_BAR; PG8_SCHED;
            PG8_STAGE(PG8_SB(0, 1), b2 + hstep, voffB);
            PG8_WAIT_V(6); PG8_BAR; PG8_MMA(1, 1, At, B1); PG8_BAR;
            PG8_LDB(B0, 1, 0); PG8_SCHED; PG8_LDA(At, 1, 0); PG8_STAGE(PG8_SA(0, 1), a2 + hstep, voffA);
            PG8_WAIT_L(8); PG8_BAR; PG8_WAIT_L(0); PG8_MMA(0, 0, At, B0); PG8_BAR; PG8_SCHED;
            PG8_LDB(B1, 1, 1); PG8_STAGE(PG8_SB(1, 0), b3, voffB);
            PG8_BAR; PG8_WAIT_L(0); PG8_MMA(0, 1, At, B1); PG8_BAR;
            PG8_LDA(At, 1, 1); PG8_STAGE(PG8_SA(1, 0), a3, voffA);
            PG8_BAR; PG8_WAIT_L(0); PG8_MMA(1, 0, At, B0); PG8_BAR; PG8_SCHED;
            PG8_STAGE(PG8_SB(1, 1), b3 + hstep, voffB);
            PG8_WAIT_V(6); PG8_BAR; PG8_MMA(1, 1, At, B1); PG8_BAR;
            }
        }
        if constexpr (ALIGN_EPI) { if (wr == 0) PG8_BAR; }
        if constexpr (!Epi::AFTER_DRAIN) { E(acc, cur, wr, wc, fr, fq); S.done(cur); }
        if (!has_next) break;
#pragma unroll
        for (int a = 0; a < 2; ++a)
#pragma unroll
            for (int b = 0; b < 2; ++b)
#pragma unroll
                for (int m = 0; m < 4; ++m)
#pragma unroll
                    for (int n = 0; n < 2; ++n) acc[a][b][m][n] = (f32x4){0.f, 0.f, 0.f, 0.f};
        cur = nxt; cA = nA; cB = nB; ++ui;
        if constexpr (ALIGN_EPI) { if (wr == 1) PG8_BAR; }
    }
    PG8_WAIT_V(0);
    if constexpr (!ALIGN_EPI) { if (wr == 0) PG8_BAR; }
    PG8_BAR;
    if constexpr (Epi::AFTER_DRAIN) { E.fused(acc, cur, wr, wc, fr, fq, lds, wid, lane); S.done(cur); }
#undef PG8_SA
#undef PG8_SB
#undef PG8_STAGE
#undef PG8_LDA
#undef PG8_LDB
#undef PG8_MMA
#undef PG8_WAIT_V
#undef PG8_WAIT_L
#undef PG8_BAR
#undef PG8_SCHED
}
}

#define GAS __attribute__((address_space(1)))
#define LAS __attribute__((address_space(3)))
typedef unsigned short bf16;
typedef unsigned v4u __attribute__((ext_vector_type(4)));
typedef unsigned v2u __attribute__((ext_vector_type(2)));
typedef float f32x4 __attribute__((ext_vector_type(4)));
typedef float f32x2 __attribute__((ext_vector_type(2)));
typedef short bf16x8 __attribute__((ext_vector_type(8)));
typedef _Float16 f16x2 __attribute__((ext_vector_type(2)));

#ifndef MK_MULTI
#define MK_MULTI 0
#endif
constexpr int NPHASE = 9;
constexpr int MP = 16384, MS = 512, MT = MP + MS, DM = 1024, EA = 2048;
constexpr float LN_EPS = 1e-5f, ALPHA = 1.4142135623730951f;
constexpr size_t MiB = 1u << 20;
constexpr size_t WS_CTL = 0, WS_LB = 64 * 1024, WS_WSB = 1 * MiB, WS_WINA = 2 * MiB, WS_WOUTA = 18 * MiB, WS_WINB = 22 * MiB, WS_WOUTB = 34 * MiB, WS_PART = 38 * MiB;
constexpr size_t WS_XB = 44 * MiB;
constexpr size_t WS_Q = 78 * MiB, WS_LF = 144 * MiB, WS_V = 210 * MiB, WS_G = 276 * MiB, WS_O = 342 * MiB, WS_D = 408 * MiB, WS_DP = 474 * MiB, WS_END = 482 * MiB;
constexpr size_t WS_U = WS_Q, WS_VB = WS_LF, WS_Z = WS_V, WS_H1F = WS_G;
static_assert(WS_LF - WS_Q == pg8::SEC_STRIDE * 2 && WS_V - WS_LF == pg8::SEC_STRIDE * 2 && WS_G - WS_V == pg8::SEC_STRIDE * 2 && WS_O - WS_G == pg8::SEC_STRIDE * 2, "section stride");
constexpr size_t OUT_Y = 0, OUT_HP = 17301504, OUT_HS = 19398656, OUT_CV = 52953088;
constexpr int LDS_BYTES = 131072 + 1024;
constexpr size_t WS_BAR = 32 * 1024;

__device__ __forceinline__ unsigned pkbf(float lo, float hi) { return pg8::cvt_pk_bf16(lo, hi); }
__device__ __forceinline__ float bf_lo(unsigned w) { return __builtin_bit_cast(float, w << 16); }
__device__ __forceinline__ float bf_hi(unsigned w) { return __builtin_bit_cast(float, w & 0xffff0000u); }
__device__ __forceinline__ float wave_sum(float v) {
#pragma unroll
    for (int o = 1; o < 64; o <<= 1) v += __shfl_xor(v, o);
    return v;
}
#define LDS_WAIT() asm volatile("s_waitcnt lgkmcnt(0)" ::: "memory")

__device__ __forceinline__ void p0_transpose_item(const float* W, int K, int N, bf16* WT, LAS float* scr, int item, int lane, bool gmlp = false) {
    const int nblk = N / 32, kb = item / nblk, nb = item % nblk, k0 = 64 * kb, nd = 32 * nb;
    int n0 = nd;
    if (gmlp) { if (nd < 4096) { const int tile = nd >> 8, half = (nd >> 7) & 1, cc = nd & 127; n0 = (half ? 4096 : 0) + tile * 128 + cc; } else n0 = 2048 + (nd - 4096); }
    float wv[32];
#pragma unroll
    for (int i = 0; i < 32; ++i) { const int kk = 2 * i + (lane >> 5); wv[i] = __builtin_nontemporal_load(W + (size_t)(k0 + kk) * N + n0 + (lane & 31)); }
#pragma unroll
    for (int i = 0; i < 32; ++i) { const int kk = 2 * i + (lane >> 5); scr[kk * 33 + (lane & 31)] = wv[i]; }
    LDS_WAIT(); asm volatile("" ::: "memory");
    const int c = lane & 7;
#pragma unroll
    for (int j = 0; j < 4; ++j) { const int n = (lane >> 3) + 8 * j; const LAS float* s = scr + (8 * c) * 33 + n;
        v4u o; o.x = pkbf(s[0 * 33], s[1 * 33]); o.y = pkbf(s[2 * 33], s[3 * 33]); o.z = pkbf(s[4 * 33], s[5 * 33]); o.w = pkbf(s[6 * 33], s[7 * 33]);
        *(v4u*)(WT + (size_t)(nd + n) * K + k0 + 8 * c) = o; }
    LDS_WAIT(); asm volatile("" ::: "memory");
}

typedef GAS unsigned gu32;
#define XB_TMO      128
#define XB_XCNT(j)  (256  + 64 * (j))
#define XB_XSUB(j)  (1280 + 64 * (j))
#define XB_XGEN(j)  (2304 + 64 * (j))
#define XB_TOP      3328
#define XB_TOPGEN   3392
#define XCD_BAR_WORDS 3456
#define XB_SPIN_CAP (1u << 18)

__device__ __forceinline__ unsigned xb_ld(unsigned* p)              { return __hip_atomic_load(p, __ATOMIC_RELAXED, __HIP_MEMORY_SCOPE_AGENT); }
__device__ __forceinline__ unsigned xb_add(unsigned* p, unsigned v) { return __hip_atomic_fetch_add(p, v, __ATOMIC_RELAXED, __HIP_MEMORY_SCOPE_AGENT); }
__device__ __forceinline__ unsigned xb_xcc_id() { return (unsigned)__builtin_amdgcn_s_getreg((3 << 11) | 20) & 0xFu; }
#define XB_SPIN(cond, bar) do { unsigned _sp = 0; while (cond) { __builtin_amdgcn_s_sleep(1); \
    if ((++_sp & 255u) == 0u) { if (xb_ld(&(bar)[XB_TMO])) break; if (_sp > XB_SPIN_CAP) { atomicAdd(&(bar)[XB_TMO], 1u); break; } } } } while (0)

struct XcdBarrier {
    unsigned* bar; unsigned x;
    volatile LAS unsigned* st;
};

__device__ __forceinline__ XcdBarrier xcd_barrier_post(unsigned* bar, volatile LAS unsigned* st) {
    XcdBarrier b; b.bar = bar; b.x = xb_xcc_id(); b.st = st;
    if (threadIdx.x == 0) (void)xb_add(&bar[XB_XCNT(b.x)], 1u);
    return b;
}
__device__ __forceinline__ void xcd_barrier_complete(unsigned* bar, unsigned x, unsigned& nloc, unsigned& nx) {
    const unsigned G = gridDim.x * gridDim.y * gridDim.z;
    unsigned sum, cnt, mine, sp = 0u;
    for (;;) {
        sum = 0u; cnt = 0u; mine = 0u;
#pragma unroll
        for (unsigned j = 0; j < 16; ++j) { const unsigned c = xb_ld(&bar[XB_XCNT(j)]); sum += c; cnt += (c > 0u) ? 1u : 0u; mine = (j == x) ? c : mine; }
        if (sum == G) break;
        __builtin_amdgcn_s_sleep(1);
        if ((++sp & 255u) == 0u) { if (xb_ld(&bar[XB_TMO])) break; if (sp > XB_SPIN_CAP) { atomicAdd(&bar[XB_TMO], 1u); break; } }
    }
    nloc = mine > 0u ? mine : 1u; nx = cnt > 0u ? cnt : 1u;
}

__device__ __forceinline__ void xcd_barrier(const XcdBarrier& b) {
    asm volatile("s_waitcnt vmcnt(0)" ::: "memory");
    __syncthreads();
    if (threadIdx.x == 0) {
        unsigned* bar = b.bar;
        __builtin_amdgcn_s_waitcnt(0);
        unsigned nloc = b.st[0], nx = b.st[1];
        if (nloc == 0u) { xcd_barrier_complete(bar, b.x, nloc, nx); b.st[0] = nloc; b.st[1] = nx; }
        const unsigned old = xb_add(&bar[XB_XSUB(b.x)], 1u);
        const unsigned gen = old / nloc;
        if (old + 1u == (gen + 1u) * nloc) {
            __builtin_amdgcn_fence(__ATOMIC_RELEASE, "agent");
            asm volatile("s_waitcnt vmcnt(0)" ::: "memory");
            const unsigned og = xb_add(&bar[XB_TOP], 1u);
            const unsigned tg = og / nx;
            if (og + 1u == (tg + 1u) * nx) xb_add(&bar[XB_TOPGEN], 1u);
            else XB_SPIN(xb_ld(&bar[XB_TOPGEN]) == tg, bar);
            __builtin_amdgcn_fence(__ATOMIC_ACQUIRE, "agent");
            xb_add(&bar[XB_XGEN(b.x)], 1u);
            asm volatile("s_waitcnt vmcnt(0)" ::: "memory");
        } else {
            XB_SPIN(xb_ld(&bar[XB_XGEN(b.x)]) == gen, bar);
            __builtin_amdgcn_fence(__ATOMIC_ACQUIRE, "agent");
            asm volatile("s_waitcnt vmcnt(0)" ::: "memory");
        }
    }
    __syncthreads();
}

struct Ptrs {
    const float *xp, *xs, *state, *w_in_a, *lb_logits, *gnorm, *w_out_a, *w_in_b, *lnv_g, *lnv_b, *w_s, *b_s, *w_out_b, *ln_g, *ln_b;
    float* out; unsigned char* ws;
};

__device__ __forceinline__ void p0_prologue(const Ptrs& P, LAS unsigned char* lds) {
    const int tid = threadIdx.x, lane = tid & 63, wave = __builtin_amdgcn_readfirstlane(tid >> 6);
    LAS float* scr = (LAS float*)(lds + wave * 16384);
    const int gw = blockIdx.x * 8 + wave, NGW = gridDim.x * 8;
    constexpr int I_A = (DM / 64) * (4 * EA / 32), I_OA = (EA / 64) * (DM / 32), I_B = (DM / 64) * (3 * EA / 32), I_OB = I_OA, NITEMS = I_A + I_OA + I_B + I_OB;
    const int n_early = (gridDim.x >= 128) ? I_A : NITEMS;
    for (int it = gw; it < n_early; it += NGW) {
        int r = it;
        if (r < I_A) { p0_transpose_item(P.w_in_a, DM, 4 * EA, (bf16*)(P.ws + WS_WINA), scr, r, lane); continue; } r -= I_A;
        if (r < I_OA) { p0_transpose_item(P.w_out_a, EA, DM, (bf16*)(P.ws + WS_WOUTA), scr, r, lane); continue; } r -= I_OA;
        if (r < I_B) { p0_transpose_item(P.w_in_b, DM, 3 * EA, (bf16*)(P.ws + WS_WINB), scr, r, lane, true); continue; } r -= I_B;
        p0_transpose_item(P.w_out_b, EA, DM, (bf16*)(P.ws + WS_WOUTB), scr, r, lane);
    }
    const size_t gtid = (size_t)blockIdx.x * 512 + tid, GT = (size_t)gridDim.x * 512;
    {
        const f32x4* xp4 = (const f32x4*)P.xp; const f32x4* xs4 = (const f32x4*)P.xs; v2u* xb = (v2u*)(P.ws + WS_XB);
        constexpr size_t NP4 = (size_t)MP * DM / 4, NT4 = (size_t)MT * DM / 4;
        for (size_t q = gtid; q < NT4; q += 4 * GT) { f32x4 v[4];
#pragma unroll
            for (int k = 0; k < 4; ++k) { size_t qq = q + k * GT; qq = qq < NT4 ? qq : NT4 - 1; v[k] = __builtin_nontemporal_load(qq < NP4 ? xp4 + qq : xs4 + (qq - NP4)); }
#pragma unroll
            for (int k = 0; k < 4; ++k) { const size_t qq = q + k * GT; if (qq < NT4) { v2u o; o.x = pkbf(v[k].x, v[k].y); o.y = pkbf(v[k].z, v[k].w); xb[qq] = o; } } }
    }
    {
        const f32x4* w4 = (const f32x4*)P.w_s; v2u* wb = (v2u*)(P.ws + WS_WSB);
        for (size_t q = gtid; q < (size_t)16 * 128 * 128 / 4; q += GT) { const int e = (int)(q * 4), s = e & 127, t = (e >> 7) & 127; const f32x4 v = w4[q];
            v2u o; o.x = pkbf(s <= t ? v.x : 0.f, s + 1 <= t ? v.y : 0.f); o.y = pkbf(s + 2 <= t ? v.z : 0.f, s + 3 <= t ? v.w : 0.f); wb[q] = o; }
    }
    if (gtid < 2048) { float* lb = (float*)(P.ws + WS_LB); lb[gtid] = 1.0f / (1.0f + expf(P.lb_logits[2048 + gtid] - P.lb_logits[gtid])); }
    if (gtid < 4) { ((unsigned*)(P.ws + WS_CTL))[64 * gtid] = 0u; }
}

__device__ __forceinline__ void p0_late_weights(const Ptrs& P, LAS unsigned char* lds, int widx, int nw) {
    const int tid = threadIdx.x, lane = tid & 63, wave = __builtin_amdgcn_readfirstlane(tid >> 6);
    LAS float* scr = (LAS float*)(lds + wave * 16384);
    constexpr int I_OA = (EA / 64) * (DM / 32), I_B = (DM / 64) * (3 * EA / 32), I_OB = I_OA, NLATE = I_OA + I_B + I_OB;
    for (int it = widx * 8 + wave; it < NLATE; it += nw * 8) {
        int r = it;
        if (r < I_OA) { p0_transpose_item(P.w_out_a, EA, DM, (bf16*)(P.ws + WS_WOUTA), scr, r, lane); continue; } r -= I_OA;
        if (r < I_B) { p0_transpose_item(P.w_in_b, DM, 3 * EA, (bf16*)(P.ws + WS_WINB), scr, r, lane, true); continue; } r -= I_B;
        p0_transpose_item(P.w_out_b, EA, DM, (bf16*)(P.ws + WS_WOUTB), scr, r, lane);
    }
}

struct OneUnit {
    pg8::Unit u0;
    __device__ __forceinline__ bool next(int i, pg8::Unit& u) const { if (i != 0) return false; u = u0; return true; }
    __device__ __forceinline__ void a_ready(const pg8::Unit&) const {}
    __device__ __forceinline__ void done(const pg8::Unit&) const {}
};
template <bool FINAL, int NR, bool PARTS = false>
__device__ __forceinline__ void ln_rows(const Ptrs& P, const f32x4* g4, const f32x4* b4, int mbase, int mstride, int mend, int lane) {
    const bf16* D = (const bf16*)(P.ws + WS_D); bf16* H1B = (bf16*)(P.ws + WS_XB);
    f32x4 v[NR][4]; float s[NR];
#pragma unroll
    for (int k = 0; k < NR; ++k) { int m = mbase + k * mstride; m = m < mend ? m : mend - 1;
        f32x4 x[4];
        if (FINAL) { const v2u* h4 = (const v2u*)(H1B + (size_t)m * DM);
#pragma unroll
            for (int j = 0; j < 4; ++j) { const v2u r = __builtin_nontemporal_load(h4 + 64 * j + lane); x[j].x = bf_lo(r.x); x[j].y = bf_hi(r.x); x[j].z = bf_lo(r.y); x[j].w = bf_hi(r.y); } }
        else { const f32x4* x4 = (const f32x4*)(m < MP ? P.xp + (size_t)m * DM : P.xs + (size_t)(m - MP) * DM);
#pragma unroll
            for (int j = 0; j < 4; ++j) x[j] = __builtin_nontemporal_load(x4 + 64 * j + lane); }
        if (PARTS) { const f32x4* d4 = (const f32x4*)(P.ws + WS_DP) + (size_t)(m - MP) * (DM / 4);
#pragma unroll
            for (int j = 0; j < 4; ++j) v[k][j] = x[j] * ALPHA + ((d4[64 * j + lane] + d4[64 * j + lane + 512 * DM / 4]) + (d4[64 * j + lane + 2 * 512 * DM / 4] + d4[64 * j + lane + 3 * 512 * DM / 4])); }
        else { const v2u* d4 = (const v2u*)(D + (size_t)m * DM);
#pragma unroll
            for (int j = 0; j < 4; ++j) { const v2u r = __builtin_nontemporal_load(d4 + 64 * j + lane); f32x4 d; d.x = bf_lo(r.x); d.y = bf_hi(r.x); d.z = bf_lo(r.y); d.w = bf_hi(r.y); v[k][j] = x[j] * ALPHA + d; } } }
#pragma unroll
    for (int k = 0; k < NR; ++k) { s[k] = 0.f;
#pragma unroll
        for (int j = 0; j < 4; ++j) s[k] += (v[k][j].x + v[k][j].y) + (v[k][j].z + v[k][j].w); }
#pragma unroll
    for (int o = 1; o < 64; o <<= 1) {
#pragma unroll
        for (int k = 0; k < NR; ++k) s[k] += __shfl_xor(s[k], o); }
#pragma unroll
    for (int k = 0; k < NR; ++k) { const float mean = s[k] * (1.0f / DM); s[k] = 0.f;
#pragma unroll
        for (int j = 0; j < 4; ++j) { v[k][j] = v[k][j] - mean; s[k] += (v[k][j].x * v[k][j].x + v[k][j].y * v[k][j].y) + (v[k][j].z * v[k][j].z + v[k][j].w * v[k][j].w); } }
#pragma unroll
    for (int o = 1; o < 64; o <<= 1) {
#pragma unroll
        for (int k = 0; k < NR; ++k) s[k] += __shfl_xor(s[k], o); }
#pragma unroll
    for (int j = 0; j < 4; ++j) { const f32x4 gg = g4[64 * j + lane], bb = b4[64 * j + lane];
#pragma unroll
        for (int k = 0; k < NR; ++k) { const int m = mbase + k * mstride; if (m < mend) { const float rstd = __builtin_amdgcn_rsqf(s[k] * (1.0f / DM) + LN_EPS); const f32x4 y = v[k][j] * rstd * gg + bb;
            if (FINAL) { __builtin_nontemporal_store(y, (f32x4*)(P.out + OUT_Y + (size_t)m * DM) + 64 * j + lane); }
            else { v2u o; o.x = pkbf(y.x, y.y); o.y = pkbf(y.z, y.w); ((v2u*)(H1B + (size_t)m * DM))[64 * j + lane] = o; } } } }
}
template <bool FINAL>
__device__ __forceinline__ void ln_phase(const Ptrs& P, LAS unsigned char* lds, int layer) {
    const int tid = threadIdx.x, lane = tid & 63, wave = tid >> 6;
    const int G = (int)gridDim.x, bx = (int)blockIdx.x;
    const f32x4* g4 = (const f32x4*)(P.ln_g + layer * DM); const f32x4* b4 = (const f32x4*)(P.ln_b + layer * DM);
    if (G <= 32) {
        for (int m = bx * 8 + wave; m < MT; m += G * 8) ln_rows<FINAL, 1>(P, g4, b4, m, 0, MT, lane);
        return;
    }
    if (bx < 32) {
        unsigned* cnt = (unsigned*)(P.ws + WS_CTL) + 64 * (2 + layer);
        const int unit = bx >> 2, ks = bx & 3;
        pg8::Gemm g{(const bf16*)(P.ws + WS_O) + ks * 512, (const bf16*)(P.ws + (FINAL ? WS_WOUTB : WS_WOUTA)) + ks * 512, MT, DM, EA, 8};
        OneUnit S; S.u0.pm = MP / 256 + (unit >> 2); S.u0.pn = unit & 3;
        pg8::EpiF32 E{(float*)(P.ws + WS_DP) + (size_t)ks * 512 * DM - (size_t)MP * DM, DM};
        pg8::gemm_phase<pg8::EpiF32, OneUnit, true, true>(lds, g, S, E);
        asm volatile("s_waitcnt vmcnt(0)" ::: "memory");
        __syncthreads();
        if (tid == 0) {
            __builtin_amdgcn_fence(__ATOMIC_RELEASE, "agent"); asm volatile("s_waitcnt vmcnt(0)" ::: "memory");
            __hip_atomic_fetch_add(cnt, 1u, __ATOMIC_RELAXED, __HIP_MEMORY_SCOPE_AGENT);
            while (__hip_atomic_load(cnt, __ATOMIC_RELAXED, __HIP_MEMORY_SCOPE_AGENT) < 32u) __builtin_amdgcn_s_sleep(4);
            __builtin_amdgcn_fence(__ATOMIC_ACQUIRE, "agent"); asm volatile("s_waitcnt vmcnt(0)" ::: "memory");
        }
        __syncthreads();
        __builtin_amdgcn_fence(__ATOMIC_ACQUIRE, "agent");
        ln_rows<FINAL, 2, true>(P, g4, b4, MP + bx * 16 + wave * 2, 1, MT, lane);
    } else {
        const int nw = (G - 32) * 8;
        for (int m = (bx - 32) * 8 + wave; m < MP; m += 3 * nw) ln_rows<FINAL, 3>(P, g4, b4, m, nw, MP, lane);
    }
}

#define MFMA16(a, b, c) __builtin_amdgcn_mfma_f32_16x16x32_bf16((a), (b), (c), 0, 0, 0)
__device__ __forceinline__ void hgrn_unit(LAS unsigned char* lds, const bf16* Q, const bf16* LF, const bf16* V, const bf16* G, bf16* O, const float* gnorm,
                                          int m0, int h, float* s_out, int nb, int ne, bool store_state) {
    const int tid = threadIdx.x, lane = tid & 63, wid = __builtin_amdgcn_readfirstlane(tid >> 6);
    const int i = lane & 15, g = lane >> 4, wq = wid & 3, hc = h * 128;
    constexpr int SQ = 136, SK = 72, nch = 32;
    LAS unsigned char* QD = lds; LAS unsigned char* KI = lds + 17408; LAS unsigned char* KET = lds + 34816; LAS unsigned char* VT = lds + 53248; LAS unsigned char* ST = lds + 71680;
    LAS float* DEC = (LAS float*)(lds + 106496); LAS float* GN = (LAS float*)(lds + 111104);
    if (tid < 128) GN[tid] = gnorm[hc + tid];
    if (wid < 4) {
        const int t0 = 16 * wid;
        v2u gq_n[8], gq_c[8], po[8];
        const bf16* gp = G + ((size_t)h * MT + (size_t)(m0 + t0 + i)) * 128 + 4 * g;
        bf16* orow = O + (size_t)(m0 + t0 + i) * 2048 + hc + 4 * g;
        bf16* prow = orow;
#define LOAD_GATE(nn) do { const int nc_ = (nn) < nch ? (nn) : nch - 1; const bf16* gb_ = gp + (size_t)nc_ * 8192; \
        _Pragma("unroll") for (int vt = 0; vt < 8; ++vt) gq_n[vt] = __builtin_nontemporal_load((const v2u*)(gb_ + 16 * vt)); } while (0)
#define STORE_PREV() do { _Pragma("unroll") for (int vt = 0; vt < 8; ++vt) *(v2u*)(prow + 16 * vt) = po[vt]; } while (0)
        LOAD_GATE(nb);
        for (int n = 0; n < ne; ++n) {
            if (n < nb) { __syncthreads(); __syncthreads(); continue; }
            int i_ = i, g_ = g; asm volatile("" : "+v"(i_), "+v"(g_));
#pragma unroll
            for (int vt = 0; vt < 8; ++vt) gq_c[vt] = gq_n[vt];
            if (n > nb) STORE_PREV();
            LOAD_GATE(n + 1);
            __syncthreads();
            {
                bf16x8 bq[4];
#pragma unroll
                for (int kk = 0; kk < 4; ++kk) bq[kk] = *(const LAS bf16x8*)(QD + ((t0 + i_) * SQ + 32 * kk + 8 * g_) * 2);
                bf16x8 pc[2];
                {
                    f32x4 sT[4];
#pragma unroll
                    for (int st = 0; st < 4; ++st) {
                        f32x4 a4 = (f32x4){0.f, 0.f, 0.f, 0.f};
#pragma unroll
                        for (int kk = 0; kk < 4; ++kk) { const bf16x8 a = *(const LAS bf16x8*)(KI + ((16 * st + i_) * SQ + 32 * kk + 8 * g_) * 2); a4 = MFMA16(a, bq[kk], a4); }
#pragma unroll
                        for (int r = 0; r < 4; ++r) if (16 * st + 4 * g_ + r > t0 + i_) a4[r] = 0.f;
                        sT[st] = a4;
                    }
#pragma unroll
                    for (int c = 0; c < 2; ++c) { v4u w; w.x = pkbf(sT[2 * c][0], sT[2 * c][1]); w.y = pkbf(sT[2 * c][2], sT[2 * c][3]); w.z = pkbf(sT[2 * c + 1][0], sT[2 * c + 1][1]); w.w = pkbf(sT[2 * c + 1][2], sT[2 * c + 1][3]);
                        pc[c] = __builtin_bit_cast(bf16x8, w); }
                }
                f32x4 oa[8]; float ss = 0.f;
#pragma unroll
                for (int vt = 0; vt < 8; ++vt) {
                    f32x4 acc = (f32x4){0.f, 0.f, 0.f, 0.f};
#pragma unroll
                    for (int c = 0; c < 2; ++c) {
                        const v2u lo = *(const LAS v2u*)(VT + ((16 * vt + i_) * SK + 32 * c + 4 * g_) * 2), hi = *(const LAS v2u*)(VT + ((16 * vt + i_) * SK + 32 * c + 16 + 4 * g_) * 2);
                        v4u w; w.x = lo.x; w.y = lo.y; w.z = hi.x; w.w = hi.y; acc = MFMA16(__builtin_bit_cast(bf16x8, w), pc[c], acc); }
#pragma unroll
                    for (int kk = 0; kk < 4; ++kk) { const bf16x8 a = *(const LAS bf16x8*)(ST + ((16 * vt + i_) * SQ + 32 * kk + 8 * g_) * 2); acc = MFMA16(a, bq[kk], acc); }
                    oa[vt] = acc; ss += (acc[0] * acc[0] + acc[1] * acc[1]) + (acc[2] * acc[2] + acc[3] * acc[3]);
                }
                ss += __shfl_xor(ss, 16); ss += __shfl_xor(ss, 32);
                const float sc = __builtin_amdgcn_rsqf(ss * (1.0f / 128.0f) + LN_EPS);
#pragma unroll
                for (int vt = 0; vt < 8; ++vt) { const v2u gg = gq_c[vt]; const f32x4 gn = *(const LAS f32x4*)(GN + 16 * vt + 4 * g_) * sc;
                    po[vt].x = pkbf(oa[vt][0] * gn[0] * bf_lo(gg.x), oa[vt][1] * gn[1] * bf_hi(gg.x)); po[vt].y = pkbf(oa[vt][2] * gn[2] * bf_lo(gg.y), oa[vt][3] * gn[3] * bf_hi(gg.y)); }
                prow = orow + (size_t)n * (64 * 2048);
            }
            __syncthreads();
        }
        STORE_PREV();
#undef STORE_PREV
#undef LOAD_GATE
    } else {
        const int cp = i, rg = g, c0 = 32 * wq + 2 * cp;
        const size_t pofs = ((size_t)h * MT + (size_t)(m0 + 16 * rg)) * 128 + c0;
        const bf16* qp = Q + pofs; const bf16* lp = LF + pofs; const bf16* vp = V + pofs;
        unsigned rq[16], rl[16], rv[16];
        unsigned sq[16], sk[16], ske0[8], ske1[8]; float det0, det1;
#define LOAD_RAW(nn) do { const int nc_ = (nn) < nch ? (nn) : nch - 1; const bf16* qb_ = qp + (size_t)nc_ * 8192; const bf16* lb_ = lp + (size_t)nc_ * 8192; const bf16* vb_ = vp + (size_t)nc_ * 8192; \
        _Pragma("unroll") for (int r = 0; r < 16; ++r) { rl[r] = *(const unsigned*)(lb_ + r * 128); rq[r] = *(const unsigned*)(qb_ + r * 128); } (void)vb_; } while (0)
#define LOAD_V(nn) do { const int nc_ = (nn) < nch ? (nn) : nch - 1; const bf16* vb_ = vp + (size_t)nc_ * 8192; _Pragma("unroll") for (int r = 0; r < 16; ++r) rv[r] = *(const unsigned*)(vb_ + r * 128); } while (0)
#define PREP_REGS() do { \
        float su0 = 0.f, su1 = 0.f; \
        _Pragma("unroll") for (int r = 0; r < 16; ++r) { const f16x2 hh = __builtin_bit_cast(f16x2, rl[r]); su0 += (float)hh.x; su1 += (float)hh.y; } \
        float off0 = 0.f, off1 = 0.f, tot0 = 0.f, tot1 = 0.f; \
        _Pragma("unroll") for (int j = 0; j < 4; ++j) { const float a_ = __shfl(su0, cpx + 16 * j), b_ = __shfl(su1, cpx + 16 * j); if (j < rgx) { off0 += a_; off1 += b_; } tot0 += a_; tot1 += b_; } \
        const float et0 = __expf(tot0), et1 = __expf(tot1); float p0 = __expf(off0), p1 = __expf(off1); det0 = et0; det1 = et1; \
        float kp0 = 0.f, kp1 = 0.f; \
        _Pragma("unroll") for (int r = 0; r < 16; ++r) { const f16x2 hh = __builtin_bit_cast(f16x2, rl[r]); const float f0 = __expf((float)hh.x), f1 = __expf((float)hh.y); \
            p0 *= f0; p1 *= f1; \
            const float ki0 = (1.0f - f0) * __builtin_amdgcn_rcpf(p0), ki1 = (1.0f - f1) * __builtin_amdgcn_rcpf(p1); const float ke0 = ki0 * et0, ke1 = ki1 * et1; \
            sq[r] = pkbf(bf_lo(rq[r]) * p0, bf_hi(rq[r]) * p1); sk[r] = pkbf(ki0, ki1); \
            if (r & 1) { ske0[r >> 1] = pkbf(kp0, ke0); ske1[r >> 1] = pkbf(kp1, ke1); } \
            kp0 = ke0; kp1 = ke1; } } while (0)
#define DUMP_REGS() do { \
        _Pragma("unroll") for (int r = 0; r < 16; ++r) { *(LAS unsigned*)(QD + ((16 * rgx + r) * SQ + c0x) * 2) = sq[r]; *(LAS unsigned*)(KI + ((16 * rgx + r) * SQ + c0x) * 2) = sk[r]; } \
        { v4u w_; w_.x = ske0[0]; w_.y = ske0[1]; w_.z = ske0[2]; w_.w = ske0[3]; *(LAS v4u*)(KET + (c0x * SK + 16 * rgx) * 2) = w_; w_.x = ske0[4]; w_.y = ske0[5]; w_.z = ske0[6]; w_.w = ske0[7]; *(LAS v4u*)(KET + (c0x * SK + 16 * rgx + 8) * 2) = w_; \
          w_.x = ske1[0]; w_.y = ske1[1]; w_.z = ske1[2]; w_.w = ske1[3]; *(LAS v4u*)(KET + ((c0x + 1) * SK + 16 * rgx) * 2) = w_; w_.x = ske1[4]; w_.y = ske1[5]; w_.z = ske1[6]; w_.w = ske1[7]; *(LAS v4u*)(KET + ((c0x + 1) * SK + 16 * rgx + 8) * 2) = w_; \
          _Pragma("unroll") for (int hh_ = 0; hh_ < 2; ++hh_) { \
            w_.x = (rv[8 * hh_ + 0] & 0xffffu) | (rv[8 * hh_ + 1] << 16); w_.y = (rv[8 * hh_ + 2] & 0xffffu) | (rv[8 * hh_ + 3] << 16); w_.z = (rv[8 * hh_ + 4] & 0xffffu) | (rv[8 * hh_ + 5] << 16); w_.w = (rv[8 * hh_ + 6] & 0xffffu) | (rv[8 * hh_ + 7] << 16); \
            *(LAS v4u*)(VT + (c0x * SK + 16 * rgx + 8 * hh_) * 2) = w_; \
            w_.x = (rv[8 * hh_ + 0] >> 16) | (rv[8 * hh_ + 1] & 0xffff0000u); w_.y = (rv[8 * hh_ + 2] >> 16) | (rv[8 * hh_ + 3] & 0xffff0000u); w_.z = (rv[8 * hh_ + 4] >> 16) | (rv[8 * hh_ + 5] & 0xffff0000u); w_.w = (rv[8 * hh_ + 6] >> 16) | (rv[8 * hh_ + 7] & 0xffff0000u); \
            *(LAS v4u*)(VT + ((c0x + 1) * SK + 16 * rgx + 8 * hh_) * 2) = w_; } } \
        if (rgx == 0) { f32x2 p_; p_.x = det0; p_.y = det1; *(LAS f32x2*)(DEC + c0x) = p_; } } while (0)
        f32x4 S[8][2];
#define WRITE_ST() do { _Pragma("unroll") for (int kt = 0; kt < 8; ++kt) _Pragma("unroll") for (int j = 0; j < 2; ++j) { v2u w_; w_.x = pkbf(S[kt][j][0], S[kt][j][1]); w_.y = pkbf(S[kt][j][2], S[kt][j][3]); \
        *(LAS v2u*)(ST + ((16 * (2 * wq + j) + i) * SQ + 16 * kt + 4 * g) * 2) = w_; } } while (0)
#pragma unroll
        for (int kt = 0; kt < 8; ++kt)
#pragma unroll
            for (int j = 0; j < 2; ++j) S[kt][j] = (f32x4){0.f, 0.f, 0.f, 0.f};
        LOAD_RAW(0); LOAD_V(0);
        WRITE_ST();
        { const int cpx = cp, rgx = rg, c0x = c0; PREP_REGS(); (void)c0x; }
        LOAD_RAW(1);
        for (int n = 0; n < ne; ++n) {
            int i_ = i, g_ = g; asm volatile("" : "+v"(i_), "+v"(g_));
            const int cpx = i_, rgx = g_, c0x = 32 * wq + 2 * i_;
            DUMP_REGS();
            asm volatile("" ::: "memory");
            LOAD_V(n + 1);
            __syncthreads();
            {
                bf16x8 bv[2][2];
#pragma unroll
                for (int j = 0; j < 2; ++j)
#pragma unroll
                    for (int c = 0; c < 2; ++c) bv[j][c] = *(const LAS bf16x8*)(VT + ((16 * (2 * wq + j) + i_) * SK + 32 * c + 8 * g_) * 2);
#pragma unroll
                for (int kt = 0; kt < 8; ++kt) {
                    const f32x4 d = *(const LAS f32x4*)(DEC + 16 * kt + 4 * g_);
                    const bf16x8 a0 = *(const LAS bf16x8*)(KET + ((16 * kt + i_) * SK + 8 * g_) * 2), a1 = *(const LAS bf16x8*)(KET + ((16 * kt + i_) * SK + 32 + 8 * g_) * 2);
#pragma unroll
                    for (int j = 0; j < 2; ++j) { f32x4 acc = S[kt][j] * d; acc = MFMA16(a0, bv[j][0], acc); acc = MFMA16(a1, bv[j][1], acc); S[kt][j] = acc; }
                }
            }
            PREP_REGS();
            LOAD_RAW(n + 2);
            __syncthreads();
            WRITE_ST();
        }
        if (store_state) {
            float* op = s_out + (4 * g) * 128 + 32 * wq + i;
#pragma unroll
            for (int kt = 0; kt < 8; ++kt) {
#pragma unroll
                for (int j = 0; j < 2; ++j)
#pragma unroll
                    for (int r = 0; r < 4; ++r) __builtin_nontemporal_store(S[kt][j][r], op + r * 128 + 16 * j);
                op += 2048; asm volatile("" : "+v"(op));
            }
        }
#undef WRITE_ST
#undef DUMP_REGS
#undef PREP_REGS
#undef LOAD_RAW
#undef LOAD_V
    }
}

__device__ __forceinline__ void hgrn_sample_units(LAS unsigned char* lds, const bf16* Q, const bf16* LF, const bf16* V, const bf16* G, bf16* O, const float* gnorm,
                                                  const float* state, float* out_hs, int su0, int stride) {
    int tid_ = threadIdx.x; asm volatile("" : "+v"(tid_));
    const int tid = tid_, lane = tid & 63, wid = tid >> 6, kr = tid >> 5, vc = tid & 31;
    LAS float* SQv = (LAS float*)lds; LAS float* SFv = SQv + 512; LAS float* SKv = SQv + 1024; LAS float* SVv = SQv + 1536; LAS float* RED = SQv + 2048;
    if (su0 >= 2048) return;
    f32x4 S[8], Sn[8]; unsigned short nq, nl, nv;
    const int tt = tid >> 7, tk = tid & 127;
#define SU_LOAD(su_) do { const int b_ = (su_) >> 4, h_ = (su_) & 15; const f32x4* sp_ = (const f32x4*)(state + (size_t)(su_) * 16384 + kr * 128 + 4 * vc); \
        _Pragma("unroll") for (int p = 0; p < 8; ++p) Sn[p] = __builtin_nontemporal_load(sp_ + p * 512); \
        const size_t idx_ = ((size_t)h_ * MT + (size_t)(MP + 4 * b_ + tt)) * 128 + tk; nq = Q[idx_]; nl = LF[idx_]; nv = V[idx_]; } while (0)
    SU_LOAD(su0);
    for (int su = su0; su < 2048; su += stride) {
        const int b = su >> 4, h = su & 15;
#pragma unroll
        for (int p = 0; p < 8; ++p) S[p] = Sn[p];
        { const float q = __builtin_bit_cast(float, (unsigned)nq << 16), v = __builtin_bit_cast(float, (unsigned)nv << 16);
          const float f = __expf((float)__builtin_bit_cast(_Float16, nl));
          SQv[tid] = q; SFv[tid] = f; SKv[tid] = 1.0f - f; SVv[tid] = v; }
        { const int sn = (su + stride) < 2048 ? (su + stride) : su; SU_LOAD(sn); }
        __syncthreads();
        f32x4 o[4];
#pragma unroll
        for (int t = 0; t < 4; ++t) {
            const f32x4 vv = *(const LAS f32x4*)(SVv + t * 128 + 4 * vc); f32x4 acc = (f32x4){0.f, 0.f, 0.f, 0.f};
#pragma unroll
            for (int p = 0; p < 8; ++p) { const int k = t * 128 + kr + 16 * p; const float f = SFv[k], kn = SKv[k], q = SQv[k]; S[p] = S[p] * f + vv * kn; acc += S[p] * q; }
            o[t] = acc;
        }
        { f32x4* op = (f32x4*)(out_hs + (size_t)su * 16384 + kr * 128 + 4 * vc);
#pragma unroll
          for (int p = 0; p < 8; ++p) __builtin_nontemporal_store(S[p], op + p * 512); }
#pragma unroll
        for (int t = 0; t < 4; ++t) { o[t].x += __shfl_xor(o[t].x, 32); o[t].y += __shfl_xor(o[t].y, 32); o[t].z += __shfl_xor(o[t].z, 32); o[t].w += __shfl_xor(o[t].w, 32); }
        if (lane < 32) {
#pragma unroll
            for (int t = 0; t < 4; ++t) *(LAS f32x4*)(RED + (wid * 4 + t) * 128 + 4 * vc) = o[t];
        }
        __syncthreads();
        if (wid < 4) {
            const int t = wid; float a0 = 0.f, a1 = 0.f;
#pragma unroll
            for (int w2 = 0; w2 < 8; ++w2) { a0 += RED[(w2 * 4 + t) * 128 + lane]; a1 += RED[(w2 * 4 + t) * 128 + lane + 64]; }
            const float ss = wave_sum(a0 * a0 + a1 * a1); const float sc = __builtin_amdgcn_rsqf(ss * (1.0f / 128.0f) + LN_EPS);
            const int row = MP + 4 * b + t; const size_t gi = ((size_t)h * MT + (size_t)row) * 128;
            const float g0 = __builtin_bit_cast(float, (unsigned)G[gi + lane] << 16), g1 = __builtin_bit_cast(float, (unsigned)G[gi + lane + 64] << 16);
            bf16* orow = O + (size_t)row * 2048 + h * 128;
            orow[lane] = (bf16)(pkbf(a0 * sc * gnorm[h * 128 + lane] * g0, 0.f) & 0xffffu); orow[lane + 64] = (bf16)(pkbf(a1 * sc * gnorm[h * 128 + lane + 64] * g1, 0.f) & 0xffffu);
        }
        __syncthreads();
    }
#undef SU_LOAD
}

__device__ __forceinline__ void hgrn_phase(const Ptrs& P, LAS unsigned char* lds, int ctr_idx) {
    const bf16* Q = (const bf16*)(P.ws + WS_Q); const bf16* LF = (const bf16*)(P.ws + WS_LF); const bf16* V = (const bf16*)(P.ws + WS_V); const bf16* G = (const bf16*)(P.ws + WS_G);
    bf16* O = (bf16*)(P.ws + WS_O);
    const int Gd = (int)gridDim.x, bx = (int)blockIdx.x;
    if (Gd >= 256) {
        constexpr int SPLIT = 16;
        if (bx < 256) { const int pu = bx & 127; const bool late = bx >= 128;
            hgrn_unit(lds, Q, LF, V, G, O, P.gnorm, (pu >> 4) * 2048, pu & 15, P.out + OUT_HP + (size_t)pu * 16384, late ? SPLIT : 0, late ? 32 : SPLIT, late); }
        if (bx < 128) hgrn_sample_units(lds, Q, LF, V, G, O, P.gnorm, P.state, P.out + OUT_HS, bx, 128);
    } else {
        const bool split = Gd > 128;
        if (!split || bx < 128) {
            for (int pu = bx; pu < 128; pu += (split ? 128 : Gd)) hgrn_unit(lds, Q, LF, V, G, O, P.gnorm, (pu >> 4) * 2048, pu & 15, P.out + OUT_HP + (size_t)pu * 16384, 0, 32, true);
        }
        if (!split || bx >= 128) { const int sid = split ? bx - 128 : bx, ns = split ? Gd - 128 : Gd; __syncthreads(); hgrn_sample_units(lds, Q, LF, V, G, O, P.gnorm, P.state, P.out + OUT_HS, sid, ns); }
    }
    (void)ctr_idx;
}

__device__ __forceinline__ void gate_phase(const Ptrs& P, LAS unsigned char* lds) {
    const int tid = threadIdx.x, lane = tid & 63, wid = __builtin_amdgcn_readfirstlane(tid >> 6);
    const int i = lane & 15, g = lane >> 4;
    constexpr int SW = 136;
    const bf16* U = (const bf16*)(P.ws + WS_U); const bf16* Vb = (const bf16*)(P.ws + WS_VB); bf16* GT = (bf16*)(P.ws + WS_O);
    const float* part = (const float*)(P.ws + WS_PART); const bf16* WSB = (const bf16*)(P.ws + WS_WSB);
    LAS unsigned char* WT = lds; LAS unsigned char* VNT = lds + 34816; LAS f32x2* STT = (LAS f32x2*)(lds + 69632);
    int cur_grp = -1;
    for (int u = blockIdx.x; u < 2048; u += gridDim.x) {
        const int grp = u & 15, m0 = (u >> 4) * 128;
        v2u uq[8]; float bq_[8];
        { const size_t og0 = ((size_t)grp * MT + (size_t)(m0 + i)) * 128 + 16 * wid + 4 * g;
#pragma unroll
          for (int tt = 0; tt < 8; ++tt) { uq[tt] = __builtin_nontemporal_load((const v2u*)(U + og0 + (size_t)tt * 16 * 128)); bq_[tt] = P.b_s[grp * 128 + 16 * tt + i]; } }
        __syncthreads();
        if (grp != cur_grp) {
#pragma unroll
            for (int it = 0; it < 4; ++it) { const int idx = tid + 512 * it, row = idx >> 4, c16 = idx & 15;
                *(LAS v4u*)(WT + (row * SW) * 2 + c16 * 16) = *(const v4u*)(WSB + (size_t)grp * 16384 + row * 128 + c16 * 8); }
            cur_grp = grp;
        }
        unsigned vraw[16];
#pragma unroll
        for (int r = 0; r < 16; ++r) vraw[r] = __builtin_nontemporal_load((const unsigned*)(Vb + ((size_t)grp * MT + (size_t)(m0 + 16 * wid + r)) * 128 + 2 * lane));
        if (tid < 128) { const f32x2* pr = (const f32x2*)(part + (size_t)(m0 + tid) * 64); float s = 0.f, ss = 0.f;
#pragma unroll
            for (int j = 0; j < 32; ++j) { const f32x2 p = pr[j]; s += p.x; ss += p.y; }
            const float mean = s * (1.0f / 2048.0f), var = ss * (1.0f / 2048.0f) - mean * mean; f32x2 o; o.x = mean; o.y = 1.0f / sqrtf(var + LN_EPS); STT[tid] = o; }
        __syncthreads();
        {
            const int c0 = grp * 128 + 2 * lane; const float g0 = P.lnv_g[c0], g1 = P.lnv_g[c0 + 1], b0 = P.lnv_b[c0], b1 = P.lnv_b[c0 + 1];
            float y0[16], y1[16];
#pragma unroll
            for (int r = 0; r < 16; ++r) { const int row = 16 * wid + r; const unsigned raw = vraw[r]; const f32x2 st = STT[row];
                y0[r] = (bf_lo(raw) - st.x) * st.y * g0 + b0; y1[r] = (bf_hi(raw) - st.x) * st.y * g1 + b1; }
#pragma unroll
            for (int hh = 0; hh < 2; ++hh) { v4u w0, w1;
                w0.x = pkbf(y0[8 * hh + 0], y0[8 * hh + 1]); w0.y = pkbf(y0[8 * hh + 2], y0[8 * hh + 3]); w0.z = pkbf(y0[8 * hh + 4], y0[8 * hh + 5]); w0.w = pkbf(y0[8 * hh + 6], y0[8 * hh + 7]);
                w1.x = pkbf(y1[8 * hh + 0], y1[8 * hh + 1]); w1.y = pkbf(y1[8 * hh + 2], y1[8 * hh + 3]); w1.z = pkbf(y1[8 * hh + 4], y1[8 * hh + 5]); w1.w = pkbf(y1[8 * hh + 6], y1[8 * hh + 7]);
                *(LAS v4u*)(VNT + ((2 * lane) * SW + 16 * wid + 8 * hh) * 2) = w0; *(LAS v4u*)(VNT + ((2 * lane + 1) * SW + 16 * wid + 8 * hh) * 2) = w1; }
        }
        __syncthreads();
        {
            bf16x8 av[4];
#pragma unroll
            for (int kk = 0; kk < 4; ++kk) av[kk] = *(const LAS bf16x8*)(VNT + ((16 * wid + i) * SW + 32 * kk + 8 * g) * 2);
#pragma unroll
            for (int tt = 0; tt < 8; ++tt) {
                f32x4 acc = (f32x4){0.f, 0.f, 0.f, 0.f};
#pragma unroll
                for (int kk = 0; kk < 4; ++kk) if (kk <= (tt >> 1)) { const bf16x8 b = *(const LAS bf16x8*)(WT + ((16 * tt + i) * SW + 32 * kk + 8 * g) * 2); acc = MFMA16(av[kk], b, acc); }
                const int t = 16 * tt + i; const float bias = bq_[tt];
                const size_t off = (size_t)(m0 + t) * 2048 + grp * 128 + 16 * wid + 4 * g;
                const v2u uu = uq[tt];
                v2u w; w.x = pkbf(bf_lo(uu.x) * (acc[0] + bias), bf_hi(uu.x) * (acc[1] + bias));
                w.y = pkbf(bf_lo(uu.y) * (acc[2] + bias), bf_hi(uu.y) * (acc[3] + bias));
                *(v2u*)(GT + off) = w;
            }
        }
    }
    for (int sb = (int)gridDim.x - 1 - (int)blockIdx.x; sb < 128; sb += gridDim.x) {
        __syncthreads();
        const int mrow = MP + 4 * sb;
        if (tid < 4) { const f32x2* pr = (const f32x2*)(part + (size_t)(mrow + tid) * 64); float s = 0.f, ss = 0.f;
            for (int j = 0; j < 32; ++j) { const f32x2 p = pr[j]; s += p.x; ss += p.y; }
            const float mean = s * (1.0f / 2048.0f), var = ss * (1.0f / 2048.0f) - mean * mean; f32x2 o; o.x = mean; o.y = 1.0f / sqrtf(var + LN_EPS); STT[tid] = o; }
        __syncthreads();
        const int c = 4 * tid, grp = c >> 7;
        const f32x4 lg = *(const f32x4*)(P.lnv_g + c), lb = *(const f32x4*)(P.lnv_b + c);
        f32x4 vn[4];
#pragma unroll
        for (int t = 0; t < 4; ++t) { const v2u raw = *(const v2u*)(Vb + ((size_t)grp * MT + (size_t)(mrow + t)) * 128 + (c & 127)); const f32x2 st = STT[t];
            f32x4 x; x.x = bf_lo(raw.x); x.y = bf_hi(raw.x); x.z = bf_lo(raw.y); x.w = bf_hi(raw.y);
            vn[t] = (x - st.x) * st.y * lg + lb;
            __builtin_nontemporal_store(vn[t], (f32x4*)(P.out + OUT_CV + (size_t)(4 * sb + t) * 2048 + c)); }
#pragma unroll
        for (int t = 0; t < 4; ++t) { const float bias = P.b_s[grp * 128 + t]; f32x4 mx = (f32x4){bias, bias, bias, bias};
#pragma unroll
            for (int s = 0; s < 4; ++s) if (s <= t) mx += vn[s] * P.w_s[(size_t)grp * 16384 + t * 128 + s];
            const size_t off = (size_t)(mrow + t) * 2048 + c; const size_t offg = ((size_t)grp * MT + (size_t)(mrow + t)) * 128 + (c & 127); const v2u uu = *(const v2u*)(U + offg);
            v2u w; w.x = pkbf(bf_lo(uu.x) * mx.x, bf_hi(uu.x) * mx.y); w.y = pkbf(bf_lo(uu.y) * mx.z, bf_hi(uu.y) * mx.w);
            *(v2u*)(GT + off) = w; }
    }
}

struct Args { const float* in[15]; float* out; unsigned char* ws; int ph_lo, ph_hi; };
__global__ void __launch_bounds__(512, 2) mk_fwd(Args a) {
    extern __shared__ __attribute__((aligned(16))) unsigned char lds_raw[];
    LAS unsigned char* lds = (LAS unsigned char*)lds_raw;
    Ptrs P;
    P.xp = a.in[0]; P.xs = a.in[1]; P.state = a.in[2]; P.w_in_a = a.in[3]; P.lb_logits = a.in[4]; P.gnorm = a.in[5]; P.w_out_a = a.in[6]; P.w_in_b = a.in[7];
    P.lnv_g = a.in[8]; P.lnv_b = a.in[9]; P.w_s = a.in[10]; P.b_s = a.in[11]; P.w_out_b = a.in[12]; P.ln_g = a.in[13]; P.ln_b = a.in[14]; P.out = a.out; P.ws = a.ws;
    const int lo = a.ph_lo, hi = a.ph_hi;
    volatile LAS unsigned* bst = (volatile LAS unsigned*)(lds + 131072 + 64);
    if (threadIdx.x == 0) { bst[0] = 0u; bst[1] = 0u; }
    __syncthreads();
    XcdBarrier bar = xcd_barrier_post((unsigned*)(P.ws + WS_BAR), bst);
    if (lo < 0) cg::this_grid().sync();
#define IN(k) (lo <= (k) && (k) < hi)
#define SEAM(k) do { if (IN(k) && IN((k) + 1)) { xcd_barrier(bar); } } while (0)
#ifndef PROBE_REP
#define PROBE_REP -1
#endif
#define REP(k) for (int rep_ = 0; rep_ < ((PROBE_REP == (k)) ? 2 : 1); ++rep_, (void)((PROBE_REP == (k) && rep_ == 1) ? (cg::this_grid().sync(), 0) : 0))
    const int G = (int)gridDim.x, c = (int)blockIdx.x;
    if (IN(0)) REP(0) { p0_prologue(P, lds); }
    SEAM(0);
    if (IN(1)) REP(1) {
        pg8::Gemm g{(const bf16*)(P.ws + WS_XB), (const bf16*)(P.ws + WS_WINA), MT, 4 * EA, DM}; pg8::StaticOrder S; S.init(MT, 4 * EA, G, c);
        pg8::EpiHgrnIn E{(bf16*)(P.ws + WS_Q), (const float*)(P.ws + WS_LB)};
        pg8::gemm_phase<pg8::EpiHgrnIn, pg8::StaticOrder, true, true>(lds, g, S, E);
        if (G >= 128) {
            const int nfull = S.nwg / G, nlast = S.nwg - nfull * G;
            __syncthreads();
            if (nlast == 0 || nlast >= G) p0_late_weights(P, lds, c, G);
            else if (c >= nlast) p0_late_weights(P, lds, c - nlast, G - nlast);
        }
    }
    SEAM(1);
    if (IN(2)) REP(2) { hgrn_phase(P, lds, rep_); }
    SEAM(2);
    if (IN(3)) REP(3) {
        const int Mo = G > 32 ? MP : MT;
        pg8::Gemm g{(const bf16*)(P.ws + WS_O), (const bf16*)(P.ws + WS_WOUTA), Mo, DM, EA}; pg8::StaticOrder S; S.init(Mo, DM, G, c);
        pg8::EpiBf16Plain E{(bf16*)(P.ws + WS_D), DM};
        pg8::gemm_phase<pg8::EpiBf16Plain, pg8::StaticOrder, true, true>(lds, g, S, E);
    }
    SEAM(3);
    if (IN(4)) REP(4) { ln_phase<false>(P, lds, 0); }
    SEAM(4);
    if (IN(5)) REP(5) {
        pg8::Gemm g{(const bf16*)(P.ws + WS_XB), (const bf16*)(P.ws + WS_WINB), MT, 3 * EA, DM}; pg8::StaticOrder S; S.init(MT, 3 * EA, G, c);
        pg8::EpiGmlpIn E{(bf16*)(P.ws + WS_U), (float*)(P.ws + WS_PART)};
        pg8::gemm_phase<pg8::EpiGmlpIn, pg8::StaticOrder, true, true>(lds, g, S, E);
    }
    SEAM(5);
    if (IN(6)) REP(6) { gate_phase(P, lds); }
    SEAM(6);
    if (IN(7)) REP(7) {
        const int Mo = G > 32 ? MP : MT;
        pg8::Gemm g{(const bf16*)(P.ws + WS_O), (const bf16*)(P.ws + WS_WOUTB), Mo, DM, EA}; pg8::StaticOrder S; S.init(Mo, DM, G, c);
        pg8::EpiBf16Plain E{(bf16*)(P.ws + WS_D), DM};
        pg8::gemm_phase<pg8::EpiBf16Plain, pg8::StaticOrder, true, true>(lds, g, S, E);
    }
    SEAM(7);
    if (IN(8)) REP(8) { ln_phase<true>(P, lds, 1); }
#undef IN
#undef SEAM
}

extern "C" void kernel_launch(void* const* d_in, const int* in_sizes, int n_in, void* d_out, int out_size, void* d_ws, size_t ws_size, hipStream_t stream) {
    static int grid = 0;
    if (grid == 0) {
        if (n_in != 15 || ws_size < WS_END || out_size != 54001664) { fprintf(stderr, "kernel_launch: unexpected problem (n_in %d, out %d, ws %zu)\n", n_in, out_size, ws_size); grid = -1; return; }
        int dev = 0, cus = 0, per_cu = 0;
        if (hipGetDevice(&dev) != hipSuccess || hipDeviceGetAttribute(&cus, hipDeviceAttributeMultiprocessorCount, dev) != hipSuccess) { grid = -1; return; }
        if (hipFuncSetAttribute((const void*)mk_fwd, hipFuncAttributeMaxDynamicSharedMemorySize, LDS_BYTES) != hipSuccess) { fprintf(stderr, "kernel_launch: hipFuncSetAttribute failed\n"); grid = -1; return; }
        if (hipOccupancyMaxActiveBlocksPerMultiprocessor(&per_cu, (const void*)mk_fwd, 512, LDS_BYTES) != hipSuccess || per_cu < 1) { fprintf(stderr, "kernel_launch: occupancy query gave %d\n", per_cu); (void)hipGetLastError(); per_cu = 1; }
        grid = cus * 1;
        (void)in_sizes;
    }
    if (grid < 0) return;
    Args a{};
    for (int i = 0; i < 15; ++i) a.in[i] = (const float*)d_in[i];
    a.out = (float*)d_out; a.ws = (unsigned char*)d_ws;
#if MK_MULTI
    for (int p = 0; p < NPHASE; ++p) { a.ph_lo = p; a.ph_hi = p + 1; hipLaunchKernelGGL(mk_fwd, dim3(grid), dim3(512), LDS_BYTES, stream, a); }
#else
    a.ph_lo = 0; a.ph_hi = NPHASE;
    if (hipMemsetAsync((char*)d_ws + WS_BAR, 0, XCD_BAR_WORDS * 4, stream) != hipSuccess) { fprintf(stderr, "kernel_launch: memset of the barrier words failed\n"); return; }
    void* args[] = {&a};
    hipError_t e = hipLaunchCooperativeKernel((const void*)mk_fwd, dim3(grid), dim3(512), args, LDS_BYTES, stream);
    if (e != hipSuccess) fprintf(stderr, "kernel_launch: cooperative launch failed: %s (grid %d)\n", hipGetErrorString(e), grid);
#endif
}
```

```cpp
#include <hip/hip_runtime.h>
#include <hip/hip_cooperative_groups.h>
#include <cstdio>
#include <cstdint>
namespace cg = cooperative_groups;
#define MK_MULTI 0
namespace pg8 {
#define PG8_LAS __attribute__((address_space(3)))
typedef unsigned short bf16_t;
typedef short bf16x8 __attribute__((ext_vector_type(8)));
typedef float f32x4 __attribute__((ext_vector_type(4)));
typedef unsigned u32x4 __attribute__((ext_vector_type(4)));
constexpr int BM = 256, BK = 64, HALF = 128, HTB = HALF * BK * 2  , STAGE_BYTES = 8 * HTB, NXCD = 8, WGM = 8;

__host__ __device__ __forceinline__ int lds_byte(int r, int c) { const int st = (r >> 4) * 2 + (c >> 5), rr = r & 15, cc = c & 31, ob = rr * 64 + cc * 2; return st * 1024 + (ob ^ (((ob >> 9) & 1) << 5)); }
__host__ __device__ __forceinline__ void stage_rc(int b, int& R, int& C) { const int st = b / 1024, sb = b % 1024, swz = sb ^ (((sb >> 9) & 1) << 5); R = (st >> 1) * 16 + swz / 64; C = (st & 1) * 32 + (swz % 64) / 2; }
__host__ __device__ __forceinline__ int perm32(int rho) { const int n = rho >> 4, i = rho & 15; return 8 * (i >> 2) + 4 * n + (i & 3); }

struct Unit { int pm, pn; };
struct Gemm { const bf16_t* A; const bf16_t* Bt; int M, N, K; int nt = 0; };

struct StaticOrder {
    int nM, nN, nwg, G, c;
    __host__ __device__ void init(int M, int N, int G_, int c_) { nM = M / BM; nN = N / BM; nwg = nM * nN; G = G_; c = c_; }
    __host__ __device__ bool next(int i, Unit& u) const {
        const long L = (long)i * G + c; if (L >= nwg) return false;
        int wgid = (int)L; { const int q = nwg / NXCD, r = nwg % NXCD, xcd = wgid % NXCD, off = wgid / NXCD; wgid = (xcd < r ? xcd * (q + 1) : r * (q + 1) + (xcd - r) * q) + off; }
        const int nig = WGM * nN, gid = wgid / nig, fm = gid * WGM, gsz = (nM - fm) < WGM ? (nM - fm) : WGM;
        u.pm = fm + ((wgid % nig) % gsz); u.pn = (wgid % nig) / gsz; return true;
    }
    __device__ __forceinline__ void a_ready(const Unit&) const {}
    __device__ __forceinline__ void done(const Unit&) const {}
};

typedef float cvt_f32x2 __attribute__((ext_vector_type(2)));
typedef __bf16 cvt_bf16x2 __attribute__((ext_vector_type(2)));
__device__ __forceinline__ unsigned cvt_pk_bf16(float lo, float hi) { cvt_f32x2 v; v.x = lo; v.y = hi; const cvt_bf16x2 b = __builtin_convertvector(v, cvt_bf16x2); return __builtin_bit_cast(unsigned, b); }
typedef unsigned u32x2 __attribute__((ext_vector_type(2)));
constexpr size_t MROWS = 16896;
constexpr size_t SEC_STRIDE = (size_t)16896 * 2048;
typedef float f32x2 __attribute__((ext_vector_type(2)));
typedef _Float16 f16x2 __attribute__((ext_vector_type(2)));
__device__ __forceinline__ float silu_f(float x) { return x * __builtin_amdgcn_rcpf(1.0f + __expf(-x)); }
__device__ __forceinline__ float gelu_tanh_f(float x) { const float u = 1.5957691216057308f * (x + 0.044715f * x * x * x); return x * __builtin_amdgcn_rcpf(1.0f + __expf(-u)); }
__device__ __forceinline__ unsigned pk_f16(float lo, float hi) { f16x2 p; p.x = (_Float16)lo; p.y = (_Float16)hi; return __builtin_bit_cast(unsigned, p); }

struct EpiHgrnIn {
    static constexpr bool PERM = true, AFTER_DRAIN = false;
    bf16_t* B0; const float* lb;
    __device__ __forceinline__ void operator()(const f32x4 (&acc)[2][2][4][2], const Unit& u, int wr, int wc, int fr, int fq) const {
        const int sec = u.pn >> 3;
        const int row0 = u.pm * BM + wr * 64 + fr, col0 = (u.pn & 7) * BM + wc * 32 + 8 * fq;
        bf16_t* base = B0 + (size_t)sec * SEC_STRIDE;
        f32x4 l0[2], l1[2];
#pragma unroll
        for (int bj = 0; bj < 2; ++bj) { l0[bj] = (f32x4){0.f, 0.f, 0.f, 0.f}; l1[bj] = l0[bj]; }
        if (sec == 1) {
#pragma unroll
            for (int bj = 0; bj < 2; ++bj) { l0[bj] = *(const f32x4*)(lb + col0 + bj * HALF); l1[bj] = *(const f32x4*)(lb + col0 + bj * HALF + 4); }
        }
#pragma unroll
        for (int ai = 0; ai < 2; ++ai)
#pragma unroll
            for (int m = 0; m < 4; ++m) { bf16_t* rowp = base + ((size_t)((u.pn & 7) * 2) * MROWS + (size_t)(row0 + ai * HALF + m * 16)) * 128 + wc * 32 + 8 * fq;
#pragma unroll
                for (int bj = 0; bj < 2; ++bj) { f32x4 v0 = acc[ai][bj][m][0], v1 = acc[ai][bj][m][1]; u32x4 w;
                    if (sec == 1) {
#pragma unroll
                        for (int j = 0; j < 4; ++j) { const float s0 = __builtin_amdgcn_rcpf(1.0f + __expf(-v0[j])), s1 = __builtin_amdgcn_rcpf(1.0f + __expf(-v1[j]));
                            v0[j] = __logf(l0[bj][j] + (1.0f - l0[bj][j]) * s0); v1[j] = __logf(l1[bj][j] + (1.0f - l1[bj][j]) * s1); }
                        w.x = pk_f16(v0[0], v0[1]); w.y = pk_f16(v0[2], v0[3]); w.z = pk_f16(v1[0], v1[1]); w.w = pk_f16(v1[2], v1[3]);
                    } else {
                        if (sec != 2) {
#pragma unroll
                            for (int j = 0; j < 4; ++j) { v0[j] = silu_f(v0[j]); v1[j] = silu_f(v1[j]); } }
                        w.x = cvt_pk_bf16(v0[0], v0[1]); w.y = cvt_pk_bf16(v0[2], v0[3]); w.z = cvt_pk_bf16(v1[0], v1[1]); w.w = cvt_pk_bf16(v1[2], v1[3]);
                    }
                    *(u32x4*)(rowp + (size_t)bj * MROWS * 128) = w; } }
    }
};
struct EpiGmlpIn {
    static constexpr bool PERM = true, AFTER_DRAIN = false;
    bf16_t* B0; float* part;
    __device__ __forceinline__ void operator()(const f32x4 (&acc)[2][2][4][2], const Unit& u, int wr, int wc, int fr, int fq) const {
        const int row0 = u.pm * BM + wr * 64 + fr;
        if (u.pn < 16) {
#pragma unroll
            for (int ai = 0; ai < 2; ++ai)
#pragma unroll
                for (int m = 0; m < 4; ++m) { const int row = row0 + ai * HALF + m * 16; bf16_t* rowp = B0 + ((size_t)u.pn * MROWS + (size_t)row) * 128 + wc * 32 + 8 * fq;
                    f32x4 v0 = acc[ai][0][m][0], v1 = acc[ai][0][m][1]; const f32x4 z0 = acc[ai][1][m][0], z1 = acc[ai][1][m][1]; u32x4 w;
#pragma unroll
                    for (int j = 0; j < 4; ++j) { v0[j] = gelu_tanh_f(v0[j]) * silu_f(z0[j]); v1[j] = gelu_tanh_f(v1[j]) * silu_f(z1[j]); }
                    w.x = cvt_pk_bf16(v0[0], v0[1]); w.y = cvt_pk_bf16(v0[2], v0[3]); w.z = cvt_pk_bf16(v1[0], v1[1]); w.w = cvt_pk_bf16(v1[2], v1[3]);
                    *(u32x4*)rowp = w; }
        } else {
            const int g0 = (u.pn - 16) * 2;
#pragma unroll
            for (int ai = 0; ai < 2; ++ai)
#pragma unroll
                for (int m = 0; m < 4; ++m) { const int row = row0 + ai * HALF + m * 16; bf16_t* rowp = B0 + SEC_STRIDE + ((size_t)g0 * MROWS + (size_t)row) * 128 + wc * 32 + 8 * fq; float s = 0.f, ss = 0.f;
#pragma unroll
                    for (int bj = 0; bj < 2; ++bj) { f32x4 v0 = acc[ai][bj][m][0], v1 = acc[ai][bj][m][1]; u32x4 w;
#pragma unroll
                        for (int j = 0; j < 4; ++j) { v0[j] = gelu_tanh_f(v0[j]); v1[j] = gelu_tanh_f(v1[j]); s += v0[j] + v1[j]; ss += v0[j] * v0[j] + v1[j] * v1[j]; }
                        w.x = cvt_pk_bf16(v0[0], v0[1]); w.y = cvt_pk_bf16(v0[2], v0[3]); w.z = cvt_pk_bf16(v1[0], v1[1]); w.w = cvt_pk_bf16(v1[2], v1[3]);
                        *(u32x4*)(rowp + (size_t)bj * MROWS * 128) = w; }
                    s += __shfl_xor(s, 16); s += __shfl_xor(s, 32); ss += __shfl_xor(ss, 16); ss += __shfl_xor(ss, 32);
                    if (fq == 0) { f32x2 o; o.x = s; o.y = ss; *(f32x2*)(part + (size_t)row * 64 + ((u.pn - 16) * 4 + wc) * 2) = o; } }
        }
    }
};
struct EpiF32 {
    static constexpr bool PERM = false, AFTER_DRAIN = false;
    float* C; int ldc;
    __device__ __forceinline__ void operator()(const f32x4 (&acc)[2][2][4][2], const Unit& u, int wr, int wc, int fr, int fq) const {
        const int row0 = u.pm * BM + wr * 64 + fr, col0 = u.pn * BM + wc * 32 + 4 * fq;
#pragma unroll
        for (int ai = 0; ai < 2; ++ai)
#pragma unroll
            for (int m = 0; m < 4; ++m) { float* rowp = C + (size_t)(row0 + ai * HALF + m * 16) * ldc + col0;
#pragma unroll
                for (int bj = 0; bj < 2; ++bj)
#pragma unroll
                    for (int n = 0; n < 2; ++n) *(f32x4*)(rowp + bj * HALF + n * 16) = acc[ai][bj][m][n]; }
    }
};
struct EpiBf16Plain {
    static constexpr bool PERM = true, AFTER_DRAIN = false;
    bf16_t* C; int ldc;
    __device__ __forceinline__ void operator()(const f32x4 (&acc)[2][2][4][2], const Unit& u, int wr, int wc, int fr, int fq) const {
        const int row0 = u.pm * BM + wr * 64 + fr, col0 = u.pn * BM + wc * 32 + 8 * fq;
#pragma unroll
        for (int ai = 0; ai < 2; ++ai)
#pragma unroll
            for (int m = 0; m < 4; ++m) { bf16_t* rowp = C + (size_t)(row0 + ai * HALF + m * 16) * ldc + col0;
#pragma unroll
                for (int bj = 0; bj < 2; ++bj) { const f32x4 v0 = acc[ai][bj][m][0], v1 = acc[ai][bj][m][1]; u32x4 w;
                    w.x = cvt_pk_bf16(v0[0], v0[1]); w.y = cvt_pk_bf16(v0[2], v0[3]); w.z = cvt_pk_bf16(v1[0], v1[1]); w.w = cvt_pk_bf16(v1[2], v1[3]);
                    *(u32x4*)(rowp + bj * HALF) = w; } }
    }
};
template <class Epi, class Sched, bool ALIGN_EPI = false, bool SP2 = false>
__device__ __forceinline__ void gemm_phase(PG8_LAS unsigned char* lds, const Gemm g, const Sched& S, const Epi& E) {
    const int tid = threadIdx.x, wid = __builtin_amdgcn_readfirstlane(tid >> 6), lane = tid & 63, wr = wid >> 2, wc = wid & 3, fr = lane & 15, fq = lane >> 4;
    const int K = g.K, nt = g.nt ? g.nt : K / BK;
    unsigned voffA[2], voffB[2];
#pragma unroll
    for (int i = 0; i < 2; ++i) { int R, C; stage_rc(tid * 16 + i * 8192, R, C); const int Rb = Epi::PERM ? ((R & ~31) + perm32(R & 31)) : R;
        voffA[i] = (unsigned)(R * K + C) * 2u; voffB[i] = (unsigned)(Rb * K + C) * 2u; }
    const size_t kstep = (size_t)(BK * 2);
    const size_t hstep = (size_t)HALF * K * 2;
    const size_t tstep = 2 * hstep;
    const unsigned ldsw = (unsigned)wid * 1024u;
    const int aoff = lds_byte(wr * 64 + fr, fq * 8), boff = lds_byte(wc * 32 + fr, fq * 8);
#define PG8_SA(b, h) (((b) * 2 + (h)) * HTB)
#define PG8_SB(b, h) ((4 + (b) * 2 + (h)) * HTB)
#define PG8_STAGE(bufoff, gbase, voff) do { _Pragma("unroll") for (int _i = 0; _i < 2; ++_i) \
        __builtin_amdgcn_global_load_lds((const unsigned*)((const char*)(gbase) + (voff)[_i]), (PG8_LAS unsigned*)(lds + (bufoff) + ldsw + _i * 8192), 16, 0, 0); } while (0)
#define PG8_LDA(dst, b, h) do { _Pragma("unroll") for (int m = 0; m < 4; ++m) _Pragma("unroll") for (int k = 0; k < 2; ++k) dst[m][k] = *(const PG8_LAS bf16x8*)(lds + PG8_SA(b, h) + aoff + m * 2048 + k * 1024); } while (0)
#define PG8_LDB(dst, b, h) do { _Pragma("unroll") for (int n = 0; n < 2; ++n) _Pragma("unroll") for (int k = 0; k < 2; ++k) dst[n][k] = *(const PG8_LAS bf16x8*)(lds + PG8_SB(b, h) + boff + n * 2048 + k * 1024); } while (0)
#define PG8_MMA(ai, bj, At, Bt) do { __builtin_amdgcn_s_setprio(1); _Pragma("unroll") for (int m = 0; m < 4; ++m) _Pragma("unroll") for (int n = 0; n < 2; ++n) _Pragma("unroll") for (int k = 0; k < 2; ++k) \
        acc[ai][bj][m][n] = __builtin_amdgcn_mfma_f32_16x16x32_bf16(Bt[n][k], At[m][k], acc[ai][bj][m][n], 0, 0, 0); __builtin_amdgcn_s_setprio(0); } while (0)
#define PG8_WAIT_V(n) asm volatile("s_waitcnt vmcnt(" #n ")" ::: "memory")
#define PG8_WAIT_L(n) asm volatile("s_waitcnt lgkmcnt(" #n ")" ::: "memory")
#define PG8_BAR __builtin_amdgcn_s_barrier()
#define PG8_SCHED __builtin_amdgcn_sched_barrier(0)
    Unit cur, nxt; int ui = 0;
    if (!S.next(0, cur)) return;
    f32x4 acc[2][2][4][2];
#pragma unroll
    for (int a = 0; a < 2; ++a)
#pragma unroll
        for (int b = 0; b < 2; ++b)
#pragma unroll
            for (int m = 0; m < 4; ++m)
#pragma unroll
                for (int n = 0; n < 2; ++n) acc[a][b][m][n] = (f32x4){0.f, 0.f, 0.f, 0.f};
    bf16x8 At[4][2], B0[2][2], B1[2][2];
    const char* cA = (const char*)g.A + (size_t)cur.pm * tstep; const char* cB = (const char*)g.Bt + (size_t)cur.pn * tstep;
    S.a_ready(cur);
    if constexpr (SP2) {
        PG8_STAGE(PG8_SB(0, 0), cB, voffB); PG8_STAGE(PG8_SB(0, 1), cB + hstep, voffB); PG8_STAGE(PG8_SA(0, 0), cA, voffA); PG8_STAGE(PG8_SA(0, 1), cA + hstep, voffA);
        if (wr == 1) PG8_BAR;
        PG8_WAIT_V(2); PG8_BAR;
        PG8_STAGE(PG8_SB(1, 0), cB + kstep, voffB); PG8_STAGE(PG8_SA(1, 0), cA + kstep, voffA); PG8_STAGE(PG8_SB(1, 1), cB + hstep + kstep, voffB);
        PG8_WAIT_V(6); PG8_BAR;
    } else {
        PG8_STAGE(PG8_SB(0, 0), cB, voffB); PG8_STAGE(PG8_SA(0, 0), cA, voffA); PG8_STAGE(PG8_SB(0, 1), cB + hstep, voffB); PG8_STAGE(PG8_SA(0, 1), cA + hstep, voffA);
        if (wr == 1) PG8_BAR;
        PG8_WAIT_V(4); PG8_BAR;
        PG8_STAGE(PG8_SB(1, 0), cB + kstep, voffB); PG8_STAGE(PG8_SA(1, 0), cA + kstep, voffA); PG8_STAGE(PG8_SB(1, 1), cB + hstep + kstep, voffB);
        PG8_WAIT_V(6); PG8_BAR;
    }
    for (;;) {
        const bool has_next = S.next(ui + 1, nxt);
        const char* nA = has_next ? (const char*)g.A + (size_t)nxt.pm * tstep : cA; const char* nB = has_next ? (const char*)g.Bt + (size_t)nxt.pn * tstep : cB;
        for (int t = 0; t < nt; t += 2) {
            const bool last = (t == nt - 2);
            const char* a1 = cA + (size_t)(t + 1) * kstep;
            const char* a2 = last ? nA : cA + (size_t)(t + 2) * kstep; const char* b2 = last ? nB : cB + (size_t)(t + 2) * kstep;
            const char* a3 = a2 + kstep; const char* b3 = b2 + kstep;
            if (last && has_next) S.a_ready(nxt);
            if constexpr (SP2) {
            PG8_LDB(B0, 0, 0); PG8_LDB(B1, 0, 1); PG8_SCHED; PG8_LDA(At, 0, 0); PG8_STAGE(PG8_SA(1, 1), a1 + hstep, voffA);
            PG8_WAIT_V(8); PG8_WAIT_L(0); PG8_BAR; PG8_MMA(0, 0, At, B0); PG8_MMA(0, 1, At, B1); PG8_BAR; PG8_SCHED;
            PG8_LDA(At, 0, 1); PG8_STAGE(PG8_SB(0, 0), b2, voffB); PG8_STAGE(PG8_SB(0, 1), b2 + hstep, voffB); PG8_STAGE(PG8_SA(0, 0), a2, voffA);
            PG8_WAIT_V(8); PG8_WAIT_L(0); PG8_BAR; PG8_MMA(1, 0, At, B0); PG8_MMA(1, 1, At, B1); PG8_BAR; PG8_SCHED;
            PG8_LDB(B0, 1, 0); PG8_LDB(B1, 1, 1); PG8_SCHED; PG8_LDA(At, 1, 0); PG8_STAGE(PG8_SA(0, 1), a2 + hstep, voffA);
            PG8_WAIT_V(8); PG8_WAIT_L(0); PG8_BAR; PG8_MMA(0, 0, At, B0); PG8_MMA(0, 1, At, B1); PG8_BAR; PG8_SCHED;
            PG8_LDA(At, 1, 1); PG8_STAGE(PG8_SB(1, 0), b3, voffB); PG8_STAGE(PG8_SB(1, 1), b3 + hstep, voffB); PG8_STAGE(PG8_SA(1, 0), a3, voffA);
            PG8_WAIT_V(8); PG8_WAIT_L(0); PG8_BAR; PG8_MMA(1, 0, At, B0); PG8_MMA(1, 1, At, B1); PG8_BAR; PG8_SCHED;
            } else {
            PG8_LDB(B0, 0, 0); PG8_SCHED; PG8_LDA(At, 0, 0); PG8_STAGE(PG8_SA(1, 1), a1 + hstep, voffA);
            PG8_WAIT_L(8); PG8_BAR; PG8_WAIT_L(0); PG8_MMA(0, 0, At, B0); PG8_BAR; PG8_SCHED;
            PG8_LDB(B1, 0, 1); PG8_STAGE(PG8_SB(0, 0), b2, voffB);
            PG8_BAR; PG8_WAIT_L(0); PG8_MMA(0, 1, At, B1); PG8_BAR;
            PG8_LDA(At, 0, 1); PG8_STAGE(PG8_SA(0, 0), a2, voffA);
            PG8_BAR; PG8_WAIT_L(0); PG8_MMA(1, 0, At, B0); PG8_BAR; PG8_SCHED;
            PG8_STAGE(PG8_SB(0, 1), b2 + hstep, voffB);
            PG8_WAIT_V(6); PG8_BAR; PG8_MMA(1, 1, At, B1); PG8_BAR;
            PG8_LDB(B0, 1, 0); PG8_SCHED; PG8_LDA(At, 1, 0); PG8_STAGE(PG8_SA(0, 1), a2 + hstep, voffA);
            PG8_WAIT_L(8); PG8_BAR; PG8_WAIT_L(0); PG8_MMA(0, 0, At, B0); PG8_BAR; PG8_SCHED;
            PG8_LDB(B1, 1, 1); PG8_STAGE(PG8_SB(1, 0), b3, voffB);
            PG8_BAR; PG8_WAIT_L(0); PG8_MMA(0, 1, At, B1); PG8_BAR;
            PG8_LDA(At, 1, 1); PG8_STAGE(PG8_SA(1, 0), a3, voffA);
            PG8_BAR; PG8_WAIT_L(0); PG8_MMA(1, 0, At, B0); PG8_BAR; PG8_SCHED;
            PG8_STAGE(PG8_SB(1, 1), b3 + hstep, voffB);
            PG8_WAIT_V(6); PG8_BAR; PG8_MMA(1, 1, At, B1); PG8_BAR;
            }
        }
        if constexpr (ALIGN_EPI) { if (wr == 0) PG8_BAR; }
        if constexpr (!Epi::AFTER_DRAIN) { E(acc, cur, wr, wc, fr, fq); S.done(cur); }
        if (!has_next) break;
#pragma unroll
        for (int a = 0; a < 2; ++a)
#pragma unroll
            for (int b = 0; b < 2; ++b)
#pragma unroll
                for (int m = 0; m < 4; ++m)
#pragma unroll
                    for (int n = 0; n < 2; ++n) acc[a][b][m][n] = (f32x4){0.f, 0.f, 0.f, 0.f};
        cur = nxt; cA = nA; cB = nB; ++ui;
        if constexpr (ALIGN_EPI) { if (wr == 1) PG8_BAR; }
    }
    PG8_WAIT_V(0);
    if constexpr (!ALIGN_EPI) { if (wr == 0) PG8_BAR; }
    PG8_BAR;
    if constexpr (Epi::AFTER_DRAIN) { E.fused(acc, cur, wr, wc, fr, fq, lds, wid, lane); S.done(cur); }
#undef PG8_SA
#undef PG8_SB
#undef PG8_STAGE
#undef PG8_LDA
#undef PG8_LDB
#undef PG8_MMA
#undef PG8_WAIT_V
#undef PG8_WAIT_L
#undef PG8_BAR
#undef PG8_SCHED
}
}

#define GAS __attribute__((address_space(1)))
#define LAS __attribute__((address_space(3)))
typedef unsigned short bf16;
typedef unsigned v4u __attribute__((ext_vector_type(4)));
typedef unsigned v2u __attribute__((ext_vector_type(2)));
typedef float f32x4 __attribute__((ext_vector_type(4)));
typedef float f32x2 __attribute__((ext_vector_type(2)));
typedef short bf16x8 __attribute__((ext_vector_type(8)));
typedef _Float16 f16x2 __attribute__((ext_vector_type(2)));

#ifndef MK_MULTI
#define MK_MULTI 0
#endif
constexpr int NPHASE = 9;
constexpr int MP = 16384, MS = 512, MT = MP + MS, DM = 1024, EA = 2048;
constexpr float LN_EPS = 1e-5f, ALPHA = 1.4142135623730951f;
constexpr size_t MiB = 1u << 20;
constexpr size_t WS_CTL = 0, WS_LB = 64 * 1024, WS_WSB = 1 * MiB, WS_WINA = 2 * MiB, WS_WOUTA = 18 * MiB, WS_WINB = 22 * MiB, WS_WOUTB = 34 * MiB, WS_PART = 38 * MiB;
constexpr size_t WS_XB = 44 * MiB;
constexpr size_t WS_Q = 78 * MiB, WS_LF = 144 * MiB, WS_V = 210 * MiB, WS_G = 276 * MiB, WS_O = 342 * MiB, WS_D = 408 * MiB, WS_DP = 474 * MiB, WS_END = 482 * MiB;
constexpr size_t WS_U = WS_Q, WS_VB = WS_LF, WS_Z = WS_V, WS_H1F = WS_G;
static_assert(WS_LF - WS_Q == pg8::SEC_STRIDE * 2 && WS_V - WS_LF == pg8::SEC_STRIDE * 2 && WS_G - WS_V == pg8::SEC_STRIDE * 2 && WS_O - WS_G == pg8::SEC_STRIDE * 2, "section stride");
constexpr size_t OUT_Y = 0, OUT_HP = 17301504, OUT_HS = 19398656, OUT_CV = 52953088;
constexpr int LDS_BYTES = 131072 + 1024;
constexpr size_t WS_BAR = 32 * 1024;

__device__ __forceinline__ unsigned pkbf(float lo, float hi) { return pg8::cvt_pk_bf16(lo, hi); }
__device__ __forceinline__ float bf_lo(unsigned w) { return __builtin_bit_cast(float, w << 16); }
__device__ __forceinline__ float bf_hi(unsigned w) { return __builtin_bit_cast(float, w & 0xffff0000u); }
__device__ __forceinline__ float wave_sum(float v) {
#pragma unroll
    for (int o = 1; o < 64; o <<= 1) v += __shfl_xor(v, o);
    return v;
}
#define LDS_WAIT() asm volatile("s_waitcnt lgkmcnt(0)" ::: "memory")

__device__ __forceinline__ void p0_transpose_item(const float* W, int K, int N, bf16* WT, LAS float* scr, int item, int lane, bool gmlp = false) {
    const int nblk = N / 32, kb = item / nblk, nb = item % nblk, k0 = 64 * kb, nd = 32 * nb;
    int n0 = nd;
    if (gmlp) { if (nd < 4096) { const int tile = nd >> 8, half = (nd >> 7) & 1, cc = nd & 127; n0 = (half ? 4096 : 0) + tile * 128 + cc; } else n0 = 2048 + (nd - 4096); }
    float wv[32];
#pragma unroll
    for (int i = 0; i < 32; ++i) { const int kk = 2 * i + (lane >> 5); wv[i] = __builtin_nontemporal_load(W + (size_t)(k0 + kk) * N + n0 + (lane & 31)); }
#pragma unroll
    for (int i = 0; i < 32; ++i) { const int kk = 2 * i + (lane >> 5); scr[kk * 33 + (lane & 31)] = wv[i]; }
    LDS_WAIT(); asm volatile("" ::: "memory");
    const int c = lane & 7;
#pragma unroll
    for (int j = 0; j < 4; ++j) { const int n = (lane >> 3) + 8 * j; const LAS float* s = scr + (8 * c) * 33 + n;
        v4u o; o.x = pkbf(s[0 * 33], s[1 * 33]); o.y = pkbf(s[2 * 33], s[3 * 33]); o.z = pkbf(s[4 * 33], s[5 * 33]); o.w = pkbf(s[6 * 33], s[7 * 33]);
        *(v4u*)(WT + (size_t)(nd + n) * K + k0 + 8 * c) = o; }
    LDS_WAIT(); asm volatile("" ::: "memory");
}

typedef GAS unsigned gu32;
#define XB_TMO      128
#define XB_XCNT(j)  (256  + 64 * (j))
#define XB_XSUB(j)  (1280 + 64 * (j))
#define XB_XGEN(j)  (2304 + 64 * (j))
#define XB_TOP      3328
#define XB_TOPGEN   3392
#define XCD_BAR_WORDS 3456
#define XB_SPIN_CAP (1u << 18)

__device__ __forceinline__ unsigned xb_ld(unsigned* p)              { return __hip_atomic_load(p, __ATOMIC_RELAXED, __HIP_MEMORY_SCOPE_AGENT); }
__device__ __forceinline__ unsigned xb_add(unsigned* p, unsigned v) { return __hip_atomic_fetch_add(p, v, __ATOMIC_RELAXED, __HIP_MEMORY_SCOPE_AGENT); }
__device__ __forceinline__ unsigned xb_xcc_id() { return (unsigned)__builtin_amdgcn_s_getreg((3 << 11) | 20) & 0xFu; }
#define XB_SPIN(cond, bar) do { unsigned _sp = 0; while (cond) { __builtin_amdgcn_s_sleep(1); \
    if ((++_sp & 255u) == 0u) { if (xb_ld(&(bar)[XB_TMO])) break; if (_sp > XB_SPIN_CAP) { atomicAdd(&(bar)[XB_TMO], 1u); break; } } } } while (0)

struct XcdBarrier {
    unsigned* bar; unsigned x;
    volatile LAS unsigned* st;
};

__device__ __forceinline__ XcdBarrier xcd_barrier_post(unsigned* bar, volatile LAS unsigned* st) {
    XcdBarrier b; b.bar = bar; b.x = xb_xcc_id(); b.st = st;
    if (threadIdx.x == 0) (void)xb_add(&bar[XB_XCNT(b.x)], 1u);
    return b;
}
__device__ __forceinline__ void xcd_barrier_complete(unsigned* bar, unsigned x, unsigned& nloc, unsigned& nx) {
    const unsigned G = gridDim.x * gridDim.y * gridDim.z;
    unsigned sum, cnt, mine, sp = 0u;
    for (;;) {
        sum = 0u; cnt = 0u; mine = 0u;
#pragma unroll
        for (unsigned j = 0; j < 16; ++j) { const unsigned c = xb_ld(&bar[XB_XCNT(j)]); sum += c; cnt += (c > 0u) ? 1u : 0u; mine = (j == x) ? c : mine; }
        if (sum == G) break;
        __builtin_amdgcn_s_sleep(1);
        if ((++sp & 255u) == 0u) { if (xb_ld(&bar[XB_TMO])) break; if (sp > XB_SPIN_CAP) { atomicAdd(&bar[XB_TMO], 1u); break; } }
    }
    nloc = mine > 0u ? mine : 1u; nx = cnt > 0u ? cnt : 1u;
}

__device__ __forceinline__ void xcd_barrier(const XcdBarrier& b) {
    asm volatile("s_waitcnt vmcnt(0)" ::: "memory");
    __syncthreads();
    if (threadIdx.x == 0) {
        unsigned* bar = b.bar;
        __builtin_amdgcn_s_waitcnt(0);
        unsigned nloc = b.st[0], nx = b.st[1];
        if (nloc == 0u) { xcd_barrier_complete(bar, b.x, nloc, nx); b.st[0] = nloc; b.st[1] = nx; }
        const unsigned old = xb_add(&bar[XB_XSUB(b.x)], 1u);
        const unsigned gen = old / nloc;
        if (old + 1u == (gen + 1u) * nloc) {
            __builtin_amdgcn_fence(__ATOMIC_RELEASE, "agent");
            asm volatile("s_waitcnt vmcnt(0)" ::: "memory");
            const unsigned og = xb_add(&bar[XB_TOP], 1u);
            const unsigned tg = og / nx;
            if (og + 1u == (tg + 1u) * nx) xb_add(&bar[XB_TOPGEN], 1u);
            else XB_SPIN(xb_ld(&bar[XB_TOPGEN]) == tg, bar);
            __builtin_amdgcn_fence(__ATOMIC_ACQUIRE, "agent");
            xb_add(&bar[XB_XGEN(b.x)], 1u);
            asm volatile("s_waitcnt vmcnt(0)" ::: "memory");
        } else {
            XB_SPIN(xb_ld(&bar[XB_XGEN(b.x)]) == gen, bar);
            __builtin_amdgcn_fence(__ATOMIC_ACQUIRE, "agent");
            asm volatile("s_waitcnt vmcnt(0)" ::: "memory");
        }
    }
    __syncthreads();
}

struct Ptrs {
    const float *xp, *xs, *state, *w_in_a, *lb_logits, *gnorm, *w_out_a, *w_in_b, *lnv_g, *lnv_b, *w_s, *b_s, *w_out_b, *ln_g, *ln_b;
    float* out; unsigned char* ws;
};

__device__ __forceinline__ void p0_prologue(const Ptrs& P, LAS unsigned char* lds) {
    const int tid = threadIdx.x, lane = tid & 63, wave = __builtin_amdgcn_readfirstlane(tid >> 6);
    LAS float* scr = (LAS float*)(lds + wave * 16384);
    const int gw = blockIdx.x * 8 + wave, NGW = gridDim.x * 8;
    constexpr int I_A = (DM / 64) * (4 * EA / 32), I_OA = (EA / 64) * (DM / 32), I_B = (DM / 64) * (3 * EA / 32), I_OB = I_OA, NITEMS = I_A + I_OA + I_B + I_OB;
    const int n_early = (gridDim.x >= 128) ? I_A : NITEMS;
    for (int it = gw; it < n_early; it += NGW) {
        int r = it;
        if (r < I_A) { p0_transpose_item(P.w_in_a, DM, 4 * EA, (bf16*)(P.ws + WS_WINA), scr, r, lane); continue; } r -= I_A;
        if (r < I_OA) { p0_transpose_item(P.w_out_a, EA, DM, (bf16*)(P.ws + WS_WOUTA), scr, r, lane); continue; } r -= I_OA;
        if (r < I_B) { p0_transpose_item(P.w_in_b, DM, 3 * EA, (bf16*)(P.ws + WS_WINB), scr, r, lane, true); continue; } r -= I_B;
        p0_transpose_item(P.w_out_b, EA, DM, (bf16*)(P.ws + WS_WOUTB), scr, r, lane);
    }
    const size_t gtid = (size_t)blockIdx.x * 512 + tid, GT = (size_t)gridDim.x * 512;
    {
        const f32x4* xp4 = (const f32x4*)P.xp; const f32x4* xs4 = (const f32x4*)P.xs; v2u* xb = (v2u*)(P.ws + WS_XB);
        constexpr size_t NP4 = (size_t)MP * DM / 4, NT4 = (size_t)MT * DM / 4;
        for (size_t q = gtid; q < NT4; q += 4 * GT) { f32x4 v[4];
#pragma unroll
            for (int k = 0; k < 4; ++k) { size_t qq = q + k * GT; qq = qq < NT4 ? qq : NT4 - 1; v[k] = __builtin_nontemporal_load(qq < NP4 ? xp4 + qq : xs4 + (qq - NP4)); }
#pragma unroll
            for (int k = 0; k < 4; ++k) { const size_t qq = q + k * GT; if (qq < NT4) { v2u o; o.x = pkbf(v[k].x, v[k].y); o.y = pkbf(v[k].z, v[k].w); xb[qq] = o; } } }
    }
    {
        const f32x4* w4 = (const f32x4*)P.w_s; v2u* wb = (v2u*)(P.ws + WS_WSB);
        for (size_t q = gtid; q < (size_t)16 * 128 * 128 / 4; q += GT) { const int e = (int)(q * 4), s = e & 127, t = (e >> 7) & 127; const f32x4 v = w4[q];
            v2u o; o.x = pkbf(s <= t ? v.x : 0.f, s + 1 <= t ? v.y : 0.f); o.y = pkbf(s + 2 <= t ? v.z : 0.f, s + 3 <= t ? v.w : 0.f); wb[q] = o; }
    }
    if (gtid < 2048) { float* lb = (float*)(P.ws + WS_LB); lb[gtid] = 1.0f / (1.0f + expf(P.lb_logits[2048 + gtid] - P.lb_logits[gtid])); }
    if (gtid < 4) { ((unsigned*)(P.ws + WS_CTL))[64 * gtid] = 0u; }
}

__device__ __forceinline__ void p0_late_weights(const Ptrs& P, LAS unsigned char* lds, int widx, int nw) {
    const int tid = threadIdx.x, lane = tid & 63, wave = __builtin_amdgcn_readfirstlane(tid >> 6);
    LAS float* scr = (LAS float*)(lds + wave * 16384);
    constexpr int I_OA = (EA / 64) * (DM / 32), I_B = (DM / 64) * (3 * EA / 32), I_OB = I_OA, NLATE = I_OA + I_B + I_OB;
    for (int it = widx * 8 + wave; it < NLATE; it += nw * 8) {
        int r = it;
        if (r < I_OA) { p0_transpose_item(P.w_out_a, EA, DM, (bf16*)(P.ws + WS_WOUTA), scr, r, lane); continue; } r -= I_OA;
        if (r < I_B) { p0_transpose_item(P.w_in_b, DM, 3 * EA, (bf16*)(P.ws + WS_WINB), scr, r, lane, true); continue; } r -= I_B;
        p0_transpose_item(P.w_out_b, EA, DM, (bf16*)(P.ws + WS_WOUTB), scr, r, lane);
    }
}

struct OneUnit {
    pg8::Unit u0;
    __device__ __forceinline__ bool next(int i, pg8::Unit& u) const { if (i != 0) return false; u = u0; return true; }
    __device__ __forceinline__ void a_ready(const pg8::Unit&) const {}
    __device__ __forceinline__ void done(const pg8::Unit&) const {}
};
template <bool FINAL, int NR, bool PARTS = false>
__device__ __forceinline__ void ln_rows(const Ptrs& P, const f32x4* g4, const f32x4* b4, int mbase, int mstride, int mend, int lane) {
    const bf16* D = (const bf16*)(P.ws + WS_D); bf16* H1B = (bf16*)(P.ws + WS_XB);
    f32x4 v[NR][4]; float s[NR];
#pragma unroll
    for (int k = 0; k < NR; ++k) { int m = mbase + k * mstride; m = m < mend ? m : mend - 1;
        f32x4 x[4];
        if (FINAL) { const v2u* h4 = (const v2u*)(H1B + (size_t)m * DM);
#pragma unroll
            for (int j = 0; j < 4; ++j) { const v2u r = __builtin_nontemporal_load(h4 + 64 * j + lane); x[j].x = bf_lo(r.x); x[j].y = bf_hi(r.x); x[j].z = bf_lo(r.y); x[j].w = bf_hi(r.y); } }
        else { const f32x4* x4 = (const f32x4*)(m < MP ? P.xp + (size_t)m * DM : P.xs + (size_t)(m - MP) * DM);
#pragma unroll
            for (int j = 0; j < 4; ++j) x[j] = __builtin_nontemporal_load(x4 + 64 * j + lane); }
        if (PARTS) { const f32x4* d4 = (const f32x4*)(P.ws + WS_DP) + (size_t)(m - MP) * (DM / 4);
#pragma unroll
            for (int j = 0; j < 4; ++j) v[k][j] = x[j] * ALPHA + ((d4[64 * j + lane] + d4[64 * j + lane + 512 * DM / 4]) + (d4[64 * j + lane + 2 * 512 * DM / 4] + d4[64 * j + lane + 3 * 512 * DM / 4])); }
        else { const v2u* d4 = (const v2u*)(D + (size_t)m * DM);
#pragma unroll
            for (int j = 0; j < 4; ++j) { const v2u r = __builtin_nontemporal_load(d4 + 64 * j + lane); f32x4 d; d.x = bf_lo(r.x); d.y = bf_hi(r.x); d.z = bf_lo(r.y); d.w = bf_hi(r.y); v[k][j] = x[j] * ALPHA + d; } } }
#pragma unroll
    for (int k = 0; k < NR; ++k) { s[k] = 0.f;
#pragma unroll
        for (int j = 0; j < 4; ++j) s[k] += (v[k][j].x + v[k][j].y) + (v[k][j].z + v[k][j].w); }
#pragma unroll
    for (int o = 1; o < 64; o <<= 1) {
#pragma unroll
        for (int k = 0; k < NR; ++k) s[k] += __shfl_xor(s[k], o); }
#pragma unroll
    for (int k = 0; k < NR; ++k) { const float mean = s[k] * (1.0f / DM); s[k] = 0.f;
#pragma unroll
        for (int j = 0; j < 4; ++j) { v[k][j] = v[k][j] - mean; s[k] += (v[k][j].x * v[k][j].x + v[k][j].y * v[k][j].y) + (v[k][j].z * v[k][j].z + v[k][j].w * v[k][j].w); } }
#pragma unroll
    for (int o = 1; o < 64; o <<= 1) {
#pragma unroll
        for (int k = 0; k < NR; ++k) s[k] += __shfl_xor(s[k], o); }
#pragma unroll
    for (int j = 0; j < 4; ++j) { const f32x4 gg = g4[64 * j + lane], bb = b4[64 * j + lane];
#pragma unroll
        for (int k = 0; k < NR; ++k) { const int m = mbase + k * mstride; if (m < mend) { const float rstd = __builtin_amdgcn_rsqf(s[k] * (1.0f / DM) + LN_EPS); const f32x4 y = v[k][j] * rstd * gg + bb;
            if (FINAL) { __builtin_nontemporal_store(y, (f32x4*)(P.out + OUT_Y + (size_t)m * DM) + 64 * j + lane); }
            else { v2u o; o.x = pkbf(y.x, y.y); o.y = pkbf(y.z, y.w); ((v2u*)(H1B + (size_t)m * DM))[64 * j + lane] = o; } } } }
}
template <bool FINAL>
__device__ __forceinline__ void ln_phase(const Ptrs& P, LAS unsigned char* lds, int layer) {
    const int tid = threadIdx.x, lane = tid & 63, wave = tid >> 6;
    const int G = (int)gridDim.x, bx = (int)blockIdx.x;
    const f32x4* g4 = (const f32x4*)(P.ln_g + layer * DM); const f32x4* b4 = (const f32x4*)(P.ln_b + layer * DM);
    if (G <= 32) {
        for (int m = bx * 8 + wave; m < MT; m += G * 8) ln_rows<FINAL, 1>(P, g4, b4, m, 0, MT, lane);
        return;
    }
    if (bx < 32) {
        unsigned* cnt = (unsigned*)(P.ws + WS_CTL) + 64 * (2 + layer);
        const int unit = bx >> 2, ks = bx & 3;
        pg8::Gemm g{(const bf16*)(P.ws + WS_O) + ks * 512, (const bf16*)(P.ws + (FINAL ? WS_WOUTB : WS_WOUTA)) + ks * 512, MT, DM, EA, 8};
        OneUnit S; S.u0.pm = MP / 256 + (unit >> 2); S.u0.pn = unit & 3;
        pg8::EpiF32 E{(float*)(P.ws + WS_DP) + (size_t)ks * 512 * DM - (size_t)MP * DM, DM};
        pg8::gemm_phase<pg8::EpiF32, OneUnit, true, true>(lds, g, S, E);
        asm volatile("s_waitcnt vmcnt(0)" ::: "memory");
        __syncthreads();
        if (tid == 0) {
            __builtin_amdgcn_fence(__ATOMIC_RELEASE, "agent"); asm volatile("s_waitcnt vmcnt(0)" ::: "memory");
            __hip_atomic_fetch_add(cnt, 1u, __ATOMIC_RELAXED, __HIP_MEMORY_SCOPE_AGENT);
            while (__hip_atomic_load(cnt, __ATOMIC_RELAXED, __HIP_MEMORY_SCOPE_AGENT) < 32u) __builtin_amdgcn_s_sleep(4);
            __builtin_amdgcn_fence(__ATOMIC_ACQUIRE, "agent"); asm volatile("s_waitcnt vmcnt(0)" ::: "memory");
        }
        __syncthreads();
        __builtin_amdgcn_fence(__ATOMIC_ACQUIRE, "agent");
        ln_rows<FINAL, 2, true>(P, g4, b4, MP + bx * 16 + wave * 2, 1, MT, lane);
    } else {
        const int nw = (G - 32) * 8;
        for (int m = (bx - 32) * 8 + wave; m < MP; m += 3 * nw) ln_rows<FINAL, 3>(P, g4, b4, m, nw, MP, lane);
    }
}

#define MFMA16(a, b, c) __builtin_amdgcn_mfma_f32_16x16x32_bf16((a), (b), (c), 0, 0, 0)
__device__ __forceinline__ void hgrn_unit(LAS unsigned char* lds, const bf16* Q, const bf16* LF, const bf16* V, const bf16* G, bf16* O, const float* gnorm,
                                          int m0, int h, float* s_out, int nb, int ne, bool store_state) {
    const int tid = threadIdx.x, lane = tid & 63, wid = __builtin_amdgcn_readfirstlane(tid >> 6);
    const int i = lane & 15, g = lane >> 4, wq = wid & 3, hc = h * 128;
    constexpr int SQ = 136, SK = 72, nch = 32;
    LAS unsigned char* QD = lds; LAS unsigned char* KI = lds + 17408; LAS unsigned char* KET = lds + 34816; LAS unsigned char* VT = lds + 53248; LAS unsigned char* ST = lds + 71680;
    LAS float* DEC = (LAS float*)(lds + 106496); LAS float* GN = (LAS float*)(lds + 111104);
    if (tid < 128) GN[tid] = gnorm[hc + tid];
    if (wid < 4) {
        const int t0 = 16 * wid;
        v2u gq_n[8], gq_c[8], po[8];
        const bf16* gp = G + ((size_t)h * MT + (size_t)(m0 + t0 + i)) * 128 + 4 * g;
        bf16* orow = O + (size_t)(m0 + t0 + i) * 2048 + hc + 4 * g;
        bf16* prow = orow;
#define LOAD_GATE(nn) do { const int nc_ = (nn) < nch ? (nn) : nch - 1; const bf16* gb_ = gp + (size_t)nc_ * 8192; \
        _Pragma("unroll") for (int vt = 0; vt < 8; ++vt) gq_n[vt] = __builtin_nontemporal_load((const v2u*)(gb_ + 16 * vt)); } while (0)
#define STORE_PREV() do { _Pragma("unroll") for (int vt = 0; vt < 8; ++vt) *(v2u*)(prow + 16 * vt) = po[vt]; } while (0)
        if (nb > 0) {
            const size_t so_ = ((size_t)h * MT + (size_t)(m0 + 16 * wid + (lane >> 4))) * 128 + 8 * (lane & 15);
            const bf16* sl_ = LF + so_; const bf16* sv_ = V + so_;
            LAS unsigned char* RLs = lds + ((16 * wid + (lane >> 4)) * 128 + 8 * (lane & 15)) * 2; LAS unsigned char* RVs = RLs + 16384;
            v4u r0[8], r1[8], r2[8];
#define WU_LOAD(R, cc) do { const int nc_ = (cc) < nch ? (cc) : nch - 1; const size_t co_ = (size_t)nc_ * 8192; \
            _Pragma("unroll") for (int j = 0; j < 4; ++j) { R[j] = *(const v4u*)(sl_ + co_ + (size_t)j * 4 * 128); R[4 + j] = *(const v4u*)(sv_ + co_ + (size_t)j * 4 * 128); } } while (0)
#define WU_STAGE(R) do { _Pragma("unroll") for (int j = 0; j < 4; ++j) { *(LAS v4u*)(RLs + j * 4 * 256) = R[j]; *(LAS v4u*)(RVs + j * 4 * 256) = R[4 + j]; } } while (0)
            WU_LOAD(r0, 1); WU_LOAD(r1, 2); WU_LOAD(r2, 3);
            for (int n = 0; n < nb; n += 3) {
                WU_STAGE(r0); WU_LOAD(r0, n + 4); __syncthreads(); __syncthreads();
                WU_STAGE(r1); WU_LOAD(r1, n + 5); __syncthreads(); __syncthreads();
                WU_STAGE(r2); WU_LOAD(r2, n + 6); __syncthreads(); __syncthreads();
            }
#undef WU_LOAD
#undef WU_STAGE
        }
        LOAD_GATE(nb);
        for (int n = nb; n < ne; ++n) {
            int i_ = i, g_ = g; asm volatile("" : "+v"(i_), "+v"(g_));
#pragma unroll
            for (int vt = 0; vt < 8; ++vt) gq_c[vt] = gq_n[vt];
            if (n > nb) STORE_PREV();
            LOAD_GATE(n + 1);
            __syncthreads();
            {
                bf16x8 bq[4];
#pragma unroll
                for (int kk = 0; kk < 4; ++kk) bq[kk] = *(const LAS bf16x8*)(QD + ((t0 + i_) * SQ + 32 * kk + 8 * g_) * 2);
                bf16x8 pc[2];
                {
                    f32x4 sT[4];
#pragma unroll
                    for (int st = 0; st < 4; ++st) {
                        f32x4 a4 = (f32x4){0.f, 0.f, 0.f, 0.f};
#pragma unroll
                        for (int kk = 0; kk < 4; ++kk) { const bf16x8 a = *(const LAS bf16x8*)(KI + ((16 * st + i_) * SQ + 32 * kk + 8 * g_) * 2); a4 = MFMA16(a, bq[kk], a4); }
#pragma unroll
                        for (int r = 0; r < 4; ++r) if (16 * st + 4 * g_ + r > t0 + i_) a4[r] = 0.f;
                        sT[st] = a4;
                    }
#pragma unroll
                    for (int c = 0; c < 2; ++c) { v4u w; w.x = pkbf(sT[2 * c][0], sT[2 * c][1]); w.y = pkbf(sT[2 * c][2], sT[2 * c][3]); w.z = pkbf(sT[2 * c + 1][0], sT[2 * c + 1][1]); w.w = pkbf(sT[2 * c + 1][2], sT[2 * c + 1][3]);
                        pc[c] = __builtin_bit_cast(bf16x8, w); }
                }
                f32x4 oa[8]; float ss = 0.f;
#pragma unroll
                for (int vt = 0; vt < 8; ++vt) {
                    f32x4 acc = (f32x4){0.f, 0.f, 0.f, 0.f};
#pragma unroll
                    for (int c = 0; c < 2; ++c) {
                        const v2u lo = *(const LAS v2u*)(VT + ((16 * vt + i_) * SK + 32 * c + 4 * g_) * 2), hi = *(const LAS v2u*)(VT + ((16 * vt + i_) * SK + 32 * c + 16 + 4 * g_) * 2);
                        v4u w; w.x = lo.x; w.y = lo.y; w.z = hi.x; w.w = hi.y; acc = MFMA16(__builtin_bit_cast(bf16x8, w), pc[c], acc); }
#pragma unroll
                    for (int kk = 0; kk < 4; ++kk) { const bf16x8 a = *(const LAS bf16x8*)(ST + ((16 * vt + i_) * SQ + 32 * kk + 8 * g_) * 2); acc = MFMA16(a, bq[kk], acc); }
                    oa[vt] = acc; ss += (acc[0] * acc[0] + acc[1] * acc[1]) + (acc[2] * acc[2] + acc[3] * acc[3]);
                }
                ss += __shfl_xor(ss, 16); ss += __shfl_xor(ss, 32);
                const float sc = __builtin_amdgcn_rsqf(ss * (1.0f / 128.0f) + LN_EPS);
#pragma unroll
                for (int vt = 0; vt < 8; ++vt) { const v2u gg = gq_c[vt]; const f32x4 gn = *(const LAS f32x4*)(GN + 16 * vt + 4 * g_) * sc;
                    po[vt].x = pkbf(oa[vt][0] * gn[0] * bf_lo(gg.x), oa[vt][1] * gn[1] * bf_hi(gg.x)); po[vt].y = pkbf(oa[vt][2] * gn[2] * bf_lo(gg.y), oa[vt][3] * gn[3] * bf_hi(gg.y)); }
                prow = orow + (size_t)n * (64 * 2048);
            }
            __syncthreads();
        }
        STORE_PREV();
#undef STORE_PREV
#undef LOAD_GATE
    } else {
        const int cp = i, rg = g, c0 = 32 * wq + 2 * cp;
        const size_t pofs = ((size_t)h * MT + (size_t)(m0 + 16 * rg)) * 128 + c0;
        const bf16* qp = Q + pofs; const bf16* lp = LF + pofs; const bf16* vp = V + pofs;
        unsigned rq[16], rl[16], rv[16];
        unsigned sq[16], sk[16], ske0[8], ske1[8]; float det0, det1;
#define LOAD_RAW(nn) do { const int nc_ = (nn) < nch ? (nn) : nch - 1; const bf16* qb_ = qp + (size_t)nc_ * 8192; const bf16* lb_ = lp + (size_t)nc_ * 8192; const bf16* vb_ = vp + (size_t)nc_ * 8192; \
        _Pragma("unroll") for (int r = 0; r < 16; ++r) { rl[r] = *(const unsigned*)(lb_ + r * 128); rq[r] = *(const unsigned*)(qb_ + r * 128); } (void)vb_; } while (0)
#define LOAD_V(nn) do { const int nc_ = (nn) < nch ? (nn) : nch - 1; const bf16* vb_ = vp + (size_t)nc_ * 8192; _Pragma("unroll") for (int r = 0; r < 16; ++r) rv[r] = *(const unsigned*)(vb_ + r * 128); } while (0)
#define PREP_REGS(full_) do { \
        float su0 = 0.f, su1 = 0.f; \
        _Pragma("unroll") for (int r = 0; r < 16; ++r) { const f16x2 hh = __builtin_bit_cast(f16x2, rl[r]); su0 += (float)hh.x; su1 += (float)hh.y; } \
        float off0 = 0.f, off1 = 0.f, tot0 = 0.f, tot1 = 0.f; \
        _Pragma("unroll") for (int j = 0; j < 4; ++j) { const float a_ = __shfl(su0, cpx + 16 * j), b_ = __shfl(su1, cpx + 16 * j); if (j < rgx) { off0 += a_; off1 += b_; } tot0 += a_; tot1 += b_; } \
        const float et0 = __expf(tot0), et1 = __expf(tot1); float p0 = __expf(off0), p1 = __expf(off1); det0 = et0; det1 = et1; \
        float kp0 = 0.f, kp1 = 0.f; \
        _Pragma("unroll") for (int r = 0; r < 16; ++r) { const f16x2 hh = __builtin_bit_cast(f16x2, rl[r]); const float f0 = __expf((float)hh.x), f1 = __expf((float)hh.y); \
            p0 *= f0; p1 *= f1; \
            const float ki0 = (1.0f - f0) * __builtin_amdgcn_rcpf(p0), ki1 = (1.0f - f1) * __builtin_amdgcn_rcpf(p1); const float ke0 = ki0 * et0, ke1 = ki1 * et1; \
            if (full_) { sq[r] = pkbf(bf_lo(rq[r]) * p0, bf_hi(rq[r]) * p1); sk[r] = pkbf(ki0, ki1); } \
            if (r & 1) { ske0[r >> 1] = pkbf(kp0, ke0); ske1[r >> 1] = pkbf(kp1, ke1); } \
            kp0 = ke0; kp1 = ke1; } } while (0)
#define DUMP_REGS(full_) do { \
        if (full_) _Pragma("unroll") for (int r = 0; r < 16; ++r) { *(LAS unsigned*)(QD + ((16 * rgx + r) * SQ + c0x) * 2) = sq[r]; *(LAS unsigned*)(KI + ((16 * rgx + r) * SQ + c0x) * 2) = sk[r]; } \
        { v4u w_; w_.x = ske0[0]; w_.y = ske0[1]; w_.z = ske0[2]; w_.w = ske0[3]; *(LAS v4u*)(KET + (c0x * SK + 16 * rgx) * 2) = w_; w_.x = ske0[4]; w_.y = ske0[5]; w_.z = ske0[6]; w_.w = ske0[7]; *(LAS v4u*)(KET + (c0x * SK + 16 * rgx + 8) * 2) = w_; \
          w_.x = ske1[0]; w_.y = ske1[1]; w_.z = ske1[2]; w_.w = ske1[3]; *(LAS v4u*)(KET + ((c0x + 1) * SK + 16 * rgx) * 2) = w_; w_.x = ske1[4]; w_.y = ske1[5]; w_.z = ske1[6]; w_.w = ske1[7]; *(LAS v4u*)(KET + ((c0x + 1) * SK + 16 * rgx + 8) * 2) = w_; \
          _Pragma("unroll") for (int hh_ = 0; hh_ < 2; ++hh_) { \
            w_.x = (rv[8 * hh_ + 0] & 0xffffu) | (rv[8 * hh_ + 1] << 16); w_.y = (rv[8 * hh_ + 2] & 0xffffu) | (rv[8 * hh_ + 3] << 16); w_.z = (rv[8 * hh_ + 4] & 0xffffu) | (rv[8 * hh_ + 5] << 16); w_.w = (rv[8 * hh_ + 6] & 0xffffu) | (rv[8 * hh_ + 7] << 16); \
            *(LAS v4u*)(VT + (c0x * SK + 16 * rgx + 8 * hh_) * 2) = w_; \
            w_.x = (rv[8 * hh_ + 0] >> 16) | (rv[8 * hh_ + 1] & 0xffff0000u); w_.y = (rv[8 * hh_ + 2] >> 16) | (rv[8 * hh_ + 3] & 0xffff0000u); w_.z = (rv[8 * hh_ + 4] >> 16) | (rv[8 * hh_ + 5] & 0xffff0000u); w_.w = (rv[8 * hh_ + 6] >> 16) | (rv[8 * hh_ + 7] & 0xffff0000u); \
            *(LAS v4u*)(VT + ((c0x + 1) * SK + 16 * rgx + 8 * hh_) * 2) = w_; } } \
        if (rgx == 0) { f32x2 p_; p_.x = det0; p_.y = det1; *(LAS f32x2*)(DEC + c0x) = p_; } } while (0)
        f32x4 S[8][2];
#define WRITE_ST() do { _Pragma("unroll") for (int kt = 0; kt < 8; ++kt) _Pragma("unroll") for (int j = 0; j < 2; ++j) { v2u w_; w_.x = pkbf(S[kt][j][0], S[kt][j][1]); w_.y = pkbf(S[kt][j][2], S[kt][j][3]); \
        *(LAS v2u*)(ST + ((16 * (2 * wq + j) + i) * SQ + 16 * kt + 4 * g) * 2) = w_; } } while (0)
#pragma unroll
        for (int kt = 0; kt < 8; ++kt)
#pragma unroll
            for (int j = 0; j < 2; ++j) S[kt][j] = (f32x4){0.f, 0.f, 0.f, 0.f};
        LOAD_RAW(0); LOAD_V(0);
        WRITE_ST();
        { const int cpx = cp, rgx = rg, c0x = c0; PREP_REGS(nb == 0); (void)c0x; }
        if (nb > 0) {
            { const int nc_ = nb < nch ? nb : nch - 1; const bf16* qb_ = qp + (size_t)nc_ * 8192;
#pragma unroll
              for (int r = 0; r < 16; ++r) rq[r] = *(const unsigned*)(qb_ + r * 128); }
            for (int n = 0; n < nb; ++n) {
                int i_ = i, g_ = g; asm volatile("" : "+v"(i_), "+v"(g_));
                const int cpx = i_, rgx = g_, c0x = 32 * wq + 2 * i_;
                DUMP_REGS(false);
                __syncthreads();
                {
                    bf16x8 bv[2][2];
#pragma unroll
                    for (int j = 0; j < 2; ++j)
#pragma unroll
                        for (int c = 0; c < 2; ++c) bv[j][c] = *(const LAS bf16x8*)(VT + ((16 * (2 * wq + j) + i_) * SK + 32 * c + 8 * g_) * 2);
#pragma unroll
                    for (int kt = 0; kt < 8; ++kt) {
                        const f32x4 d = *(const LAS f32x4*)(DEC + 16 * kt + 4 * g_);
                        const bf16x8 a0 = *(const LAS bf16x8*)(KET + ((16 * kt + i_) * SK + 8 * g_) * 2), a1 = *(const LAS bf16x8*)(KET + ((16 * kt + i_) * SK + 32 + 8 * g_) * 2);
#pragma unroll
                        for (int j = 0; j < 2; ++j) { f32x4 acc = S[kt][j] * d; acc = MFMA16(a0, bv[j][0], acc); acc = MFMA16(a1, bv[j][1], acc); S[kt][j] = acc; }
                    }
                }
#pragma unroll
                for (int r = 0; r < 16; ++r) { rl[r] = *(const LAS unsigned*)(lds + ((16 * rgx + r) * 128 + c0x) * 2); rv[r] = *(const LAS unsigned*)(lds + 16384 + ((16 * rgx + r) * 128 + c0x) * 2); }
                PREP_REGS(n + 1 == nb);
                __syncthreads();
            }
            WRITE_ST();
            LOAD_RAW(nb + 1);
        } else { LOAD_RAW(1); }
        for (int n = nb; n < ne; ++n) {
            int i_ = i, g_ = g; asm volatile("" : "+v"(i_), "+v"(g_));
            const int cpx = i_, rgx = g_, c0x = 32 * wq + 2 * i_;
            DUMP_REGS(true);
            asm volatile("" ::: "memory");
            LOAD_V(n + 1);
            __syncthreads();
            {
                bf16x8 bv[2][2];
#pragma unroll
                for (int j = 0; j < 2; ++j)
#pragma unroll
                    for (int c = 0; c < 2; ++c) bv[j][c] = *(const LAS bf16x8*)(VT + ((16 * (2 * wq + j) + i_) * SK + 32 * c + 8 * g_) * 2);
#pragma unroll
                for (int kt = 0; kt < 8; ++kt) {
                    const f32x4 d = *(const LAS f32x4*)(DEC + 16 * kt + 4 * g_);
                    const bf16x8 a0 = *(const LAS bf16x8*)(KET + ((16 * kt + i_) * SK + 8 * g_) * 2), a1 = *(const LAS bf16x8*)(KET + ((16 * kt + i_) * SK + 32 + 8 * g_) * 2);
#pragma unroll
                    for (int j = 0; j < 2; ++j) { f32x4 acc = S[kt][j] * d; acc = MFMA16(a0, bv[j][0], acc); acc = MFMA16(a1, bv[j][1], acc); S[kt][j] = acc; }
                }
            }
            PREP_REGS(true);
            LOAD_RAW(n + 2);
            __syncthreads();
            WRITE_ST();
        }
        if (store_state) {
            float* op = s_out + (4 * g) * 128 + 32 * wq + i;
#pragma unroll
            for (int kt = 0; kt < 8; ++kt) {
#pragma unroll
                for (int j = 0; j < 2; ++j)
#pragma unroll
                    for (int r = 0; r < 4; ++r) __builtin_nontemporal_store(S[kt][j][r], op + r * 128 + 16 * j);
                op += 2048; asm volatile("" : "+v"(op));
            }
        }
#undef WRITE_ST
#undef DUMP_REGS
#undef PREP_REGS
#undef LOAD_RAW
#undef LOAD_V
    }
}

__device__ __forceinline__ void hgrn_sample_units(LAS unsigned char* lds, const bf16* Q, const bf16* LF, const bf16* V, const bf16* G, bf16* O, const float* gnorm,
                                                  const float* state, float* out_hs, int su0, int stride) {
    int tid_ = threadIdx.x; asm volatile("" : "+v"(tid_));
    const int tid = tid_, lane = tid & 63, wid = tid >> 6, kr = tid >> 5, vc = tid & 31;
    LAS float* SQv = (LAS float*)lds; LAS float* SFv = SQv + 512; LAS float* SKv = SQv + 1024; LAS float* SVv = SQv + 1536; LAS float* RED = SQv + 2048;
    if (su0 >= 2048) return;
    f32x4 S[8], Sn[8]; unsigned short nq, nl, nv;
    const int tt = tid >> 7, tk = tid & 127;
#define SU_LOAD(su_) do { const int b_ = (su_) >> 4, h_ = (su_) & 15; const f32x4* sp_ = (const f32x4*)(state + (size_t)(su_) * 16384 + kr * 128 + 4 * vc); \
        _Pragma("unroll") for (int p = 0; p < 8; ++p) Sn[p] = __builtin_nontemporal_load(sp_ + p * 512); \
        const size_t idx_ = ((size_t)h_ * MT + (size_t)(MP + 4 * b_ + tt)) * 128 + tk; nq = Q[idx_]; nl = LF[idx_]; nv = V[idx_]; } while (0)
    SU_LOAD(su0);
    for (int su = su0; su < 2048; su += stride) {
        const int b = su >> 4, h = su & 15;
#pragma unroll
        for (int p = 0; p < 8; ++p) S[p] = Sn[p];
        { const float q = __builtin_bit_cast(float, (unsigned)nq << 16), v = __builtin_bit_cast(float, (unsigned)nv << 16);
          const float f = __expf((float)__builtin_bit_cast(_Float16, nl));
          SQv[tid] = q; SFv[tid] = f; SKv[tid] = 1.0f - f; SVv[tid] = v; }
        { const int sn = (su + stride) < 2048 ? (su + stride) : su; SU_LOAD(sn); }
        __syncthreads();
        f32x4 o[4];
#pragma unroll
        for (int t = 0; t < 4; ++t) {
            const f32x4 vv = *(const LAS f32x4*)(SVv + t * 128 + 4 * vc); f32x4 acc = (f32x4){0.f, 0.f, 0.f, 0.f};
#pragma unroll
            for (int p = 0; p < 8; ++p) { const int k = t * 128 + kr + 16 * p; const float f = SFv[k], kn = SKv[k], q = SQv[k]; S[p] = S[p] * f + vv * kn; acc += S[p] * q; }
            o[t] = acc;
        }
        { f32x4* op = (f32x4*)(out_hs + (size_t)su * 16384 + kr * 128 + 4 * vc);
#pragma unroll
          for (int p = 0; p < 8; ++p) __builtin_nontemporal_store(S[p], op + p * 512); }
#pragma unroll
        for (int t = 0; t < 4; ++t) { o[t].x += __shfl_xor(o[t].x, 32); o[t].y += __shfl_xor(o[t].y, 32); o[t].z += __shfl_xor(o[t].z, 32); o[t].w += __shfl_xor(o[t].w, 32); }
        if (lane < 32) {
#pragma unroll
            for (int t = 0; t < 4; ++t) *(LAS f32x4*)(RED + (wid * 4 + t) * 128 + 4 * vc) = o[t];
        }
        __syncthreads();
        if (wid < 4) {
            const int t = wid; float a0 = 0.f, a1 = 0.f;
#pragma unroll
            for (int w2 = 0; w2 < 8; ++w2) { a0 += RED[(w2 * 4 + t) * 128 + lane]; a1 += RED[(w2 * 4 + t) * 128 + lane + 64]; }
            const float ss = wave_sum(a0 * a0 + a1 * a1); const float sc = __builtin_amdgcn_rsqf(ss * (1.0f / 128.0f) + LN_EPS);
            const int row = MP + 4 * b + t; const size_t gi = ((size_t)h * MT + (size_t)row) * 128;
            const float g0 = __builtin_bit_cast(float, (unsigned)G[gi + lane] << 16), g1 = __builtin_bit_cast(float, (unsigned)G[gi + lane + 64] << 16);
            bf16* orow = O + (size_t)row * 2048 + h * 128;
            orow[lane] = (bf16)(pkbf(a0 * sc * gnorm[h * 128 + lane] * g0, 0.f) & 0xffffu); orow[lane + 64] = (bf16)(pkbf(a1 * sc * gnorm[h * 128 + lane + 64] * g1, 0.f) & 0xffffu);
        }
        __syncthreads();
    }
#undef SU_LOAD
}

__device__ __forceinline__ void hgrn_phase(const Ptrs& P, LAS unsigned char* lds, int ctr_idx) {
    const bf16* Q = (const bf16*)(P.ws + WS_Q); const bf16* LF = (const bf16*)(P.ws + WS_LF); const bf16* V = (const bf16*)(P.ws + WS_V); const bf16* G = (const bf16*)(P.ws + WS_G);
    bf16* O = (bf16*)(P.ws + WS_O);
    const int Gd = (int)gridDim.x, bx = (int)blockIdx.x;
    if (Gd >= 256) {
        constexpr int SPLIT = 15; static_assert(SPLIT % 3 == 0, "the warm-up loader's register ring has three slots");
        if (bx < 256) { const int pu = bx & 127; const bool late = bx >= 128;
            hgrn_unit(lds, Q, LF, V, G, O, P.gnorm, (pu >> 4) * 2048, pu & 15, P.out + OUT_HP + (size_t)pu * 16384, late ? SPLIT : 0, late ? 32 : SPLIT, late); }
        if (bx < 128) hgrn_sample_units(lds, Q, LF, V, G, O, P.gnorm, P.state, P.out + OUT_HS, bx, 128);
    } else {
        const bool split = Gd > 128;
        if (!split || bx < 128) {
            for (int pu = bx; pu < 128; pu += (split ? 128 : Gd)) hgrn_unit(lds, Q, LF, V, G, O, P.gnorm, (pu >> 4) * 2048, pu & 15, P.out + OUT_HP + (size_t)pu * 16384, 0, 32, true);
        }
        if (!split || bx >= 128) { const int sid = split ? bx - 128 : bx, ns = split ? Gd - 128 : Gd; __syncthreads(); hgrn_sample_units(lds, Q, LF, V, G, O, P.gnorm, P.state, P.out + OUT_HS, sid, ns); }
    }
    (void)ctr_idx;
}

__device__ __forceinline__ void gate_phase(const Ptrs& P, LAS unsigned char* lds) {
    const int tid = threadIdx.x, lane = tid & 63, wid = __builtin_amdgcn_readfirstlane(tid >> 6);
    const int i = lane & 15, g = lane >> 4;
    constexpr int SW = 136;
    const bf16* U = (const bf16*)(P.ws + WS_U); const bf16* Vb = (const bf16*)(P.ws + WS_VB); bf16* GT = (bf16*)(P.ws + WS_O);
    const float* part = (const float*)(P.ws + WS_PART); const bf16* WSB = (const bf16*)(P.ws + WS_WSB);
    LAS unsigned char* WT = lds; LAS unsigned char* VNT = lds + 34816; LAS f32x2* STT = (LAS f32x2*)(lds + 69632);
    int cur_grp = -1;
    for (int u = blockIdx.x; u < 2048; u += gridDim.x) {
        const int grp = u & 15, m0 = (u >> 4) * 128;
        v2u uq[8]; float bq_[8];
        { const size_t og0 = ((size_t)grp * MT + (size_t)(m0 + i)) * 128 + 16 * wid + 4 * g;
#pragma unroll
          for (int tt = 0; tt < 8; ++tt) { uq[tt] = __builtin_nontemporal_load((const v2u*)(U + og0 + (size_t)tt * 16 * 128)); bq_[tt] = P.b_s[grp * 128 + 16 * tt + i]; } }
        __syncthreads();
        if (grp != cur_grp) {
#pragma unroll
            for (int it = 0; it < 4; ++it) { const int idx = tid + 512 * it, row = idx >> 4, c16 = idx & 15;
                *(LAS v4u*)(WT + (row * SW) * 2 + c16 * 16) = *(const v4u*)(WSB + (size_t)grp * 16384 + row * 128 + c16 * 8); }
            cur_grp = grp;
        }
        unsigned vraw[16];
#pragma unroll
        for (int r = 0; r < 16; ++r) vraw[r] = __builtin_nontemporal_load((const unsigned*)(Vb + ((size_t)grp * MT + (size_t)(m0 + 16 * wid + r)) * 128 + 2 * lane));
        if (tid < 128) { const f32x2* pr = (const f32x2*)(part + (size_t)(m0 + tid) * 64); float s = 0.f, ss = 0.f;
#pragma unroll
            for (int j = 0; j < 32; ++j) { const f32x2 p = pr[j]; s += p.x; ss += p.y; }
            const float mean = s * (1.0f / 2048.0f), var = ss * (1.0f / 2048.0f) - mean * mean; f32x2 o; o.x = mean; o.y = 1.0f / sqrtf(var + LN_EPS); STT[tid] = o; }
        __syncthreads();
        {
            const int c0 = grp * 128 + 2 * lane; const float g0 = P.lnv_g[c0], g1 = P.lnv_g[c0 + 1], b0 = P.lnv_b[c0], b1 = P.lnv_b[c0 + 1];
            float y0[16], y1[16];
#pragma unroll
            for (int r = 0; r < 16; ++r) { const int row = 16 * wid + r; const unsigned raw = vraw[r]; const f32x2 st = STT[row];
                y0[r] = (bf_lo(raw) - st.x) * st.y * g0 + b0; y1[r] = (bf_hi(raw) - st.x) * st.y * g1 + b1; }
#pragma unroll
            for (int hh = 0; hh < 2; ++hh) { v4u w0, w1;
                w0.x = pkbf(y0[8 * hh + 0], y0[8 * hh + 1]); w0.y = pkbf(y0[8 * hh + 2], y0[8 * hh + 3]); w0.z = pkbf(y0[8 * hh + 4], y0[8 * hh + 5]); w0.w = pkbf(y0[8 * hh + 6], y0[8 * hh + 7]);
                w1.x = pkbf(y1[8 * hh + 0], y1[8 * hh + 1]); w1.y = pkbf(y1[8 * hh + 2], y1[8 * hh + 3]); w1.z = pkbf(y1[8 * hh + 4], y1[8 * hh + 5]); w1.w = pkbf(y1[8 * hh + 6], y1[8 * hh + 7]);
                *(LAS v4u*)(VNT + ((2 * lane) * SW + 16 * wid + 8 * hh) * 2) = w0; *(LAS v4u*)(VNT + ((2 * lane + 1) * SW + 16 * wid + 8 * hh) * 2) = w1; }
        }
        __syncthreads();
        {
            bf16x8 av[4];
#pragma unroll
            for (int kk = 0; kk < 4; ++kk) av[kk] = *(const LAS bf16x8*)(VNT + ((16 * wid + i) * SW + 32 * kk + 8 * g) * 2);
#pragma unroll
            for (int tt = 0; tt < 8; ++tt) {
                f32x4 acc = (f32x4){0.f, 0.f, 0.f, 0.f};
#pragma unroll
                for (int kk = 0; kk < 4; ++kk) if (kk <= (tt >> 1)) { const bf16x8 b = *(const LAS bf16x8*)(WT + ((16 * tt + i) * SW + 32 * kk + 8 * g) * 2); acc = MFMA16(av[kk], b, acc); }
                const int t = 16 * tt + i; const float bias = bq_[tt];
                const size_t off = (size_t)(m0 + t) * 2048 + grp * 128 + 16 * wid + 4 * g;
                const v2u uu = uq[tt];
                v2u w; w.x = pkbf(bf_lo(uu.x) * (acc[0] + bias), bf_hi(uu.x) * (acc[1] + bias));
                w.y = pkbf(bf_lo(uu.y) * (acc[2] + bias), bf_hi(uu.y) * (acc[3] + bias));
                *(v2u*)(GT + off) = w;
            }
        }
    }
    for (int sb = (int)gridDim.x - 1 - (int)blockIdx.x; sb < 128; sb += gridDim.x) {
        __syncthreads();
        const int mrow = MP + 4 * sb;
        if (tid < 4) { const f32x2* pr = (const f32x2*)(part + (size_t)(mrow + tid) * 64); float s = 0.f, ss = 0.f;
            for (int j = 0; j < 32; ++j) { const f32x2 p = pr[j]; s += p.x; ss += p.y; }
            const float mean = s * (1.0f / 2048.0f), var = ss * (1.0f / 2048.0f) - mean * mean; f32x2 o; o.x = mean; o.y = 1.0f / sqrtf(var + LN_EPS); STT[tid] = o; }
        __syncthreads();
        const int c = 4 * tid, grp = c >> 7;
        const f32x4 lg = *(const f32x4*)(P.lnv_g + c), lb = *(const f32x4*)(P.lnv_b + c);
        f32x4 vn[4];
#pragma unroll
        for (int t = 0; t < 4; ++t) { const v2u raw = *(const v2u*)(Vb + ((size_t)grp * MT + (size_t)(mrow + t)) * 128 + (c & 127)); const f32x2 st = STT[t];
            f32x4 x; x.x = bf_lo(raw.x); x.y = bf_hi(raw.x); x.z = bf_lo(raw.y); x.w = bf_hi(raw.y);
            vn[t] = (x - st.x) * st.y * lg + lb;
            __builtin_nontemporal_store(vn[t], (f32x4*)(P.out + OUT_CV + (size_t)(4 * sb + t) * 2048 + c)); }
#pragma unroll
        for (int t = 0; t < 4; ++t) { const float bias = P.b_s[grp * 128 + t]; f32x4 mx = (f32x4){bias, bias, bias, bias};
#pragma unroll
            for (int s = 0; s < 4; ++s) if (s <= t) mx += vn[s] * P.w_s[(size_t)grp * 16384 + t * 128 + s];
            const size_t off = (size_t)(mrow + t) * 2048 + c; const size_t offg = ((size_t)grp * MT + (size_t)(mrow + t)) * 128 + (c & 127); const v2u uu = *(const v2u*)(U + offg);
            v2u w; w.x = pkbf(bf_lo(uu.x) * mx.x, bf_hi(uu.x) * mx.y); w.y = pkbf(bf_lo(uu.y) * mx.z, bf_hi(uu.y) * mx.w);
            *(v2u*)(GT + off) = w; }
    }
}

struct Args { const float* in[15]; float* out; unsigned char* ws; int ph_lo, ph_hi; };
__global__ void __launch_bounds__(512, 2) mk_fwd(Args a) {
    extern __shared__ __attribute__((aligned(16))) unsigned char lds_raw[];
    LAS unsigned char* lds = (LAS unsigned char*)lds_raw;
    Ptrs P;
    P.xp = a.in[0]; P.xs = a.in[1]; P.state = a.in[2]; P.w_in_a = a.in[3]; P.lb_logits = a.in[4]; P.gnorm = a.in[5]; P.w_out_a = a.in[6]; P.w_in_b = a.in[7];
    P.lnv_g = a.in[8]; P.lnv_b = a.in[9]; P.w_s = a.in[10]; P.b_s = a.in[11]; P.w_out_b = a.in[12]; P.ln_g = a.in[13]; P.ln_b = a.in[14]; P.out = a.out; P.ws = a.ws;
    const int lo = a.ph_lo, hi = a.ph_hi;
    volatile LAS unsigned* bst = (volatile LAS unsigned*)(lds + 131072 + 64);
    if (threadIdx.x == 0) { bst[0] = 0u; bst[1] = 0u; }
    __syncthreads();
    XcdBarrier bar = xcd_barrier_post((unsigned*)(P.ws + WS_BAR), bst);
    if (lo < 0) cg::this_grid().sync();
#define IN(k) (lo <= (k) && (k) < hi)
#define SEAM(k) do { if (IN(k) && IN((k) + 1)) { xcd_barrier(bar); } } while (0)
#ifndef PROBE_REP
#define PROBE_REP -1
#endif
#define REP(k) for (int rep_ = 0; rep_ < ((PROBE_REP == (k)) ? 2 : 1); ++rep_, (void)((PROBE_REP == (k) && rep_ == 1) ? (cg::this_grid().sync(), 0) : 0))
    const int G = (int)gridDim.x, c = (int)blockIdx.x;
    if (IN(0)) REP(0) { p0_prologue(P, lds); }
    SEAM(0);
    if (IN(1)) REP(1) {
        pg8::Gemm g{(const bf16*)(P.ws + WS_XB), (const bf16*)(P.ws + WS_WINA), MT, 4 * EA, DM}; pg8::StaticOrder S; S.init(MT, 4 * EA, G, c);
        pg8::EpiHgrnIn E{(bf16*)(P.ws + WS_Q), (const float*)(P.ws + WS_LB)};
        pg8::gemm_phase<pg8::EpiHgrnIn, pg8::StaticOrder, true, true>(lds, g, S, E);
        if (G >= 128) {
            const int nfull = S.nwg / G, nlast = S.nwg - nfull * G;
            __syncthreads();
            if (nlast == 0 || nlast >= G) p0_late_weights(P, lds, c, G);
            else if (c >= nlast) p0_late_weights(P, lds, c - nlast, G - nlast);
        }
    }
    SEAM(1);
    if (IN(2)) REP(2) { hgrn_phase(P, lds, rep_); }
    SEAM(2);
    if (IN(3)) REP(3) {
        const int Mo = G > 32 ? MP : MT;
        pg8::Gemm g{(const bf16*)(P.ws + WS_O), (const bf16*)(P.ws + WS_WOUTA), Mo, DM, EA}; pg8::StaticOrder S; S.init(Mo, DM, G, c);
        pg8::EpiBf16Plain E{(bf16*)(P.ws + WS_D), DM};
        pg8::gemm_phase<pg8::EpiBf16Plain, pg8::StaticOrder, true, true>(lds, g, S, E);
    }
    SEAM(3);
    if (IN(4)) REP(4) { ln_phase<false>(P, lds, 0); }
    SEAM(4);
    if (IN(5)) REP(5) {
        pg8::Gemm g{(const bf16*)(P.ws + WS_XB), (const bf16*)(P.ws + WS_WINB), MT, 3 * EA, DM}; pg8::StaticOrder S; S.init(MT, 3 * EA, G, c);
        pg8::EpiGmlpIn E{(bf16*)(P.ws + WS_U), (float*)(P.ws + WS_PART)};
        pg8::gemm_phase<pg8::EpiGmlpIn, pg8::StaticOrder, true, true>(lds, g, S, E);
    }
    SEAM(5);
    if (IN(6)) REP(6) { gate_phase(P, lds); }
    SEAM(6);
    if (IN(7)) REP(7) {
        const int Mo = G > 32 ? MP : MT;
        pg8::Gemm g{(const bf16*)(P.ws + WS_O), (const bf16*)(P.ws + WS_WOUTB), Mo, DM, EA}; pg8::StaticOrder S; S.init(Mo, DM, G, c);
        pg8::EpiBf16Plain E{(bf16*)(P.ws + WS_D), DM};
        pg8::gemm_phase<pg8::EpiBf16Plain, pg8::StaticOrder, true, true>(lds, g, S, E);
    }
    SEAM(7);
    if (IN(8)) REP(8) { ln_phase<true>(P, lds, 1); }
#undef IN
#undef SEAM
}

extern "C" void kernel_launch(void* const* d_in, const int* in_sizes, int n_in, void* d_out, int out_size, void* d_ws, size_t ws_size, hipStream_t stream) {
    static int grid = 0;
    if (grid == 0) {
        if (n_in != 15 || ws_size < WS_END || out_size != 54001664) { fprintf(stderr, "kernel_launch: unexpected problem (n_in %d, out %d, ws %zu)\n", n_in, out_size, ws_size); grid = -1; return; }
        int dev = 0, cus = 0, per_cu = 0;
        if (hipGetDevice(&dev) != hipSuccess || hipDeviceGetAttribute(&cus, hipDeviceAttributeMultiprocessorCount, dev) != hipSuccess) { grid = -1; return; }
        if (hipFuncSetAttribute((const void*)mk_fwd, hipFuncAttributeMaxDynamicSharedMemorySize, LDS_BYTES) != hipSuccess) { fprintf(stderr, "kernel_launch: hipFuncSetAttribute failed\n"); grid = -1; return; }
        if (hipOccupancyMaxActiveBlocksPerMultiprocessor(&per_cu, (const void*)mk_fwd, 512, LDS_BYTES) != hipSuccess || per_cu < 1) { fprintf(stderr, "kernel_launch: occupancy query gave %d\n", per_cu); (void)hipGetLastError(); per_cu = 1; }
        grid = cus * 1;
        (void)in_sizes;
    }
    if (grid < 0) return;
    Args a{};
    for (int i = 0; i < 15; ++i) a.in[i] = (const float*)d_in[i];
    a.out = (float*)d_out; a.ws = (unsigned char*)d_ws;
#if MK_MULTI
    for (int p = 0; p < NPHASE; ++p) { a.ph_lo = p; a.ph_hi = p + 1; hipLaunchKernelGGL(mk_fwd, dim3(grid), dim3(512), LDS_BYTES, stream, a); }
#else
    a.ph_lo = 0; a.ph_hi = NPHASE;
    if (hipMemsetAsync((char*)d_ws + WS_BAR, 0, XCD_BAR_WORDS * 4, stream) != hipSuccess) { fprintf(stderr, "kernel_launch: memset of the barrier words failed\n"); return; }
    void* args[] = {&a};
    hipError_t e = hipLaunchCooperativeKernel((const void*)mk_fwd, dim3(grid), dim3(512), args, LDS_BYTES, stream);
    if (e != hipSuccess) fprintf(stderr, "kernel_launch: cooperative launch failed: %s (grid %d)\n", hipGetErrorString(e), grid);
#endif
}
```

```cpp
#include <hip/hip_runtime.h>
#include <hip/hip_cooperative_groups.h>
#include <cstdio>
#include <cstdint>
namespace cg = cooperative_groups;
#define MK_MULTI 0
namespace pg8 {
#define PG8_LAS __attribute__((address_space(3)))
typedef unsigned short bf16_t;
typedef short bf16x8 __attribute__((ext_vector_type(8)));
typedef float f32x4 __attribute__((ext_vector_type(4)));
typedef unsigned u32x4 __attribute__((ext_vector_type(4)));
constexpr int BM = 256, BK = 64, HALF = 128, HTB = HALF * BK * 2  , STAGE_BYTES = 8 * HTB, NXCD = 8, WGM = 8;

__host__ __device__ __forceinline__ int lds_byte(int r, int c) { const int st = (r >> 4) * 2 + (c >> 5), rr = r & 15, cc = c & 31, ob = rr * 64 + cc * 2; return st * 1024 + (ob ^ (((ob >> 9) & 1) << 5)); }
__host__ __device__ __forceinline__ void stage_rc(int b, int& R, int& C) { const int st = b / 1024, sb = b % 1024, swz = sb ^ (((sb >> 9) & 1) << 5); R = (st >> 1) * 16 + swz / 64; C = (st & 1) * 32 + (swz % 64) / 2; }
__host__ __device__ __forceinline__ int perm32(int rho) { const int n = rho >> 4, i = rho & 15; return 8 * (i >> 2) + 4 * n + (i & 3); }

struct Unit { int pm, pn; };
struct Gemm { const bf16_t* A; const bf16_t* Bt; int M, N, K; int nt = 0; };

struct StaticOrder {
    int nM, nN, nwg, G, c;
    __host__ __device__ void init(int M, int N, int G_, int c_) { nM = M / BM; nN = N / BM; nwg = nM * nN; G = G_; c = c_; }
    __host__ __device__ bool next(int i, Unit& u) const {
        const long L = (long)i * G + c; if (L >= nwg) return false;
        int wgid = (int)L; { const int q = nwg / NXCD, r = nwg % NXCD, xcd = wgid % NXCD, off = wgid / NXCD; wgid = (xcd < r ? xcd * (q + 1) : r * (q + 1) + (xcd - r) * q) + off; }
        const int nig = WGM * nN, gid = wgid / nig, fm = gid * WGM, gsz = (nM - fm) < WGM ? (nM - fm) : WGM;
        u.pm = fm + ((wgid % nig) % gsz); u.pn = (wgid % nig) / gsz; return true;
    }
    __device__ __forceinline__ void a_ready(const Unit&) const {}
    __device__ __forceinline__ void done(const Unit&) const {}
};

typedef float cvt_f32x2 __attribute__((ext_vector_type(2)));
typedef __bf16 cvt_bf16x2 __attribute__((ext_vector_type(2)));
__device__ __forceinline__ unsigned cvt_pk_bf16(float lo, float hi) { cvt_f32x2 v; v.x = lo; v.y = hi; const cvt_bf16x2 b = __builtin_convertvector(v, cvt_bf16x2); return __builtin_bit_cast(unsigned, b); }
typedef unsigned u32x2 __attribute__((ext_vector_type(2)));
constexpr size_t MROWS = 16896;
constexpr size_t SEC_STRIDE = (size_t)16896 * 2048;
typedef float f32x2 __attribute__((ext_vector_type(2)));
typedef _Float16 f16x2 __attribute__((ext_vector_type(2)));
__device__ __forceinline__ float silu_f(float x) { return x * __builtin_amdgcn_rcpf(1.0f + __expf(-x)); }
__device__ __forceinline__ float gelu_tanh_f(float x) { const float u = 1.5957691216057308f * (x + 0.044715f * x * x * x); return x * __builtin_amdgcn_rcpf(1.0f + __expf(-u)); }
__device__ __forceinline__ unsigned pk_f16(float lo, float hi) { f16x2 p; p.x = (_Float16)lo; p.y = (_Float16)hi; return __builtin_bit_cast(unsigned, p); }

struct EpiHgrnIn {
    static constexpr bool PERM = true, AFTER_DRAIN = false;
    bf16_t* B0; const float* lb;
    __device__ __forceinline__ void operator()(const f32x4 (&acc)[2][2][4][2], const Unit& u, int wr, int wc, int fr, int fq) const {
        const int sec = u.pn >> 3;
        const int row0 = u.pm * BM + wr * 64 + fr, col0 = (u.pn & 7) * BM + wc * 32 + 8 * fq;
        bf16_t* base = B0 + (size_t)sec * SEC_STRIDE;
        f32x4 l0[2], l1[2];
#pragma unroll
        for (int bj = 0; bj < 2; ++bj) { l0[bj] = (f32x4){0.f, 0.f, 0.f, 0.f}; l1[bj] = l0[bj]; }
        if (sec == 1) {
#pragma unroll
            for (int bj = 0; bj < 2; ++bj) { l0[bj] = *(const f32x4*)(lb + col0 + bj * HALF); l1[bj] = *(const f32x4*)(lb + col0 + bj * HALF + 4); }
        }
#pragma unroll
        for (int ai = 0; ai < 2; ++ai)
#pragma unroll
            for (int m = 0; m < 4; ++m) { bf16_t* rowp = base + ((size_t)((u.pn & 7) * 2) * MROWS + (size_t)(row0 + ai * HALF + m * 16)) * 128 + wc * 32 + 8 * fq;
#pragma unroll
                for (int bj = 0; bj < 2; ++bj) { f32x4 v0 = acc[ai][bj][m][0], v1 = acc[ai][bj][m][1]; u32x4 w;
                    if (sec == 1) {
#pragma unroll
                        for (int j = 0; j < 4; ++j) { const float s0 = __builtin_amdgcn_rcpf(1.0f + __expf(-v0[j])), s1 = __builtin_amdgcn_rcpf(1.0f + __expf(-v1[j]));
                            v0[j] = __logf(l0[bj][j] + (1.0f - l0[bj][j]) * s0); v1[j] = __logf(l1[bj][j] + (1.0f - l1[bj][j]) * s1); }
                        w.x = pk_f16(v0[0], v0[1]); w.y = pk_f16(v0[2], v0[3]); w.z = pk_f16(v1[0], v1[1]); w.w = pk_f16(v1[2], v1[3]);
                    } else {
                        if (sec != 2) {
#pragma unroll
                            for (int j = 0; j < 4; ++j) { v0[j] = silu_f(v0[j]); v1[j] = silu_f(v1[j]); } }
                        w.x = cvt_pk_bf16(v0[0], v0[1]); w.y = cvt_pk_bf16(v0[2], v0[3]); w.z = cvt_pk_bf16(v1[0], v1[1]); w.w = cvt_pk_bf16(v1[2], v1[3]);
                    }
                    *(u32x4*)(rowp + (size_t)bj * MROWS * 128) = w; } }
    }
};
struct EpiGmlpIn {
    static constexpr bool PERM = true, AFTER_DRAIN = false;
    bf16_t* B0; float* part;
    __device__ __forceinline__ void operator()(const f32x4 (&acc)[2][2][4][2], const Unit& u, int wr, int wc, int fr, int fq) const {
        const int row0 = u.pm * BM + wr * 64 + fr;
        if (u.pn < 16) {
#pragma unroll
            for (int ai = 0; ai < 2; ++ai)
#pragma unroll
                for (int m = 0; m < 4; ++m) { const int row = row0 + ai * HALF + m * 16; bf16_t* rowp = B0 + ((size_t)u.pn * MROWS + (size_t)row) * 128 + wc * 32 + 8 * fq;
                    f32x4 v0 = acc[ai][0][m][0], v1 = acc[ai][0][m][1]; const f32x4 z0 = acc[ai][1][m][0], z1 = acc[ai][1][m][1]; u32x4 w;
#pragma unroll
                    for (int j = 0; j < 4; ++j) { v0[j] = gelu_tanh_f(v0[j]) * silu_f(z0[j]); v1[j] = gelu_tanh_f(v1[j]) * silu_f(z1[j]); }
                    w.x = cvt_pk_bf16(v0[0], v0[1]); w.y = cvt_pk_bf16(v0[2], v0[3]); w.z = cvt_pk_bf16(v1[0], v1[1]); w.w = cvt_pk_bf16(v1[2], v1[3]);
                    *(u32x4*)rowp = w; }
        } else {
            const int g0 = (u.pn - 16) * 2;
#pragma unroll
            for (int ai = 0; ai < 2; ++ai)
#pragma unroll
                for (int m = 0; m < 4; ++m) { const int row = row0 + ai * HALF + m * 16; bf16_t* rowp = B0 + SEC_STRIDE + ((size_t)g0 * MROWS + (size_t)row) * 128 + wc * 32 + 8 * fq; float s = 0.f, ss = 0.f;
#pragma unroll
                    for (int bj = 0; bj < 2; ++bj) { f32x4 v0 = acc[ai][bj][m][0], v1 = acc[ai][bj][m][1]; u32x4 w;
#pragma unroll
                        for (int j = 0; j < 4; ++j) { v0[j] = gelu_tanh_f(v0[j]); v1[j] = gelu_tanh_f(v1[j]); s += v0[j] + v1[j]; ss += v0[j] * v0[j] + v1[j] * v1[j]; }
                        w.x = cvt_pk_bf16(v0[0], v0[1]); w.y = cvt_pk_bf16(v0[2], v0[3]); w.z = cvt_pk_bf16(v1[0], v1[1]); w.w = cvt_pk_bf16(v1[2], v1[3]);
                        *(u32x4*)(rowp + (size_t)bj * MROWS * 128) = w; }
                    s += __shfl_xor(s, 16); s += __shfl_xor(s, 32); ss += __shfl_xor(ss, 16); ss += __shfl_xor(ss, 32);
                    if (fq == 0) { f32x2 o; o.x = s; o.y = ss; *(f32x2*)(part + (size_t)row * 64 + ((u.pn - 16) * 4 + wc) * 2) = o; } }
        }
    }
};
struct EpiF32 {
    static constexpr bool PERM = false, AFTER_DRAIN = false;
    float* C; int ldc;
    __device__ __forceinline__ void operator()(const f32x4 (&acc)[2][2][4][2], const Unit& u, int wr, int wc, int fr, int fq) const {
        const int row0 = u.pm * BM + wr * 64 + fr, col0 = u.pn * BM + wc * 32 + 4 * fq;
#pragma unroll
        for (int ai = 0; ai < 2; ++ai)
#pragma unroll
            for (int m = 0; m < 4; ++m) { float* rowp = C + (size_t)(row0 + ai * HALF + m * 16) * ldc + col0;
#pragma unroll
                for (int bj = 0; bj < 2; ++bj)
#pragma unroll
                    for (int n = 0; n < 2; ++n) *(f32x4*)(rowp + bj * HALF + n * 16) = acc[ai][bj][m][n]; }
    }
};
struct EpiBf16Plain {
    static constexpr bool PERM = true, AFTER_DRAIN = false;
    bf16_t* C; int ldc;
    __device__ __forceinline__ void operator()(const f32x4 (&acc)[2][2][4][2], const Unit& u, int wr, int wc, int fr, int fq) const {
        const int row0 = u.pm * BM + wr * 64 + fr, col0 = u.pn * BM + wc * 32 + 8 * fq;
#pragma unroll
        for (int ai = 0; ai < 2; ++ai)
#pragma unroll
            for (int m = 0; m < 4; ++m) { bf16_t* rowp = C + (size_t)(row0 + ai * HALF + m * 16) * ldc + col0;
#pragma unroll
                for (int bj = 0; bj < 2; ++bj) { const f32x4 v0 = acc[ai][bj][m][0], v1 = acc[ai][bj][m][1]; u32x4 w;
                    w.x = cvt_pk_bf16(v0[0], v0[1]); w.y = cvt_pk_bf16(v0[2], v0[3]); w.z = cvt_pk_bf16(v1[0], v1[1]); w.w = cvt_pk_bf16(v1[2], v1[3]);
                    *(u32x4*)(rowp + bj * HALF) = w; } }
    }
};
template <class Epi, class Sched, bool ALIGN_EPI = false, bool SP2 = false>
__device__ __forceinline__ void gemm_phase(PG8_LAS unsigned char* lds, const Gemm g, const Sched& S, const Epi& E) {
    const int tid = threadIdx.x, wid = __builtin_amdgcn_readfirstlane(tid >> 6), lane = tid & 63, wr = wid >> 2, wc = wid & 3, fr = lane & 15, fq = lane >> 4;
    const int K = g.K, nt = g.nt ? g.nt : K / BK;
    unsigned voffA[2], voffB[2];
#pragma unroll
    for (int i = 0; i < 2; ++i) { int R, C; stage_rc(tid * 16 + i * 8192, R, C); const int Rb = Epi::PERM ? ((R & ~31) + perm32(R & 31)) : R;
        voffA[i] = (unsigned)(R * K + C) * 2u; voffB[i] = (unsigned)(Rb * K + C) * 2u; }
    const size_t kstep = (size_t)(BK * 2);
    const size_t hstep = (size_t)HALF * K * 2;
    const size_t tstep = 2 * hstep;
    const unsigned ldsw = (unsigned)wid * 1024u;
    const int aoff = lds_byte(wr * 64 + fr, fq * 8), boff = lds_byte(wc * 32 + fr, fq * 8);
#define PG8_SA(b, h) (((b) * 2 + (h)) * HTB)
#define PG8_SB(b, h) ((4 + (b) * 2 + (h)) * HTB)
#define PG8_STAGE(bufoff, gbase, voff) do { _Pragma("unroll") for (int _i = 0; _i < 2; ++_i) \
        __builtin_amdgcn_global_load_lds((const unsigned*)((const char*)(gbase) + (voff)[_i]), (PG8_LAS unsigned*)(lds + (bufoff) + ldsw + _i * 8192), 16, 0, 0); } while (0)
#define PG8_LDA(dst, b, h) do { _Pragma("unroll") for (int m = 0; m < 4; ++m) _Pragma("unroll") for (int k = 0; k < 2; ++k) dst[m][k] = *(const PG8_LAS bf16x8*)(lds + PG8_SA(b, h) + aoff + m * 2048 + k * 1024); } while (0)
#define PG8_LDB(dst, b, h) do { _Pragma("unroll") for (int n = 0; n < 2; ++n) _Pragma("unroll") for (int k = 0; k < 2; ++k) dst[n][k] = *(const PG8_LAS bf16x8*)(lds + PG8_SB(b, h) + boff + n * 2048 + k * 1024); } while (0)
#define PG8_MMA(ai, bj, At, Bt) do { __builtin_amdgcn_s_setprio(1); _Pragma("unroll") for (int m = 0; m < 4; ++m) _Pragma("unroll") for (int n = 0; n < 2; ++n) _Pragma("unroll") for (int k = 0; k < 2; ++k) \
        acc[ai][bj][m][n] = __builtin_amdgcn_mfma_f32_16x16x32_bf16(Bt[n][k], At[m][k], acc[ai][bj][m][n], 0, 0, 0); __builtin_amdgcn_s_setprio(0); } while (0)
#define PG8_WAIT_V(n) asm volatile("s_waitcnt vmcnt(" #n ")" ::: "memory")
#define PG8_WAIT_L(n) asm volatile("s_waitcnt lgkmcnt(" #n ")" ::: "memory")
#define PG8_BAR __builtin_amdgcn_s_barrier()
#define PG8_SCHED __builtin_amdgcn_sched_barrier(0)
    Unit cur, nxt; int ui = 0;
    if (!S.next(0, cur)) return;
    f32x4 acc[2][2][4][2];
#pragma unroll
    for (int a = 0; a < 2; ++a)
#pragma unroll
        for (int b = 0; b < 2; ++b)
#pragma unroll
            for (int m = 0; m < 4; ++m)
#pragma unroll
                for (int n = 0; n < 2; ++n) acc[a][b][m][n] = (f32x4){0.f, 0.f, 0.f, 0.f};
    bf16x8 At[4][2], B0[2][2], B1[2][2];
    const char* cA = (const char*)g.A + (size_t)cur.pm * tstep; const char* cB = (const char*)g.Bt + (size_t)cur.pn * tstep;
    S.a_ready(cur);
    if constexpr (SP2) {
        PG8_STAGE(PG8_SB(0, 0), cB, voffB); PG8_STAGE(PG8_SB(0, 1), cB + hstep, voffB); PG8_STAGE(PG8_SA(0, 0), cA, voffA); PG8_STAGE(PG8_SA(0, 1), cA + hstep, voffA);
        if (wr == 1) PG8_BAR;
        PG8_WAIT_V(2); PG8_BAR;
        PG8_STAGE(PG8_SB(1, 0), cB + kstep, voffB); PG8_STAGE(PG8_SA(1, 0), cA + kstep, voffA); PG8_STAGE(PG8_SB(1, 1), cB + hstep + kstep, voffB);
        PG8_WAIT_V(6); PG8_BAR;
    } else {
        PG8_STAGE(PG8_SB(0, 0), cB, voffB); PG8_STAGE(PG8_SA(0, 0), cA, voffA); PG8_STAGE(PG8_SB(0, 1), cB + hstep, voffB); PG8_STAGE(PG8_SA(0, 1), cA + hstep, voffA);
        if (wr == 1) PG8_BAR;
        PG8_WAIT_V(4); PG8_BAR;
        PG8_STAGE(PG8_SB(1, 0), cB + kstep, voffB); PG8_STAGE(PG8_SA(1, 0), cA + kstep, voffA); PG8_STAGE(PG8_SB(1, 1), cB + hstep + kstep, voffB);
        PG8_WAIT_V(6); PG8_BAR;
    }
    for (;;) {
        const bool has_next = S.next(ui + 1, nxt);
        const char* nA = has_next ? (const char*)g.A + (size_t)nxt.pm * tstep : cA; const char* nB = has_next ? (const char*)g.Bt + (size_t)nxt.pn * tstep : cB;
        for (int t = 0; t < nt; t += 2) {
            const bool last = (t == nt - 2);
            const char* a1 = cA + (size_t)(t + 1) * kstep;
            const char* a2 = last ? nA : cA + (size_t)(t + 2) * kstep; const char* b2 = last ? nB : cB + (size_t)(t + 2) * kstep;
            const char* a3 = a2 + kstep; const char* b3 = b2 + kstep;
            if (last && has_next) S.a_ready(nxt);
            if constexpr (SP2) {
            PG8_LDB(B0, 0, 0); PG8_LDB(B1, 0, 1); PG8_SCHED; PG8_LDA(At, 0, 0); PG8_STAGE(PG8_SA(1, 1), a1 + hstep, voffA);
            PG8_WAIT_V(8); PG8_WAIT_L(0); PG8_BAR; PG8_MMA(0, 0, At, B0); PG8_MMA(0, 1, At, B1); PG8_BAR; PG8_SCHED;
            PG8_LDA(At, 0, 1); PG8_STAGE(PG8_SB(0, 0), b2, voffB); PG8_STAGE(PG8_SB(0, 1), b2 + hstep, voffB); PG8_STAGE(PG8_SA(0, 0), a2, voffA);
            PG8_WAIT_V(8); PG8_WAIT_L(0); PG8_BAR; PG8_MMA(1, 0, At, B0); PG8_MMA(1, 1, At, B1); PG8_BAR; PG8_SCHED;
            PG8_LDB(B0, 1, 0); PG8_LDB(B1, 1, 1); PG8_SCHED; PG8_LDA(At, 1, 0); PG8_STAGE(PG8_SA(0, 1), a2 + hstep, voffA);
            PG8_WAIT_V(8); PG8_WAIT_L(0); PG8_BAR; PG8_MMA(0, 0, At, B0); PG8_MMA(0, 1, At, B1); PG8_BAR; PG8_SCHED;
            PG8_LDA(At, 1, 1); PG8_STAGE(PG8_SB(1, 0), b3, voffB); PG8_STAGE(PG8_SB(1, 1), b3 + hstep, voffB); PG8_STAGE(PG8_SA(1, 0), a3, voffA);
            PG8_WAIT_V(8); PG8_WAIT_L(0); PG8_BAR; PG8_MMA(1, 0, At, B0); PG8_MMA(1, 1, At, B1); PG8_BAR; PG8_SCHED;
            } else {
            PG8_LDB(B0, 0, 0); PG8_SCHED; PG8_LDA(At, 0, 0); PG8_STAGE(PG8_SA(1, 1), a1 + hstep, voffA);
            PG8_WAIT_L(8); PG8_BAR; PG8_WAIT_L(0); PG8_MMA(0, 0, At, B0); PG8_BAR; PG8_SCHED;
            PG8_LDB(B1, 0, 1); PG8_STAGE(PG8_SB(0, 0), b2, voffB);
            PG8_BAR; PG8_WAIT_L(0); PG8_MMA(0, 1, At, B1); PG8_BAR;
            PG8_LDA(At, 0, 1); PG8_STAGE(PG8_SA(0, 0), a2, voffA);
            PG8_BAR; PG8_WAIT_L(0); PG8_MMA(1, 0, At, B0); PG8_BAR; PG8_SCHED;
            PG8_STAGE(PG8_SB(0, 1), b2 + hstep, voffB);
            PG8_WAIT_V(6); PG8_BAR; PG8_MMA(1, 1, At, B1); PG8_BAR;
            PG8_LDB(B0, 1, 0); PG8_SCHED; PG8_LDA(At, 1, 0); PG8_STAGE(PG8_SA(0, 1), a2 + hstep, voffA);
            PG8_WAIT_L(8); PG8_BAR; PG8_WAIT_L(0); PG8_MMA(0, 0, At, B0); PG8_BAR; PG8_SCHED;
            PG8_LDB(B1, 1, 1); PG8_STAGE(PG8_SB(1, 0), b3, voffB);
            PG8_BAR; PG8_WAIT_L(0); PG8_MMA(0, 1, At, B1); PG8_BAR;
            PG8_LDA(At, 1, 1); PG8_STAGE(PG8_SA(1, 0), a3, voffA);
            PG8_BAR; PG8_WAIT_L(0); PG8_MMA(1, 0, At, B0); PG8_BAR; PG8_SCHED;
            PG8_STAGE(PG8_SB(1, 1), b3 + hstep, voffB);
            PG8_WAIT_V(6); PG8_BAR; PG8_MMA(1, 1, At, B1); PG8_BAR;
            }
        }
        if constexpr (ALIGN_EPI) { if (wr == 0) PG8_BAR; }
        if constexpr (!Epi::AFTER_DRAIN) { E(acc, cur, wr, wc, fr, fq); S.done(cur); }
        if (!has_next) break;
#pragma unroll
        for (int a = 0; a < 2; ++a)
#pragma unroll
            for (int b = 0; b < 2; ++b)
#pragma unroll
                for (int m = 0; m < 4; ++m)
#pragma unroll
                    for (int n = 0; n < 2; ++n) acc[a][b][m][n] = (f32x4){0.f, 0.f, 0.f, 0.f};
        cur = nxt; cA = nA; cB = nB; ++ui;
        if constexpr (ALIGN_EPI) { if (wr == 1) PG8_BAR; }
    }
    PG8_WAIT_V(0);
    if constexpr (!ALIGN_EPI) { if (wr == 0) PG8_BAR; }
    PG8_BAR;
    if constexpr (Epi::AFTER_DRAIN) { E.fused(acc, cur, wr, wc, fr, fq, lds, wid, lane); S.done(cur); }
#undef PG8_SA
#undef PG8_SB
#undef PG8_STAGE
#undef PG8_LDA
#undef PG8_LDB
#undef PG8_MMA
#undef PG8_WAIT_V
#undef PG8_WAIT_L
#undef PG8_BAR
#undef PG8_SCHED
}
}

#define GAS __attribute__((address_space(1)))
#define LAS __attribute__((address_space(3)))
typedef unsigned short bf16;
typedef unsigned v4u __attribute__((ext_vector_type(4)));
typedef unsigned v2u __attribute__((ext_vector_type(2)));
typedef float f32x4 __attribute__((ext_vector_type(4)));
typedef float f32x2 __attribute__((ext_vector_type(2)));
typedef short bf16x8 __attribute__((ext_vector_type(8)));
typedef _Float16 f16x2 __attribute__((ext_vector_type(2)));

#ifndef MK_MULTI
#define MK_MULTI 0
#endif
constexpr int NPHASE = 9;
constexpr int MP = 16384, MS = 512, MT = MP + MS, DM = 1024, EA = 2048;
constexpr float LN_EPS = 1e-5f, ALPHA = 1.4142135623730951f;
constexpr size_t MiB = 1u << 20;
constexpr size_t WS_CTL = 0, WS_LB = 64 * 1024, WS_WSB = 1 * MiB, WS_WINA = 2 * MiB, WS_WOUTA = 18 * MiB, WS_WINB = 22 * MiB, WS_WOUTB = 34 * MiB, WS_PART = 38 * MiB;
constexpr size_t WS_XB = 44 * MiB;
constexpr size_t WS_Q = 78 * MiB, WS_LF = 144 * MiB, WS_V = 210 * MiB, WS_G = 276 * MiB, WS_O = 342 * MiB, WS_D = 408 * MiB, WS_DP = 474 * MiB, WS_END = 482 * MiB;
constexpr size_t WS_U = WS_Q, WS_VB = WS_LF, WS_Z = WS_V, WS_H1F = WS_G;
static_assert(WS_LF - WS_Q == pg8::SEC_STRIDE * 2 && WS_V - WS_LF == pg8::SEC_STRIDE * 2 && WS_G - WS_V == pg8::SEC_STRIDE * 2 && WS_O - WS_G == pg8::SEC_STRIDE * 2, "section stride");
constexpr size_t OUT_Y = 0, OUT_HP = 17301504, OUT_HS = 19398656, OUT_CV = 52953088;
constexpr int LDS_BYTES = 131072 + 1024;
constexpr size_t WS_BAR = 32 * 1024;

__device__ __forceinline__ unsigned pkbf(float lo, float hi) { return pg8::cvt_pk_bf16(lo, hi); }
__device__ __forceinline__ float bf_lo(unsigned w) { return __builtin_bit_cast(float, w << 16); }
__device__ __forceinline__ float bf_hi(unsigned w) { return __builtin_bit_cast(float, w & 0xffff0000u); }
__device__ __forceinline__ float wave_sum(float v) {
#pragma unroll
    for (int o = 1; o < 64; o <<= 1) v += __shfl_xor(v, o);
    return v;
}
#define LDS_WAIT() asm volatile("s_waitcnt lgkmcnt(0)" ::: "memory")

__device__ __forceinline__ void p0_transpose_item(const float* W, int K, int N, bf16* WT, LAS float* scr, int item, int lane, bool gmlp = false) {
    const int nblk = N / 32, kb = item / nblk, nb = item % nblk, k0 = 64 * kb, nd = 32 * nb;
    int n0 = nd;
    if (gmlp) { if (nd < 4096) { const int tile = nd >> 8, half = (nd >> 7) & 1, cc = nd & 127; n0 = (half ? 4096 : 0) + tile * 128 + cc; } else n0 = 2048 + (nd - 4096); }
    float wv[32];
#pragma unroll
    for (int i = 0; i < 32; ++i) { const int kk = 2 * i + (lane >> 5); wv[i] = __builtin_nontemporal_load(W + (size_t)(k0 + kk) * N + n0 + (lane & 31)); }
#pragma unroll
    for (int i = 0; i < 32; ++i) { const int kk = 2 * i + (lane >> 5); scr[kk * 33 + (lane & 31)] = wv[i]; }
    LDS_WAIT(); asm volatile("" ::: "memory");
    const int c = lane & 7;
#pragma unroll
    for (int j = 0; j < 4; ++j) { const int n = (lane >> 3) + 8 * j; const LAS float* s = scr + (8 * c) * 33 + n;
        v4u o; o.x = pkbf(s[0 * 33], s[1 * 33]); o.y = pkbf(s[2 * 33], s[3 * 33]); o.z = pkbf(s[4 * 33], s[5 * 33]); o.w = pkbf(s[6 * 33], s[7 * 33]);
        *(v4u*)(WT + (size_t)(nd + n) * K + k0 + 8 * c) = o; }
    LDS_WAIT(); asm volatile("" ::: "memory");
}

typedef GAS unsigned gu32;
#define XB_TMO      128
#define XB_XCNT(j)  (256  + 64 * (j))
#define XB_XSUB(j)  (1280 + 64 * (j))
#define XB_XGEN(j)  (2304 + 64 * (j))
#define XB_TOP      3328
#define XB_TOPGEN   3392
#define XCD_BAR_WORDS 3456
#define XB_SPIN_CAP (1u << 18)

__device__ __forceinline__ unsigned xb_ld(unsigned* p)              { return __hip_atomic_load(p, __ATOMIC_RELAXED, __HIP_MEMORY_SCOPE_AGENT); }
__device__ __forceinline__ unsigned xb_add(unsigned* p, unsigned v) { return __hip_atomic_fetch_add(p, v, __ATOMIC_RELAXED, __HIP_MEMORY_SCOPE_AGENT); }
__device__ __forceinline__ unsigned xb_xcc_id() { return (unsigned)__builtin_amdgcn_s_getreg((3 << 11) | 20) & 0xFu; }
#define XB_SPIN(cond, bar) do { unsigned _sp = 0; while (cond) { __builtin_amdgcn_s_sleep(1); \
    if ((++_sp & 255u) == 0u) { if (xb_ld(&(bar)[XB_TMO])) break; if (_sp > XB_SPIN_CAP) { atomicAdd(&(bar)[XB_TMO], 1u); break; } } } } while (0)

struct XcdBarrier {
    unsigned* bar; unsigned x;
    volatile LAS unsigned* st;
};

__device__ __forceinline__ XcdBarrier xcd_barrier_post(unsigned* bar, volatile LAS unsigned* st) {
    XcdBarrier b; b.bar = bar; b.x = xb_xcc_id(); b.st = st;
    if (threadIdx.x == 0) (void)xb_add(&bar[XB_XCNT(b.x)], 1u);
    return b;
}
__device__ __forceinline__ void xcd_barrier_complete(unsigned* bar, unsigned x, unsigned& nloc, unsigned& nx) {
    const unsigned G = gridDim.x * gridDim.y * gridDim.z;
    unsigned sum, cnt, mine, sp = 0u;
    for (;;) {
        sum = 0u; cnt = 0u; mine = 0u;
#pragma unroll
        for (unsigned j = 0; j < 16; ++j) { const unsigned c = xb_ld(&bar[XB_XCNT(j)]); sum += c; cnt += (c > 0u) ? 1u : 0u; mine = (j == x) ? c : mine; }
        if (sum == G) break;
        __builtin_amdgcn_s_sleep(1);
        if ((++sp & 255u) == 0u) { if (xb_ld(&bar[XB_TMO])) break; if (sp > XB_SPIN_CAP) { atomicAdd(&bar[XB_TMO], 1u); break; } }
    }
    nloc = mine > 0u ? mine : 1u; nx = cnt > 0u ? cnt : 1u;
}

__device__ __forceinline__ void xcd_barrier(const XcdBarrier& b) {
    asm volatile("s_waitcnt vmcnt(0)" ::: "memory");
    __syncthreads();
    if (threadIdx.x == 0) {
        unsigned* bar = b.bar;
        __builtin_amdgcn_s_waitcnt(0);
        unsigned nloc = b.st[0], nx = b.st[1];
        if (nloc == 0u) { xcd_barrier_complete(bar, b.x, nloc, nx); b.st[0] = nloc; b.st[1] = nx; }
        const unsigned old = xb_add(&bar[XB_XSUB(b.x)], 1u);
        const unsigned gen = old / nloc;
        if (old + 1u == (gen + 1u) * nloc) {
            __builtin_amdgcn_fence(__ATOMIC_RELEASE, "agent");
            asm volatile("s_waitcnt vmcnt(0)" ::: "memory");
            const unsigned og = xb_add(&bar[XB_TOP], 1u);
            const unsigned tg = og / nx;
            if (og + 1u == (tg + 1u) * nx) xb_add(&bar[XB_TOPGEN], 1u);
            else XB_SPIN(xb_ld(&bar[XB_TOPGEN]) == tg, bar);
            __builtin_amdgcn_fence(__ATOMIC_ACQUIRE, "agent");
            xb_add(&bar[XB_XGEN(b.x)], 1u);
            asm volatile("s_waitcnt vmcnt(0)" ::: "memory");
        } else {
            XB_SPIN(xb_ld(&bar[XB_XGEN(b.x)]) == gen, bar);
            __builtin_amdgcn_fence(__ATOMIC_ACQUIRE, "agent");
            asm volatile("s_waitcnt vmcnt(0)" ::: "memory");
        }
    }
    __syncthreads();
}

struct Ptrs {
    const float *xp, *xs, *state, *w_in_a, *lb_logits, *gnorm, *w_out_a, *w_in_b, *lnv_g, *lnv_b, *w_s, *b_s, *w_out_b, *ln_g, *ln_b;
    float* out; unsigned char* ws;
};

__device__ __forceinline__ void p0_prologue(const Ptrs& P, LAS unsigned char* lds) {
    const int tid = threadIdx.x, lane = tid & 63, wave = __builtin_amdgcn_readfirstlane(tid >> 6);
    LAS float* scr = (LAS float*)(lds + wave * 16384);
    const int gw = blockIdx.x * 8 + wave, NGW = gridDim.x * 8;
    constexpr int I_A = (DM / 64) * (4 * EA / 32), I_OA = (EA / 64) * (DM / 32), I_B = (DM / 64) * (3 * EA / 32), I_OB = I_OA, NITEMS = I_A + I_OA + I_B + I_OB;
    const int n_early = (gridDim.x >= 128) ? I_A : NITEMS;
    for (int it = gw; it < n_early; it += NGW) {
        int r = it;
        if (r < I_A) { p0_transpose_item(P.w_in_a, DM, 4 * EA, (bf16*)(P.ws + WS_WINA), scr, r, lane); continue; } r -= I_A;
        if (r < I_OA) { p0_transpose_item(P.w_out_a, EA, DM, (bf16*)(P.ws + WS_WOUTA), scr, r, lane); continue; } r -= I_OA;
        if (r < I_B) { p0_transpose_item(P.w_in_b, DM, 3 * EA, (bf16*)(P.ws + WS_WINB), scr, r, lane, true); continue; } r -= I_B;
        p0_transpose_item(P.w_out_b, EA, DM, (bf16*)(P.ws + WS_WOUTB), scr, r, lane);
    }
    const size_t gtid = (size_t)blockIdx.x * 512 + tid, GT = (size_t)gridDim.x * 512;
    {
        const f32x4* xp4 = (const f32x4*)P.xp; const f32x4* xs4 = (const f32x4*)P.xs; v2u* xb = (v2u*)(P.ws + WS_XB);
        constexpr size_t NP4 = (size_t)MP * DM / 4, NT4 = (size_t)MT * DM / 4;
        for (size_t q = gtid; q < NT4; q += 4 * GT) { f32x4 v[4];
#pragma unroll
            for (int k = 0; k < 4; ++k) { size_t qq = q + k * GT; qq = qq < NT4 ? qq : NT4 - 1; v[k] = __builtin_nontemporal_load(qq < NP4 ? xp4 + qq : xs4 + (qq - NP4)); }
#pragma unroll
            for (int k = 0; k < 4; ++k) { const size_t qq = q + k * GT; if (qq < NT4) { v2u o; o.x = pkbf(v[k].x, v[k].y); o.y = pkbf(v[k].z, v[k].w); xb[qq] = o; } } }
    }
    {
        const f32x4* w4 = (const f32x4*)P.w_s; v2u* wb = (v2u*)(P.ws + WS_WSB);
        for (size_t q = gtid; q < (size_t)16 * 128 * 128 / 4; q += GT) { const int e = (int)(q * 4), s = e & 127, t = (e >> 7) & 127; const f32x4 v = w4[q];
            v2u o; o.x = pkbf(s <= t ? v.x : 0.f, s + 1 <= t ? v.y : 0.f); o.y = pkbf(s + 2 <= t ? v.z : 0.f, s + 3 <= t ? v.w : 0.f); wb[q] = o; }
    }
    if (gtid < 2048) { float* lb = (float*)(P.ws + WS_LB); lb[gtid] = 1.0f / (1.0f + expf(P.lb_logits[2048 + gtid] - P.lb_logits[gtid])); }
    if (gtid < 4) { ((unsigned*)(P.ws + WS_CTL))[64 * gtid] = 0u; }
}

__device__ __forceinline__ void p0_late_weights(const Ptrs& P, LAS unsigned char* lds, int widx, int nw) {
    const int tid = threadIdx.x, lane = tid & 63, wave = __builtin_amdgcn_readfirstlane(tid >> 6);
    LAS float* scr = (LAS float*)(lds + wave * 16384);
    constexpr int I_OA = (EA / 64) * (DM / 32), I_B = (DM / 64) * (3 * EA / 32), I_OB = I_OA, NLATE = I_OA + I_B + I_OB;
    for (int it = widx * 8 + wave; it < NLATE; it += nw * 8) {
        int r = it;
        if (r < I_OA) { p0_transpose_item(P.w_out_a, EA, DM, (bf16*)(P.ws + WS_WOUTA), scr, r, lane); continue; } r -= I_OA;
        if (r < I_B) { p0_transpose_item(P.w_in_b, DM, 3 * EA, (bf16*)(P.ws + WS_WINB), scr, r, lane, true); continue; } r -= I_B;
        p0_transpose_item(P.w_out_b, EA, DM, (bf16*)(P.ws + WS_WOUTB), scr, r, lane);
    }
}

struct OneUnit {
    pg8::Unit u0;
    __device__ __forceinline__ bool next(int i, pg8::Unit& u) const { if (i != 0) return false; u = u0; return true; }
    __device__ __forceinline__ void a_ready(const pg8::Unit&) const {}
    __device__ __forceinline__ void done(const pg8::Unit&) const {}
};
template <bool FINAL, int NR, bool PARTS = false>
__device__ __forceinline__ void ln_rows(const Ptrs& P, const f32x4* g4, const f32x4* b4, int mbase, int mstride, int mend, int lane) {
    const bf16* D = (const bf16*)(P.ws + WS_D); bf16* H1B = (bf16*)(P.ws + WS_XB);
    f32x4 v[NR][4]; float s[NR];
#pragma unroll
    for (int k = 0; k < NR; ++k) { int m = mbase + k * mstride; m = m < mend ? m : mend - 1;
        f32x4 x[4];
        if (FINAL) { const v2u* h4 = (const v2u*)(H1B + (size_t)m * DM);
#pragma unroll
            for (int j = 0; j < 4; ++j) { const v2u r = __builtin_nontemporal_load(h4 + 64 * j + lane); x[j].x = bf_lo(r.x); x[j].y = bf_hi(r.x); x[j].z = bf_lo(r.y); x[j].w = bf_hi(r.y); } }
        else { const f32x4* x4 = (const f32x4*)(m < MP ? P.xp + (size_t)m * DM : P.xs + (size_t)(m - MP) * DM);
#pragma unroll
            for (int j = 0; j < 4; ++j) x[j] = __builtin_nontemporal_load(x4 + 64 * j + lane); }
        if (PARTS) { const f32x4* d4 = (const f32x4*)(P.ws + WS_DP) + (size_t)(m - MP) * (DM / 4);
#pragma unroll
            for (int j = 0; j < 4; ++j) v[k][j] = x[j] * ALPHA + ((d4[64 * j + lane] + d4[64 * j + lane + 512 * DM / 4]) + (d4[64 * j + lane + 2 * 512 * DM / 4] + d4[64 * j + lane + 3 * 512 * DM / 4])); }
        else { const v2u* d4 = (const v2u*)(D + (size_t)m * DM);
#pragma unroll
            for (int j = 0; j < 4; ++j) { const v2u r = __builtin_nontemporal_load(d4 + 64 * j + lane); f32x4 d; d.x = bf_lo(r.x); d.y = bf_hi(r.x); d.z = bf_lo(r.y); d.w = bf_hi(r.y); v[k][j] = x[j] * ALPHA + d; } } }
#pragma unroll
    for (int k = 0; k < NR; ++k) { s[k] = 0.f;
#pragma unroll
        for (int j = 0; j < 4; ++j) s[k] += (v[k][j].x + v[k][j].y) + (v[k][j].z + v[k][j].w); }
#pragma unroll
    for (int o = 1; o < 64; o <<= 1) {
#pragma unroll
        for (int k = 0; k < NR; ++k) s[k] += __shfl_xor(s[k], o); }
#pragma unroll
    for (int k = 0; k < NR; ++k) { const float mean = s[k] * (1.0f / DM); s[k] = 0.f;
#pragma unroll
        for (int j = 0; j < 4; ++j) { v[k][j] = v[k][j] - mean; s[k] += (v[k][j].x * v[k][j].x + v[k][j].y * v[k][j].y) + (v[k][j].z * v[k][j].z + v[k][j].w * v[k][j].w); } }
#pragma unroll
    for (int o = 1; o < 64; o <<= 1) {
#pragma unroll
        for (int k = 0; k < NR; ++k) s[k] += __shfl_xor(s[k], o); }
#pragma unroll
    for (int j = 0; j < 4; ++j) { const f32x4 gg = g4[64 * j + lane], bb = b4[64 * j + lane];
#pragma unroll
        for (int k = 0; k < NR; ++k) { const int m = mbase + k * mstride; if (m < mend) { const float rstd = __builtin_amdgcn_rsqf(s[k] * (1.0f / DM) + LN_EPS); const f32x4 y = v[k][j] * rstd * gg + bb;
            if (FINAL) { __builtin_nontemporal_store(y, (f32x4*)(P.out + OUT_Y + (size_t)m * DM) + 64 * j + lane); }
            else { v2u o; o.x = pkbf(y.x, y.y); o.y = pkbf(y.z, y.w); ((v2u*)(H1B + (size_t)m * DM))[64 * j + lane] = o; } } } }
}
template <bool FINAL>
__device__ __forceinline__ void ln_phase(const Ptrs& P, LAS unsigned char* lds, int layer) {
    const int tid = threadIdx.x, lane = tid & 63, wave = tid >> 6;
    const int G = (int)gridDim.x, bx = (int)blockIdx.x;
    const f32x4* g4 = (const f32x4*)(P.ln_g + layer * DM); const f32x4* b4 = (const f32x4*)(P.ln_b + layer * DM);
    if (G <= 32) {
        for (int m = bx * 8 + wave; m < MT; m += G * 8) ln_rows<FINAL, 1>(P, g4, b4, m, 0, MT, lane);
        return;
    }
    if (bx < 32) {
        unsigned* cnt = (unsigned*)(P.ws + WS_CTL) + 64 * (2 + layer);
        const int unit = bx >> 2, ks = bx & 3;
        pg8::Gemm g{(const bf16*)(P.ws + WS_O) + ks * 512, (const bf16*)(P.ws + (FINAL ? WS_WOUTB : WS_WOUTA)) + ks * 512, MT, DM, EA, 8};
        OneUnit S; S.u0.pm = MP / 256 + (unit >> 2); S.u0.pn = unit & 3;
        pg8::EpiF32 E{(float*)(P.ws + WS_DP) + (size_t)ks * 512 * DM - (size_t)MP * DM, DM};
        pg8::gemm_phase<pg8::EpiF32, OneUnit, true, true>(lds, g, S, E);
        asm volatile("s_waitcnt vmcnt(0)" ::: "memory");
        __syncthreads();
        if (tid == 0) {
            __builtin_amdgcn_fence(__ATOMIC_RELEASE, "agent"); asm volatile("s_waitcnt vmcnt(0)" ::: "memory");
            __hip_atomic_fetch_add(cnt, 1u, __ATOMIC_RELAXED, __HIP_MEMORY_SCOPE_AGENT);
            while (__hip_atomic_load(cnt, __ATOMIC_RELAXED, __HIP_MEMORY_SCOPE_AGENT) < 32u) __builtin_amdgcn_s_sleep(4);
            __builtin_amdgcn_fence(__ATOMIC_ACQUIRE, "agent"); asm volatile("s_waitcnt vmcnt(0)" ::: "memory");
        }
        __syncthreads();
        __builtin_amdgcn_fence(__ATOMIC_ACQUIRE, "agent");
        ln_rows<FINAL, 2, true>(P, g4, b4, MP + bx * 16 + wave * 2, 1, MT, lane);
    } else {
        const int nw = (G - 32) * 8;
        for (int m = (bx - 32) * 8 + wave; m < MP; m += 3 * nw) ln_rows<FINAL, 3>(P, g4, b4, m, nw, MP, lane);
    }
}

#define MFMA16(a, b, c) __builtin_amdgcn_mfma_f32_16x16x32_bf16((a), (b), (c), 0, 0, 0)
__device__ __forceinline__ void hgrn_unit(LAS unsigned char* lds, const bf16* Q, const bf16* LF, const bf16* V, const bf16* G, bf16* O, const float* gnorm,
                                          int m0, int h, float* s_out, int nb, int ne, bool store_state) {
    const int tid = threadIdx.x, lane = tid & 63, wid = __builtin_amdgcn_readfirstlane(tid >> 6);
    const int i = lane & 15, g = lane >> 4, wq = wid & 3, hc = h * 128;
    constexpr int SQ = 136, SK = 72, nch = 32;
    LAS unsigned char* QD = lds; LAS unsigned char* KI = lds + 17408; LAS unsigned char* KET = lds + 34816; LAS unsigned char* VT = lds + 53248; LAS unsigned char* ST = lds + 71680;
    LAS float* DEC = (LAS float*)(lds + 106496); LAS float* GN = (LAS float*)(lds + 111104);
    if (tid < 128) GN[tid] = gnorm[hc + tid];
    if (wid < 4) {
        const int t0 = 16 * wid;
        v2u gq_n[8], gq_c[8], po[8];
        const bf16* gp = G + ((size_t)h * MT + (size_t)(m0 + t0 + i)) * 128 + 4 * g;
        bf16* orow = O + (size_t)(m0 + t0 + i) * 2048 + hc + 4 * g;
        bf16* prow = orow;
#define LOAD_GATE(nn) do { const int nc_ = (nn) < nch ? (nn) : nch - 1; const bf16* gb_ = gp + (size_t)nc_ * 8192; \
        _Pragma("unroll") for (int vt = 0; vt < 8; ++vt) gq_n[vt] = __builtin_nontemporal_load((const v2u*)(gb_ + 16 * vt)); } while (0)
#define STORE_PREV() do { _Pragma("unroll") for (int vt = 0; vt < 8; ++vt) *(v2u*)(prow + 16 * vt) = po[vt]; } while (0)
        if (nb > 0) {
            const size_t so_ = ((size_t)h * MT + (size_t)(m0 + 16 * wid + (lane >> 4))) * 128 + 8 * (lane & 15);
            const bf16* sl_ = LF + so_; const bf16* sv_ = V + so_;
            LAS unsigned char* RLs = lds + ((16 * wid + (lane >> 4)) * 128 + 8 * (lane & 15)) * 2; LAS unsigned char* RVs = RLs + 16384;
            v4u r0[8], r1[8], r2[8];
#define WU_LOAD(R, cc) do { const int nc_ = (cc) < nch ? (cc) : nch - 1; const size_t co_ = (size_t)nc_ * 8192; \
            _Pragma("unroll") for (int j = 0; j < 4; ++j) { R[j] = *(const v4u*)(sl_ + co_ + (size_t)j * 4 * 128); R[4 + j] = *(const v4u*)(sv_ + co_ + (size_t)j * 4 * 128); } } while (0)
#define WU_STAGE(R) do { _Pragma("unroll") for (int j = 0; j < 4; ++j) { *(LAS v4u*)(RLs + j * 4 * 256) = R[j]; *(LAS v4u*)(RVs + j * 4 * 256) = R[4 + j]; } } while (0)
            WU_LOAD(r0, 1); WU_LOAD(r1, 2); WU_LOAD(r2, 3);
            for (int n = 0; n < nb; n += 3) {
                WU_STAGE(r0); WU_LOAD(r0, n + 4); __syncthreads(); __syncthreads();
                WU_STAGE(r1); WU_LOAD(r1, n + 5); __syncthreads(); __syncthreads();
                WU_STAGE(r2); WU_LOAD(r2, n + 6); __syncthreads(); __syncthreads();
            }
#undef WU_LOAD
#undef WU_STAGE
        }
        LOAD_GATE(nb);
        for (int n = nb; n < ne; ++n) {
            int i_ = i, g_ = g; asm volatile("" : "+v"(i_), "+v"(g_));
#pragma unroll
            for (int vt = 0; vt < 8; ++vt) gq_c[vt] = gq_n[vt];
            if (n > nb) STORE_PREV();
            LOAD_GATE(n + 1);
            __syncthreads();
            {
                bf16x8 bq[4];
#pragma unroll
                for (int kk = 0; kk < 4; ++kk) bq[kk] = *(const LAS bf16x8*)(QD + ((t0 + i_) * SQ + 32 * kk + 8 * g_) * 2);
                bf16x8 pc[2];
                {
                    f32x4 sT[4];
#pragma unroll
                    for (int st = 0; st < 4; ++st) {
                        f32x4 a4 = (f32x4){0.f, 0.f, 0.f, 0.f};
#pragma unroll
                        for (int kk = 0; kk < 4; ++kk) { const bf16x8 a = *(const LAS bf16x8*)(KI + ((16 * st + i_) * SQ + 32 * kk + 8 * g_) * 2); a4 = MFMA16(a, bq[kk], a4); }
#pragma unroll
                        for (int r = 0; r < 4; ++r) if (16 * st + 4 * g_ + r > t0 + i_) a4[r] = 0.f;
                        sT[st] = a4;
                    }
#pragma unroll
                    for (int c = 0; c < 2; ++c) { v4u w; w.x = pkbf(sT[2 * c][0], sT[2 * c][1]); w.y = pkbf(sT[2 * c][2], sT[2 * c][3]); w.z = pkbf(sT[2 * c + 1][0], sT[2 * c + 1][1]); w.w = pkbf(sT[2 * c + 1][2], sT[2 * c + 1][3]);
                        pc[c] = __builtin_bit_cast(bf16x8, w); }
                }
                f32x4 oa[8]; float ss = 0.f;
#pragma unroll
                for (int vt = 0; vt < 8; ++vt) {
                    f32x4 acc = (f32x4){0.f, 0.f, 0.f, 0.f};
#pragma unroll
                    for (int c = 0; c < 2; ++c) {
                        const v2u lo = *(const LAS v2u*)(VT + ((16 * vt + i_) * SK + 32 * c + 4 * g_) * 2), hi = *(const LAS v2u*)(VT + ((16 * vt + i_) * SK + 32 * c + 16 + 4 * g_) * 2);
                        v4u w; w.x = lo.x; w.y = lo.y; w.z = hi.x; w.w = hi.y; acc = MFMA16(__builtin_bit_cast(bf16x8, w), pc[c], acc); }
#pragma unroll
                    for (int kk = 0; kk < 4; ++kk) { const bf16x8 a = *(const LAS bf16x8*)(ST + ((16 * vt + i_) * SQ + 32 * kk + 8 * g_) * 2); acc = MFMA16(a, bq[kk], acc); }
                    oa[vt] = acc; ss += (acc[0] * acc[0] + acc[1] * acc[1]) + (acc[2] * acc[2] + acc[3] * acc[3]);
                }
                ss += __shfl_xor(ss, 16); ss += __shfl_xor(ss, 32);
                const float sc = __builtin_amdgcn_rsqf(ss * (1.0f / 128.0f) + LN_EPS);
#pragma unroll
                for (int vt = 0; vt < 8; ++vt) { const v2u gg = gq_c[vt]; const f32x4 gn = *(const LAS f32x4*)(GN + 16 * vt + 4 * g_) * sc;
                    po[vt].x = pkbf(oa[vt][0] * gn[0] * bf_lo(gg.x), oa[vt][1] * gn[1] * bf_hi(gg.x)); po[vt].y = pkbf(oa[vt][2] * gn[2] * bf_lo(gg.y), oa[vt][3] * gn[3] * bf_hi(gg.y)); }
                prow = orow + (size_t)n * (64 * 2048);
            }
            __syncthreads();
        }
        STORE_PREV();
#undef STORE_PREV
#undef LOAD_GATE
    } else {
        const int cp = i, rg = g, c0 = 32 * wq + 2 * cp;
        const size_t pofs = ((size_t)h * MT + (size_t)(m0 + 16 * rg)) * 128 + c0;
        const bf16* qp = Q + pofs; const bf16* lp = LF + pofs; const bf16* vp = V + pofs;
        unsigned rq[16], rl[16], rv[16];
        unsigned sq[16], sk[16], ske0[8], ske1[8]; float det0, det1;
#define LOAD_RAW(nn) do { const int nc_ = (nn) < nch ? (nn) : nch - 1; const bf16* qb_ = qp + (size_t)nc_ * 8192; const bf16* lb_ = lp + (size_t)nc_ * 8192; const bf16* vb_ = vp + (size_t)nc_ * 8192; \
        _Pragma("unroll") for (int r = 0; r < 16; ++r) { rl[r] = *(const unsigned*)(lb_ + r * 128); rq[r] = *(const unsigned*)(qb_ + r * 128); } (void)vb_; } while (0)
#define LOAD_V(nn) do { const int nc_ = (nn) < nch ? (nn) : nch - 1; const bf16* vb_ = vp + (size_t)nc_ * 8192; _Pragma("unroll") for (int r = 0; r < 16; ++r) rv[r] = *(const unsigned*)(vb_ + r * 128); } while (0)
#define PREP_REGS(full_) do { \
        float su0 = 0.f, su1 = 0.f; \
        _Pragma("unroll") for (int r = 0; r < 16; ++r) { const f16x2 hh = __builtin_bit_cast(f16x2, rl[r]); su0 += (float)hh.x; su1 += (float)hh.y; } \
        float off0 = 0.f, off1 = 0.f, tot0 = 0.f, tot1 = 0.f; \
        _Pragma("unroll") for (int j = 0; j < 4; ++j) { const float a_ = __shfl(su0, cpx + 16 * j), b_ = __shfl(su1, cpx + 16 * j); if (j < rgx) { off0 += a_; off1 += b_; } tot0 += a_; tot1 += b_; } \
        const float et0 = __expf(tot0), et1 = __expf(tot1); float p0 = __expf(off0), p1 = __expf(off1); det0 = et0; det1 = et1; \
        float kp0 = 0.f, kp1 = 0.f; \
        _Pragma("unroll") for (int r = 0; r < 16; ++r) { const f16x2 hh = __builtin_bit_cast(f16x2, rl[r]); const float f0 = __expf((float)hh.x), f1 = __expf((float)hh.y); \
            p0 *= f0; p1 *= f1; \
            const float ki0 = (1.0f - f0) * __builtin_amdgcn_rcpf(p0), ki1 = (1.0f - f1) * __builtin_amdgcn_rcpf(p1); const float ke0 = ki0 * et0, ke1 = ki1 * et1; \
            if (full_) { sq[r] = pkbf(bf_lo(rq[r]) * p0, bf_hi(rq[r]) * p1); sk[r] = pkbf(ki0, ki1); } \
            if (r & 1) { ske0[r >> 1] = pkbf(kp0, ke0); ske1[r >> 1] = pkbf(kp1, ke1); } \
            kp0 = ke0; kp1 = ke1; } } while (0)
#define DUMP_REGS(full_) do { \
        if (full_) _Pragma("unroll") for (int r = 0; r < 16; ++r) { *(LAS unsigned*)(QD + ((16 * rgx + r) * SQ + c0x) * 2) = sq[r]; *(LAS unsigned*)(KI + ((16 * rgx + r) * SQ + c0x) * 2) = sk[r]; } \
        { v4u w_; w_.x = ske0[0]; w_.y = ske0[1]; w_.z = ske0[2]; w_.w = ske0[3]; *(LAS v4u*)(KET + (c0x * SK + 16 * rgx) * 2) = w_; w_.x = ske0[4]; w_.y = ske0[5]; w_.z = ske0[6]; w_.w = ske0[7]; *(LAS v4u*)(KET + (c0x * SK + 16 * rgx + 8) * 2) = w_; \
          w_.x = ske1[0]; w_.y = ske1[1]; w_.z = ske1[2]; w_.w = ske1[3]; *(LAS v4u*)(KET + ((c0x + 1) * SK + 16 * rgx) * 2) = w_; w_.x = ske1[4]; w_.y = ske1[5]; w_.z = ske1[6]; w_.w = ske1[7]; *(LAS v4u*)(KET + ((c0x + 1) * SK + 16 * rgx + 8) * 2) = w_; \
          _Pragma("unroll") for (int hh_ = 0; hh_ < 2; ++hh_) { \
            w_.x = (rv[8 * hh_ + 0] & 0xffffu) | (rv[8 * hh_ + 1] << 16); w_.y = (rv[8 * hh_ + 2] & 0xffffu) | (rv[8 * hh_ + 3] << 16); w_.z = (rv[8 * hh_ + 4] & 0xffffu) | (rv[8 * hh_ + 5] << 16); w_.w = (rv[8 * hh_ + 6] & 0xffffu) | (rv[8 * hh_ + 7] << 16); \
            *(LAS v4u*)(VT + (c0x * SK + 16 * rgx + 8 * hh_) * 2) = w_; \
            w_.x = (rv[8 * hh_ + 0] >> 16) | (rv[8 * hh_ + 1] & 0xffff0000u); w_.y = (rv[8 * hh_ + 2] >> 16) | (rv[8 * hh_ + 3] & 0xffff0000u); w_.z = (rv[8 * hh_ + 4] >> 16) | (rv[8 * hh_ + 5] & 0xffff0000u); w_.w = (rv[8 * hh_ + 6] >> 16) | (rv[8 * hh_ + 7] & 0xffff0000u); \
            *(LAS v4u*)(VT + ((c0x + 1) * SK + 16 * rgx + 8 * hh_) * 2) = w_; } } \
        if (rgx == 0) { f32x2 p_; p_.x = det0; p_.y = det1; *(LAS f32x2*)(DEC + c0x) = p_; } } while (0)
        f32x4 S[8][2];
#define WRITE_ST() do { _Pragma("unroll") for (int kt = 0; kt < 8; ++kt) _Pragma("unroll") for (int j = 0; j < 2; ++j) { v2u w_; w_.x = pkbf(S[kt][j][0], S[kt][j][1]); w_.y = pkbf(S[kt][j][2], S[kt][j][3]); \
        *(LAS v2u*)(ST + ((16 * (2 * wq + j) + i) * SQ + 16 * kt + 4 * g) * 2) = w_; } } while (0)
#pragma unroll
        for (int kt = 0; kt < 8; ++kt)
#pragma unroll
            for (int j = 0; j < 2; ++j) S[kt][j] = (f32x4){0.f, 0.f, 0.f, 0.f};
        LOAD_RAW(0); LOAD_V(0);
        WRITE_ST();
        { const int cpx = cp, rgx = rg, c0x = c0; PREP_REGS(nb == 0); (void)c0x; }
        if (nb > 0) {
            { const int nc_ = nb < nch ? nb : nch - 1; const bf16* qb_ = qp + (size_t)nc_ * 8192;
#pragma unroll
              for (int r = 0; r < 16; ++r) rq[r] = *(const unsigned*)(qb_ + r * 128); }
            for (int n = 0; n < nb; ++n) {
                int i_ = i, g_ = g; asm volatile("" : "+v"(i_), "+v"(g_));
                const int cpx = i_, rgx = g_, c0x = 32 * wq + 2 * i_;
                DUMP_REGS(false);
                __syncthreads();
                {
                    bf16x8 bv[2][2];
#pragma unroll
                    for (int j = 0; j < 2; ++j)
#pragma unroll
                        for (int c = 0; c < 2; ++c) bv[j][c] = *(const LAS bf16x8*)(VT + ((16 * (2 * wq + j) + i_) * SK + 32 * c + 8 * g_) * 2);
#pragma unroll
                    for (int kt = 0; kt < 8; ++kt) {
                        const f32x4 d = *(const LAS f32x4*)(DEC + 16 * kt + 4 * g_);
                        const bf16x8 a0 = *(const LAS bf16x8*)(KET + ((16 * kt + i_) * SK + 8 * g_) * 2), a1 = *(const LAS bf16x8*)(KET + ((16 * kt + i_) * SK + 32 + 8 * g_) * 2);
#pragma unroll
                        for (int j = 0; j < 2; ++j) { f32x4 acc = S[kt][j] * d; acc = MFMA16(a0, bv[j][0], acc); acc = MFMA16(a1, bv[j][1], acc); S[kt][j] = acc; }
                    }
                }
#pragma unroll
                for (int r = 0; r < 16; ++r) { rl[r] = *(const LAS unsigned*)(lds + ((16 * rgx + r) * 128 + c0x) * 2); rv[r] = *(const LAS unsigned*)(lds + 16384 + ((16 * rgx + r) * 128 + c0x) * 2); }
                PREP_REGS(n + 1 == nb);
                __syncthreads();
            }
            WRITE_ST();
            LOAD_RAW(nb + 1);
        } else { LOAD_RAW(1); }
        for (int n = nb; n < ne; ++n) {
            int i_ = i, g_ = g; asm volatile("" : "+v"(i_), "+v"(g_));
            const int cpx = i_, rgx = g_, c0x = 32 * wq + 2 * i_;
            DUMP_REGS(true);
            asm volatile("" ::: "memory");
            LOAD_V(n + 1);
            __syncthreads();
            {
                bf16x8 bv[2][2];
#pragma unroll
                for (int j = 0; j < 2; ++j)
#pragma unroll
                    for (int c = 0; c < 2; ++c) bv[j][c] = *(const LAS bf16x8*)(VT + ((16 * (2 * wq + j) + i_) * SK + 32 * c + 8 * g_) * 2);
#pragma unroll
                for (int kt = 0; kt < 8; ++kt) {
                    const f32x4 d = *(const LAS f32x4*)(DEC + 16 * kt + 4 * g_);
                    const bf16x8 a0 = *(const LAS bf16x8*)(KET + ((16 * kt + i_) * SK + 8 * g_) * 2), a1 = *(const LAS bf16x8*)(KET + ((16 * kt + i_) * SK + 32 + 8 * g_) * 2);
#pragma unroll
                    for (int j = 0; j < 2; ++j) { f32x4 acc = S[kt][j] * d; acc = MFMA16(a0, bv[j][0], acc); acc = MFMA16(a1, bv[j][1], acc); S[kt][j] = acc; }
                }
            }
            PREP_REGS(true);
            LOAD_RAW(n + 2);
            __syncthreads();
            WRITE_ST();
        }
        if (store_state) {
            float* op = s_out + (4 * g) * 128 + 32 * wq + i;
#pragma unroll
            for (int kt = 0; kt < 8; ++kt) {
#pragma unroll
                for (int j = 0; j < 2; ++j)
#pragma unroll
                    for (int r = 0; r < 4; ++r) __builtin_nontemporal_store(S[kt][j][r], op + r * 128 + 16 * j);
                op += 2048; asm volatile("" : "+v"(op));
            }
        }
#undef WRITE_ST
#undef DUMP_REGS
#undef PREP_REGS
#undef LOAD_RAW
#undef LOAD_V
    }
}

__device__ __forceinline__ void hgrn_sample_units(LAS unsigned char* lds, const bf16* Q, const bf16* LF, const bf16* V, const bf16* G, bf16* O, const float* gnorm,
                                                  const float* state, float* out_hs, int su0, int stride) {
    int tid_ = threadIdx.x; asm volatile("" : "+v"(tid_));
    const int tid = tid_, lane = tid & 63, wid = tid >> 6, kr = tid >> 5, vc = tid & 31;
    LAS float* SQv = (LAS float*)lds; LAS float* SFv = SQv + 512; LAS float* SKv = SQv + 1024; LAS float* SVv = SQv + 1536; LAS float* RED = SQv + 2048;
    if (su0 >= 2048) return;
    f32x4 S[8], Sn[8]; unsigned short nq, nl, nv;
    const int tt = tid >> 7, tk = tid & 127;
#define SU_LOAD(su_) do { const int b_ = (su_) >> 4, h_ = (su_) & 15; const f32x4* sp_ = (const f32x4*)(state + (size_t)(su_) * 16384 + kr * 128 + 4 * vc); \
        _Pragma("unroll") for (int p = 0; p < 8; ++p) Sn[p] = __builtin_nontemporal_load(sp_ + p * 512); \
        const size_t idx_ = ((size_t)h_ * MT + (size_t)(MP + 4 * b_ + tt)) * 128 + tk; nq = Q[idx_]; nl = LF[idx_]; nv = V[idx_]; } while (0)
    SU_LOAD(su0);
    for (int su = su0; su < 2048; su += stride) {
        const int b = su >> 4, h = su & 15;
#pragma unroll
        for (int p = 0; p < 8; ++p) S[p] = Sn[p];
        { const float q = __builtin_bit_cast(float, (unsigned)nq << 16), v = __builtin_bit_cast(float, (unsigned)nv << 16);
          const float f = __expf((float)__builtin_bit_cast(_Float16, nl));
          SQv[tid] = q; SFv[tid] = f; SKv[tid] = 1.0f - f; SVv[tid] = v; }
        { const int sn = (su + stride) < 2048 ? (su + stride) : su; SU_LOAD(sn); }
        __syncthreads();
        f32x4 o[4];
#pragma unroll
        for (int t = 0; t < 4; ++t) {
            const f32x4 vv = *(const LAS f32x4*)(SVv + t * 128 + 4 * vc); f32x4 acc = (f32x4){0.f, 0.f, 0.f, 0.f};
#pragma unroll
            for (int p = 0; p < 8; ++p) { const int k = t * 128 + kr + 16 * p; const float f = SFv[k], kn = SKv[k], q = SQv[k]; S[p] = S[p] * f + vv * kn; acc += S[p] * q; }
            o[t] = acc;
        }
        { f32x4* op = (f32x4*)(out_hs + (size_t)su * 16384 + kr * 128 + 4 * vc);
#pragma unroll
          for (int p = 0; p < 8; ++p) __builtin_nontemporal_store(S[p], op + p * 512); }
#pragma unroll
        for (int t = 0; t < 4; ++t) { o[t].x += __shfl_xor(o[t].x, 32); o[t].y += __shfl_xor(o[t].y, 32); o[t].z += __shfl_xor(o[t].z, 32); o[t].w += __shfl_xor(o[t].w, 32); }
        if (lane < 32) {
#pragma unroll
            for (int t = 0; t < 4; ++t) *(LAS f32x4*)(RED + (wid * 4 + t) * 128 + 4 * vc) = o[t];
        }
        __syncthreads();
        if (wid < 4) {
            const int t = wid; float a0 = 0.f, a1 = 0.f;
#pragma unroll
            for (int w2 = 0; w2 < 8; ++w2) { a0 += RED[(w2 * 4 + t) * 128 + lane]; a1 += RED[(w2 * 4 + t) * 128 + lane + 64]; }
            const float ss = wave_sum(a0 * a0 + a1 * a1); const float sc = __builtin_amdgcn_rsqf(ss * (1.0f / 128.0f) + LN_EPS);
            const int row = MP + 4 * b + t; const size_t gi = ((size_t)h * MT + (size_t)row) * 128;
            const float g0 = __builtin_bit_cast(float, (unsigned)G[gi + lane] << 16), g1 = __builtin_bit_cast(float, (unsigned)G[gi + lane + 64] << 16);
            bf16* orow = O + (size_t)row * 2048 + h * 128;
            orow[lane] = (bf16)(pkbf(a0 * sc * gnorm[h * 128 + lane] * g0, 0.f) & 0xffffu); orow[lane + 64] = (bf16)(pkbf(a1 * sc * gnorm[h * 128 + lane + 64] * g1, 0.f) & 0xffffu);
        }
        __syncthreads();
    }
#undef SU_LOAD
}

__device__ __forceinline__ void hgrn_phase(const Ptrs& P, LAS unsigned char* lds, int ctr_idx) {
    const bf16* Q = (const bf16*)(P.ws + WS_Q); const bf16* LF = (const bf16*)(P.ws + WS_LF); const bf16* V = (const bf16*)(P.ws + WS_V); const bf16* G = (const bf16*)(P.ws + WS_G);
    bf16* O = (bf16*)(P.ws + WS_O);
    const int Gd = (int)gridDim.x, bx = (int)blockIdx.x;
    if (Gd >= 256) {
        constexpr int SPLIT = 15; static_assert(SPLIT % 3 == 0, "the warm-up loader's register ring has three slots");
        if (bx < 256) { const int pu = bx & 127; const bool late = bx >= 128;
            hgrn_unit(lds, Q, LF, V, G, O, P.gnorm, (pu >> 4) * 2048, pu & 15, P.out + OUT_HP + (size_t)pu * 16384, late ? SPLIT : 0, late ? 32 : SPLIT, late); }
        if (bx < 128) hgrn_sample_units(lds, Q, LF, V, G, O, P.gnorm, P.state, P.out + OUT_HS, bx, 128);
    } else {
        const bool split = Gd > 128;
        if (!split || bx < 128) {
            for (int pu = bx; pu < 128; pu += (split ? 128 : Gd)) hgrn_unit(lds, Q, LF, V, G, O, P.gnorm, (pu >> 4) * 2048, pu & 15, P.out + OUT_HP + (size_t)pu * 16384, 0, 32, true);
        }
        if (!split || bx >= 128) { const int sid = split ? bx - 128 : bx, ns = split ? Gd - 128 : Gd; __syncthreads(); hgrn_sample_units(lds, Q, LF, V, G, O, P.gnorm, P.state, P.out + OUT_HS, sid, ns); }
    }
    (void)ctr_idx;
}

__device__ __forceinline__ void gate_phase(const Ptrs& P, LAS unsigned char* lds) {
    const int tid = threadIdx.x, lane = tid & 63, wid = __builtin_amdgcn_readfirstlane(tid >> 6);
    const int i = lane & 15, g = lane >> 4;
    constexpr int SW = 136;
    const bf16* U = (const bf16*)(P.ws + WS_U); const bf16* Vb = (const bf16*)(P.ws + WS_VB); bf16* GT = (bf16*)(P.ws + WS_O);
    const float* part = (const float*)(P.ws + WS_PART); const bf16* WSB = (const bf16*)(P.ws + WS_WSB);
    LAS unsigned char* WT = lds; LAS unsigned char* VNT = lds + 34816; LAS f32x2* STT = (LAS f32x2*)(lds + 69632); LAS unsigned char* OT = lds + 70656;
    int cur_grp = -1;
    for (int u = blockIdx.x; u < 2048; u += gridDim.x) {
        const int grp = u & 15, m0 = (u >> 4) * 128;
        float bq_[8]; v4u uzq[4];
#pragma unroll
        for (int tt = 0; tt < 8; ++tt) bq_[tt] = P.b_s[grp * 128 + 16 * tt + i];
#pragma unroll
        for (int it = 0; it < 4; ++it) { const int idx = tid + 512 * it, row = idx >> 4, c16 = idx & 15; uzq[it] = __builtin_nontemporal_load((const v4u*)(U + ((size_t)grp * MT + (size_t)(m0 + row)) * 128 + c16 * 8)); }
        __syncthreads();
        if (grp != cur_grp) {
#pragma unroll
            for (int it = 0; it < 4; ++it) { const int idx = tid + 512 * it, row = idx >> 4, c16 = idx & 15;
                *(LAS v4u*)(WT + (row * SW) * 2 + c16 * 16) = *(const v4u*)(WSB + (size_t)grp * 16384 + row * 128 + c16 * 8); }
            cur_grp = grp;
        }
        unsigned vraw[16];
#pragma unroll
        for (int r = 0; r < 16; ++r) vraw[r] = __builtin_nontemporal_load((const unsigned*)(Vb + ((size_t)grp * MT + (size_t)(m0 + 16 * wid + r)) * 128 + 2 * lane));
        if (tid < 128) { const f32x2* pr = (const f32x2*)(part + (size_t)(m0 + tid) * 64); float s = 0.f, ss = 0.f;
#pragma unroll
            for (int j = 0; j < 32; ++j) { const f32x2 p = pr[j]; s += p.x; ss += p.y; }
            const float mean = s * (1.0f / 2048.0f), var = ss * (1.0f / 2048.0f) - mean * mean; f32x2 o; o.x = mean; o.y = 1.0f / sqrtf(var + LN_EPS); STT[tid] = o; }
        __syncthreads();
        {
            const int c0 = grp * 128 + 2 * lane; const float g0 = P.lnv_g[c0], g1 = P.lnv_g[c0 + 1], b0 = P.lnv_b[c0], b1 = P.lnv_b[c0 + 1];
            float y0[16], y1[16];
#pragma unroll
            for (int r = 0; r < 16; ++r) { const int row = 16 * wid + r; const unsigned raw = vraw[r]; const f32x2 st = STT[row];
                y0[r] = (bf_lo(raw) - st.x) * st.y * g0 + b0; y1[r] = (bf_hi(raw) - st.x) * st.y * g1 + b1; }
#pragma unroll
            for (int hh = 0; hh < 2; ++hh) { v4u w0, w1;
                w0.x = pkbf(y0[8 * hh + 0], y0[8 * hh + 1]); w0.y = pkbf(y0[8 * hh + 2], y0[8 * hh + 3]); w0.z = pkbf(y0[8 * hh + 4], y0[8 * hh + 5]); w0.w = pkbf(y0[8 * hh + 6], y0[8 * hh + 7]);
                w1.x = pkbf(y1[8 * hh + 0], y1[8 * hh + 1]); w1.y = pkbf(y1[8 * hh + 2], y1[8 * hh + 3]); w1.z = pkbf(y1[8 * hh + 4], y1[8 * hh + 5]); w1.w = pkbf(y1[8 * hh + 6], y1[8 * hh + 7]);
                *(LAS v4u*)(VNT + ((2 * lane) * SW + 16 * wid + 8 * hh) * 2) = w0; *(LAS v4u*)(VNT + ((2 * lane + 1) * SW + 16 * wid + 8 * hh) * 2) = w1; }
        }
        __syncthreads();
        {
            bf16x8 av[4];
#pragma unroll
            for (int kk = 0; kk < 4; ++kk) av[kk] = *(const LAS bf16x8*)(VNT + ((16 * wid + i) * SW + 32 * kk + 8 * g) * 2);
#pragma unroll
            for (int tt = 0; tt < 8; ++tt) {
                f32x4 acc = (f32x4){0.f, 0.f, 0.f, 0.f};
#pragma unroll
                for (int kk = 0; kk < 4; ++kk) if (kk <= (tt >> 1)) { const bf16x8 b = *(const LAS bf16x8*)(WT + ((16 * tt + i) * SW + 32 * kk + 8 * g) * 2); acc = MFMA16(av[kk], b, acc); }
                const int t = 16 * tt + i; const float bias = bq_[tt];
                v2u w; w.x = pkbf(acc[0] + bias, acc[1] + bias); w.y = pkbf(acc[2] + bias, acc[3] + bias);
                *(LAS v2u*)(OT + (t * SW + 16 * wid + 4 * g) * 2) = w;
            }
        }
        __syncthreads();
#pragma unroll
        for (int it = 0; it < 4; ++it) { const int idx = tid + 512 * it, row = idx >> 4, c16 = idx & 15;
            const v4u mx = *(const LAS v4u*)(OT + (row * SW) * 2 + c16 * 16); const v4u uu = uzq[it]; v4u w;
            w.x = pkbf(bf_lo(uu.x) * bf_lo(mx.x), bf_hi(uu.x) * bf_hi(mx.x)); w.y = pkbf(bf_lo(uu.y) * bf_lo(mx.y), bf_hi(uu.y) * bf_hi(mx.y));
            w.z = pkbf(bf_lo(uu.z) * bf_lo(mx.z), bf_hi(uu.z) * bf_hi(mx.z)); w.w = pkbf(bf_lo(uu.w) * bf_lo(mx.w), bf_hi(uu.w) * bf_hi(mx.w));
            *(v4u*)(GT + (size_t)(m0 + row) * 2048 + grp * 128 + c16 * 8) = w; }
    }
    for (int sb = (int)gridDim.x - 1 - (int)blockIdx.x; sb < 128; sb += gridDim.x) {
        __syncthreads();
        const int mrow = MP + 4 * sb;
        if (tid < 4) { const f32x2* pr = (const f32x2*)(part + (size_t)(mrow + tid) * 64); float s = 0.f, ss = 0.f;
            for (int j = 0; j < 32; ++j) { const f32x2 p = pr[j]; s += p.x; ss += p.y; }
            const float mean = s * (1.0f / 2048.0f), var = ss * (1.0f / 2048.0f) - mean * mean; f32x2 o; o.x = mean; o.y = 1.0f / sqrtf(var + LN_EPS); STT[tid] = o; }
        __syncthreads();
        const int c = 4 * tid, grp = c >> 7;
        const f32x4 lg = *(const f32x4*)(P.lnv_g + c), lb = *(const f32x4*)(P.lnv_b + c);
        f32x4 vn[4];
#pragma unroll
        for (int t = 0; t < 4; ++t) { const v2u raw = *(const v2u*)(Vb + ((size_t)grp * MT + (size_t)(mrow + t)) * 128 + (c & 127)); const f32x2 st = STT[t];
            f32x4 x; x.x = bf_lo(raw.x); x.y = bf_hi(raw.x); x.z = bf_lo(raw.y); x.w = bf_hi(raw.y);
            vn[t] = (x - st.x) * st.y * lg + lb;
            __builtin_nontemporal_store(vn[t], (f32x4*)(P.out + OUT_CV + (size_t)(4 * sb + t) * 2048 + c)); }
#pragma unroll
        for (int t = 0; t < 4; ++t) { const float bias = P.b_s[grp * 128 + t]; f32x4 mx = (f32x4){bias, bias, bias, bias};
#pragma unroll
            for (int s = 0; s < 4; ++s) if (s <= t) mx += vn[s] * P.w_s[(size_t)grp * 16384 + t * 128 + s];
            const size_t off = (size_t)(mrow + t) * 2048 + c; const size_t offg = ((size_t)grp * MT + (size_t)(mrow + t)) * 128 + (c & 127); const v2u uu = *(const v2u*)(U + offg);
            v2u w; w.x = pkbf(bf_lo(uu.x) * mx.x, bf_hi(uu.x) * mx.y); w.y = pkbf(bf_lo(uu.y) * mx.z, bf_hi(uu.y) * mx.w);
            *(v2u*)(GT + off) = w; }
    }
}

struct Args { const float* in[15]; float* out; unsigned char* ws; int ph_lo, ph_hi; };
__global__ void __launch_bounds__(512, 2) mk_fwd(Args a) {
    extern __shared__ __attribute__((aligned(16))) unsigned char lds_raw[];
    LAS unsigned char* lds = (LAS unsigned char*)lds_raw;
    Ptrs P;
    P.xp = a.in[0]; P.xs = a.in[1]; P.state = a.in[2]; P.w_in_a = a.in[3]; P.lb_logits = a.in[4]; P.gnorm = a.in[5]; P.w_out_a = a.in[6]; P.w_in_b = a.in[7];
    P.lnv_g = a.in[8]; P.lnv_b = a.in[9]; P.w_s = a.in[10]; P.b_s = a.in[11]; P.w_out_b = a.in[12]; P.ln_g = a.in[13]; P.ln_b = a.in[14]; P.out = a.out; P.ws = a.ws;
    const int lo = a.ph_lo, hi = a.ph_hi;
    volatile LAS unsigned* bst = (volatile LAS unsigned*)(lds + 131072 + 64);
    if (threadIdx.x == 0) { bst[0] = 0u; bst[1] = 0u; }
    __syncthreads();
    XcdBarrier bar = xcd_barrier_post((unsigned*)(P.ws + WS_BAR), bst);
    if (lo < 0) cg::this_grid().sync();
#define IN(k) (lo <= (k) && (k) < hi)
#define SEAM(k) do { if (IN(k) && IN((k) + 1)) { xcd_barrier(bar); } } while (0)
#ifndef PROBE_REP
#define PROBE_REP -1
#endif
#define REP(k) for (int rep_ = 0; rep_ < ((PROBE_REP == (k)) ? 2 : 1); ++rep_, (void)((PROBE_REP == (k) && rep_ == 1) ? (cg::this_grid().sync(), 0) : 0))
    const int G = (int)gridDim.x, c = (int)blockIdx.x;
    if (IN(0)) REP(0) { p0_prologue(P, lds); }
    SEAM(0);
    if (IN(1)) REP(1) {
        pg8::Gemm g{(const bf16*)(P.ws + WS_XB), (const bf16*)(P.ws + WS_WINA), MT, 4 * EA, DM}; pg8::StaticOrder S; S.init(MT, 4 * EA, G, c);
        pg8::EpiHgrnIn E{(bf16*)(P.ws + WS_Q), (const float*)(P.ws + WS_LB)};
        pg8::gemm_phase<pg8::EpiHgrnIn, pg8::StaticOrder, true, true>(lds, g, S, E);
        if (G >= 128) {
            const int nfull = S.nwg / G, nlast = S.nwg - nfull * G;
            __syncthreads();
            if (nlast == 0 || nlast >= G) p0_late_weights(P, lds, c, G);
            else if (c >= nlast) p0_late_weights(P, lds, c - nlast, G - nlast);
        }
    }
    SEAM(1);
    if (IN(2)) REP(2) { hgrn_phase(P, lds, rep_); }
    SEAM(2);
    if (IN(3)) REP(3) {
        const int Mo = G > 32 ? MP : MT;
        pg8::Gemm g{(const bf16*)(P.ws + WS_O), (const bf16*)(P.ws + WS_WOUTA), Mo, DM, EA}; pg8::StaticOrder S; S.init(Mo, DM, G, c);
        pg8::EpiBf16Plain E{(bf16*)(P.ws + WS_D), DM};
        pg8::gemm_phase<pg8::EpiBf16Plain, pg8::StaticOrder, true, true>(lds, g, S, E);
    }
    SEAM(3);
    if (IN(4)) REP(4) { ln_phase<false>(P, lds, 0); }
    SEAM(4);
    if (IN(5)) REP(5) {
        pg8::Gemm g{(const bf16*)(P.ws + WS_XB), (const bf16*)(P.ws + WS_WINB), MT, 3 * EA, DM}; pg8::StaticOrder S; S.init(MT, 3 * EA, G, c);
        pg8::EpiGmlpIn E{(bf16*)(P.ws + WS_U), (float*)(P.ws + WS_PART)};
        pg8::gemm_phase<pg8::EpiGmlpIn, pg8::StaticOrder, true, true>(lds, g, S, E);
    }
    SEAM(5);
    if (IN(6)) REP(6) { gate_phase(P, lds); }
    SEAM(6);
    if (IN(7)) REP(7) {
        const int Mo = G > 32 ? MP : MT;
        pg8::Gemm g{(const bf16*)(P.ws + WS_O), (const bf16*)(P.ws + WS_WOUTB), Mo, DM, EA}; pg8::StaticOrder S; S.init(Mo, DM, G, c);
        pg8::EpiBf16Plain E{(bf16*)(P.ws + WS_D), DM};
        pg8::gemm_phase<pg8::EpiBf16Plain, pg8::StaticOrder, true, true>(lds, g, S, E);
    }
    SEAM(7);
    if (IN(8)) REP(8) { ln_phase<true>(P, lds, 1); }
#undef IN
#undef SEAM
}

extern "C" void kernel_launch(void* const* d_in, const int* in_sizes, int n_in, void* d_out, int out_size, void* d_ws, size_t ws_size, hipStream_t stream) {
    static int grid = 0;
    if (grid == 0) {
        if (n_in != 15 || ws_size < WS_END || out_size != 54001664) { fprintf(stderr, "kernel_launch: unexpected problem (n_in %d, out %d, ws %zu)\n", n_in, out_size, ws_size); grid = -1; return; }
        int dev = 0, cus = 0, per_cu = 0;
        if (hipGetDevice(&dev) != hipSuccess || hipDeviceGetAttribute(&cus, hipDeviceAttributeMultiprocessorCount, dev) != hipSuccess) { grid = -1; return; }
        if (hipFuncSetAttribute((const void*)mk_fwd, hipFuncAttributeMaxDynamicSharedMemorySize, LDS_BYTES) != hipSuccess) { fprintf(stderr, "kernel_launch: hipFuncSetAttribute failed\n"); grid = -1; return; }
        if (hipOccupancyMaxActiveBlocksPerMultiprocessor(&per_cu, (const void*)mk_fwd, 512, LDS_BYTES) != hipSuccess || per_cu < 1) { fprintf(stderr, "kernel_launch: occupancy query gave %d\n", per_cu); (void)hipGetLastError(); per_cu = 1; }
        grid = cus * 1;
        (void)in_sizes;
    }
    if (grid < 0) return;
    Args a{};
    for (int i = 0; i < 15; ++i) a.in[i] = (const float*)d_in[i];
    a.out = (float*)d_out; a.ws = (unsigned char*)d_ws;
#if MK_MULTI
    for (int p = 0; p < NPHASE; ++p) { a.ph_lo = p; a.ph_hi = p + 1; hipLaunchKernelGGL(mk_fwd, dim3(grid), dim3(512), LDS_BYTES, stream, a); }
#else
    a.ph_lo = 0; a.ph_hi = NPHASE;
    if (hipMemsetAsync((char*)d_ws + WS_BAR, 0, XCD_BAR_WORDS * 4, stream) != hipSuccess) { fprintf(stderr, "kernel_launch: memset of the barrier words failed\n"); return; }
    void* args[] = {&a};
    hipError_t e = hipLaunchCooperativeKernel((const void*)mk_fwd, dim3(grid), dim3(512), args, LDS_BYTES, stream);
    if (e != hipSuccess) fprintf(stderr, "kernel_launch: cooperative launch failed: %s (grid %d)\n", hipGetErrorString(e), grid);
#endif
}
```

```cpp
#include <hip/hip_runtime.h>
#include <hip/hip_cooperative_groups.h>
#include <cstdio>
#include <cstdint>
namespace cg = cooperative_groups;
#define MK_MULTI 0
namespace pg8 {
#define PG8_LAS __attribute__((address_space(3)))
typedef unsigned short bf16_t;
typedef short bf16x8 __attribute__((ext_vector_type(8)));
typedef float f32x4 __attribute__((ext_vector_type(4)));
typedef unsigned u32x4 __attribute__((ext_vector_type(4)));
constexpr int BM = 256, BK = 64, HALF = 128, HTB = HALF * BK * 2  , STAGE_BYTES = 8 * HTB, NXCD = 8, WGM = 8;

__host__ __device__ __forceinline__ int lds_byte(int r, int c) { const int st = (r >> 4) * 2 + (c >> 5), rr = r & 15, cc = c & 31, ob = rr * 64 + cc * 2; return st * 1024 + (ob ^ (((ob >> 9) & 1) << 5)); }
__host__ __device__ __forceinline__ void stage_rc(int b, int& R, int& C) { const int st = b / 1024, sb = b % 1024, swz = sb ^ (((sb >> 9) & 1) << 5); R = (st >> 1) * 16 + swz / 64; C = (st & 1) * 32 + (swz % 64) / 2; }
__host__ __device__ __forceinline__ int perm32(int rho) { const int n = rho >> 4, i = rho & 15; return 8 * (i >> 2) + 4 * n + (i & 3); }

struct Unit { int pm, pn; };
struct Gemm { const bf16_t* A; const bf16_t* Bt; int M, N, K; int nt = 0; };

struct StaticOrder {
    int nM, nN, nwg, G, c;
    __host__ __device__ void init(int M, int N, int G_, int c_) { nM = M / BM; nN = N / BM; nwg = nM * nN; G = G_; c = c_; }
    __host__ __device__ bool next(int i, Unit& u) const {
        const long L = (long)i * G + c; if (L >= nwg) return false;
        int wgid = (int)L; { const int q = nwg / NXCD, r = nwg % NXCD, xcd = wgid % NXCD, off = wgid / NXCD; wgid = (xcd < r ? xcd * (q + 1) : r * (q + 1) + (xcd - r) * q) + off; }
        const int nig = WGM * nN, gid = wgid / nig, fm = gid * WGM, gsz = (nM - fm) < WGM ? (nM - fm) : WGM;
        u.pm = fm + ((wgid % nig) % gsz); u.pn = (wgid % nig) / gsz; return true;
    }
    __device__ __forceinline__ void a_ready(const Unit&) const {}
    __device__ __forceinline__ void done(const Unit&) const {}
};

typedef float cvt_f32x2 __attribute__((ext_vector_type(2)));
typedef __bf16 cvt_bf16x2 __attribute__((ext_vector_type(2)));
__device__ __forceinline__ unsigned cvt_pk_bf16(float lo, float hi) { cvt_f32x2 v; v.x = lo; v.y = hi; const cvt_bf16x2 b = __builtin_convertvector(v, cvt_bf16x2); return __builtin_bit_cast(unsigned, b); }
typedef unsigned u32x2 __attribute__((ext_vector_type(2)));
constexpr size_t MROWS = 16896;
constexpr size_t SEC_STRIDE = (size_t)16896 * 2048;
typedef float f32x2 __attribute__((ext_vector_type(2)));
typedef _Float16 f16x2 __attribute__((ext_vector_type(2)));
__device__ __forceinline__ float silu_f(float x) { return x * __builtin_amdgcn_rcpf(1.0f + __expf(-x)); }
__device__ __forceinline__ float gelu_tanh_f(float x) { const float u = 1.5957691216057308f * (x + 0.044715f * x * x * x); return x * __builtin_amdgcn_rcpf(1.0f + __expf(-u)); }
__device__ __forceinline__ unsigned pk_f16(float lo, float hi) { f16x2 p; p.x = (_Float16)lo; p.y = (_Float16)hi; return __builtin_bit_cast(unsigned, p); }

struct EpiHgrnIn {
    static constexpr bool PERM = true, AFTER_DRAIN = false;
    bf16_t* B0; const float* lb;
    __device__ __forceinline__ void operator()(const f32x4 (&acc)[2][2][4][2], const Unit& u, int wr, int wc, int fr, int fq) const {
        const int sec = u.pn >> 3;
        const int row0 = u.pm * BM + wr * 64 + fr, col0 = (u.pn & 7) * BM + wc * 32 + 8 * fq;
        bf16_t* base = B0 + (size_t)sec * SEC_STRIDE;
        f32x4 l0[2], l1[2];
#pragma unroll
        for (int bj = 0; bj < 2; ++bj) { l0[bj] = (f32x4){0.f, 0.f, 0.f, 0.f}; l1[bj] = l0[bj]; }
        if (sec == 1) {
#pragma unroll
            for (int bj = 0; bj < 2; ++bj) { l0[bj] = *(const f32x4*)(lb + col0 + bj * HALF); l1[bj] = *(const f32x4*)(lb + col0 + bj * HALF + 4); }
        }
#pragma unroll
        for (int ai = 0; ai < 2; ++ai)
#pragma unroll
            for (int m = 0; m < 4; ++m) { bf16_t* rowp = base + ((size_t)((u.pn & 7) * 2) * MROWS + (size_t)(row0 + ai * HALF + m * 16)) * 128 + wc * 32 + 8 * fq;
#pragma unroll
                for (int bj = 0; bj < 2; ++bj) { f32x4 v0 = acc[ai][bj][m][0], v1 = acc[ai][bj][m][1]; u32x4 w;
                    if (sec == 1) {
#pragma unroll
                        for (int j = 0; j < 4; ++j) { const float s0 = __builtin_amdgcn_rcpf(1.0f + __expf(-v0[j])), s1 = __builtin_amdgcn_rcpf(1.0f + __expf(-v1[j]));
                            v0[j] = __logf(l0[bj][j] + (1.0f - l0[bj][j]) * s0); v1[j] = __logf(l1[bj][j] + (1.0f - l1[bj][j]) * s1); }
                        w.x = pk_f16(v0[0], v0[1]); w.y = pk_f16(v0[2], v0[3]); w.z = pk_f16(v1[0], v1[1]); w.w = pk_f16(v1[2], v1[3]);
                    } else {
                        if (sec != 2) {
#pragma unroll
                            for (int j = 0; j < 4; ++j) { v0[j] = silu_f(v0[j]); v1[j] = silu_f(v1[j]); } }
                        w.x = cvt_pk_bf16(v0[0], v0[1]); w.y = cvt_pk_bf16(v0[2], v0[3]); w.z = cvt_pk_bf16(v1[0], v1[1]); w.w = cvt_pk_bf16(v1[2], v1[3]);
                    }
                    *(u32x4*)(rowp + (size_t)bj * MROWS * 128) = w; } }
    }
};
struct EpiGmlpIn {
    static constexpr bool PERM = true, AFTER_DRAIN = false;
    bf16_t* B0; float* part;
    __device__ __forceinline__ void operator()(const f32x4 (&acc)[2][2][4][2], const Unit& u, int wr, int wc, int fr, int fq) const {
        const int row0 = u.pm * BM + wr * 64 + fr;
        if (u.pn < 16) {
#pragma unroll
            for (int ai = 0; ai < 2; ++ai)
#pragma unroll
                for (int m = 0; m < 4; ++m) { const int row = row0 + ai * HALF + m * 16; bf16_t* rowp = B0 + ((size_t)u.pn * MROWS + (size_t)row) * 128 + wc * 32 + 8 * fq;
                    f32x4 v0 = acc[ai][0][m][0], v1 = acc[ai][0][m][1]; const f32x4 z0 = acc[ai][1][m][0], z1 = acc[ai][1][m][1]; u32x4 w;
#pragma unroll
                    for (int j = 0; j < 4; ++j) { v0[j] = gelu_tanh_f(v0[j]) * silu_f(z0[j]); v1[j] = gelu_tanh_f(v1[j]) * silu_f(z1[j]); }
                    w.x = cvt_pk_bf16(v0[0], v0[1]); w.y = cvt_pk_bf16(v0[2], v0[3]); w.z = cvt_pk_bf16(v1[0], v1[1]); w.w = cvt_pk_bf16(v1[2], v1[3]);
                    *(u32x4*)rowp = w; }
        } else {
            const int g0 = (u.pn - 16) * 2;
#pragma unroll
            for (int ai = 0; ai < 2; ++ai)
#pragma unroll
                for (int m = 0; m < 4; ++m) { const int row = row0 + ai * HALF + m * 16; bf16_t* rowp = B0 + SEC_STRIDE + ((size_t)g0 * MROWS + (size_t)row) * 128 + wc * 32 + 8 * fq; float s = 0.f, ss = 0.f;
#pragma unroll
                    for (int bj = 0; bj < 2; ++bj) { f32x4 v0 = acc[ai][bj][m][0], v1 = acc[ai][bj][m][1]; u32x4 w;
#pragma unroll
                        for (int j = 0; j < 4; ++j) { v0[j] = gelu_tanh_f(v0[j]); v1[j] = gelu_tanh_f(v1[j]); s += v0[j] + v1[j]; ss += v0[j] * v0[j] + v1[j] * v1[j]; }
                        w.x = cvt_pk_bf16(v0[0], v0[1]); w.y = cvt_pk_bf16(v0[2], v0[3]); w.z = cvt_pk_bf16(v1[0], v1[1]); w.w = cvt_pk_bf16(v1[2], v1[3]);
                        *(u32x4*)(rowp + (size_t)bj * MROWS * 128) = w; }
                    s += __shfl_xor(s, 16); s += __shfl_xor(s, 32); ss += __shfl_xor(ss, 16); ss += __shfl_xor(ss, 32);
                    if (fq == 0) { f32x2 o; o.x = s; o.y = ss; *(f32x2*)(part + (size_t)row * 64 + ((u.pn - 16) * 4 + wc) * 2) = o; } }
        }
    }
};
struct EpiF32 {
    static constexpr bool PERM = false, AFTER_DRAIN = false;
    float* C; int ldc;
    __device__ __forceinline__ void operator()(const f32x4 (&acc)[2][2][4][2], const Unit& u, int wr, int wc, int fr, int fq) const {
        const int row0 = u.pm * BM + wr * 64 + fr, col0 = u.pn * BM + wc * 32 + 4 * fq;
#pragma unroll
        for (int ai = 0; ai < 2; ++ai)
#pragma unroll
            for (int m = 0; m < 4; ++m) { float* rowp = C + (size_t)(row0 + ai * HALF + m * 16) * ldc + col0;
#pragma unroll
                for (int bj = 0; bj < 2; ++bj)
#pragma unroll
                    for (int n = 0; n < 2; ++n) *(f32x4*)(rowp + bj * HALF + n * 16) = acc[ai][bj][m][n]; }
    }
};
struct EpiBf16Plain {
    static constexpr bool PERM = true, AFTER_DRAIN = false;
    bf16_t* C; int ldc;
    __device__ __forceinline__ void operator()(const f32x4 (&acc)[2][2][4][2], const Unit& u, int wr, int wc, int fr, int fq) const {
        const int row0 = u.pm * BM + wr * 64 + fr, col0 = u.pn * BM + wc * 32 + 8 * fq;
#pragma unroll
        for (int ai = 0; ai < 2; ++ai)
#pragma unroll
            for (int m = 0; m < 4; ++m) { bf16_t* rowp = C + (size_t)(row0 + ai * HALF + m * 16) * ldc + col0;
#pragma unroll
                for (int bj = 0; bj < 2; ++bj) { const f32x4 v0 = acc[ai][bj][m][0], v1 = acc[ai][bj][m][1]; u32x4 w;
                    w.x = cvt_pk_bf16(v0[0], v0[1]); w.y = cvt_pk_bf16(v0[2], v0[3]); w.z = cvt_pk_bf16(v1[0], v1[1]); w.w = cvt_pk_bf16(v1[2], v1[3]);
                    *(u32x4*)(rowp + bj * HALF) = w; } }
    }
};
template <class Epi, class Sched, bool ALIGN_EPI = false, bool SP2 = false>
__device__ __forceinline__ void gemm_phase(PG8_LAS unsigned char* lds, const Gemm g, const Sched& S, const Epi& E) {
    const int tid = threadIdx.x, wid = __builtin_amdgcn_readfirstlane(tid >> 6), lane = tid & 63, wr = wid >> 2, wc = wid & 3, fr = lane & 15, fq = lane >> 4;
    const int K = g.K, nt = g.nt ? g.nt : K / BK;
    unsigned voffA[2], voffB[2];
#pragma unroll
    for (int i = 0; i < 2; ++i) { int R, C; stage_rc(tid * 16 + i * 8192, R, C); const int Rb = Epi::PERM ? ((R & ~31) + perm32(R & 31)) : R;
        voffA[i] = (unsigned)(R * K + C) * 2u; voffB[i] = (unsigned)(Rb * K + C) * 2u; }
    const size_t kstep = (size_t)(BK * 2);
    const size_t hstep = (size_t)HALF * K * 2;
    const size_t tstep = 2 * hstep;
    const unsigned ldsw = (unsigned)wid * 1024u;
    const int aoff = lds_byte(wr * 64 + fr, fq * 8), boff = lds_byte(wc * 32 + fr, fq * 8);
#define PG8_SA(b, h) (((b) * 2 + (h)) * HTB)
#define PG8_SB(b, h) ((4 + (b) * 2 + (h)) * HTB)
#define PG8_STAGE(bufoff, gbase, voff) do { _Pragma("unroll") for (int _i = 0; _i < 2; ++_i) \
        __builtin_amdgcn_global_load_lds((const unsigned*)((const char*)(gbase) + (voff)[_i]), (PG8_LAS unsigned*)(lds + (bufoff) + ldsw + _i * 8192), 16, 0, 0); } while (0)
#define PG8_LDA(dst, b, h) do { _Pragma("unroll") for (int m = 0; m < 4; ++m) _Pragma("unroll") for (int k = 0; k < 2; ++k) dst[m][k] = *(const PG8_LAS bf16x8*)(lds + PG8_SA(b, h) + aoff + m * 2048 + k * 1024); } while (0)
#define PG8_LDB(dst, b, h) do { _Pragma("unroll") for (int n = 0; n < 2; ++n) _Pragma("unroll") for (int k = 0; k < 2; ++k) dst[n][k] = *(const PG8_LAS bf16x8*)(lds + PG8_SB(b, h) + boff + n * 2048 + k * 1024); } while (0)
#define PG8_MMA(ai, bj, At, Bt) do { __builtin_amdgcn_s_setprio(1); _Pragma("unroll") for (int m = 0; m < 4; ++m) _Pragma("unroll") for (int n = 0; n < 2; ++n) _Pragma("unroll") for (int k = 0; k < 2; ++k) \
        acc[ai][bj][m][n] = __builtin_amdgcn_mfma_f32_16x16x32_bf16(Bt[n][k], At[m][k], acc[ai][bj][m][n], 0, 0, 0); __builtin_amdgcn_s_setprio(0); } while (0)
#define PG8_WAIT_V(n) asm volatile("s_waitcnt vmcnt(" #n ")" ::: "memory")
#define PG8_WAIT_L(n) asm volatile("s_waitcnt lgkmcnt(" #n ")" ::: "memory")
#define PG8_BAR __builtin_amdgcn_s_barrier()
#define PG8_SCHED __builtin_amdgcn_sched_barrier(0)
    Unit cur, nxt; int ui = 0;
    if (!S.next(0, cur)) return;
    f32x4 acc[2][2][4][2];
#pragma unroll
    for (int a = 0; a < 2; ++a)
#pragma unroll
        for (int b = 0; b < 2; ++b)
#pragma unroll
            for (int m = 0; m < 4; ++m)
#pragma unroll
                for (int n = 0; n < 2; ++n) acc[a][b][m][n] = (f32x4){0.f, 0.f, 0.f, 0.f};
    bf16x8 At[4][2], B0[2][2], B1[2][2];
    const char* cA = (const char*)g.A + (size_t)cur.pm * tstep; const char* cB = (const char*)g.Bt + (size_t)cur.pn * tstep;
    S.a_ready(cur);
    if constexpr (SP2) {
        PG8_STAGE(PG8_SB(0, 0), cB, voffB); PG8_STAGE(PG8_SB(0, 1), cB + hstep, voffB); PG8_STAGE(PG8_SA(0, 0), cA, voffA); PG8_STAGE(PG8_SA(0, 1), cA + hstep, voffA);
        if (wr == 1) PG8_BAR;
        PG8_WAIT_V(2); PG8_BAR;
        PG8_STAGE(PG8_SB(1, 0), cB + kstep, voffB); PG8_STAGE(PG8_SA(1, 0), cA + kstep, voffA); PG8_STAGE(PG8_SB(1, 1), cB + hstep + kstep, voffB);
        PG8_WAIT_V(6); PG8_BAR;
    } else {
        PG8_STAGE(PG8_SB(0, 0), cB, voffB); PG8_STAGE(PG8_SA(0, 0), cA, voffA); PG8_STAGE(PG8_SB(0, 1), cB + hstep, voffB); PG8_STAGE(PG8_SA(0, 1), cA + hstep, voffA);
        if (wr == 1) PG8_BAR;
        PG8_WAIT_V(4); PG8_BAR;
        PG8_STAGE(PG8_SB(1, 0), cB + kstep, voffB); PG8_STAGE(PG8_SA(1, 0), cA + kstep, voffA); PG8_STAGE(PG8_SB(1, 1), cB + hstep + kstep, voffB);
        PG8_WAIT_V(6); PG8_BAR;
    }
    for (;;) {
        const bool has_next = S.next(ui + 1, nxt);
        const char* nA = has_next ? (const char*)g.A + (size_t)nxt.pm * tstep : cA; const char* nB = has_next ? (const char*)g.Bt + (size_t)nxt.pn * tstep : cB;
        for (int t = 0; t < nt; t += 2) {
            const bool last = (t == nt - 2);
            const char* a1 = cA + (size_t)(t + 1) * kstep;
            const char* a2 = last ? nA : cA + (size_t)(t + 2) * kstep; const char* b2 = last ? nB : cB + (size_t)(t + 2) * kstep;
            const char* a3 = a2 + kstep; const char* b3 = b2 + kstep;
            if (last && has_next) S.a_ready(nxt);
            if constexpr (SP2) {
            PG8_LDB(B0, 0, 0); PG8_LDB(B1, 0, 1); PG8_SCHED; PG8_LDA(At, 0, 0); PG8_STAGE(PG8_SA(1, 1), a1 + hstep, voffA);
            PG8_WAIT_V(8); PG8_WAIT_L(0); PG8_BAR; PG8_MMA(0, 0, At, B0); PG8_MMA(0, 1, At, B1); PG8_BAR; PG8_SCHED;
            PG8_LDA(At, 0, 1); PG8_STAGE(PG8_SB(0, 0), b2, voffB); PG8_STAGE(PG8_SB(0, 1), b2 + hstep, voffB); PG8_STAGE(PG8_SA(0, 0), a2, voffA);
            PG8_WAIT_V(8); PG8_WAIT_L(0); PG8_BAR; PG8_MMA(1, 0, At, B0); PG8_MMA(1, 1, At, B1); PG8_BAR; PG8_SCHED;
            PG8_LDB(B0, 1, 0); PG8_LDB(B1, 1, 1); PG8_SCHED; PG8_LDA(At, 1, 0); PG8_STAGE(PG8_SA(0, 1), a2 + hstep, voffA);
            PG8_WAIT_V(8); PG8_WAIT_L(0); PG8_BAR; PG8_MMA(0, 0, At, B0); PG8_MMA(0, 1, At, B1); PG8_BAR; PG8_SCHED;
            PG8_LDA(At, 1, 1); PG8_STAGE(PG8_SB(1, 0), b3, voffB); PG8_STAGE(PG8_SB(1, 1), b3 + hstep, voffB); PG8_STAGE(PG8_SA(1, 0), a3, voffA);
            PG8_WAIT_V(8); PG8_WAIT_L(0); PG8_BAR; PG8_MMA(1, 0, At, B0); PG8_MMA(1, 1, At, B1); PG8_BAR; PG8_SCHED;
            } else {
            PG8_LDB(B0, 0, 0); PG8_SCHED; PG8_LDA(At, 0, 0); PG8_STAGE(PG8_SA(1, 1), a1 + hstep, voffA);
            PG8_WAIT_L(8); PG8_BAR; PG8_WAIT_L(0); PG8_MMA(0, 0, At, B0); PG8_BAR; PG8_SCHED;
            PG8_LDB(B1, 0, 1); PG8_STAGE(PG8_SB(0, 0), b2, voffB);
            PG8_BAR; PG8_WAIT_L(0); PG8_MMA(0, 1, At, B1); PG8_BAR;
            PG8_LDA(At, 0, 1); PG8_STAGE(PG8_SA(0, 0), a2, voffA);
            PG8_BAR; PG8_WAIT_L(0); PG8_MMA(1, 0, At, B0); PG8_BAR; PG8_SCHED;
            PG8_STAGE(PG8_SB(0, 1), b2 + hstep, voffB);
            PG8_WAIT_V(6); PG8_BAR; PG8_MMA(1, 1, At, B1); PG8_BAR;
            PG8_LDB(B0, 1, 0); PG8_SCHED; PG8_LDA(At, 1, 0); PG8_STAGE(PG8_SA(0, 1), a2 + hstep, voffA);
            PG8_WAIT_L(8); PG8_BAR; PG8_WAIT_L(0); PG8_MMA(0, 0, At, B0); PG8_BAR; PG8_SCHED;
            PG8_LDB(B1, 1, 1); PG8_STAGE(PG8_SB(1, 0), b3, voffB);
            PG8_BAR; PG8_WAIT_L(0); PG8_MMA(0, 1, At, B1); PG8_BAR;
            PG8_LDA(At, 1, 1); PG8_STAGE(PG8_SA(1, 0), a3, voffA);
            PG8_BAR; PG8_WAIT_L(0); PG8_MMA(1, 0, At, B0); PG8_BAR; PG8_SCHED;
            PG8_STAGE(PG8_SB(1, 1), b3 + hstep, voffB);
            PG8_WAIT_V(6); PG8_BAR; PG8_MMA(1, 1, At, B1); PG8_BAR;
            }
        }
        if constexpr (ALIGN_EPI) { if (wr == 0) PG8_BAR; }
        if constexpr (!Epi::AFTER_DRAIN) { E(acc, cur, wr, wc, fr, fq); S.done(cur); }
        if (!has_next) break;
#pragma unroll
        for (int a = 0; a < 2; ++a)
#pragma unroll
            for (int b = 0; b < 2; ++b)
#pragma unroll
                for (int m = 0; m < 4; ++m)
#pragma unroll
                    for (int n = 0; n < 2; ++n) acc[a][b][m][n] = (f32x4){0.f, 0.f, 0.f, 0.f};
        cur = nxt; cA = nA; cB = nB; ++ui;
        if constexpr (ALIGN_EPI) { if (wr == 1) PG8_BAR; }
    }
    PG8_WAIT_V(0);
    if constexpr (!ALIGN_EPI) { if (wr == 0) PG8_BAR; }
    PG8_BAR;
    if constexpr (Epi::AFTER_DRAIN) { E.fused(acc, cur, wr, wc, fr, fq, lds, wid, lane); S.done(cur); }
#undef PG8_SA
#undef PG8_SB
#undef PG8_STAGE
#undef PG8_LDA
#undef PG8_LDB
#undef PG8_MMA
#undef PG8_WAIT_V
#undef PG8_WAIT_L
#undef PG8_BAR
#undef PG8_SCHED
}
}

#define GAS __attribute__((address_space(1)))
#define LAS __attribute__((address_space(3)))
typedef unsigned short bf16;
typedef unsigned v4u __attribute__((ext_vector_type(4)));
typedef unsigned v2u __attribute__((ext_vector_type(2)));
typedef float f32x4 __attribute__((ext_vector_type(4)));
typedef float f32x2 __attribute__((ext_vector_type(2)));
typedef short bf16x8 __attribute__((ext_vector_type(8)));
typedef _Float16 f16x2 __attribute__((ext_vector_type(2)));

#ifndef MK_MULTI
#define MK_MULTI 0
#endif
constexpr int NPHASE = 9;
constexpr int MP = 16384, MS = 512, MT = MP + MS, DM = 1024, EA = 2048;
constexpr float LN_EPS = 1e-5f, ALPHA = 1.4142135623730951f;
constexpr size_t MiB = 1u << 20;
constexpr size_t WS_CTL = 0, WS_LB = 64 * 1024, WS_WSB = 1 * MiB, WS_WINA = 2 * MiB, WS_WOUTA = 18 * MiB, WS_WINB = 22 * MiB, WS_WOUTB = 34 * MiB, WS_PART = 38 * MiB;
constexpr size_t WS_XB = 44 * MiB;
constexpr size_t WS_Q = 78 * MiB, WS_LF = 144 * MiB, WS_V = 210 * MiB, WS_G = 276 * MiB, WS_O = 342 * MiB, WS_D = 408 * MiB, WS_DP = 474 * MiB, WS_END = 482 * MiB;
constexpr size_t WS_U = WS_Q, WS_VB = WS_LF, WS_Z = WS_V, WS_H1F = WS_G;
static_assert(WS_LF - WS_Q == pg8::SEC_STRIDE * 2 && WS_V - WS_LF == pg8::SEC_STRIDE * 2 && WS_G - WS_V == pg8::SEC_STRIDE * 2 && WS_O - WS_G == pg8::SEC_STRIDE * 2, "section stride");
constexpr size_t OUT_Y = 0, OUT_HP = 17301504, OUT_HS = 19398656, OUT_CV = 52953088;
constexpr int LDS_BYTES = 131072 + 1024;
constexpr size_t WS_BAR = 32 * 1024;

__device__ __forceinline__ unsigned pkbf(float lo, float hi) { return pg8::cvt_pk_bf16(lo, hi); }
__device__ __forceinline__ float bf_lo(unsigned w) { return __builtin_bit_cast(float, w << 16); }
__device__ __forceinline__ float bf_hi(unsigned w) { return __builtin_bit_cast(float, w & 0xffff0000u); }
__device__ __forceinline__ float wave_sum(float v) {
#pragma unroll
    for (int o = 1; o < 64; o <<= 1) v += __shfl_xor(v, o);
    return v;
}
#define LDS_WAIT() asm volatile("s_waitcnt lgkmcnt(0)" ::: "memory")

__device__ __forceinline__ void p0_transpose_item(const float* W, int K, int N, bf16* WT, LAS float* scr, int item, int lane, bool gmlp = false) {
    const int nblk = N / 32, kb = item / nblk, nb = item % nblk, k0 = 64 * kb, nd = 32 * nb;
    int n0 = nd;
    if (gmlp) { if (nd < 4096) { const int tile = nd >> 8, half = (nd >> 7) & 1, cc = nd & 127; n0 = (half ? 4096 : 0) + tile * 128 + cc; } else n0 = 2048 + (nd - 4096); }
    float wv[32];
#pragma unroll
    for (int i = 0; i < 32; ++i) { const int kk = 2 * i + (lane >> 5); wv[i] = __builtin_nontemporal_load(W + (size_t)(k0 + kk) * N + n0 + (lane & 31)); }
#pragma unroll
    for (int i = 0; i < 32; ++i) { const int kk = 2 * i + (lane >> 5); scr[kk * 33 + (lane & 31)] = wv[i]; }
    LDS_WAIT(); asm volatile("" ::: "memory");
    const int c = lane & 7;
#pragma unroll
    for (int j = 0; j < 4; ++j) { const int n = (lane >> 3) + 8 * j; const LAS float* s = scr + (8 * c) * 33 + n;
        v4u o; o.x = pkbf(s[0 * 33], s[1 * 33]); o.y = pkbf(s[2 * 33], s[3 * 33]); o.z = pkbf(s[4 * 33], s[5 * 33]); o.w = pkbf(s[6 * 33], s[7 * 33]);
        *(v4u*)(WT + (size_t)(nd + n) * K + k0 + 8 * c) = o; }
    LDS_WAIT(); asm volatile("" ::: "memory");
}

typedef GAS unsigned gu32;
#define XB_TMO      128
#define XB_XCNT(j)  (256  + 64 * (j))
#define XB_XSUB(j)  (1280 + 64 * (j))
#define XB_XGEN(j)  (2304 + 64 * (j))
#define XB_TOP      3328
#define XB_TOPGEN   3392
#define XCD_BAR_WORDS 3456
#define XB_SPIN_CAP (1u << 18)

__device__ __forceinline__ unsigned xb_ld(unsigned* p)              { return __hip_atomic_load(p, __ATOMIC_RELAXED, __HIP_MEMORY_SCOPE_AGENT); }
__device__ __forceinline__ unsigned xb_add(unsigned* p, unsigned v) { return __hip_atomic_fetch_add(p, v, __ATOMIC_RELAXED, __HIP_MEMORY_SCOPE_AGENT); }
__device__ __forceinline__ unsigned xb_xcc_id() { return (unsigned)__builtin_amdgcn_s_getreg((3 << 11) | 20) & 0xFu; }
#define XB_SPIN(cond, bar) do { unsigned _sp = 0; while (cond) { __builtin_amdgcn_s_sleep(1); \
    if ((++_sp & 255u) == 0u) { if (xb_ld(&(bar)[XB_TMO])) break; if (_sp > XB_SPIN_CAP) { atomicAdd(&(bar)[XB_TMO], 1u); break; } } } } while (0)

struct XcdBarrier {
    unsigned* bar; unsigned x;
    volatile LAS unsigned* st;
};

__device__ __forceinline__ XcdBarrier xcd_barrier_post(unsigned* bar, volatile LAS unsigned* st) {
    XcdBarrier b; b.bar = bar; b.x = xb_xcc_id(); b.st = st;
    if (threadIdx.x == 0) (void)xb_add(&bar[XB_XCNT(b.x)], 1u);
    return b;
}
__device__ __forceinline__ void xcd_barrier_complete(unsigned* bar, unsigned x, unsigned& nloc, unsigned& nx) {
    const unsigned G = gridDim.x * gridDim.y * gridDim.z;
    unsigned sum, cnt, mine, sp = 0u;
    for (;;) {
        sum = 0u; cnt = 0u; mine = 0u;
#pragma unroll
        for (unsigned j = 0; j < 16; ++j) { const unsigned c = xb_ld(&bar[XB_XCNT(j)]); sum += c; cnt += (c > 0u) ? 1u : 0u; mine = (j == x) ? c : mine; }
        if (sum == G) break;
        __builtin_amdgcn_s_sleep(1);
        if ((++sp & 255u) == 0u) { if (xb_ld(&bar[XB_TMO])) break; if (sp > XB_SPIN_CAP) { atomicAdd(&bar[XB_TMO], 1u); break; } }
    }
    nloc = mine > 0u ? mine : 1u; nx = cnt > 0u ? cnt : 1u;
}

__device__ __forceinline__ void xcd_barrier(const XcdBarrier& b) {
    asm volatile("s_waitcnt vmcnt(0)" ::: "memory");
    __syncthreads();
    if (threadIdx.x == 0) {
        unsigned* bar = b.bar;
        __builtin_amdgcn_s_waitcnt(0);
        unsigned nloc = b.st[0], nx = b.st[1];
        if (nloc == 0u) { xcd_barrier_complete(bar, b.x, nloc, nx); b.st[0] = nloc; b.st[1] = nx; }
        const unsigned old = xb_add(&bar[XB_XSUB(b.x)], 1u);
        const unsigned gen = old / nloc;
        if (old + 1u == (gen + 1u) * nloc) {
            __builtin_amdgcn_fence(__ATOMIC_RELEASE, "agent");
            asm volatile("s_waitcnt vmcnt(0)" ::: "memory");
            const unsigned og = xb_add(&bar[XB_TOP], 1u);
            const unsigned tg = og / nx;
            if (og + 1u == (tg + 1u) * nx) xb_add(&bar[XB_TOPGEN], 1u);
            else XB_SPIN(xb_ld(&bar[XB_TOPGEN]) == tg, bar);
            __builtin_amdgcn_fence(__ATOMIC_ACQUIRE, "agent");
            xb_add(&bar[XB_XGEN(b.x)], 1u);
            asm volatile("s_waitcnt vmcnt(0)" ::: "memory");
        } else {
            XB_SPIN(xb_ld(&bar[XB_XGEN(b.x)]) == gen, bar);
            __builtin_amdgcn_fence(__ATOMIC_ACQUIRE, "agent");
            asm volatile("s_waitcnt vmcnt(0)" ::: "memory");
        }
    }
    __syncthreads();
}

struct Ptrs {
    const float *xp, *xs, *state, *w_in_a, *lb_logits, *gnorm, *w_out_a, *w_in_b, *lnv_g, *lnv_b, *w_s, *b_s, *w_out_b, *ln_g, *ln_b;
    float* out; unsigned char* ws;
};

__device__ __forceinline__ void p0_prologue(const Ptrs& P, LAS unsigned char* lds) {
    const int tid = threadIdx.x, lane = tid & 63, wave = __builtin_amdgcn_readfirstlane(tid >> 6);
    LAS float* scr = (LAS float*)(lds + wave * 16384);
    const int gw = blockIdx.x * 8 + wave, NGW = gridDim.x * 8;
    constexpr int I_A = (DM / 64) * (4 * EA / 32), I_OA = (EA / 64) * (DM / 32), I_B = (DM / 64) * (3 * EA / 32), I_OB = I_OA, NITEMS = I_A + I_OA + I_B + I_OB;
    const int n_early = (gridDim.x >= 128) ? I_A : NITEMS;
    for (int it = gw; it < n_early; it += NGW) {
        int r = it;
        if (r < I_A) { p0_transpose_item(P.w_in_a, DM, 4 * EA, (bf16*)(P.ws + WS_WINA), scr, r, lane); continue; } r -= I_A;
        if (r < I_OA) { p0_transpose_item(P.w_out_a, EA, DM, (bf16*)(P.ws + WS_WOUTA), scr, r, lane); continue; } r -= I_OA;
        if (r < I_B) { p0_transpose_item(P.w_in_b, DM, 3 * EA, (bf16*)(P.ws + WS_WINB), scr, r, lane, true); continue; } r -= I_B;
        p0_transpose_item(P.w_out_b, EA, DM, (bf16*)(P.ws + WS_WOUTB), scr, r, lane);
    }
    const size_t gtid = (size_t)blockIdx.x * 512 + tid, GT = (size_t)gridDim.x * 512;
    {
        const f32x4* xp4 = (const f32x4*)P.xp; const f32x4* xs4 = (const f32x4*)P.xs; v2u* xb = (v2u*)(P.ws + WS_XB);
        constexpr size_t NP4 = (size_t)MP * DM / 4, NT4 = (size_t)MT * DM / 4;
        for (size_t q = gtid; q < NT4; q += 4 * GT) { f32x4 v[4];
#pragma unroll
            for (int k = 0; k < 4; ++k) { size_t qq = q + k * GT; qq = qq < NT4 ? qq : NT4 - 1; v[k] = __builtin_nontemporal_load(qq < NP4 ? xp4 + qq : xs4 + (qq - NP4)); }
#pragma unroll
            for (int k = 0; k < 4; ++k) { const size_t qq = q + k * GT; if (qq < NT4) { v2u o; o.x = pkbf(v[k].x, v[k].y); o.y = pkbf(v[k].z, v[k].w); xb[qq] = o; } } }
    }
    {
        const f32x4* w4 = (const f32x4*)P.w_s; v2u* wb = (v2u*)(P.ws + WS_WSB);
        for (size_t q = gtid; q < (size_t)16 * 128 * 128 / 4; q += GT) { const int e = (int)(q * 4), s = e & 127, t = (e >> 7) & 127; const f32x4 v = w4[q];
            v2u o; o.x = pkbf(s <= t ? v.x : 0.f, s + 1 <= t ? v.y : 0.f); o.y = pkbf(s + 2 <= t ? v.z : 0.f, s + 3 <= t ? v.w : 0.f); wb[q] = o; }
    }
    if (gtid < 2048) { float* lb = (float*)(P.ws + WS_LB); lb[gtid] = 1.0f / (1.0f + expf(P.lb_logits[2048 + gtid] - P.lb_logits[gtid])); }
    if (gtid < 4) { ((unsigned*)(P.ws + WS_CTL))[64 * gtid] = 0u; }
}

__device__ __forceinline__ void p0_late_weights(const Ptrs& P, LAS unsigned char* lds, int widx, int nw) {
    const int tid = threadIdx.x, lane = tid & 63, wave = __builtin_amdgcn_readfirstlane(tid >> 6);
    LAS float* scr = (LAS float*)(lds + wave * 16384);
    constexpr int I_OA = (EA / 64) * (DM / 32), I_B = (DM / 64) * (3 * EA / 32), I_OB = I_OA, NLATE = I_OA + I_B + I_OB;
    for (int it = widx * 8 + wave; it < NLATE; it += nw * 8) {
        int r = it;
        if (r < I_OA) { p0_transpose_item(P.w_out_a, EA, DM, (bf16*)(P.ws + WS_WOUTA), scr, r, lane); continue; } r -= I_OA;
        if (r < I_B) { p0_transpose_item(P.w_in_b, DM, 3 * EA, (bf16*)(P.ws + WS_WINB), scr, r, lane, true); continue; } r -= I_B;
        p0_transpose_item(P.w_out_b, EA, DM, (bf16*)(P.ws + WS_WOUTB), scr, r, lane);
    }
}

struct OneUnit {
    pg8::Unit u0;
    __device__ __forceinline__ bool next(int i, pg8::Unit& u) const { if (i != 0) return false; u = u0; return true; }
    __device__ __forceinline__ void a_ready(const pg8::Unit&) const {}
    __device__ __forceinline__ void done(const pg8::Unit&) const {}
};
template <bool FINAL, int NR, bool PARTS = false>
__device__ __forceinline__ void ln_rows(const Ptrs& P, const f32x4* g4, const f32x4* b4, int mbase, int mstride, int mend, int lane) {
    const bf16* D = (const bf16*)(P.ws + WS_D); bf16* H1B = (bf16*)(P.ws + WS_XB);
    f32x4 v[NR][4]; float s[NR];
#pragma unroll
    for (int k = 0; k < NR; ++k) { int m = mbase + k * mstride; m = m < mend ? m : mend - 1;
        f32x4 x[4];
        if (FINAL) { const v2u* h4 = (const v2u*)(H1B + (size_t)m * DM);
#pragma unroll
            for (int j = 0; j < 4; ++j) { const v2u r = __builtin_nontemporal_load(h4 + 64 * j + lane); x[j].x = bf_lo(r.x); x[j].y = bf_hi(r.x); x[j].z = bf_lo(r.y); x[j].w = bf_hi(r.y); } }
        else { const f32x4* x4 = (const f32x4*)(m < MP ? P.xp + (size_t)m * DM : P.xs + (size_t)(m - MP) * DM);
#pragma unroll
            for (int j = 0; j < 4; ++j) x[j] = __builtin_nontemporal_load(x4 + 64 * j + lane); }
        if (PARTS) { const f32x4* d4 = (const f32x4*)(P.ws + WS_DP) + (size_t)(m - MP) * (DM / 4);
#pragma unroll
            for (int j = 0; j < 4; ++j) v[k][j] = x[j] * ALPHA + ((d4[64 * j + lane] + d4[64 * j + lane + 512 * DM / 4]) + (d4[64 * j + lane + 2 * 512 * DM / 4] + d4[64 * j + lane + 3 * 512 * DM / 4])); }
        else { const v2u* d4 = (const v2u*)(D + (size_t)m * DM);
#pragma unroll
            for (int j = 0; j < 4; ++j) { const v2u r = __builtin_nontemporal_load(d4 + 64 * j + lane); f32x4 d; d.x = bf_lo(r.x); d.y = bf_hi(r.x); d.z = bf_lo(r.y); d.w = bf_hi(r.y); v[k][j] = x[j] * ALPHA + d; } } }
#pragma unroll
    for (int k = 0; k < NR; ++k) { s[k] = 0.f;
#pragma unroll
        for (int j = 0; j < 4; ++j) s[k] += (v[k][j].x + v[k][j].y) + (v[k][j].z + v[k][j].w); }
#pragma unroll
    for (int o = 1; o < 64; o <<= 1) {
#pragma unroll
        for (int k = 0; k < NR; ++k) s[k] += __shfl_xor(s[k], o); }
#pragma unroll
    for (int k = 0; k < NR; ++k) { const float mean = s[k] * (1.0f / DM); s[k] = 0.f;
#pragma unroll
        for (int j = 0; j < 4; ++j) { v[k][j] = v[k][j] - mean; s[k] += (v[k][j].x * v[k][j].x + v[k][j].y * v[k][j].y) + (v[k][j].z * v[k][j].z + v[k][j].w * v[k][j].w); } }
#pragma unroll
    for (int o = 1; o < 64; o <<= 1) {
#pragma unroll
        for (int k = 0; k < NR; ++k) s[k] += __shfl_xor(s[k], o); }
#pragma unroll
    for (int j = 0; j < 4; ++j) { const f32x4 gg = g4[64 * j + lane], bb = b4[64 * j + lane];
#pragma unroll
        for (int k = 0; k < NR; ++k) { const int m = mbase + k * mstride; if (m < mend) { const float rstd = __builtin_amdgcn_rsqf(s[k] * (1.0f / DM) + LN_EPS); const f32x4 y = v[k][j] * rstd * gg + bb;
            if (FINAL) { __builtin_nontemporal_store(y, (f32x4*)(P.out + OUT_Y + (size_t)m * DM) + 64 * j + lane); }
            else { v2u o; o.x = pkbf(y.x, y.y); o.y = pkbf(y.z, y.w); ((v2u*)(H1B + (size_t)m * DM))[64 * j + lane] = o; } } } }
}
template <bool FINAL>
__device__ __forceinline__ void ln_phase(const Ptrs& P, LAS unsigned char* lds, int layer) {
    const int tid = threadIdx.x, lane = tid & 63, wave = tid >> 6;
    const int G = (int)gridDim.x, bx = (int)blockIdx.x;
    const f32x4* g4 = (const f32x4*)(P.ln_g + layer * DM); const f32x4* b4 = (const f32x4*)(P.ln_b + layer * DM);
    if (G <= 32) {
        for (int m = bx * 8 + wave; m < MT; m += G * 8) ln_rows<FINAL, 1>(P, g4, b4, m, 0, MT, lane);
        return;
    }
    if (bx < 32) {
        unsigned* cnt = (unsigned*)(P.ws + WS_CTL) + 64 * (2 + layer);
        const int unit = bx >> 2, ks = bx & 3;
        pg8::Gemm g{(const bf16*)(P.ws + WS_O) + ks * 512, (const bf16*)(P.ws + (FINAL ? WS_WOUTB : WS_WOUTA)) + ks * 512, MT, DM, EA, 8};
        OneUnit S; S.u0.pm = MP / 256 + (unit >> 2); S.u0.pn = unit & 3;
        pg8::EpiF32 E{(float*)(P.ws + WS_DP) + (size_t)ks * 512 * DM - (size_t)MP * DM, DM};
        pg8::gemm_phase<pg8::EpiF32, OneUnit, true, true>(lds, g, S, E);
        asm volatile("s_waitcnt vmcnt(0)" ::: "memory");
        __syncthreads();
        if (tid == 0) {
            __builtin_amdgcn_fence(__ATOMIC_RELEASE, "agent"); asm volatile("s_waitcnt vmcnt(0)" ::: "memory");
            __hip_atomic_fetch_add(cnt, 1u, __ATOMIC_RELAXED, __HIP_MEMORY_SCOPE_AGENT);
            while (__hip_atomic_load(cnt, __ATOMIC_RELAXED, __HIP_MEMORY_SCOPE_AGENT) < 32u) __builtin_amdgcn_s_sleep(4);
            __builtin_amdgcn_fence(__ATOMIC_ACQUIRE, "agent"); asm volatile("s_waitcnt vmcnt(0)" ::: "memory");
        }
        __syncthreads();
        __builtin_amdgcn_fence(__ATOMIC_ACQUIRE, "agent");
        ln_rows<FINAL, 2, true>(P, g4, b4, MP + bx * 16 + wave * 2, 1, MT, lane);
    } else {
        const int nw = (G - 32) * 8;
        for (int m = (bx - 32) * 8 + wave; m < MP; m += 3 * nw) ln_rows<FINAL, 3>(P, g4, b4, m, nw, MP, lane);
    }
}

#define MFMA16(a, b, c) __builtin_amdgcn_mfma_f32_16x16x32_bf16((a), (b), (c), 0, 0, 0)
__device__ __forceinline__ void hgrn_unit(LAS unsigned char* lds, const bf16* Q, const bf16* LF, const bf16* V, const bf16* G, bf16* O, const float* gnorm,
                                          int m0, int h, float* s_out, int nb, int ne, bool store_state) {
    const int tid = threadIdx.x, lane = tid & 63, wid = __builtin_amdgcn_readfirstlane(tid >> 6);
    const int i = lane & 15, g = lane >> 4, wq = wid & 3, hc = h * 128;
    constexpr int SQ = 136, SK = 72, nch = 32;
    LAS unsigned char* QD = lds; LAS unsigned char* KI = lds + 17408; LAS unsigned char* KET = lds + 34816; LAS unsigned char* VT = lds + 53248; LAS unsigned char* ST = lds + 71680;
    LAS float* DEC = (LAS float*)(lds + 106496); LAS float* GN = (LAS float*)(lds + 111104);
    if (tid < 128) GN[tid] = gnorm[hc + tid];
    if (wid < 4) {
        const int t0 = 16 * wid;
        v4u gq_n[4], gq_c[4];
        LAS unsigned char* OT = lds + 111616;
        const bf16* gp = G + ((size_t)h * MT + (size_t)(m0 + t0 + g)) * 128 + 8 * i;
        bf16* orow = O + (size_t)(m0 + t0 + g) * 2048 + hc + 8 * i;
        bf16* prow = orow;
#define LOAD_GATE(nn) do { const int nc_ = (nn) < nch ? (nn) : nch - 1; const bf16* gb_ = gp + (size_t)nc_ * 8192; \
        _Pragma("unroll") for (int j = 0; j < 4; ++j) gq_n[j] = __builtin_nontemporal_load((const v4u*)(gb_ + (size_t)j * 4 * 128)); } while (0)
#define STORE_PREV() do { _Pragma("unroll") for (int j = 0; j < 4; ++j) { const v4u ot_ = *(const LAS v4u*)(OT + ((t0 + g + 4 * j) * 136 + 8 * i) * 2); const v4u gg_ = gq_c[j]; v4u w_; \
        w_.x = pkbf(bf_lo(ot_.x) * bf_lo(gg_.x), bf_hi(ot_.x) * bf_hi(gg_.x)); w_.y = pkbf(bf_lo(ot_.y) * bf_lo(gg_.y), bf_hi(ot_.y) * bf_hi(gg_.y)); \
        w_.z = pkbf(bf_lo(ot_.z) * bf_lo(gg_.z), bf_hi(ot_.z) * bf_hi(gg_.z)); w_.w = pkbf(bf_lo(ot_.w) * bf_lo(gg_.w), bf_hi(ot_.w) * bf_hi(gg_.w)); \
        *(v4u*)(prow + (size_t)j * 4 * 2048) = w_; } } while (0)
        if (nb > 0) {
            const size_t so_ = ((size_t)h * MT + (size_t)(m0 + 16 * wid + (lane >> 4))) * 128 + 8 * (lane & 15);
            const bf16* sl_ = LF + so_; const bf16* sv_ = V + so_;
            LAS unsigned char* RLs = lds + ((16 * wid + (lane >> 4)) * 128 + 8 * (lane & 15)) * 2; LAS unsigned char* RVs = RLs + 16384;
            v4u r0[8], r1[8], r2[8];
#define WU_LOAD(R, cc) do { const int nc_ = (cc) < nch ? (cc) : nch - 1; const size_t co_ = (size_t)nc_ * 8192; \
            _Pragma("unroll") for (int j = 0; j < 4; ++j) { R[j] = *(const v4u*)(sl_ + co_ + (size_t)j * 4 * 128); R[4 + j] = *(const v4u*)(sv_ + co_ + (size_t)j * 4 * 128); } } while (0)
#define WU_STAGE(R) do { _Pragma("unroll") for (int j = 0; j < 4; ++j) { *(LAS v4u*)(RLs + j * 4 * 256) = R[j]; *(LAS v4u*)(RVs + j * 4 * 256) = R[4 + j]; } } while (0)
            WU_LOAD(r0, 1); WU_LOAD(r1, 2); WU_LOAD(r2, 3);
            for (int n = 0; n < nb; n += 3) {
                WU_STAGE(r0); WU_LOAD(r0, n + 4); __syncthreads(); __syncthreads();
                WU_STAGE(r1); WU_LOAD(r1, n + 5); __syncthreads(); __syncthreads();
                WU_STAGE(r2); WU_LOAD(r2, n + 6); __syncthreads(); __syncthreads();
            }
#undef WU_LOAD
#undef WU_STAGE
        }
        LOAD_GATE(nb);
        for (int n = nb; n < ne; ++n) {
            int i_ = i, g_ = g; asm volatile("" : "+v"(i_), "+v"(g_));
            if (n > nb) STORE_PREV();
#pragma unroll
            for (int j = 0; j < 4; ++j) gq_c[j] = gq_n[j];
            LOAD_GATE(n + 1);
            __syncthreads();
            {
                bf16x8 bq[4];
#pragma unroll
                for (int kk = 0; kk < 4; ++kk) bq[kk] = *(const LAS bf16x8*)(QD + ((t0 + i_) * SQ + 32 * kk + 8 * g_) * 2);
                bf16x8 pc[2];
                {
                    f32x4 sT[4];
#pragma unroll
                    for (int st = 0; st < 4; ++st) {
                        f32x4 a4 = (f32x4){0.f, 0.f, 0.f, 0.f};
#pragma unroll
                        for (int kk = 0; kk < 4; ++kk) { const bf16x8 a = *(const LAS bf16x8*)(KI + ((16 * st + i_) * SQ + 32 * kk + 8 * g_) * 2); a4 = MFMA16(a, bq[kk], a4); }
#pragma unroll
                        for (int r = 0; r < 4; ++r) if (16 * st + 4 * g_ + r > t0 + i_) a4[r] = 0.f;
                        sT[st] = a4;
                    }
#pragma unroll
                    for (int c = 0; c < 2; ++c) { v4u w; w.x = pkbf(sT[2 * c][0], sT[2 * c][1]); w.y = pkbf(sT[2 * c][2], sT[2 * c][3]); w.z = pkbf(sT[2 * c + 1][0], sT[2 * c + 1][1]); w.w = pkbf(sT[2 * c + 1][2], sT[2 * c + 1][3]);
                        pc[c] = __builtin_bit_cast(bf16x8, w); }
                }
                f32x4 oa[8]; float ss = 0.f;
#pragma unroll
                for (int vt = 0; vt < 8; ++vt) {
                    f32x4 acc = (f32x4){0.f, 0.f, 0.f, 0.f};
#pragma unroll
                    for (int c = 0; c < 2; ++c) {
                        const v2u lo = *(const LAS v2u*)(VT + ((16 * vt + i_) * SK + 32 * c + 4 * g_) * 2), hi = *(const LAS v2u*)(VT + ((16 * vt + i_) * SK + 32 * c + 16 + 4 * g_) * 2);
                        v4u w; w.x = lo.x; w.y = lo.y; w.z = hi.x; w.w = hi.y; acc = MFMA16(__builtin_bit_cast(bf16x8, w), pc[c], acc); }
#pragma unroll
                    for (int kk = 0; kk < 4; ++kk) { const bf16x8 a = *(const LAS bf16x8*)(ST + ((16 * vt + i_) * SQ + 32 * kk + 8 * g_) * 2); acc = MFMA16(a, bq[kk], acc); }
                    oa[vt] = acc; ss += (acc[0] * acc[0] + acc[1] * acc[1]) + (acc[2] * acc[2] + acc[3] * acc[3]);
                }
                ss += __shfl_xor(ss, 16); ss += __shfl_xor(ss, 32);
                const float sc = __builtin_amdgcn_rsqf(ss * (1.0f / 128.0f) + LN_EPS);
#pragma unroll
                for (int vt = 0; vt < 8; ++vt) { const f32x4 gn = *(const LAS f32x4*)(GN + 16 * vt + 4 * g_) * sc; v2u w_;
                    w_.x = pkbf(oa[vt][0] * gn[0], oa[vt][1] * gn[1]); w_.y = pkbf(oa[vt][2] * gn[2], oa[vt][3] * gn[3]);
                    *(LAS v2u*)(OT + ((t0 + i_) * 136 + 16 * vt + 4 * g_) * 2) = w_; }
                prow = orow + (size_t)n * (64 * 2048);
            }
            __syncthreads();
        }
        STORE_PREV();
#undef STORE_PREV
#undef LOAD_GATE
    } else {
        const int cp = i, rg = g, c0 = 32 * wq + 2 * cp;
        const size_t pofs = ((size_t)h * MT + (size_t)(m0 + 16 * rg)) * 128 + c0;
        const bf16* qp = Q + pofs; const bf16* lp = LF + pofs; const bf16* vp = V + pofs;
        unsigned rq[16], rl[16], rv[16];
        unsigned sq[16], sk[16], ske0[8], ske1[8]; float det0, det1;
#define LOAD_RAW(nn) do { const int nc_ = (nn) < nch ? (nn) : nch - 1; const bf16* qb_ = qp + (size_t)nc_ * 8192; const bf16* lb_ = lp + (size_t)nc_ * 8192; const bf16* vb_ = vp + (size_t)nc_ * 8192; \
        _Pragma("unroll") for (int r = 0; r < 16; ++r) { rl[r] = *(const unsigned*)(lb_ + r * 128); rq[r] = *(const unsigned*)(qb_ + r * 128); } (void)vb_; } while (0)
#define LOAD_V(nn) do { const int nc_ = (nn) < nch ? (nn) : nch - 1; const bf16* vb_ = vp + (size_t)nc_ * 8192; _Pragma("unroll") for (int r = 0; r < 16; ++r) rv[r] = *(const unsigned*)(vb_ + r * 128); } while (0)
#define PREP_REGS(full_) do { \
        float su0 = 0.f, su1 = 0.f; \
        _Pragma("unroll") for (int r = 0; r < 16; ++r) { const f16x2 hh = __builtin_bit_cast(f16x2, rl[r]); su0 += (float)hh.x; su1 += (float)hh.y; } \
        float off0 = 0.f, off1 = 0.f, tot0 = 0.f, tot1 = 0.f; \
        _Pragma("unroll") for (int j = 0; j < 4; ++j) { const float a_ = __shfl(su0, cpx + 16 * j), b_ = __shfl(su1, cpx + 16 * j); if (j < rgx) { off0 += a_; off1 += b_; } tot0 += a_; tot1 += b_; } \
        const float et0 = __expf(tot0), et1 = __expf(tot1); float p0 = __expf(off0), p1 = __expf(off1); det0 = et0; det1 = et1; \
        float kp0 = 0.f, kp1 = 0.f; \
        _Pragma("unroll") for (int r = 0; r < 16; ++r) { const f16x2 hh = __builtin_bit_cast(f16x2, rl[r]); const float f0 = __expf((float)hh.x), f1 = __expf((float)hh.y); \
            p0 *= f0; p1 *= f1; \
            const float ki0 = (1.0f - f0) * __builtin_amdgcn_rcpf(p0), ki1 = (1.0f - f1) * __builtin_amdgcn_rcpf(p1); const float ke0 = ki0 * et0, ke1 = ki1 * et1; \
            if (full_) { sq[r] = pkbf(bf_lo(rq[r]) * p0, bf_hi(rq[r]) * p1); sk[r] = pkbf(ki0, ki1); } \
            if (r & 1) { ske0[r >> 1] = pkbf(kp0, ke0); ske1[r >> 1] = pkbf(kp1, ke1); } \
            kp0 = ke0; kp1 = ke1; } } while (0)
#define DUMP_REGS(full_) do { \
        if (full_) _Pragma("unroll") for (int r = 0; r < 16; ++r) { *(LAS unsigned*)(QD + ((16 * rgx + r) * SQ + c0x) * 2) = sq[r]; *(LAS unsigned*)(KI + ((16 * rgx + r) * SQ + c0x) * 2) = sk[r]; } \
        { v4u w_; w_.x = ske0[0]; w_.y = ske0[1]; w_.z = ske0[2]; w_.w = ske0[3]; *(LAS v4u*)(KET + (c0x * SK + 16 * rgx) * 2) = w_; w_.x = ske0[4]; w_.y = ske0[5]; w_.z = ske0[6]; w_.w = ske0[7]; *(LAS v4u*)(KET + (c0x * SK + 16 * rgx + 8) * 2) = w_; \
          w_.x = ske1[0]; w_.y = ske1[1]; w_.z = ske1[2]; w_.w = ske1[3]; *(LAS v4u*)(KET + ((c0x + 1) * SK + 16 * rgx) * 2) = w_; w_.x = ske1[4]; w_.y = ske1[5]; w_.z = ske1[6]; w_.w = ske1[7]; *(LAS v4u*)(KET + ((c0x + 1) * SK + 16 * rgx + 8) * 2) = w_; \
          _Pragma("unroll") for (int hh_ = 0; hh_ < 2; ++hh_) { \
            w_.x = (rv[8 * hh_ + 0] & 0xffffu) | (rv[8 * hh_ + 1] << 16); w_.y = (rv[8 * hh_ + 2] & 0xffffu) | (rv[8 * hh_ + 3] << 16); w_.z = (rv[8 * hh_ + 4] & 0xffffu) | (rv[8 * hh_ + 5] << 16); w_.w = (rv[8 * hh_ + 6] & 0xffffu) | (rv[8 * hh_ + 7] << 16); \
            *(LAS v4u*)(VT + (c0x * SK + 16 * rgx + 8 * hh_) * 2) = w_; \
            w_.x = (rv[8 * hh_ + 0] >> 16) | (rv[8 * hh_ + 1] & 0xffff0000u); w_.y = (rv[8 * hh_ + 2] >> 16) | (rv[8 * hh_ + 3] & 0xffff0000u); w_.z = (rv[8 * hh_ + 4] >> 16) | (rv[8 * hh_ + 5] & 0xffff0000u); w_.w = (rv[8 * hh_ + 6] >> 16) | (rv[8 * hh_ + 7] & 0xffff0000u); \
            *(LAS v4u*)(VT + ((c0x + 1) * SK + 16 * rgx + 8 * hh_) * 2) = w_; } } \
        if (rgx == 0) { f32x2 p_; p_.x = det0; p_.y = det1; *(LAS f32x2*)(DEC + c0x) = p_; } } while (0)
        f32x4 S[8][2];
#define WRITE_ST() do { _Pragma("unroll") for (int kt = 0; kt < 8; ++kt) _Pragma("unroll") for (int j = 0; j < 2; ++j) { v2u w_; w_.x = pkbf(S[kt][j][0], S[kt][j][1]); w_.y = pkbf(S[kt][j][2], S[kt][j][3]); \
        *(LAS v2u*)(ST + ((16 * (2 * wq + j) + i) * SQ + 16 * kt + 4 * g) * 2) = w_; } } while (0)
#pragma unroll
        for (int kt = 0; kt < 8; ++kt)
#pragma unroll
            for (int j = 0; j < 2; ++j) S[kt][j] = (f32x4){0.f, 0.f, 0.f, 0.f};
        LOAD_RAW(0); LOAD_V(0);
        WRITE_ST();
        { const int cpx = cp, rgx = rg, c0x = c0; PREP_REGS(nb == 0); (void)c0x; }
        if (nb > 0) {
            { const int nc_ = nb < nch ? nb : nch - 1; const bf16* qb_ = qp + (size_t)nc_ * 8192;
#pragma unroll
              for (int r = 0; r < 16; ++r) rq[r] = *(const unsigned*)(qb_ + r * 128); }
            for (int n = 0; n < nb; ++n) {
                int i_ = i, g_ = g; asm volatile("" : "+v"(i_), "+v"(g_));
                const int cpx = i_, rgx = g_, c0x = 32 * wq + 2 * i_;
                DUMP_REGS(false);
                __syncthreads();
                {
                    bf16x8 bv[2][2];
#pragma unroll
                    for (int j = 0; j < 2; ++j)
#pragma unroll
                        for (int c = 0; c < 2; ++c) bv[j][c] = *(const LAS bf16x8*)(VT + ((16 * (2 * wq + j) + i_) * SK + 32 * c + 8 * g_) * 2);
#pragma unroll
                    for (int kt = 0; kt < 8; ++kt) {
                        const f32x4 d = *(const LAS f32x4*)(DEC + 16 * kt + 4 * g_);
                        const bf16x8 a0 = *(const LAS bf16x8*)(KET + ((16 * kt + i_) * SK + 8 * g_) * 2), a1 = *(const LAS bf16x8*)(KET + ((16 * kt + i_) * SK + 32 + 8 * g_) * 2);
#pragma unroll
                        for (int j = 0; j < 2; ++j) { f32x4 acc = S[kt][j] * d; acc = MFMA16(a0, bv[j][0], acc); acc = MFMA16(a1, bv[j][1], acc); S[kt][j] = acc; }
                    }
                }
#pragma unroll
                for (int r = 0; r < 16; ++r) { rl[r] = *(const LAS unsigned*)(lds + ((16 * rgx + r) * 128 + c0x) * 2); rv[r] = *(const LAS unsigned*)(lds + 16384 + ((16 * rgx + r) * 128 + c0x) * 2); }
                PREP_REGS(n + 1 == nb);
                __syncthreads();
            }
            WRITE_ST();
            LOAD_RAW(nb + 1);
        } else { LOAD_RAW(1); }
        for (int n = nb; n < ne; ++n) {
            int i_ = i, g_ = g; asm volatile("" : "+v"(i_), "+v"(g_));
            const int cpx = i_, rgx = g_, c0x = 32 * wq + 2 * i_;
            DUMP_REGS(true);
            asm volatile("" ::: "memory");
            LOAD_V(n + 1);
            __syncthreads();
            {
                bf16x8 bv[2][2];
#pragma unroll
                for (int j = 0; j < 2; ++j)
#pragma unroll
                    for (int c = 0; c < 2; ++c) bv[j][c] = *(const LAS bf16x8*)(VT + ((16 * (2 * wq + j) + i_) * SK + 32 * c + 8 * g_) * 2);
#pragma unroll
                for (int kt = 0; kt < 8; ++kt) {
                    const f32x4 d = *(const LAS f32x4*)(DEC + 16 * kt + 4 * g_);
                    const bf16x8 a0 = *(const LAS bf16x8*)(KET + ((16 * kt + i_) * SK + 8 * g_) * 2), a1 = *(const LAS bf16x8*)(KET + ((16 * kt + i_) * SK + 32 + 8 * g_) * 2);
#pragma unroll
                    for (int j = 0; j < 2; ++j) { f32x4 acc = S[kt][j] * d; acc = MFMA16(a0, bv[j][0], acc); acc = MFMA16(a1, bv[j][1], acc); S[kt][j] = acc; }
                }
            }
            PREP_REGS(true);
            LOAD_RAW(n + 2);
            __syncthreads();
            WRITE_ST();
        }
        if (store_state) {
            float* op = s_out + (4 * g) * 128 + 32 * wq + i;
#pragma unroll
            for (int kt = 0; kt < 8; ++kt) {
#pragma unroll
                for (int j = 0; j < 2; ++j)
#pragma unroll
                    for (int r = 0; r < 4; ++r) __builtin_nontemporal_store(S[kt][j][r], op + r * 128 + 16 * j);
                op += 2048; asm volatile("" : "+v"(op));
            }
        }
#undef WRITE_ST
#undef DUMP_REGS
#undef PREP_REGS
#undef LOAD_RAW
#undef LOAD_V
    }
}

__device__ __forceinline__ void hgrn_sample_units(LAS unsigned char* lds, const bf16* Q, const bf16* LF, const bf16* V, const bf16* G, bf16* O, const float* gnorm,
                                                  const float* state, float* out_hs, int su0, int stride) {
    int tid_ = threadIdx.x; asm volatile("" : "+v"(tid_));
    const int tid = tid_, lane = tid & 63, wid = tid >> 6, kr = tid >> 5, vc = tid & 31;
    LAS float* SQv = (LAS float*)lds; LAS float* SFv = SQv + 512; LAS float* SKv = SQv + 1024; LAS float* SVv = SQv + 1536; LAS float* RED = SQv + 2048;
    if (su0 >= 2048) return;
    f32x4 S[8], Sn[8]; unsigned short nq, nl, nv;
    const int tt = tid >> 7, tk = tid & 127;
#define SU_LOAD(su_) do { const int b_ = (su_) >> 4, h_ = (su_) & 15; const f32x4* sp_ = (const f32x4*)(state + (size_t)(su_) * 16384 + kr * 128 + 4 * vc); \
        _Pragma("unroll") for (int p = 0; p < 8; ++p) Sn[p] = __builtin_nontemporal_load(sp_ + p * 512); \
        const size_t idx_ = ((size_t)h_ * MT + (size_t)(MP + 4 * b_ + tt)) * 128 + tk; nq = Q[idx_]; nl = LF[idx_]; nv = V[idx_]; } while (0)
    SU_LOAD(su0);
    for (int su = su0; su < 2048; su += stride) {
        const int b = su >> 4, h = su & 15;
#pragma unroll
        for (int p = 0; p < 8; ++p) S[p] = Sn[p];
        { const float q = __builtin_bit_cast(float, (unsigned)nq << 16), v = __builtin_bit_cast(float, (unsigned)nv << 16);
          const float f = __expf((float)__builtin_bit_cast(_Float16, nl));
          SQv[tid] = q; SFv[tid] = f; SKv[tid] = 1.0f - f; SVv[tid] = v; }
        { const int sn = (su + stride) < 2048 ? (su + stride) : su; SU_LOAD(sn); }
        __syncthreads();
        f32x4 o[4];
#pragma unroll
        for (int t = 0; t < 4; ++t) {
            const f32x4 vv = *(const LAS f32x4*)(SVv + t * 128 + 4 * vc); f32x4 acc = (f32x4){0.f, 0.f, 0.f, 0.f};
#pragma unroll
            for (int p = 0; p < 8; ++p) { const int k = t * 128 + kr + 16 * p; const float f = SFv[k], kn = SKv[k], q = SQv[k]; S[p] = S[p] * f + vv * kn; acc += S[p] * q; }
            o[t] = acc;
        }
        { f32x4* op = (f32x4*)(out_hs + (size_t)su * 16384 + kr * 128 + 4 * vc);
#pragma unroll
          for (int p = 0; p < 8; ++p) __builtin_nontemporal_store(S[p], op + p * 512); }
#pragma unroll
        for (int t = 0; t < 4; ++t) { o[t].x += __shfl_xor(o[t].x, 32); o[t].y += __shfl_xor(o[t].y, 32); o[t].z += __shfl_xor(o[t].z, 32); o[t].w += __shfl_xor(o[t].w, 32); }
        if (lane < 32) {
#pragma unroll
            for (int t = 0; t < 4; ++t) *(LAS f32x4*)(RED + (wid * 4 + t) * 128 + 4 * vc) = o[t];
        }
        __syncthreads();
        if (wid < 4) {
            const int t = wid; float a0 = 0.f, a1 = 0.f;
#pragma unroll
            for (int w2 = 0; w2 < 8; ++w2) { a0 += RED[(w2 * 4 + t) * 128 + lane]; a1 += RED[(w2 * 4 + t) * 128 + lane + 64]; }
            const float ss = wave_sum(a0 * a0 + a1 * a1); const float sc = __builtin_amdgcn_rsqf(ss * (1.0f / 128.0f) + LN_EPS);
            const int row = MP + 4 * b + t; const size_t gi = ((size_t)h * MT + (size_t)row) * 128;
            const float g0 = __builtin_bit_cast(float, (unsigned)G[gi + lane] << 16), g1 = __builtin_bit_cast(float, (unsigned)G[gi + lane + 64] << 16);
            bf16* orow = O + (size_t)row * 2048 + h * 128;
            orow[lane] = (bf16)(pkbf(a0 * sc * gnorm[h * 128 + lane] * g0, 0.f) & 0xffffu); orow[lane + 64] = (bf16)(pkbf(a1 * sc * gnorm[h * 128 + lane + 64] * g1, 0.f) & 0xffffu);
        }
        __syncthreads();
    }
#undef SU_LOAD
}

__device__ __forceinline__ void hgrn_phase(const Ptrs& P, LAS unsigned char* lds, int ctr_idx) {
    const bf16* Q = (const bf16*)(P.ws + WS_Q); const bf16* LF = (const bf16*)(P.ws + WS_LF); const bf16* V = (const bf16*)(P.ws + WS_V); const bf16* G = (const bf16*)(P.ws + WS_G);
    bf16* O = (bf16*)(P.ws + WS_O);
    const int Gd = (int)gridDim.x, bx = (int)blockIdx.x;
    if (Gd >= 256) {
        constexpr int SPLIT = 15; static_assert(SPLIT % 3 == 0, "the warm-up loader's register ring has three slots");
        if (bx < 256) { const int pu = bx & 127; const bool late = bx >= 128;
            hgrn_unit(lds, Q, LF, V, G, O, P.gnorm, (pu >> 4) * 2048, pu & 15, P.out + OUT_HP + (size_t)pu * 16384, late ? SPLIT : 0, late ? 32 : SPLIT, late); }
        if (bx < 128) hgrn_sample_units(lds, Q, LF, V, G, O, P.gnorm, P.state, P.out + OUT_HS, bx, 128);
    } else {
        const bool split = Gd > 128;
        if (!split || bx < 128) {
            for (int pu = bx; pu < 128; pu += (split ? 128 : Gd)) hgrn_unit(lds, Q, LF, V, G, O, P.gnorm, (pu >> 4) * 2048, pu & 15, P.out + OUT_HP + (size_t)pu * 16384, 0, 32, true);
        }
        if (!split || bx >= 128) { const int sid = split ? bx - 128 : bx, ns = split ? Gd - 128 : Gd; __syncthreads(); hgrn_sample_units(lds, Q, LF, V, G, O, P.gnorm, P.state, P.out + OUT_HS, sid, ns); }
    }
    (void)ctr_idx;
}

__device__ __forceinline__ void gate_phase(const Ptrs& P, LAS unsigned char* lds) {
    const int tid = threadIdx.x, lane = tid & 63, wid = __builtin_amdgcn_readfirstlane(tid >> 6);
    const int i = lane & 15, g = lane >> 4;
    constexpr int SW = 136;
    const bf16* U = (const bf16*)(P.ws + WS_U); const bf16* Vb = (const bf16*)(P.ws + WS_VB); bf16* GT = (bf16*)(P.ws + WS_O);
    const float* part = (const float*)(P.ws + WS_PART); const bf16* WSB = (const bf16*)(P.ws + WS_WSB);
    LAS unsigned char* WT = lds; LAS unsigned char* VNT = lds + 34816; LAS f32x2* STT = (LAS f32x2*)(lds + 69632); LAS unsigned char* OT = lds + 70656;
    int cur_grp = -1;
    for (int u = blockIdx.x; u < 2048; u += gridDim.x) {
        const int grp = u & 15, m0 = (u >> 4) * 128;
        float bq_[8]; v4u uzq[4];
#pragma unroll
        for (int tt = 0; tt < 8; ++tt) bq_[tt] = P.b_s[grp * 128 + 16 * tt + i];
#pragma unroll
        for (int it = 0; it < 4; ++it) { const int idx = tid + 512 * it, row = idx >> 4, c16 = idx & 15; uzq[it] = __builtin_nontemporal_load((const v4u*)(U + ((size_t)grp * MT + (size_t)(m0 + row)) * 128 + c16 * 8)); }
        __syncthreads();
        if (grp != cur_grp) {
#pragma unroll
            for (int it = 0; it < 4; ++it) { const int idx = tid + 512 * it, row = idx >> 4, c16 = idx & 15;
                *(LAS v4u*)(WT + (row * SW) * 2 + c16 * 16) = *(const v4u*)(WSB + (size_t)grp * 16384 + row * 128 + c16 * 8); }
            cur_grp = grp;
        }
        unsigned vraw[16];
#pragma unroll
        for (int r = 0; r < 16; ++r) vraw[r] = __builtin_nontemporal_load((const unsigned*)(Vb + ((size_t)grp * MT + (size_t)(m0 + 16 * wid + r)) * 128 + 2 * lane));
        if (tid < 128) { const f32x2* pr = (const f32x2*)(part + (size_t)(m0 + tid) * 64); float s = 0.f, ss = 0.f;
#pragma unroll
            for (int j = 0; j < 32; ++j) { const f32x2 p = pr[j]; s += p.x; ss += p.y; }
            const float mean = s * (1.0f / 2048.0f), var = ss * (1.0f / 2048.0f) - mean * mean; f32x2 o; o.x = mean; o.y = 1.0f / sqrtf(var + LN_EPS); STT[tid] = o; }
        __syncthreads();
        {
            const int c0 = grp * 128 + 2 * lane; const float g0 = P.lnv_g[c0], g1 = P.lnv_g[c0 + 1], b0 = P.lnv_b[c0], b1 = P.lnv_b[c0 + 1];
            float y0[16], y1[16];
#pragma unroll
            for (int r = 0; r < 16; ++r) { const int row = 16 * wid + r; const unsigned raw = vraw[r]; const f32x2 st = STT[row];
                y0[r] = (bf_lo(raw) - st.x) * st.y * g0 + b0; y1[r] = (bf_hi(raw) - st.x) * st.y * g1 + b1; }
#pragma unroll
            for (int hh = 0; hh < 2; ++hh) { v4u w0, w1;
                w0.x = pkbf(y0[8 * hh + 0], y0[8 * hh + 1]); w0.y = pkbf(y0[8 * hh + 2], y0[8 * hh + 3]); w0.z = pkbf(y0[8 * hh + 4], y0[8 * hh + 5]); w0.w = pkbf(y0[8 * hh + 6], y0[8 * hh + 7]);
                w1.x = pkbf(y1[8 * hh + 0], y1[8 * hh + 1]); w1.y = pkbf(y1[8 * hh + 2], y1[8 * hh + 3]); w1.z = pkbf(y1[8 * hh + 4], y1[8 * hh + 5]); w1.w = pkbf(y1[8 * hh + 6], y1[8 * hh + 7]);
                *(LAS v4u*)(VNT + ((2 * lane) * SW + 16 * wid + 8 * hh) * 2) = w0; *(LAS v4u*)(VNT + ((2 * lane + 1) * SW + 16 * wid + 8 * hh) * 2) = w1; }
        }
        __syncthreads();
        {
            bf16x8 av[4];
#pragma unroll
            for (int kk = 0; kk < 4; ++kk) av[kk] = *(const LAS bf16x8*)(VNT + ((16 * wid + i) * SW + 32 * kk + 8 * g) * 2);
#pragma unroll
            for (int tt = 0; tt < 8; ++tt) {
                f32x4 acc = (f32x4){0.f, 0.f, 0.f, 0.f};
#pragma unroll
                for (int kk = 0; kk < 4; ++kk) if (kk <= (tt >> 1)) { const bf16x8 b = *(const LAS bf16x8*)(WT + ((16 * tt + i) * SW + 32 * kk + 8 * g) * 2); acc = MFMA16(av[kk], b, acc); }
                const int t = 16 * tt + i; const float bias = bq_[tt];
                v2u w; w.x = pkbf(acc[0] + bias, acc[1] + bias); w.y = pkbf(acc[2] + bias, acc[3] + bias);
                *(LAS v2u*)(OT + (t * SW + 16 * wid + 4 * g) * 2) = w;
            }
        }
        __syncthreads();
#pragma unroll
        for (int it = 0; it < 4; ++it) { const int idx = tid + 512 * it, row = idx >> 4, c16 = idx & 15;
            const v4u mx = *(const LAS v4u*)(OT + (row * SW) * 2 + c16 * 16); const v4u uu = uzq[it]; v4u w;
            w.x = pkbf(bf_lo(uu.x) * bf_lo(mx.x), bf_hi(uu.x) * bf_hi(mx.x)); w.y = pkbf(bf_lo(uu.y) * bf_lo(mx.y), bf_hi(uu.y) * bf_hi(mx.y));
            w.z = pkbf(bf_lo(uu.z) * bf_lo(mx.z), bf_hi(uu.z) * bf_hi(mx.z)); w.w = pkbf(bf_lo(uu.w) * bf_lo(mx.w), bf_hi(uu.w) * bf_hi(mx.w));
            *(v4u*)(GT + (size_t)(m0 + row) * 2048 + grp * 128 + c16 * 8) = w; }
    }
    for (int sb = (int)gridDim.x - 1 - (int)blockIdx.x; sb < 128; sb += gridDim.x) {
        __syncthreads();
        const int mrow = MP + 4 * sb;
        if (tid < 4) { const f32x2* pr = (const f32x2*)(part + (size_t)(mrow + tid) * 64); float s = 0.f, ss = 0.f;
            for (int j = 0; j < 32; ++j) { const f32x2 p = pr[j]; s += p.x; ss += p.y; }
            const float mean = s * (1.0f / 2048.0f), var = ss * (1.0f / 2048.0f) - mean * mean; f32x2 o; o.x = mean; o.y = 1.0f / sqrtf(var + LN_EPS); STT[tid] = o; }
        __syncthreads();
        const int c = 4 * tid, grp = c >> 7;
        const f32x4 lg = *(const f32x4*)(P.lnv_g + c), lb = *(const f32x4*)(P.lnv_b + c);
        f32x4 vn[4];
#pragma unroll
        for (int t = 0; t < 4; ++t) { const v2u raw = *(const v2u*)(Vb + ((size_t)grp * MT + (size_t)(mrow + t)) * 128 + (c & 127)); const f32x2 st = STT[t];
            f32x4 x; x.x = bf_lo(raw.x); x.y = bf_hi(raw.x); x.z = bf_lo(raw.y); x.w = bf_hi(raw.y);
            vn[t] = (x - st.x) * st.y * lg + lb;
            __builtin_nontemporal_store(vn[t], (f32x4*)(P.out + OUT_CV + (size_t)(4 * sb + t) * 2048 + c)); }
#pragma unroll
        for (int t = 0; t < 4; ++t) { const float bias = P.b_s[grp * 128 + t]; f32x4 mx = (f32x4){bias, bias, bias, bias};
#pragma unroll
            for (int s = 0; s < 4; ++s) if (s <= t) mx += vn[s] * P.w_s[(size_t)grp * 16384 + t * 128 + s];
            const size_t off = (size_t)(mrow + t) * 2048 + c; const size_t offg = ((size_t)grp * MT + (size_t)(mrow + t)) * 128 + (c & 127); const v2u uu = *(const v2u*)(U + offg);
            v2u w; w.x = pkbf(bf_lo(uu.x) * mx.x, bf_hi(uu.x) * mx.y); w.y = pkbf(bf_lo(uu.y) * mx.z, bf_hi(uu.y) * mx.w);
            *(v2u*)(GT + off) = w; }
    }
}

struct Args { const float* in[15]; float* out; unsigned char* ws; int ph_lo, ph_hi; };
__global__ void __launch_bounds__(512, 2) mk_fwd(Args a) {
    extern __shared__ __attribute__((aligned(16))) unsigned char lds_raw[];
    LAS unsigned char* lds = (LAS unsigned char*)lds_raw;
    Ptrs P;
    P.xp = a.in[0]; P.xs = a.in[1]; P.state = a.in[2]; P.w_in_a = a.in[3]; P.lb_logits = a.in[4]; P.gnorm = a.in[5]; P.w_out_a = a.in[6]; P.w_in_b = a.in[7];
    P.lnv_g = a.in[8]; P.lnv_b = a.in[9]; P.w_s = a.in[10]; P.b_s = a.in[11]; P.w_out_b = a.in[12]; P.ln_g = a.in[13]; P.ln_b = a.in[14]; P.out = a.out; P.ws = a.ws;
    const int lo = a.ph_lo, hi = a.ph_hi;
    volatile LAS unsigned* bst = (volatile LAS unsigned*)(lds + 131072 + 64);
    if (threadIdx.x == 0) { bst[0] = 0u; bst[1] = 0u; }
    __syncthreads();
    XcdBarrier bar = xcd_barrier_post((unsigned*)(P.ws + WS_BAR), bst);
    if (lo < 0) cg::this_grid().sync();
#define IN(k) (lo <= (k) && (k) < hi)
#define SEAM(k) do { if (IN(k) && IN((k) + 1)) { xcd_barrier(bar); } } while (0)
#ifndef PROBE_REP
#define PROBE_REP -1
#endif
#define REP(k) for (int rep_ = 0; rep_ < ((PROBE_REP == (k)) ? 2 : 1); ++rep_, (void)((PROBE_REP == (k) && rep_ == 1) ? (cg::this_grid().sync(), 0) : 0))
    const int G = (int)gridDim.x, c = (int)blockIdx.x;
    if (IN(0)) REP(0) { p0_prologue(P, lds); }
    SEAM(0);
    if (IN(1)) REP(1) {
        pg8::Gemm g{(const bf16*)(P.ws + WS_XB), (const bf16*)(P.ws + WS_WINA), MT, 4 * EA, DM}; pg8::StaticOrder S; S.init(MT, 4 * EA, G, c);
        pg8::EpiHgrnIn E{(bf16*)(P.ws + WS_Q), (const float*)(P.ws + WS_LB)};
        pg8::gemm_phase<pg8::EpiHgrnIn, pg8::StaticOrder, true, true>(lds, g, S, E);
        if (G >= 128) {
            const int nfull = S.nwg / G, nlast = S.nwg - nfull * G;
            __syncthreads();
            if (nlast == 0 || nlast >= G) p0_late_weights(P, lds, c, G);
            else if (c >= nlast) p0_late_weights(P, lds, c - nlast, G - nlast);
        }
    }
    SEAM(1);
    if (IN(2)) REP(2) { hgrn_phase(P, lds, rep_); }
    SEAM(2);
    if (IN(3)) REP(3) {
        const int Mo = G > 32 ? MP : MT;
        pg8::Gemm g{(const bf16*)(P.ws + WS_O), (const bf16*)(P.ws + WS_WOUTA), Mo, DM, EA}; pg8::StaticOrder S; S.init(Mo, DM, G, c);
        pg8::EpiBf16Plain E{(bf16*)(P.ws + WS_D), DM};
        pg8::gemm_phase<pg8::EpiBf16Plain, pg8::StaticOrder, true, true>(lds, g, S, E);
    }
    SEAM(3);
    if (IN(4)) REP(4) { ln_phase<false>(P, lds, 0); }
    SEAM(4);
    if (IN(5)) REP(5) {
        pg8::Gemm g{(const bf16*)(P.ws + WS_XB), (const bf16*)(P.ws + WS_WINB), MT, 3 * EA, DM}; pg8::StaticOrder S; S.init(MT, 3 * EA, G, c);
        pg8::EpiGmlpIn E{(bf16*)(P.ws + WS_U), (float*)(P.ws + WS_PART)};
        pg8::gemm_phase<pg8::EpiGmlpIn, pg8::StaticOrder, true, true>(lds, g, S, E);
    }
    SEAM(5);
    if (IN(6)) REP(6) { gate_phase(P, lds); }
    SEAM(6);
    if (IN(7)) REP(7) {
        const int Mo = G > 32 ? MP : MT;
        pg8::Gemm g{(const bf16*)(P.ws + WS_O), (const bf16*)(P.ws + WS_WOUTB), Mo, DM, EA}; pg8::StaticOrder S; S.init(Mo, DM, G, c);
        pg8::EpiBf16Plain E{(bf16*)(P.ws + WS_D), DM};
        pg8::gemm_phase<pg8::EpiBf16Plain, pg8::StaticOrder, true, true>(lds, g, S, E);
    }
    SEAM(7);
    if (IN(8)) REP(8) { ln_phase<true>(P, lds, 1); }
#undef IN
#undef SEAM
}

extern "C" void kernel_launch(void* const* d_in, const int* in_sizes, int n_in, void* d_out, int out_size, void* d_ws, size_t ws_size, hipStream_t stream) {
    static int grid = 0;
    if (grid == 0) {
        if (n_in != 15 || ws_size < WS_END || out_size != 54001664) { fprintf(stderr, "kernel_launch: unexpected problem (n_in %d, out %d, ws %zu)\n", n_in, out_size, ws_size); grid = -1; return; }
        int dev = 0, cus = 0, per_cu = 0;
        if (hipGetDevice(&dev) != hipSuccess || hipDeviceGetAttribute(&cus, hipDeviceAttributeMultiprocessorCount, dev) != hipSuccess) { grid = -1; return; }
        if (hipFuncSetAttribute((const void*)mk_fwd, hipFuncAttributeMaxDynamicSharedMemorySize, LDS_BYTES) != hipSuccess) { fprintf(stderr, "kernel_launch: hipFuncSetAttribute failed\n"); grid = -1; return; }
        if (hipOccupancyMaxActiveBlocksPerMultiprocessor(&per_cu, (const void*)mk_fwd, 512, LDS_BYTES) != hipSuccess || per_cu < 1) { fprintf(stderr, "kernel_launch: occupancy query gave %d\n", per_cu); (void)hipGetLastError(); per_cu = 1; }
        grid = cus * 1;
        (void)in_sizes;
    }
    if (grid < 0) return;
    Args a{};
    for (int i = 0; i < 15; ++i) a.in[i] = (const float*)d_in[i];
    a.out = (float*)d_out; a.ws = (unsigned char*)d_ws;
#if MK_MULTI
    for (int p = 0; p < NPHASE; ++p) { a.ph_lo = p; a.ph_hi = p + 1; hipLaunchKernelGGL(mk_fwd, dim3(grid), dim3(512), LDS_BYTES, stream, a); }
#else
    a.ph_lo = 0; a.ph_hi = NPHASE;
    if (hipMemsetAsync((char*)d_ws + WS_BAR, 0, XCD_BAR_WORDS * 4, stream) != hipSuccess) { fprintf(stderr, "kernel_launch: memset of the barrier words failed\n"); return; }
    void* args[] = {&a};
    hipError_t e = hipLaunchCooperativeKernel((const void*)mk_fwd, dim3(grid), dim3(512), args, LDS_BYTES, stream);
    if (e != hipSuccess) fprintf(stderr, "kernel_launch: cooperative launch failed: %s (grid %d)\n", hipGetErrorString(e), grid);
#endif
}
```

```cpp
#include <hip/hip_runtime.h>
#include <hip/hip_cooperative_groups.h>
#include <cstdio>
#include <cstdint>
namespace cg = cooperative_groups;
#define MK_MULTI 0
namespace pg8 {
#define PG8_LAS __attribute__((address_space(3)))
typedef unsigned short bf16_t;
typedef short bf16x8 __attribute__((ext_vector_type(8)));
typedef float f32x4 __attribute__((ext_vector_type(4)));
typedef unsigned u32x4 __attribute__((ext_vector_type(4)));
constexpr int BM = 256, BK = 64, HALF = 128, HTB = HALF * BK * 2  , STAGE_BYTES = 8 * HTB, NXCD = 8, WGM = 8;

__host__ __device__ __forceinline__ int lds_byte(int r, int c) { const int st = (r >> 4) * 2 + (c >> 5), rr = r & 15, cc = c & 31, ob = rr * 64 + cc * 2; return st * 1024 + (ob ^ (((ob >> 9) & 1) << 5)); }
__host__ __device__ __forceinline__ void stage_rc(int b, int& R, int& C) { const int st = b / 1024, sb = b % 1024, swz = sb ^ (((sb >> 9) & 1) << 5); R = (st >> 1) * 16 + swz / 64; C = (st & 1) * 32 + (swz % 64) / 2; }
__host__ __device__ __forceinline__ int perm32(int rho) { const int n = rho >> 4, i = rho & 15; return 8 * (i >> 2) + 4 * n + (i & 3); }

struct Unit { int pm, pn; };
struct Gemm { const bf16_t* A; const bf16_t* Bt; int M, N, K; int nt = 0; };

struct StaticOrder {
    int nM, nN, nwg, G, c;
    __host__ __device__ void init(int M, int N, int G_, int c_) { nM = M / BM; nN = N / BM; nwg = nM * nN; G = G_; c = c_; }
    __host__ __device__ bool next(int i, Unit& u) const {
        const long L = (long)i * G + c; if (L >= nwg) return false;
        int wgid = (int)L; { const int q = nwg / NXCD, r = nwg % NXCD, xcd = wgid % NXCD, off = wgid / NXCD; wgid = (xcd < r ? xcd * (q + 1) : r * (q + 1) + (xcd - r) * q) + off; }
        const int nig = WGM * nN, gid = wgid / nig, fm = gid * WGM, gsz = (nM - fm) < WGM ? (nM - fm) : WGM;
        u.pm = fm + ((wgid % nig) % gsz); u.pn = (wgid % nig) / gsz; return true;
    }
    __device__ __forceinline__ void a_ready(const Unit&) const {}
    __device__ __forceinline__ void done(const Unit&) const {}
};

typedef float cvt_f32x2 __attribute__((ext_vector_type(2)));
typedef __bf16 cvt_bf16x2 __attribute__((ext_vector_type(2)));
__device__ __forceinline__ unsigned cvt_pk_bf16(float lo, float hi) { cvt_f32x2 v; v.x = lo; v.y = hi; const cvt_bf16x2 b = __builtin_convertvector(v, cvt_bf16x2); return __builtin_bit_cast(unsigned, b); }
typedef unsigned u32x2 __attribute__((ext_vector_type(2)));
constexpr size_t MROWS = 16896;
constexpr size_t SEC_STRIDE = (size_t)16896 * 2048;
typedef float f32x2 __attribute__((ext_vector_type(2)));
typedef _Float16 f16x2 __attribute__((ext_vector_type(2)));
__device__ __forceinline__ float silu_f(float x) { return x * __builtin_amdgcn_rcpf(1.0f + __expf(-x)); }
__device__ __forceinline__ float gelu_tanh_f(float x) { const float u = 1.5957691216057308f * (x + 0.044715f * x * x * x); return x * __builtin_amdgcn_rcpf(1.0f + __expf(-u)); }
__device__ __forceinline__ unsigned pk_f16(float lo, float hi) { f16x2 p; p.x = (_Float16)lo; p.y = (_Float16)hi; return __builtin_bit_cast(unsigned, p); }

struct EpiHgrnIn {
    static constexpr bool PERM = true, AFTER_DRAIN = false;
    bf16_t* B0; const float* lb;
    __device__ __forceinline__ void operator()(const f32x4 (&acc)[2][2][4][2], const Unit& u, int wr, int wc, int fr, int fq) const {
        const int sec = u.pn >> 3;
        const int row0 = u.pm * BM + wr * 64 + fr, col0 = (u.pn & 7) * BM + wc * 32 + 8 * fq;
        bf16_t* base = B0 + (size_t)sec * SEC_STRIDE;
        f32x4 l0[2], l1[2];
#pragma unroll
        for (int bj = 0; bj < 2; ++bj) { l0[bj] = (f32x4){0.f, 0.f, 0.f, 0.f}; l1[bj] = l0[bj]; }
        if (sec == 1) {
#pragma unroll
            for (int bj = 0; bj < 2; ++bj) { l0[bj] = *(const f32x4*)(lb + col0 + bj * HALF); l1[bj] = *(const f32x4*)(lb + col0 + bj * HALF + 4); }
        }
#pragma unroll
        for (int ai = 0; ai < 2; ++ai)
#pragma unroll
            for (int m = 0; m < 4; ++m) { bf16_t* rowp = base + ((size_t)((u.pn & 7) * 2) * MROWS + (size_t)(row0 + ai * HALF + m * 16)) * 128 + wc * 32 + 8 * fq;
#pragma unroll
                for (int bj = 0; bj < 2; ++bj) { f32x4 v0 = acc[ai][bj][m][0], v1 = acc[ai][bj][m][1]; u32x4 w;
                    if (sec == 1) {
#pragma unroll
                        for (int j = 0; j < 4; ++j) { const float s0 = __builtin_amdgcn_rcpf(1.0f + __expf(-v0[j])), s1 = __builtin_amdgcn_rcpf(1.0f + __expf(-v1[j]));
                            v0[j] = __logf(l0[bj][j] + (1.0f - l0[bj][j]) * s0); v1[j] = __logf(l1[bj][j] + (1.0f - l1[bj][j]) * s1); }
                        w.x = pk_f16(v0[0], v0[1]); w.y = pk_f16(v0[2], v0[3]); w.z = pk_f16(v1[0], v1[1]); w.w = pk_f16(v1[2], v1[3]);
                    } else {
                        if (sec != 2) {
#pragma unroll
                            for (int j = 0; j < 4; ++j) { v0[j] = silu_f(v0[j]); v1[j] = silu_f(v1[j]); } }
                        w.x = cvt_pk_bf16(v0[0], v0[1]); w.y = cvt_pk_bf16(v0[2], v0[3]); w.z = cvt_pk_bf16(v1[0], v1[1]); w.w = cvt_pk_bf16(v1[2], v1[3]);
                    }
                    *(u32x4*)(rowp + (size_t)bj * MROWS * 128) = w; } }
    }
};
struct EpiGmlpIn {
    static constexpr bool PERM = true, AFTER_DRAIN = false;
    bf16_t* B0; float* part;
    __device__ __forceinline__ void operator()(const f32x4 (&acc)[2][2][4][2], const Unit& u, int wr, int wc, int fr, int fq) const {
        const int row0 = u.pm * BM + wr * 64 + fr;
        if (u.pn < 16) {
#pragma unroll
            for (int ai = 0; ai < 2; ++ai)
#pragma unroll
                for (int m = 0; m < 4; ++m) { const int row = row0 + ai * HALF + m * 16; bf16_t* rowp = B0 + ((size_t)u.pn * MROWS + (size_t)row) * 128 + wc * 32 + 8 * fq;
                    f32x4 v0 = acc[ai][0][m][0], v1 = acc[ai][0][m][1]; const f32x4 z0 = acc[ai][1][m][0], z1 = acc[ai][1][m][1]; u32x4 w;
#pragma unroll
                    for (int j = 0; j < 4; ++j) { v0[j] = gelu_tanh_f(v0[j]) * silu_f(z0[j]); v1[j] = gelu_tanh_f(v1[j]) * silu_f(z1[j]); }
                    w.x = cvt_pk_bf16(v0[0], v0[1]); w.y = cvt_pk_bf16(v0[2], v0[3]); w.z = cvt_pk_bf16(v1[0], v1[1]); w.w = cvt_pk_bf16(v1[2], v1[3]);
                    *(u32x4*)rowp = w; }
        } else {
            const int g0 = (u.pn - 16) * 2;
#pragma unroll
            for (int ai = 0; ai < 2; ++ai)
#pragma unroll
                for (int m = 0; m < 4; ++m) { const int row = row0 + ai * HALF + m * 16; bf16_t* rowp = B0 + SEC_STRIDE + ((size_t)g0 * MROWS + (size_t)row) * 128 + wc * 32 + 8 * fq; float s = 0.f, ss = 0.f;
#pragma unroll
                    for (int bj = 0; bj < 2; ++bj) { f32x4 v0 = acc[ai][bj][m][0], v1 = acc[ai][bj][m][1]; u32x4 w;
#pragma unroll
                        for (int j = 0; j < 4; ++j) { v0[j] = gelu_tanh_f(v0[j]); v1[j] = gelu_tanh_f(v1[j]); s += v0[j] + v1[j]; ss += v0[j] * v0[j] + v1[j] * v1[j]; }
                        w.x = cvt_pk_bf16(v0[0], v0[1]); w.y = cvt_pk_bf16(v0[2], v0[3]); w.z = cvt_pk_bf16(v1[0], v1[1]); w.w = cvt_pk_bf16(v1[2], v1[3]);
                        *(u32x4*)(rowp + (size_t)bj * MROWS * 128) = w; }
                    s += __shfl_xor(s, 16); s += __shfl_xor(s, 32); ss += __shfl_xor(ss, 16); ss += __shfl_xor(ss, 32);
                    if (fq == 0) { f32x2 o; o.x = s; o.y = ss; *(f32x2*)(part + (size_t)row * 64 + ((u.pn - 16) * 4 + wc) * 2) = o; } }
        }
    }
};
struct EpiF32 {
    static constexpr bool PERM = false, AFTER_DRAIN = false;
    float* C; int ldc;
    __device__ __forceinline__ void operator()(const f32x4 (&acc)[2][2][4][2], const Unit& u, int wr, int wc, int fr, int fq) const {
        const int row0 = u.pm * BM + wr * 64 + fr, col0 = u.pn * BM + wc * 32 + 4 * fq;
#pragma unroll
        for (int ai = 0; ai < 2; ++ai)
#pragma unroll
            for (int m = 0; m < 4; ++m) { float* rowp = C + (size_t)(row0 + ai * HALF + m * 16) * ldc + col0;
#pragma unroll
                for (int bj = 0; bj < 2; ++bj)
#pragma unroll
                    for (int n = 0; n < 2; ++n) *(f32x4*)(rowp + bj * HALF + n * 16) = acc[ai][bj][m][n]; }
    }
};
struct EpiBf16Plain {
    static constexpr bool PERM = true, AFTER_DRAIN = false;
    bf16_t* C; int ldc;
    __device__ __forceinline__ void operator()(const f32x4 (&acc)[2][2][4][2], const Unit& u, int wr, int wc, int fr, int fq) const {
        const int row0 = u.pm * BM + wr * 64 + fr, col0 = u.pn * BM + wc * 32 + 8 * fq;
#pragma unroll
        for (int ai = 0; ai < 2; ++ai)
#pragma unroll
            for (int m = 0; m < 4; ++m) { bf16_t* rowp = C + (size_t)(row0 + ai * HALF + m * 16) * ldc + col0;
#pragma unroll
                for (int bj = 0; bj < 2; ++bj) { const f32x4 v0 = acc[ai][bj][m][0], v1 = acc[ai][bj][m][1]; u32x4 w;
                    w.x = cvt_pk_bf16(v0[0], v0[1]); w.y = cvt_pk_bf16(v0[2], v0[3]); w.z = cvt_pk_bf16(v1[0], v1[1]); w.w = cvt_pk_bf16(v1[2], v1[3]);
                    *(u32x4*)(rowp + bj * HALF) = w; } }
    }
};
template <class Epi, class Sched, bool ALIGN_EPI = false, bool SP2 = false>
__device__ __forceinline__ void gemm_phase(PG8_LAS unsigned char* lds, const Gemm g, const Sched& S, const Epi& E) {
    const int tid = threadIdx.x, wid = __builtin_amdgcn_readfirstlane(tid >> 6), lane = tid & 63, wr = wid >> 2, wc = wid & 3, fr = lane & 15, fq = lane >> 4;
    const int K = g.K, nt = g.nt ? g.nt : K / BK;
    unsigned voffA[2], voffB[2];
#pragma unroll
    for (int i = 0; i < 2; ++i) { int R, C; stage_rc(tid * 16 + i * 8192, R, C); const int Rb = Epi::PERM ? ((R & ~31) + perm32(R & 31)) : R;
        voffA[i] = (unsigned)(R * K + C) * 2u; voffB[i] = (unsigned)(Rb * K + C) * 2u; }
    const size_t kstep = (size_t)(BK * 2);
    const size_t hstep = (size_t)HALF * K * 2;
    const size_t tstep = 2 * hstep;
    const unsigned ldsw = (unsigned)wid * 1024u;
    const int aoff = lds_byte(wr * 64 + fr, fq * 8), boff = lds_byte(wc * 32 + fr, fq * 8);
#define PG8_SA(b, h) (((b) * 2 + (h)) * HTB)
#define PG8_SB(b, h) ((4 + (b) * 2 + (h)) * HTB)
#define PG8_STAGE(bufoff, gbase, voff) do { _Pragma("unroll") for (int _i = 0; _i < 2; ++_i) \
        __builtin_amdgcn_global_load_lds((const unsigned*)((const char*)(gbase) + (voff)[_i]), (PG8_LAS unsigned*)(lds + (bufoff) + ldsw + _i * 8192), 16, 0, 0); } while (0)
#define PG8_LDA(dst, b, h) do { _Pragma("unroll") for (int m = 0; m < 4; ++m) _Pragma("unroll") for (int k = 0; k < 2; ++k) dst[m][k] = *(const PG8_LAS bf16x8*)(lds + PG8_SA(b, h) + aoff + m * 2048 + k * 1024); } while (0)
#define PG8_LDB(dst, b, h) do { _Pragma("unroll") for (int n = 0; n < 2; ++n) _Pragma("unroll") for (int k = 0; k < 2; ++k) dst[n][k] = *(const PG8_LAS bf16x8*)(lds + PG8_SB(b, h) + boff + n * 2048 + k * 1024); } while (0)
#define PG8_MMA(ai, bj, At, Bt) do { __builtin_amdgcn_s_setprio(1); _Pragma("unroll") for (int m = 0; m < 4; ++m) _Pragma("unroll") for (int n = 0; n < 2; ++n) _Pragma("unroll") for (int k = 0; k < 2; ++k) \
        acc[ai][bj][m][n] = __builtin_amdgcn_mfma_f32_16x16x32_bf16(Bt[n][k], At[m][k], acc[ai][bj][m][n], 0, 0, 0); __builtin_amdgcn_s_setprio(0); } while (0)
#define PG8_WAIT_V(n) asm volatile("s_waitcnt vmcnt(" #n ")" ::: "memory")
#define PG8_WAIT_L(n) asm volatile("s_waitcnt lgkmcnt(" #n ")" ::: "memory")
#define PG8_BAR __builtin_amdgcn_s_barrier()
#define PG8_SCHED __builtin_amdgcn_sched_barrier(0)
    Unit cur, nxt; int ui = 0;
    if (!S.next(0, cur)) return;
    f32x4 acc[2][2][4][2];
#pragma unroll
    for (int a = 0; a < 2; ++a)
#pragma unroll
        for (int b = 0; b < 2; ++b)
#pragma unroll
            for (int m = 0; m < 4; ++m)
#pragma unroll
                for (int n = 0; n < 2; ++n) acc[a][b][m][n] = (f32x4){0.f, 0.f, 0.f, 0.f};
    bf16x8 At[4][2], B0[2][2], B1[2][2];
    const char* cA = (const char*)g.A + (size_t)cur.pm * tstep; const char* cB = (const char*)g.Bt + (size_t)cur.pn * tstep;
    S.a_ready(cur);
    if constexpr (SP2) {
        PG8_STAGE(PG8_SB(0, 0), cB, voffB); PG8_STAGE(PG8_SB(0, 1), cB + hstep, voffB); PG8_STAGE(PG8_SA(0, 0), cA, voffA); PG8_STAGE(PG8_SA(0, 1), cA + hstep, voffA);
        if (wr == 1) PG8_BAR;
        PG8_WAIT_V(2); PG8_BAR;
        PG8_STAGE(PG8_SB(1, 0), cB + kstep, voffB); PG8_STAGE(PG8_SA(1, 0), cA + kstep, voffA); PG8_STAGE(PG8_SB(1, 1), cB + hstep + kstep, voffB);
        PG8_WAIT_V(6); PG8_BAR;
    } else {
        PG8_STAGE(PG8_SB(0, 0), cB, voffB); PG8_STAGE(PG8_SA(0, 0), cA, voffA); PG8_STAGE(PG8_SB(0, 1), cB + hstep, voffB); PG8_STAGE(PG8_SA(0, 1), cA + hstep, voffA);
        if (wr == 1) PG8_BAR;
        PG8_WAIT_V(4); PG8_BAR;
        PG8_STAGE(PG8_SB(1, 0), cB + kstep, voffB); PG8_STAGE(PG8_SA(1, 0), cA + kstep, voffA); PG8_STAGE(PG8_SB(1, 1), cB + hstep + kstep, voffB);
        PG8_WAIT_V(6); PG8_BAR;
    }
    for (;;) {
        const bool has_next = S.next(ui + 1, nxt);
        const char* nA = has_next ? (const char*)g.A + (size_t)nxt.pm * tstep : cA; const char* nB = has_next ? (const char*)g.Bt + (size_t)nxt.pn * tstep : cB;
        for (int t = 0; t < nt; t += 2) {
            const bool last = (t == nt - 2);
            const char* a1 = cA + (size_t)(t + 1) * kstep;
            const char* a2 = last ? nA : cA + (size_t)(t + 2) * kstep; const char* b2 = last ? nB : cB + (size_t)(t + 2) * kstep;
            const char* a3 = a2 + kstep; const char* b3 = b2 + kstep;
            if (last && has_next) S.a_ready(nxt);
            if constexpr (SP2) {
            PG8_LDB(B0, 0, 0); PG8_LDB(B1, 0, 1); PG8_SCHED; PG8_LDA(At, 0, 0); PG8_STAGE(PG8_SA(1, 1), a1 + hstep, voffA);
            PG8_WAIT_V(8); PG8_WAIT_L(0); PG8_BAR; PG8_MMA(0, 0, At, B0); PG8_MMA(0, 1, At, B1); PG8_BAR; PG8_SCHED;
            PG8_LDA(At, 0, 1); PG8_STAGE(PG8_SB(0, 0), b2, voffB); PG8_STAGE(PG8_SB(0, 1), b2 + hstep, voffB); PG8_STAGE(PG8_SA(0, 0), a2, voffA);
            PG8_WAIT_V(8); PG8_WAIT_L(0); PG8_BAR; PG8_MMA(1, 0, At, B0); PG8_MMA(1, 1, At, B1); PG8_BAR; PG8_SCHED;
            PG8_LDB(B0, 1, 0); PG8_LDB(B1, 1, 1); PG8_SCHED; PG8_LDA(At, 1, 0); PG8_STAGE(PG8_SA(0, 1), a2 + hstep, voffA);
            PG8_WAIT_V(8); PG8_WAIT_L(0); PG8_BAR; PG8_MMA(0, 0, At, B0); PG8_MMA(0, 1, At, B1); PG8_BAR; PG8_SCHED;
            PG8_LDA(At, 1, 1); PG8_STAGE(PG8_SB(1, 0), b3, voffB); PG8_STAGE(PG8_SB(1, 1), b3 + hstep, voffB); PG8_STAGE(PG8_SA(1, 0), a3, voffA);
            PG8_WAIT_V(8); PG8_WAIT_L(0); PG8_BAR; PG8_MMA(1, 0, At, B0); PG8_MMA(1, 1, At, B1); PG8_BAR; PG8_SCHED;
            } else {
            PG8_LDB(B0, 0, 0); PG8_SCHED; PG8_LDA(At, 0, 0); PG8_STAGE(PG8_SA(1, 1), a1 + hstep, voffA);
            PG8_WAIT_L(8); PG8_BAR; PG8_WAIT_L(0); PG8_MMA(0, 0, At, B0); PG8_BAR; PG8_SCHED;
            PG8_LDB(B1, 0, 1); PG8_STAGE(PG8_SB(0, 0), b2, voffB);
            PG8_BAR; PG8_WAIT_L(0); PG8_MMA(0, 1, At, B1); PG8_BAR;
            PG8_LDA(At, 0, 1); PG8_STAGE(PG8_SA(0, 0), a2, voffA);
            PG8_BAR; PG8_WAIT_L(0); PG8_MMA(1, 0, At, B0); PG8_BAR; PG8_SCHED;
            PG8_STAGE(PG8_SB(0, 1), b2 + hstep, voffB);
            PG8_WAIT_V(6); PG8_BAR; PG8_MMA(1, 1, At, B1); PG8_BAR;
            PG8_LDB(B0, 1, 0); PG8_SCHED; PG8_LDA(At, 1, 0); PG8_STAGE(PG8_SA(0, 1), a2 + hstep, voffA);
            PG8_WAIT_L(8); PG8_BAR; PG8_WAIT_L(0); PG8_MMA(0, 0, At, B0); PG8_BAR; PG8_SCHED;
            PG8_LDB(B1, 1, 1); PG8_STAGE(PG8_SB(1, 0), b3, voffB);
            PG8_BAR; PG8_WAIT_L(0); PG8_MMA(0, 1, At, B1); PG8_BAR;
            PG8_LDA(At, 1, 1); PG8_STAGE(PG8_SA(1, 0), a3, voffA);
            PG8_BAR; PG8_WAIT_L(0); PG8_MMA(1, 0, At, B0); PG8_BAR; PG8_SCHED;
            PG8_STAGE(PG8_SB(1, 1), b3 + hstep, voffB);
            PG8_WAIT_V(6); PG8_BAR; PG8_MMA(1, 1, At, B1); PG8_BAR;
            }
        }
        if constexpr (ALIGN_EPI) { if (wr == 0) PG8_BAR; }
        if constexpr (!Epi::AFTER_DRAIN) { E(acc, cur, wr, wc, fr, fq); S.done(cur); }
        if (!has_next) break;
#pragma unroll
        for (int a = 0; a < 2; ++a)
#pragma unroll
            for (int b = 0; b < 2; ++b)
#pragma unroll
                for (int m = 0; m < 4; ++m)
#pragma unroll
                    for (int n = 0; n < 2; ++n) acc[a][b][m][n] = (f32x4){0.f, 0.f, 0.f, 0.f};
        cur = nxt; cA = nA; cB = nB; ++ui;
        if constexpr (ALIGN_EPI) { if (wr == 1) PG8_BAR; }
    }
    PG8_WAIT_V(0);
    if constexpr (!ALIGN_EPI) { if (wr == 0) PG8_BAR; }
    PG8_BAR;
    if constexpr (Epi::AFTER_DRAIN) { E.fused(acc, cur, wr, wc, fr, fq, lds, wid, lane); S.done(cur); }
#undef PG8_SA
#undef PG8_SB
#undef PG8_STAGE
#undef PG8_LDA
#undef PG8_LDB
#undef PG8_MMA
#undef PG8_WAIT_V
#undef PG8_WAIT_L
#undef PG8_BAR
#undef PG8_SCHED
}
}

#define GAS __attribute__((address_space(1)))
#define LAS __attribute__((address_space(3)))
typedef unsigned short bf16;
typedef unsigned v4u __attribute__((ext_vector_type(4)));
typedef unsigned v2u __attribute__((ext_vector_type(2)));
typedef float f32x4 __attribute__((ext_vector_type(4)));
typedef float f32x2 __attribute__((ext_vector_type(2)));
typedef short bf16x8 __attribute__((ext_vector_type(8)));
typedef _Float16 f16x2 __attribute__((ext_vector_type(2)));

#ifndef MK_MULTI
#define MK_MULTI 0
#endif
constexpr int NPHASE = 9;
constexpr int MP = 16384, MS = 512, MT = MP + MS, DM = 1024, EA = 2048;
constexpr float LN_EPS = 1e-5f, ALPHA = 1.4142135623730951f;
constexpr size_t MiB = 1u << 20;
constexpr size_t WS_CTL = 0, WS_LB = 64 * 1024, WS_WSB = 1 * MiB, WS_WINA = 2 * MiB, WS_WOUTA = 18 * MiB, WS_WINB = 22 * MiB, WS_WOUTB = 34 * MiB, WS_PART = 38 * MiB;
constexpr size_t WS_XB = 44 * MiB;
constexpr size_t WS_Q = 78 * MiB, WS_LF = 144 * MiB, WS_V = 210 * MiB, WS_G = 276 * MiB, WS_O = 342 * MiB, WS_D = 408 * MiB, WS_DP = 474 * MiB, WS_END = 482 * MiB;
constexpr size_t WS_U = WS_Q, WS_VB = WS_LF, WS_Z = WS_V, WS_H1F = WS_G;
static_assert(WS_LF - WS_Q == pg8::SEC_STRIDE * 2 && WS_V - WS_LF == pg8::SEC_STRIDE * 2 && WS_G - WS_V == pg8::SEC_STRIDE * 2 && WS_O - WS_G == pg8::SEC_STRIDE * 2, "section stride");
constexpr size_t OUT_Y = 0, OUT_HP = 17301504, OUT_HS = 19398656, OUT_CV = 52953088;
constexpr int LDS_BYTES = 131072 + 1024;
constexpr size_t WS_BAR = 32 * 1024;

__device__ __forceinline__ unsigned pkbf(float lo, float hi) { return pg8::cvt_pk_bf16(lo, hi); }
__device__ __forceinline__ float bf_lo(unsigned w) { return __builtin_bit_cast(float, w << 16); }
__device__ __forceinline__ float bf_hi(unsigned w) { return __builtin_bit_cast(float, w & 0xffff0000u); }
__device__ __forceinline__ float wave_sum(float v) {
#pragma unroll
    for (int o = 1; o < 64; o <<= 1) v += __shfl_xor(v, o);
    return v;
}
#define LDS_WAIT() asm volatile("s_waitcnt lgkmcnt(0)" ::: "memory")

__device__ __forceinline__ void p0_transpose_item(const float* W, int K, int N, bf16* WT, LAS float* scr, int item, int lane, bool gmlp = false) {
    const int nblk = N / 32, kb = item / nblk, nb = item % nblk, k0 = 64 * kb, nd = 32 * nb;
    int n0 = nd;
    if (gmlp) { if (nd < 4096) { const int tile = nd >> 8, half = (nd >> 7) & 1, cc = nd & 127; n0 = (half ? 4096 : 0) + tile * 128 + cc; } else n0 = 2048 + (nd - 4096); }
    float wv[32];
#pragma unroll
    for (int i = 0; i < 32; ++i) { const int kk = 2 * i + (lane >> 5); wv[i] = __builtin_nontemporal_load(W + (size_t)(k0 + kk) * N + n0 + (lane & 31)); }
#pragma unroll
    for (int i = 0; i < 32; ++i) { const int kk = 2 * i + (lane >> 5); scr[kk * 33 + (lane & 31)] = wv[i]; }
    LDS_WAIT(); asm volatile("" ::: "memory");
    const int c = lane & 7;
#pragma unroll
    for (int j = 0; j < 4; ++j) { const int n = (lane >> 3) + 8 * j; const LAS float* s = scr + (8 * c) * 33 + n;
        v4u o; o.x = pkbf(s[0 * 33], s[1 * 33]); o.y = pkbf(s[2 * 33], s[3 * 33]); o.z = pkbf(s[4 * 33], s[5 * 33]); o.w = pkbf(s[6 * 33], s[7 * 33]);
        *(v4u*)(WT + (size_t)(nd + n) * K + k0 + 8 * c) = o; }
    LDS_WAIT(); asm volatile("" ::: "memory");
}

typedef GAS unsigned gu32;
#define XB_TMO      128
#define XB_XCNT(j)  (256  + 64 * (j))
#define XB_XSUB(j)  (1280 + 64 * (j))
#define XB_XGEN(j)  (2304 + 64 * (j))
#define XB_TOP      3328
#define XB_TOPGEN   3392
#define XCD_BAR_WORDS 3456
#define XB_SPIN_CAP (1u << 18)

__device__ __forceinline__ unsigned xb_ld(unsigned* p)              { return __hip_atomic_load(p, __ATOMIC_RELAXED, __HIP_MEMORY_SCOPE_AGENT); }
__device__ __forceinline__ unsigned xb_add(unsigned* p, unsigned v) { return __hip_atomic_fetch_add(p, v, __ATOMIC_RELAXED, __HIP_MEMORY_SCOPE_AGENT); }
__device__ __forceinline__ unsigned xb_xcc_id() { return (unsigned)__builtin_amdgcn_s_getreg((3 << 11) | 20) & 0xFu; }
#define XB_SPIN(cond, bar) do { unsigned _sp = 0; while (cond) { __builtin_amdgcn_s_sleep(1); \
    if ((++_sp & 255u) == 0u) { if (xb_ld(&(bar)[XB_TMO])) break; if (_sp > XB_SPIN_CAP) { atomicAdd(&(bar)[XB_TMO], 1u); break; } } } } while (0)

struct XcdBarrier {
    unsigned* bar; unsigned x;
    volatile LAS unsigned* st;
};

__device__ __forceinline__ XcdBarrier xcd_barrier_post(unsigned* bar, volatile LAS unsigned* st) {
    XcdBarrier b; b.bar = bar; b.x = xb_xcc_id(); b.st = st;
    if (threadIdx.x == 0) (void)xb_add(&bar[XB_XCNT(b.x)], 1u);
    return b;
}
__device__ __forceinline__ void xcd_barrier_complete(unsigned* bar, unsigned x, unsigned& nloc, unsigned& nx) {
    const unsigned G = gridDim.x * gridDim.y * gridDim.z;
    unsigned sum, cnt, mine, sp = 0u;
    for (;;) {
        sum = 0u; cnt = 0u; mine = 0u;
#pragma unroll
        for (unsigned j = 0; j < 16; ++j) { const unsigned c = xb_ld(&bar[XB_XCNT(j)]); sum += c; cnt += (c > 0u) ? 1u : 0u; mine = (j == x) ? c : mine; }
        if (sum == G) break;
        __builtin_amdgcn_s_sleep(1);
        if ((++sp & 255u) == 0u) { if (xb_ld(&bar[XB_TMO])) break; if (sp > XB_SPIN_CAP) { atomicAdd(&bar[XB_TMO], 1u); break; } }
    }
    nloc = mine > 0u ? mine : 1u; nx = cnt > 0u ? cnt : 1u;
}

__device__ __forceinline__ void xcd_barrier(const XcdBarrier& b) {
    asm volatile("s_waitcnt vmcnt(0)" ::: "memory");
    __syncthreads();
    if (threadIdx.x == 0) {
        unsigned* bar = b.bar;
        __builtin_amdgcn_s_waitcnt(0);
        unsigned nloc = b.st[0], nx = b.st[1];
        if (nloc == 0u) { xcd_barrier_complete(bar, b.x, nloc, nx); b.st[0] = nloc; b.st[1] = nx; }
        const unsigned old = xb_add(&bar[XB_XSUB(b.x)], 1u);
        const unsigned gen = old / nloc;
        if (old + 1u == (gen + 1u) * nloc) {
            __builtin_amdgcn_fence(__ATOMIC_RELEASE, "agent");
            asm volatile("s_waitcnt vmcnt(0)" ::: "memory");
            const unsigned og = xb_add(&bar[XB_TOP], 1u);
            const unsigned tg = og / nx;
            if (og + 1u == (tg + 1u) * nx) xb_add(&bar[XB_TOPGEN], 1u);
            else XB_SPIN(xb_ld(&bar[XB_TOPGEN]) == tg, bar);
            __builtin_amdgcn_fence(__ATOMIC_ACQUIRE, "agent");
            xb_add(&bar[XB_XGEN(b.x)], 1u);
            asm volatile("s_waitcnt vmcnt(0)" ::: "memory");
        } else {
            XB_SPIN(xb_ld(&bar[XB_XGEN(b.x)]) == gen, bar);
            __builtin_amdgcn_fence(__ATOMIC_ACQUIRE, "agent");
            asm volatile("s_waitcnt vmcnt(0)" ::: "memory");
        }
    }
    __syncthreads();
}

struct Ptrs {
    const float *xp, *xs, *state, *w_in_a, *lb_logits, *gnorm, *w_out_a, *w_in_b, *lnv_g, *lnv_b, *w_s, *b_s, *w_out_b, *ln_g, *ln_b;
    float* out; unsigned char* ws;
};

__device__ __forceinline__ void p0_prologue(const Ptrs& P, LAS unsigned char* lds) {
    const int tid = threadIdx.x, lane = tid & 63, wave = __builtin_amdgcn_readfirstlane(tid >> 6);
    LAS float* scr = (LAS float*)(lds + wave * 16384);
    const int gw = blockIdx.x * 8 + wave, NGW = gridDim.x * 8;
    constexpr int I_A = (DM / 64) * (4 * EA / 32), I_OA = (EA / 64) * (DM / 32), I_B = (DM / 64) * (3 * EA / 32), I_OB = I_OA, NITEMS = I_A + I_OA + I_B + I_OB;
    const int n_early = (gridDim.x >= 128) ? I_A : NITEMS;
    for (int it = gw; it < n_early; it += NGW) {
        int r = it;
        if (r < I_A) { p0_transpose_item(P.w_in_a, DM, 4 * EA, (bf16*)(P.ws + WS_WINA), scr, r, lane); continue; } r -= I_A;
        if (r < I_OA) { p0_transpose_item(P.w_out_a, EA, DM, (bf16*)(P.ws + WS_WOUTA), scr, r, lane); continue; } r -= I_OA;
        if (r < I_B) { p0_transpose_item(P.w_in_b, DM, 3 * EA, (bf16*)(P.ws + WS_WINB), scr, r, lane, true); continue; } r -= I_B;
        p0_transpose_item(P.w_out_b, EA, DM, (bf16*)(P.ws + WS_WOUTB), scr, r, lane);
    }
    const size_t gtid = (size_t)blockIdx.x * 512 + tid, GT = (size_t)gridDim.x * 512;
    {
        const f32x4* xp4 = (const f32x4*)P.xp; const f32x4* xs4 = (const f32x4*)P.xs; v2u* xb = (v2u*)(P.ws + WS_XB);
        constexpr size_t NP4 = (size_t)MP * DM / 4, NT4 = (size_t)MT * DM / 4;
        for (size_t q = gtid; q < NT4; q += 4 * GT) { f32x4 v[4];
#pragma unroll
            for (int k = 0; k < 4; ++k) { size_t qq = q + k * GT; qq = qq < NT4 ? qq : NT4 - 1; v[k] = __builtin_nontemporal_load(qq < NP4 ? xp4 + qq : xs4 + (qq - NP4)); }
#pragma unroll
            for (int k = 0; k < 4; ++k) { const size_t qq = q + k * GT; if (qq < NT4) { v2u o; o.x = pkbf(v[k].x, v[k].y); o.y = pkbf(v[k].z, v[k].w); xb[qq] = o; } } }
    }
    {
        const f32x4* w4 = (const f32x4*)P.w_s; v2u* wb = (v2u*)(P.ws + WS_WSB);
        for (size_t q = gtid; q < (size_t)16 * 128 * 128 / 4; q += GT) { const int e = (int)(q * 4), s = e & 127, t = (e >> 7) & 127; const f32x4 v = w4[q];
            v2u o; o.x = pkbf(s <= t ? v.x : 0.f, s + 1 <= t ? v.y : 0.f); o.y = pkbf(s + 2 <= t ? v.z : 0.f, s + 3 <= t ? v.w : 0.f); wb[q] = o; }
    }
    if (gtid < 2048) { float* lb = (float*)(P.ws + WS_LB); lb[gtid] = 1.0f / (1.0f + expf(P.lb_logits[2048 + gtid] - P.lb_logits[gtid])); }
    if (gtid < 4) { ((unsigned*)(P.ws + WS_CTL))[64 * gtid] = 0u; }
}

__device__ __forceinline__ void p0_late_weights(const Ptrs& P, LAS unsigned char* lds, int widx, int nw) {
    const int tid = threadIdx.x, lane = tid & 63, wave = __builtin_amdgcn_readfirstlane(tid >> 6);
    LAS float* scr = (LAS float*)(lds + wave * 16384);
    constexpr int I_OA = (EA / 64) * (DM / 32), I_B = (DM / 64) * (3 * EA / 32), I_OB = I_OA, NLATE = I_OA + I_B + I_OB;
    for (int it = widx * 8 + wave; it < NLATE; it += nw * 8) {
        int r = it;
        if (r < I_OA) { p0_transpose_item(P.w_out_a, EA, DM, (bf16*)(P.ws + WS_WOUTA), scr, r, lane); continue; } r -= I_OA;
        if (r < I_B) { p0_transpose_item(P.w_in_b, DM, 3 * EA, (bf16*)(P.ws + WS_WINB), scr, r, lane, true); continue; } r -= I_B;
        p0_transpose_item(P.w_out_b, EA, DM, (bf16*)(P.ws + WS_WOUTB), scr, r, lane);
    }
}

struct OneUnit {
    pg8::Unit u0;
    __device__ __forceinline__ bool next(int i, pg8::Unit& u) const { if (i != 0) return false; u = u0; return true; }
    __device__ __forceinline__ void a_ready(const pg8::Unit&) const {}
    __device__ __forceinline__ void done(const pg8::Unit&) const {}
};
template <bool FINAL, int NR, bool PARTS = false>
__device__ __forceinline__ void ln_rows(const Ptrs& P, const f32x4* g4, const f32x4* b4, int mbase, int mstride, int mend, int lane) {
    const bf16* D = (const bf16*)(P.ws + WS_D); bf16* H1B = (bf16*)(P.ws + WS_XB);
    f32x4 v[NR][4]; float s[NR];
#pragma unroll
    for (int k = 0; k < NR; ++k) { int m = mbase + k * mstride; m = m < mend ? m : mend - 1;
        f32x4 x[4];
        if (FINAL) { const v2u* h4 = (const v2u*)(H1B + (size_t)m * DM);
#pragma unroll
            for (int j = 0; j < 4; ++j) { const v2u r = __builtin_nontemporal_load(h4 + 64 * j + lane); x[j].x = bf_lo(r.x); x[j].y = bf_hi(r.x); x[j].z = bf_lo(r.y); x[j].w = bf_hi(r.y); } }
        else { const f32x4* x4 = (const f32x4*)(m < MP ? P.xp + (size_t)m * DM : P.xs + (size_t)(m - MP) * DM);
#pragma unroll
            for (int j = 0; j < 4; ++j) x[j] = __builtin_nontemporal_load(x4 + 64 * j + lane); }
        if (PARTS) { const f32x4* d4 = (const f32x4*)(P.ws + WS_DP) + (size_t)(m - MP) * (DM / 4);
#pragma unroll
            for (int j = 0; j < 4; ++j) v[k][j] = x[j] * ALPHA + ((d4[64 * j + lane] + d4[64 * j + lane + 512 * DM / 4]) + (d4[64 * j + lane + 2 * 512 * DM / 4] + d4[64 * j + lane + 3 * 512 * DM / 4])); }
        else { const v2u* d4 = (const v2u*)(D + (size_t)m * DM);
#pragma unroll
            for (int j = 0; j < 4; ++j) { const v2u r = __builtin_nontemporal_load(d4 + 64 * j + lane); f32x4 d; d.x = bf_lo(r.x); d.y = bf_hi(r.x); d.z = bf_lo(r.y); d.w = bf_hi(r.y); v[k][j] = x[j] * ALPHA + d; } } }
#pragma unroll
    for (int k = 0; k < NR; ++k) { s[k] = 0.f;
#pragma unroll
        for (int j = 0; j < 4; ++j) s[k] += (v[k][j].x + v[k][j].y) + (v[k][j].z + v[k][j].w); }
#pragma unroll
    for (int o = 1; o < 64; o <<= 1) {
#pragma unroll
        for (int k = 0; k < NR; ++k) s[k] += __shfl_xor(s[k], o); }
#pragma unroll
    for (int k = 0; k < NR; ++k) { const float mean = s[k] * (1.0f / DM); s[k] = 0.f;
#pragma unroll
        for (int j = 0; j < 4; ++j) { v[k][j] = v[k][j] - mean; s[k] += (v[k][j].x * v[k][j].x + v[k][j].y * v[k][j].y) + (v[k][j].z * v[k][j].z + v[k][j].w * v[k][j].w); } }
#pragma unroll
    for (int o = 1; o < 64; o <<= 1) {
#pragma unroll
        for (int k = 0; k < NR; ++k) s[k] += __shfl_xor(s[k], o); }
#pragma unroll
    for (int j = 0; j < 4; ++j) { const f32x4 gg = g4[64 * j + lane], bb = b4[64 * j + lane];
#pragma unroll
        for (int k = 0; k < NR; ++k) { const int m = mbase + k * mstride; if (m < mend) { const float rstd = __builtin_amdgcn_rsqf(s[k] * (1.0f / DM) + LN_EPS); const f32x4 y = v[k][j] * rstd * gg + bb;
            if (FINAL) { __builtin_nontemporal_store(y, (f32x4*)(P.out + OUT_Y + (size_t)m * DM) + 64 * j + lane); }
            else { v2u o; o.x = pkbf(y.x, y.y); o.y = pkbf(y.z, y.w); ((v2u*)(H1B + (size_t)m * DM))[64 * j + lane] = o; } } } }
}
template <bool FINAL>
__device__ __forceinline__ void ln_phase(const Ptrs& P, LAS unsigned char* lds, int layer) {
    const int tid = threadIdx.x, lane = tid & 63, wave = tid >> 6;
    const int G = (int)gridDim.x, bx = (int)blockIdx.x;
    const f32x4* g4 = (const f32x4*)(P.ln_g + layer * DM); const f32x4* b4 = (const f32x4*)(P.ln_b + layer * DM);
    if (G <= 32) {
        for (int m = bx * 8 + wave; m < MT; m += G * 8) ln_rows<FINAL, 1>(P, g4, b4, m, 0, MT, lane);
        return;
    }
    if (bx < 32) {
        unsigned* cnt = (unsigned*)(P.ws + WS_CTL) + 64 * (2 + layer);
        const int unit = bx >> 2, ks = bx & 3;
        pg8::Gemm g{(const bf16*)(P.ws + WS_O) + ks * 512, (const bf16*)(P.ws + (FINAL ? WS_WOUTB : WS_WOUTA)) + ks * 512, MT, DM, EA, 8};
        OneUnit S; S.u0.pm = MP / 256 + (unit >> 2); S.u0.pn = unit & 3;
        pg8::EpiF32 E{(float*)(P.ws + WS_DP) + (size_t)ks * 512 * DM - (size_t)MP * DM, DM};
        pg8::gemm_phase<pg8::EpiF32, OneUnit, true, true>(lds, g, S, E);
        asm volatile("s_waitcnt vmcnt(0)" ::: "memory");
        __syncthreads();
        if (tid == 0) {
            __builtin_amdgcn_fence(__ATOMIC_RELEASE, "agent"); asm volatile("s_waitcnt vmcnt(0)" ::: "memory");
            __hip_atomic_fetch_add(cnt, 1u, __ATOMIC_RELAXED, __HIP_MEMORY_SCOPE_AGENT);
            while (__hip_atomic_load(cnt, __ATOMIC_RELAXED, __HIP_MEMORY_SCOPE_AGENT) < 32u) __builtin_amdgcn_s_sleep(4);
            __builtin_amdgcn_fence(__ATOMIC_ACQUIRE, "agent"); asm volatile("s_waitcnt vmcnt(0)" ::: "memory");
        }
        __syncthreads();
        __builtin_amdgcn_fence(__ATOMIC_ACQUIRE, "agent");
        ln_rows<FINAL, 2, true>(P, g4, b4, MP + bx * 16 + wave * 2, 1, MT, lane);
    } else {
        const int nw = (G - 32) * 8;
        for (int m = (bx - 32) * 8 + wave; m < MP; m += 3 * nw) ln_rows<FINAL, 3>(P, g4, b4, m, nw, MP, lane);
    }
}

#define MFMA16(a, b, c) __builtin_amdgcn_mfma_f32_16x16x32_bf16((a), (b), (c), 0, 0, 0)
__device__ __forceinline__ void hgrn_unit(LAS unsigned char* lds, const bf16* Q, const bf16* LF, const bf16* V, const bf16* G, bf16* O, const float* gnorm,
                                          int m0, int h, float* s_out, int nb, int ne, bool store_state) {
    const int tid = threadIdx.x, lane = tid & 63, wid = __builtin_amdgcn_readfirstlane(tid >> 6);
    const int i = lane & 15, g = lane >> 4, wq = wid & 3, hc = h * 128;
    constexpr int SQ = 136, SK = 72, nch = 32;
    LAS unsigned char* QD = lds; LAS unsigned char* KI = lds + 17408; LAS unsigned char* KET = lds + 34816; LAS unsigned char* VT = lds + 53248; LAS unsigned char* ST = lds + 71680;
    LAS float* DEC = (LAS float*)(lds + 106496); LAS float* GN = (LAS float*)(lds + 111104);
    if (tid < 128) GN[tid] = gnorm[hc + tid];
    if (wid < 4) {
        const int t0 = 16 * wid;
        v4u gq_n[4], gq_c[4];
        LAS unsigned char* OT = lds + 111616;
        const bf16* gp = G + ((size_t)h * MT + (size_t)(m0 + t0 + g)) * 128 + 8 * i;
        bf16* orow = O + (size_t)(m0 + t0 + g) * 2048 + hc + 8 * i;
        bf16* prow = orow;
#define LOAD_GATE(nn) do { const int nc_ = (nn) < nch ? (nn) : nch - 1; const bf16* gb_ = gp + (size_t)nc_ * 8192; \
        _Pragma("unroll") for (int j = 0; j < 4; ++j) gq_n[j] = __builtin_nontemporal_load((const v4u*)(gb_ + (size_t)j * 4 * 128)); } while (0)
#define STORE_PREV() do { _Pragma("unroll") for (int j = 0; j < 4; ++j) { const v4u ot_ = *(const LAS v4u*)(OT + ((t0 + g + 4 * j) * 136 + 8 * i) * 2); const v4u gg_ = gq_c[j]; v4u w_; \
        w_.x = pkbf(bf_lo(ot_.x) * bf_lo(gg_.x), bf_hi(ot_.x) * bf_hi(gg_.x)); w_.y = pkbf(bf_lo(ot_.y) * bf_lo(gg_.y), bf_hi(ot_.y) * bf_hi(gg_.y)); \
        w_.z = pkbf(bf_lo(ot_.z) * bf_lo(gg_.z), bf_hi(ot_.z) * bf_hi(gg_.z)); w_.w = pkbf(bf_lo(ot_.w) * bf_lo(gg_.w), bf_hi(ot_.w) * bf_hi(gg_.w)); \
        *(v4u*)(prow + (size_t)j * 4 * 2048) = w_; } } while (0)
        if (nb > 0) {
            const size_t so_ = ((size_t)h * MT + (size_t)(m0 + 16 * wid + (lane >> 4))) * 128 + 8 * (lane & 15);
            const bf16* sl_ = LF + so_; const bf16* sv_ = V + so_;
            LAS unsigned char* RLs = lds + ((16 * wid + (lane >> 4)) * 128 + 8 * (lane & 15)) * 2; LAS unsigned char* RVs = RLs + 16384;
            v4u r0[8], r1[8], r2[8];
#define WU_LOAD(R, cc) do { const int nc_ = (cc) < nch ? (cc) : nch - 1; const size_t co_ = (size_t)nc_ * 8192; \
            _Pragma("unroll") for (int j = 0; j < 4; ++j) { R[j] = *(const v4u*)(sl_ + co_ + (size_t)j * 4 * 128); R[4 + j] = *(const v4u*)(sv_ + co_ + (size_t)j * 4 * 128); } } while (0)
#define WU_STAGE(R) do { _Pragma("unroll") for (int j = 0; j < 4; ++j) { *(LAS v4u*)(RLs + j * 4 * 256) = R[j]; *(LAS v4u*)(RVs + j * 4 * 256) = R[4 + j]; } } while (0)
            WU_LOAD(r0, 1); WU_LOAD(r1, 2); WU_LOAD(r2, 3);
            for (int n = 0; n < nb; n += 3) {
                WU_STAGE(r0); WU_LOAD(r0, n + 4); __syncthreads(); __syncthreads();
                WU_STAGE(r1); WU_LOAD(r1, n + 5); __syncthreads(); __syncthreads();
                WU_STAGE(r2); WU_LOAD(r2, n + 6); __syncthreads(); __syncthreads();
            }
#undef WU_LOAD
#undef WU_STAGE
        }
        LOAD_GATE(nb);
        __builtin_amdgcn_s_setprio(2);
        for (int n = nb; n < ne; ++n) {
            int i_ = i, g_ = g; asm volatile("" : "+v"(i_), "+v"(g_));
            if (n > nb) STORE_PREV();
#pragma unroll
            for (int j = 0; j < 4; ++j) gq_c[j] = gq_n[j];
            LOAD_GATE(n + 1);
            __syncthreads();
            {
                bf16x8 bq[4];
#pragma unroll
                for (int kk = 0; kk < 4; ++kk) bq[kk] = *(const LAS bf16x8*)(QD + ((t0 + i_) * SQ + 32 * kk + 8 * g_) * 2);
                bf16x8 pc[2];
                {
                    f32x4 sT[4];
#pragma unroll
                    for (int st = 0; st < 4; ++st) {
                        f32x4 a4 = (f32x4){0.f, 0.f, 0.f, 0.f};
#pragma unroll
                        for (int kk = 0; kk < 4; ++kk) { const bf16x8 a = *(const LAS bf16x8*)(KI + ((16 * st + i_) * SQ + 32 * kk + 8 * g_) * 2); a4 = MFMA16(a, bq[kk], a4); }
#pragma unroll
                        for (int r = 0; r < 4; ++r) if (16 * st + 4 * g_ + r > t0 + i_) a4[r] = 0.f;
                        sT[st] = a4;
                    }
#pragma unroll
                    for (int c = 0; c < 2; ++c) { v4u w; w.x = pkbf(sT[2 * c][0], sT[2 * c][1]); w.y = pkbf(sT[2 * c][2], sT[2 * c][3]); w.z = pkbf(sT[2 * c + 1][0], sT[2 * c + 1][1]); w.w = pkbf(sT[2 * c + 1][2], sT[2 * c + 1][3]);
                        pc[c] = __builtin_bit_cast(bf16x8, w); }
                }
                f32x4 oa[8]; float ss = 0.f;
#pragma unroll
                for (int vt = 0; vt < 8; ++vt) {
                    f32x4 acc = (f32x4){0.f, 0.f, 0.f, 0.f};
#pragma unroll
                    for (int c = 0; c < 2; ++c) {
                        const v2u lo = *(const LAS v2u*)(VT + ((16 * vt + i_) * SK + 32 * c + 4 * g_) * 2), hi = *(const LAS v2u*)(VT + ((16 * vt + i_) * SK + 32 * c + 16 + 4 * g_) * 2);
                        v4u w; w.x = lo.x; w.y = lo.y; w.z = hi.x; w.w = hi.y; acc = MFMA16(__builtin_bit_cast(bf16x8, w), pc[c], acc); }
#pragma unroll
                    for (int kk = 0; kk < 4; ++kk) { const bf16x8 a = *(const LAS bf16x8*)(ST + ((16 * vt + i_) * SQ + 32 * kk + 8 * g_) * 2); acc = MFMA16(a, bq[kk], acc); }
                    oa[vt] = acc; ss += (acc[0] * acc[0] + acc[1] * acc[1]) + (acc[2] * acc[2] + acc[3] * acc[3]);
                }
                ss += __shfl_xor(ss, 16); ss += __shfl_xor(ss, 32);
                const float sc = __builtin_amdgcn_rsqf(ss * (1.0f / 128.0f) + LN_EPS);
#pragma unroll
                for (int vt = 0; vt < 8; ++vt) { const f32x4 gn = *(const LAS f32x4*)(GN + 16 * vt + 4 * g_) * sc; v2u w_;
                    w_.x = pkbf(oa[vt][0] * gn[0], oa[vt][1] * gn[1]); w_.y = pkbf(oa[vt][2] * gn[2], oa[vt][3] * gn[3]);
                    *(LAS v2u*)(OT + ((t0 + i_) * 136 + 16 * vt + 4 * g_) * 2) = w_; }
                prow = orow + (size_t)n * (64 * 2048);
            }
            __syncthreads();
        }
        STORE_PREV();
        __builtin_amdgcn_s_setprio(0);
#undef STORE_PREV
#undef LOAD_GATE
    } else {
        const int cp = i, rg = g, c0 = 32 * wq + 2 * cp;
        const size_t pofs = ((size_t)h * MT + (size_t)(m0 + 16 * rg)) * 128 + c0;
        const bf16* qp = Q + pofs; const bf16* lp = LF + pofs; const bf16* vp = V + pofs;
        unsigned rq[16], rl[16], rv[16];
        unsigned sq[16], sk[16], ske0[8], ske1[8]; float det0, det1;
#define LOAD_RAW(nn) do { const int nc_ = (nn) < nch ? (nn) : nch - 1; const bf16* qb_ = qp + (size_t)nc_ * 8192; const bf16* lb_ = lp + (size_t)nc_ * 8192; const bf16* vb_ = vp + (size_t)nc_ * 8192; \
        _Pragma("unroll") for (int r = 0; r < 16; ++r) { rl[r] = *(const unsigned*)(lb_ + r * 128); rq[r] = *(const unsigned*)(qb_ + r * 128); } (void)vb_; } while (0)
#define LOAD_V(nn) do { const int nc_ = (nn) < nch ? (nn) : nch - 1; const bf16* vb_ = vp + (size_t)nc_ * 8192; _Pragma("unroll") for (int r = 0; r < 16; ++r) rv[r] = *(const unsigned*)(vb_ + r * 128); } while (0)
#define PREP_REGS(full_) do { \
        float su0 = 0.f, su1 = 0.f; \
        _Pragma("unroll") for (int r = 0; r < 16; ++r) { const f16x2 hh = __builtin_bit_cast(f16x2, rl[r]); su0 += (float)hh.x; su1 += (float)hh.y; } \
        float off0 = 0.f, off1 = 0.f, tot0 = 0.f, tot1 = 0.f; \
        _Pragma("unroll") for (int j = 0; j < 4; ++j) { const float a_ = __shfl(su0, cpx + 16 * j), b_ = __shfl(su1, cpx + 16 * j); if (j < rgx) { off0 += a_; off1 += b_; } tot0 += a_; tot1 += b_; } \
        const float et0 = __expf(tot0), et1 = __expf(tot1); float p0 = __expf(off0), p1 = __expf(off1); det0 = et0; det1 = et1; \
        float kp0 = 0.f, kp1 = 0.f; \
        _Pragma("unroll") for (int r = 0; r < 16; ++r) { const f16x2 hh = __builtin_bit_cast(f16x2, rl[r]); const float f0 = __expf((float)hh.x), f1 = __expf((float)hh.y); \
            p0 *= f0; p1 *= f1; \
            const float ki0 = (1.0f - f0) * __builtin_amdgcn_rcpf(p0), ki1 = (1.0f - f1) * __builtin_amdgcn_rcpf(p1); const float ke0 = ki0 * et0, ke1 = ki1 * et1; \
            if (full_) { sq[r] = pkbf(bf_lo(rq[r]) * p0, bf_hi(rq[r]) * p1); sk[r] = pkbf(ki0, ki1); } \
            if (r & 1) { ske0[r >> 1] = pkbf(kp0, ke0); ske1[r >> 1] = pkbf(kp1, ke1); } \
            kp0 = ke0; kp1 = ke1; } } while (0)
#define DUMP_REGS(full_) do { \
        if (full_) _Pragma("unroll") for (int r = 0; r < 16; ++r) { *(LAS unsigned*)(QD + ((16 * rgx + r) * SQ + c0x) * 2) = sq[r]; *(LAS unsigned*)(KI + ((16 * rgx + r) * SQ + c0x) * 2) = sk[r]; } \
        { v4u w_; w_.x = ske0[0]; w_.y = ske0[1]; w_.z = ske0[2]; w_.w = ske0[3]; *(LAS v4u*)(KET + (c0x * SK + 16 * rgx) * 2) = w_; w_.x = ske0[4]; w_.y = ske0[5]; w_.z = ske0[6]; w_.w = ske0[7]; *(LAS v4u*)(KET + (c0x * SK + 16 * rgx + 8) * 2) = w_; \
          w_.x = ske1[0]; w_.y = ske1[1]; w_.z = ske1[2]; w_.w = ske1[3]; *(LAS v4u*)(KET + ((c0x + 1) * SK + 16 * rgx) * 2) = w_; w_.x = ske1[4]; w_.y = ske1[5]; w_.z = ske1[6]; w_.w = ske1[7]; *(LAS v4u*)(KET + ((c0x + 1) * SK + 16 * rgx + 8) * 2) = w_; \
          _Pragma("unroll") for (int hh_ = 0; hh_ < 2; ++hh_) { \
            w_.x = (rv[8 * hh_ + 0] & 0xffffu) | (rv[8 * hh_ + 1] << 16); w_.y = (rv[8 * hh_ + 2] & 0xffffu) | (rv[8 * hh_ + 3] << 16); w_.z = (rv[8 * hh_ + 4] & 0xffffu) | (rv[8 * hh_ + 5] << 16); w_.w = (rv[8 * hh_ + 6] & 0xffffu) | (rv[8 * hh_ + 7] << 16); \
            *(LAS v4u*)(VT + (c0x * SK + 16 * rgx + 8 * hh_) * 2) = w_; \
            w_.x = (rv[8 * hh_ + 0] >> 16) | (rv[8 * hh_ + 1] & 0xffff0000u); w_.y = (rv[8 * hh_ + 2] >> 16) | (rv[8 * hh_ + 3] & 0xffff0000u); w_.z = (rv[8 * hh_ + 4] >> 16) | (rv[8 * hh_ + 5] & 0xffff0000u); w_.w = (rv[8 * hh_ + 6] >> 16) | (rv[8 * hh_ + 7] & 0xffff0000u); \
            *(LAS v4u*)(VT + ((c0x + 1) * SK + 16 * rgx + 8 * hh_) * 2) = w_; } } \
        if (rgx == 0) { f32x2 p_; p_.x = det0; p_.y = det1; *(LAS f32x2*)(DEC + c0x) = p_; } } while (0)
        f32x4 S[8][2];
#define WRITE_ST() do { _Pragma("unroll") for (int kt = 0; kt < 8; ++kt) _Pragma("unroll") for (int j = 0; j < 2; ++j) { v2u w_; w_.x = pkbf(S[kt][j][0], S[kt][j][1]); w_.y = pkbf(S[kt][j][2], S[kt][j][3]); \
        *(LAS v2u*)(ST + ((16 * (2 * wq + j) + i) * SQ + 16 * kt + 4 * g) * 2) = w_; } } while (0)
#pragma unroll
        for (int kt = 0; kt < 8; ++kt)
#pragma unroll
            for (int j = 0; j < 2; ++j) S[kt][j] = (f32x4){0.f, 0.f, 0.f, 0.f};
        LOAD_RAW(0); LOAD_V(0);
        WRITE_ST();
        { const int cpx = cp, rgx = rg, c0x = c0; PREP_REGS(nb == 0); (void)c0x; }
        if (nb > 0) {
            { const int nc_ = nb < nch ? nb : nch - 1; const bf16* qb_ = qp + (size_t)nc_ * 8192;
#pragma unroll
              for (int r = 0; r < 16; ++r) rq[r] = *(const unsigned*)(qb_ + r * 128); }
            for (int n = 0; n < nb; ++n) {
                int i_ = i, g_ = g; asm volatile("" : "+v"(i_), "+v"(g_));
                const int cpx = i_, rgx = g_, c0x = 32 * wq + 2 * i_;
                DUMP_REGS(false);
                __syncthreads();
                {
                    bf16x8 bv[2][2];
#pragma unroll
                    for (int j = 0; j < 2; ++j)
#pragma unroll
                        for (int c = 0; c < 2; ++c) bv[j][c] = *(const LAS bf16x8*)(VT + ((16 * (2 * wq + j) + i_) * SK + 32 * c + 8 * g_) * 2);
#pragma unroll
                    for (int kt = 0; kt < 8; ++kt) {
                        const f32x4 d = *(const LAS f32x4*)(DEC + 16 * kt + 4 * g_);
                        const bf16x8 a0 = *(const LAS bf16x8*)(KET + ((16 * kt + i_) * SK + 8 * g_) * 2), a1 = *(const LAS bf16x8*)(KET + ((16 * kt + i_) * SK + 32 + 8 * g_) * 2);
#pragma unroll
                        for (int j = 0; j < 2; ++j) { f32x4 acc = S[kt][j] * d; acc = MFMA16(a0, bv[j][0], acc); acc = MFMA16(a1, bv[j][1], acc); S[kt][j] = acc; }
                    }
                }
#pragma unroll
                for (int r = 0; r < 16; ++r) { rl[r] = *(const LAS unsigned*)(lds + ((16 * rgx + r) * 128 + c0x) * 2); rv[r] = *(const LAS unsigned*)(lds + 16384 + ((16 * rgx + r) * 128 + c0x) * 2); }
                PREP_REGS(n + 1 == nb);
                __syncthreads();
            }
            WRITE_ST();
            LOAD_RAW(nb + 1);
        } else { LOAD_RAW(1); }
        for (int n = nb; n < ne; ++n) {
            int i_ = i, g_ = g; asm volatile("" : "+v"(i_), "+v"(g_));
            const int cpx = i_, rgx = g_, c0x = 32 * wq + 2 * i_;
            DUMP_REGS(true);
            asm volatile("" ::: "memory");
            LOAD_V(n + 1);
            __syncthreads();
            {
                bf16x8 bv[2][2];
#pragma unroll
                for (int j = 0; j < 2; ++j)
#pragma unroll
                    for (int c = 0; c < 2; ++c) bv[j][c] = *(const LAS bf16x8*)(VT + ((16 * (2 * wq + j) + i_) * SK + 32 * c + 8 * g_) * 2);
#pragma unroll
                for (int kt = 0; kt < 8; ++kt) {
                    const f32x4 d = *(const LAS f32x4*)(DEC + 16 * kt + 4 * g_);
                    const bf16x8 a0 = *(const LAS bf16x8*)(KET + ((16 * kt + i_) * SK + 8 * g_) * 2), a1 = *(const LAS bf16x8*)(KET + ((16 * kt + i_) * SK + 32 + 8 * g_) * 2);
#pragma unroll
                    for (int j = 0; j < 2; ++j) { f32x4 acc = S[kt][j] * d; acc = MFMA16(a0, bv[j][0], acc); acc = MFMA16(a1, bv[j][1], acc); S[kt][j] = acc; }
                }
            }
            PREP_REGS(true);
            LOAD_RAW(n + 2);
            __syncthreads();
            WRITE_ST();
        }
        if (store_state) {
            float* op = s_out + (4 * g) * 128 + 32 * wq + i;
#pragma unroll
            for (int kt = 0; kt < 8; ++kt) {
#pragma unroll
                for (int j = 0; j < 2; ++j)
#pragma unroll
                    for (int r = 0; r < 4; ++r) __builtin_nontemporal_store(S[kt][j][r], op + r * 128 + 16 * j);
                op += 2048; asm volatile("" : "+v"(op));
            }
        }
#undef WRITE_ST
#undef DUMP_REGS
#undef PREP_REGS
#undef LOAD_RAW
#undef LOAD_V
    }
}

__device__ __forceinline__ void hgrn_sample_units(LAS unsigned char* lds, const bf16* Q, const bf16* LF, const bf16* V, const bf16* G, bf16* O, const float* gnorm,
                                                  const float* state, float* out_hs, int su0, int stride) {
    int tid_ = threadIdx.x; asm volatile("" : "+v"(tid_));
    const int tid = tid_, lane = tid & 63, wid = tid >> 6, kr = tid >> 5, vc = tid & 31;
    LAS float* SQv = (LAS float*)lds; LAS float* SFv = SQv + 512; LAS float* SKv = SQv + 1024; LAS float* SVv = SQv + 1536; LAS float* RED = SQv + 2048;
    if (su0 >= 2048) return;
    f32x4 S[8], Sn[8]; unsigned short nq, nl, nv;
    const int tt = tid >> 7, tk = tid & 127;
#define SU_LOAD(su_) do { const int b_ = (su_) >> 4, h_ = (su_) & 15; const f32x4* sp_ = (const f32x4*)(state + (size_t)(su_) * 16384 + kr * 128 + 4 * vc); \
        _Pragma("unroll") for (int p = 0; p < 8; ++p) Sn[p] = __builtin_nontemporal_load(sp_ + p * 512); \
        const size_t idx_ = ((size_t)h_ * MT + (size_t)(MP + 4 * b_ + tt)) * 128 + tk; nq = Q[idx_]; nl = LF[idx_]; nv = V[idx_]; } while (0)
    SU_LOAD(su0);
    for (int su = su0; su < 2048; su += stride) {
        const int b = su >> 4, h = su & 15;
#pragma unroll
        for (int p = 0; p < 8; ++p) S[p] = Sn[p];
        { const float q = __builtin_bit_cast(float, (unsigned)nq << 16), v = __builtin_bit_cast(float, (unsigned)nv << 16);
          const float f = __expf((float)__builtin_bit_cast(_Float16, nl));
          SQv[tid] = q; SFv[tid] = f; SKv[tid] = 1.0f - f; SVv[tid] = v; }
        { const int sn = (su + stride) < 2048 ? (su + stride) : su; SU_LOAD(sn); }
        __syncthreads();
        f32x4 o[4];
#pragma unroll
        for (int t = 0; t < 4; ++t) {
            const f32x4 vv = *(const LAS f32x4*)(SVv + t * 128 + 4 * vc); f32x4 acc = (f32x4){0.f, 0.f, 0.f, 0.f};
#pragma unroll
            for (int p = 0; p < 8; ++p) { const int k = t * 128 + kr + 16 * p; const float f = SFv[k], kn = SKv[k], q = SQv[k]; S[p] = S[p] * f + vv * kn; acc += S[p] * q; }
            o[t] = acc;
        }
        { f32x4* op = (f32x4*)(out_hs + (size_t)su * 16384 + kr * 128 + 4 * vc);
#pragma unroll
          for (int p = 0; p < 8; ++p) __builtin_nontemporal_store(S[p], op + p * 512); }
#pragma unroll
        for (int t = 0; t < 4; ++t) { o[t].x += __shfl_xor(o[t].x, 32); o[t].y += __shfl_xor(o[t].y, 32); o[t].z += __shfl_xor(o[t].z, 32); o[t].w += __shfl_xor(o[t].w, 32); }
        if (lane < 32) {
#pragma unroll
            for (int t = 0; t < 4; ++t) *(LAS f32x4*)(RED + (wid * 4 + t) * 128 + 4 * vc) = o[t];
        }
        __syncthreads();
        if (wid < 4) {
            const int t = wid; float a0 = 0.f, a1 = 0.f;
#pragma unroll
            for (int w2 = 0; w2 < 8; ++w2) { a0 += RED[(w2 * 4 + t) * 128 + lane]; a1 += RED[(w2 * 4 + t) * 128 + lane + 64]; }
            const float ss = wave_sum(a0 * a0 + a1 * a1); const float sc = __builtin_amdgcn_rsqf(ss * (1.0f / 128.0f) + LN_EPS);
            const int row = MP + 4 * b + t; const size_t gi = ((size_t)h * MT + (size_t)row) * 128;
            const float g0 = __builtin_bit_cast(float, (unsigned)G[gi + lane] << 16), g1 = __builtin_bit_cast(float, (unsigned)G[gi + lane + 64] << 16);
            bf16* orow = O + (size_t)row * 2048 + h * 128;
            orow[lane] = (bf16)(pkbf(a0 * sc * gnorm[h * 128 + lane] * g0, 0.f) & 0xffffu); orow[lane + 64] = (bf16)(pkbf(a1 * sc * gnorm[h * 128 + lane + 64] * g1, 0.f) & 0xffffu);
        }
        __syncthreads();
    }
#undef SU_LOAD
}

__device__ __forceinline__ void hgrn_phase(const Ptrs& P, LAS unsigned char* lds, int ctr_idx) {
    const bf16* Q = (const bf16*)(P.ws + WS_Q); const bf16* LF = (const bf16*)(P.ws + WS_LF); const bf16* V = (const bf16*)(P.ws + WS_V); const bf16* G = (const bf16*)(P.ws + WS_G);
    bf16* O = (bf16*)(P.ws + WS_O);
    const int Gd = (int)gridDim.x, bx = (int)blockIdx.x;
    if (Gd >= 256) {
        constexpr int SPLIT = 15; static_assert(SPLIT % 3 == 0, "the warm-up loader's register ring has three slots");
        if (bx < 256) { const int pu = bx & 127; const bool late = bx >= 128;
            hgrn_unit(lds, Q, LF, V, G, O, P.gnorm, (pu >> 4) * 2048, pu & 15, P.out + OUT_HP + (size_t)pu * 16384, late ? SPLIT : 0, late ? 32 : SPLIT, late); }
        if (bx < 128) hgrn_sample_units(lds, Q, LF, V, G, O, P.gnorm, P.state, P.out + OUT_HS, bx, 128);
    } else {
        const bool split = Gd > 128;
        if (!split || bx < 128) {
            for (int pu = bx; pu < 128; pu += (split ? 128 : Gd)) hgrn_unit(lds, Q, LF, V, G, O, P.gnorm, (pu >> 4) * 2048, pu & 15, P.out + OUT_HP + (size_t)pu * 16384, 0, 32, true);
        }
        if (!split || bx >= 128) { const int sid = split ? bx - 128 : bx, ns = split ? Gd - 128 : Gd; __syncthreads(); hgrn_sample_units(lds, Q, LF, V, G, O, P.gnorm, P.state, P.out + OUT_HS, sid, ns); }
    }
    (void)ctr_idx;
}

__device__ __forceinline__ void gate_phase(const Ptrs& P, LAS unsigned char* lds) {
    const int tid = threadIdx.x, lane = tid & 63, wid = __builtin_amdgcn_readfirstlane(tid >> 6);
    const int i = lane & 15, g = lane >> 4;
    constexpr int SW = 136;
    const bf16* U = (const bf16*)(P.ws + WS_U); const bf16* Vb = (const bf16*)(P.ws + WS_VB); bf16* GT = (bf16*)(P.ws + WS_O);
    const float* part = (const float*)(P.ws + WS_PART); const bf16* WSB = (const bf16*)(P.ws + WS_WSB);
    LAS unsigned char* WT = lds; LAS unsigned char* VNT = lds + 34816; LAS f32x2* STT = (LAS f32x2*)(lds + 69632); LAS unsigned char* OT = lds + 70656;
    int cur_grp = -1;
    for (int u = blockIdx.x; u < 2048; u += gridDim.x) {
        const int grp = u & 15, m0 = (u >> 4) * 128;
        float bq_[8]; v4u uzq[4];
#pragma unroll
        for (int tt = 0; tt < 8; ++tt) bq_[tt] = P.b_s[grp * 128 + 16 * tt + i];
#pragma unroll
        for (int it = 0; it < 4; ++it) { const int idx = tid + 512 * it, row = idx >> 4, c16 = idx & 15; uzq[it] = __builtin_nontemporal_load((const v4u*)(U + ((size_t)grp * MT + (size_t)(m0 + row)) * 128 + c16 * 8)); }
        __syncthreads();
        if (grp != cur_grp) {
#pragma unroll
            for (int it = 0; it < 4; ++it) { const int idx = tid + 512 * it, row = idx >> 4, c16 = idx & 15;
                *(LAS v4u*)(WT + (row * SW) * 2 + c16 * 16) = *(const v4u*)(WSB + (size_t)grp * 16384 + row * 128 + c16 * 8); }
            cur_grp = grp;
        }
        unsigned vraw[16];
#pragma unroll
        for (int r = 0; r < 16; ++r) vraw[r] = __builtin_nontemporal_load((const unsigned*)(Vb + ((size_t)grp * MT + (size_t)(m0 + 16 * wid + r)) * 128 + 2 * lane));
        if (tid < 128) { const f32x2* pr = (const f32x2*)(part + (size_t)(m0 + tid) * 64); float s = 0.f, ss = 0.f;
#pragma unroll
            for (int j = 0; j < 32; ++j) { const f32x2 p = pr[j]; s += p.x; ss += p.y; }
            const float mean = s * (1.0f / 2048.0f), var = ss * (1.0f / 2048.0f) - mean * mean; f32x2 o; o.x = mean; o.y = 1.0f / sqrtf(var + LN_EPS); STT[tid] = o; }
        __syncthreads();
        {
            const int c0 = grp * 128 + 2 * lane; const float g0 = P.lnv_g[c0], g1 = P.lnv_g[c0 + 1], b0 = P.lnv_b[c0], b1 = P.lnv_b[c0 + 1];
            float y0[16], y1[16];
#pragma unroll
            for (int r = 0; r < 16; ++r) { const int row = 16 * wid + r; const unsigned raw = vraw[r]; const f32x2 st = STT[row];
                y0[r] = (bf_lo(raw) - st.x) * st.y * g0 + b0; y1[r] = (bf_hi(raw) - st.x) * st.y * g1 + b1; }
#pragma unroll
            for (int hh = 0; hh < 2; ++hh) { v4u w0, w1;
                w0.x = pkbf(y0[8 * hh + 0], y0[8 * hh + 1]); w0.y = pkbf(y0[8 * hh + 2], y0[8 * hh + 3]); w0.z = pkbf(y0[8 * hh + 4], y0[8 * hh + 5]); w0.w = pkbf(y0[8 * hh + 6], y0[8 * hh + 7]);
                w1.x = pkbf(y1[8 * hh + 0], y1[8 * hh + 1]); w1.y = pkbf(y1[8 * hh + 2], y1[8 * hh + 3]); w1.z = pkbf(y1[8 * hh + 4], y1[8 * hh + 5]); w1.w = pkbf(y1[8 * hh + 6], y1[8 * hh + 7]);
                *(LAS v4u*)(VNT + ((2 * lane) * SW + 16 * wid + 8 * hh) * 2) = w0; *(LAS v4u*)(VNT + ((2 * lane + 1) * SW + 16 * wid + 8 * hh) * 2) = w1; }
        }
        __syncthreads();
        {
            bf16x8 av[4];
#pragma unroll
            for (int kk = 0; kk < 4; ++kk) av[kk] = *(const LAS bf16x8*)(VNT + ((16 * wid + i) * SW + 32 * kk + 8 * g) * 2);
#pragma unroll
            for (int tt = 0; tt < 8; ++tt) {
                f32x4 acc = (f32x4){0.f, 0.f, 0.f, 0.f};
#pragma unroll
                for (int kk = 0; kk < 4; ++kk) if (kk <= (tt >> 1)) { const bf16x8 b = *(const LAS bf16x8*)(WT + ((16 * tt + i) * SW + 32 * kk + 8 * g) * 2); acc = MFMA16(av[kk], b, acc); }
                const int t = 16 * tt + i; const float bias = bq_[tt];
                v2u w; w.x = pkbf(acc[0] + bias, acc[1] + bias); w.y = pkbf(acc[2] + bias, acc[3] + bias);
                *(LAS v2u*)(OT + (t * SW + 16 * wid + 4 * g) * 2) = w;
            }
        }
        __syncthreads();
#pragma unroll
        for (int it = 0; it < 4; ++it) { const int idx = tid + 512 * it, row = idx >> 4, c16 = idx & 15;
            const v4u mx = *(const LAS v4u*)(OT + (row * SW) * 2 + c16 * 16); const v4u uu = uzq[it]; v4u w;
            w.x = pkbf(bf_lo(uu.x) * bf_lo(mx.x), bf_hi(uu.x) * bf_hi(mx.x)); w.y = pkbf(bf_lo(uu.y) * bf_lo(mx.y), bf_hi(uu.y) * bf_hi(mx.y));
            w.z = pkbf(bf_lo(uu.z) * bf_lo(mx.z), bf_hi(uu.z) * bf_hi(mx.z)); w.w = pkbf(bf_lo(uu.w) * bf_lo(mx.w), bf_hi(uu.w) * bf_hi(mx.w));
            *(v4u*)(GT + (size_t)(m0 + row) * 2048 + grp * 128 + c16 * 8) = w; }
    }
    for (int sb = (int)gridDim.x - 1 - (int)blockIdx.x; sb < 128; sb += gridDim.x) {
        __syncthreads();
        const int mrow = MP + 4 * sb;
        if (tid < 4) { const f32x2* pr = (const f32x2*)(part + (size_t)(mrow + tid) * 64); float s = 0.f, ss = 0.f;
            for (int j = 0; j < 32; ++j) { const f32x2 p = pr[j]; s += p.x; ss += p.y; }
            const float mean = s * (1.0f / 2048.0f), var = ss * (1.0f / 2048.0f) - mean * mean; f32x2 o; o.x = mean; o.y = 1.0f / sqrtf(var + LN_EPS); STT[tid] = o; }
        __syncthreads();
        const int c = 4 * tid, grp = c >> 7;
        const f32x4 lg = *(const f32x4*)(P.lnv_g + c), lb = *(const f32x4*)(P.lnv_b + c);
        f32x4 vn[4];
#pragma unroll
        for (int t = 0; t < 4; ++t) { const v2u raw = *(const v2u*)(Vb + ((size_t)grp * MT + (size_t)(mrow + t)) * 128 + (c & 127)); const f32x2 st = STT[t];
            f32x4 x; x.x = bf_lo(raw.x); x.y = bf_hi(raw.x); x.z = bf_lo(raw.y); x.w = bf_hi(raw.y);
            vn[t] = (x - st.x) * st.y * lg + lb;
            __builtin_nontemporal_store(vn[t], (f32x4*)(P.out + OUT_CV + (size_t)(4 * sb + t) * 2048 + c)); }
#pragma unroll
        for (int t = 0; t < 4; ++t) { const float bias = P.b_s[grp * 128 + t]; f32x4 mx = (f32x4){bias, bias, bias, bias};
#pragma unroll
            for (int s = 0; s < 4; ++s) if (s <= t) mx += vn[s] * P.w_s[(size_t)grp * 16384 + t * 128 + s];
            const size_t off = (size_t)(mrow + t) * 2048 + c; const size_t offg = ((size_t)grp * MT + (size_t)(mrow + t)) * 128 + (c & 127); const v2u uu = *(const v2u*)(U + offg);
            v2u w; w.x = pkbf(bf_lo(uu.x) * mx.x, bf_hi(uu.x) * mx.y); w.y = pkbf(bf_lo(uu.y) * mx.z, bf_hi(uu.y) * mx.w);
            *(v2u*)(GT + off) = w; }
    }
}

struct Args { const float* in[15]; float* out; unsigned char* ws; int ph_lo, ph_hi; };
__global__ void __launch_bounds__(512, 2) mk_fwd(Args a) {
    extern __shared__ __attribute__((aligned(16))) unsigned char lds_raw[];
    LAS unsigned char* lds = (LAS unsigned char*)lds_raw;
    Ptrs P;
    P.xp = a.in[0]; P.xs = a.in[1]; P.state = a.in[2]; P.w_in_a = a.in[3]; P.lb_logits = a.in[4]; P.gnorm = a.in[5]; P.w_out_a = a.in[6]; P.w_in_b = a.in[7];
    P.lnv_g = a.in[8]; P.lnv_b = a.in[9]; P.w_s = a.in[10]; P.b_s = a.in[11]; P.w_out_b = a.in[12]; P.ln_g = a.in[13]; P.ln_b = a.in[14]; P.out = a.out; P.ws = a.ws;
    const int lo = a.ph_lo, hi = a.ph_hi;
    volatile LAS unsigned* bst = (volatile LAS unsigned*)(lds + 131072 + 64);
    if (threadIdx.x == 0) { bst[0] = 0u; bst[1] = 0u; }
    __syncthreads();
    XcdBarrier bar = xcd_barrier_post((unsigned*)(P.ws + WS_BAR), bst);
    if (lo < 0) cg::this_grid().sync();
#define IN(k) (lo <= (k) && (k) < hi)
#define SEAM(k) do { if (IN(k) && IN((k) + 1)) { xcd_barrier(bar); } } while (0)
#ifndef PROBE_REP
#define PROBE_REP -1
#endif
#define REP(k) for (int rep_ = 0; rep_ < ((PROBE_REP == (k)) ? 2 : 1); ++rep_, (void)((PROBE_REP == (k) && rep_ == 1) ? (cg::this_grid().sync(), 0) : 0))
    const int G = (int)gridDim.x, c = (int)blockIdx.x;
    if (IN(0)) REP(0) { p0_prologue(P, lds); }
    SEAM(0);
    if (IN(1)) REP(1) {
        pg8::Gemm g{(const bf16*)(P.ws + WS_XB), (const bf16*)(P.ws + WS_WINA), MT, 4 * EA, DM}; pg8::StaticOrder S; S.init(MT, 4 * EA, G, c);
        pg8::EpiHgrnIn E{(bf16*)(P.ws + WS_Q), (const float*)(P.ws + WS_LB)};
        pg8::gemm_phase<pg8::EpiHgrnIn, pg8::StaticOrder, true, true>(lds, g, S, E);
        if (G >= 128) {
            const int nfull = S.nwg / G, nlast = S.nwg - nfull * G;
            __syncthreads();
            if (nlast == 0 || nlast >= G) p0_late_weights(P, lds, c, G);
            else if (c >= nlast) p0_late_weights(P, lds, c - nlast, G - nlast);
        }
    }
    SEAM(1);
    if (IN(2)) REP(2) { hgrn_phase(P, lds, rep_); }
    SEAM(2);
    if (IN(3)) REP(3) {
        const int Mo = G > 32 ? MP : MT;
        pg8::Gemm g{(const bf16*)(P.ws + WS_O), (const bf16*)(P.ws + WS_WOUTA), Mo, DM, EA}; pg8::StaticOrder S; S.init(Mo, DM, G, c);
        pg8::EpiBf16Plain E{(bf16*)(P.ws + WS_D), DM};
        pg8::gemm_phase<pg8::EpiBf16Plain, pg8::StaticOrder, true, true>(lds, g, S, E);
    }
    SEAM(3);
    if (IN(4)) REP(4) { ln_phase<false>(P, lds, 0); }
    SEAM(4);
    if (IN(5)) REP(5) {
        pg8::Gemm g{(const bf16*)(P.ws + WS_XB), (const bf16*)(P.ws + WS_WINB), MT, 3 * EA, DM}; pg8::StaticOrder S; S.init(MT, 3 * EA, G, c);
        pg8::EpiGmlpIn E{(bf16*)(P.ws + WS_U), (float*)(P.ws + WS_PART)};
        pg8::gemm_phase<pg8::EpiGmlpIn, pg8::StaticOrder, true, true>(lds, g, S, E);
    }
    SEAM(5);
    if (IN(6)) REP(6) { gate_phase(P, lds); }
    SEAM(6);
    if (IN(7)) REP(7) {
        const int Mo = G > 32 ? MP : MT;
        pg8::Gemm g{(const bf16*)(P.ws + WS_O), (const bf16*)(P.ws + WS_WOUTB), Mo, DM, EA}; pg8::StaticOrder S; S.init(Mo, DM, G, c);
        pg8::EpiBf16Plain E{(bf16*)(P.ws + WS_D), DM};
        pg8::gemm_phase<pg8::EpiBf16Plain, pg8::StaticOrder, true, true>(lds, g, S, E);
    }
    SEAM(7);
    if (IN(8)) REP(8) { ln_phase<true>(P, lds, 1); }
#undef IN
#undef SEAM
}

extern "C" void kernel_launch(void* const* d_in, const int* in_sizes, int n_in, void* d_out, int out_size, void* d_ws, size_t ws_size, hipStream_t stream) {
    static int grid = 0;
    if (grid == 0) {
        if (n_in != 15 || ws_size < WS_END || out_size != 54001664) { fprintf(stderr, "kernel_launch: unexpected problem (n_in %d, out %d, ws %zu)\n", n_in, out_size, ws_size); grid = -1; return; }
        int dev = 0, cus = 0, per_cu = 0;
        if (hipGetDevice(&dev) != hipSuccess || hipDeviceGetAttribute(&cus, hipDeviceAttributeMultiprocessorCount, dev) != hipSuccess) { grid = -1; return; }
        if (hipFuncSetAttribute((const void*)mk_fwd, hipFuncAttributeMaxDynamicSharedMemorySize, LDS_BYTES) != hipSuccess) { fprintf(stderr, "kernel_launch: hipFuncSetAttribute failed\n"); grid = -1; return; }
        if (hipOccupancyMaxActiveBlocksPerMultiprocessor(&per_cu, (const void*)mk_fwd, 512, LDS_BYTES) != hipSuccess || per_cu < 1) { fprintf(stderr, "kernel_launch: occupancy query gave %d\n", per_cu); (void)hipGetLastError(); per_cu = 1; }
        grid = cus * 1;
        (void)in_sizes;
    }
    if (grid < 0) return;
    Args a{};
    for (int i = 0; i < 15; ++i) a.in[i] = (const float*)d_in[i];
    a.out = (float*)d_out; a.ws = (unsigned char*)d_ws;
#if MK_MULTI
    for (int p = 0; p < NPHASE; ++p) { a.ph_lo = p; a.ph_hi = p + 1; hipLaunchKernelGGL(mk_fwd, dim3(grid), dim3(512), LDS_BYTES, stream, a); }
#else
    a.ph_lo = 0; a.ph_hi = NPHASE;
    if (hipMemsetAsync((char*)d_ws + WS_BAR, 0, XCD_BAR_WORDS * 4, stream) != hipSuccess) { fprintf(stderr, "kernel_launch: memset of the barrier words failed\n"); return; }
    void* args[] = {&a};
    hipError_t e = hipLaunchCooperativeKernel((const void*)mk_fwd, dim3(grid), dim3(512), args, LDS_BYTES, stream);
    if (e != hipSuccess) fprintf(stderr, "kernel_launch: cooperative launch failed: %s (grid %d)\n", hipGetErrorString(e), grid);
#endif
}
```

```cpp
#include <hip/hip_runtime.h>
#include <hip/hip_cooperative_groups.h>
#include <cstdio>
#include <cstdint>
namespace cg = cooperative_groups;
#define MK_MULTI 0
namespace pg8 {
#define PG8_LAS __attribute__((address_space(3)))
typedef unsigned short bf16_t;
typedef short bf16x8 __attribute__((ext_vector_type(8)));
typedef float f32x4 __attribute__((ext_vector_type(4)));
typedef unsigned u32x4 __attribute__((ext_vector_type(4)));
constexpr int BM = 256, BK = 64, HALF = 128, HTB = HALF * BK * 2  , STAGE_BYTES = 8 * HTB, NXCD = 8, WGM = 8;

__host__ __device__ __forceinline__ int lds_byte(int r, int c) { const int st = (r >> 4) * 2 + (c >> 5), rr = r & 15, cc = c & 31, ob = rr * 64 + cc * 2; return st * 1024 + (ob ^ (((ob >> 9) & 1) << 5)); }
__host__ __device__ __forceinline__ void stage_rc(int b, int& R, int& C) { const int st = b / 1024, sb = b % 1024, swz = sb ^ (((sb >> 9) & 1) << 5); R = (st >> 1) * 16 + swz / 64; C = (st & 1) * 32 + (swz % 64) / 2; }
__host__ __device__ __forceinline__ int perm32(int rho) { const int n = rho >> 4, i = rho & 15; return 8 * (i >> 2) + 4 * n + (i & 3); }

struct Unit { int pm, pn; };
struct Gemm { const bf16_t* A; const bf16_t* Bt; int M, N, K; int nt = 0; };

struct StaticOrder {
    int nM, nN, nwg, G, c;
    __host__ __device__ void init(int M, int N, int G_, int c_) { nM = M / BM; nN = N / BM; nwg = nM * nN; G = G_; c = c_; }
    __host__ __device__ bool next(int i, Unit& u) const {
        const long L = (long)i * G + c; if (L >= nwg) return false;
        int wgid = (int)L; { const int q = nwg / NXCD, r = nwg % NXCD, xcd = wgid % NXCD, off = wgid / NXCD; wgid = (xcd < r ? xcd * (q + 1) : r * (q + 1) + (xcd - r) * q) + off; }
        const int nig = WGM * nN, gid = wgid / nig, fm = gid * WGM, gsz = (nM - fm) < WGM ? (nM - fm) : WGM;
        u.pm = fm + ((wgid % nig) % gsz); u.pn = (wgid % nig) / gsz; return true;
    }
    __device__ __forceinline__ void a_ready(const Unit&) const {}
    __device__ __forceinline__ void done(const Unit&) const {}
};

typedef float cvt_f32x2 __attribute__((ext_vector_type(2)));
typedef __bf16 cvt_bf16x2 __attribute__((ext_vector_type(2)));
__device__ __forceinline__ unsigned cvt_pk_bf16(float lo, float hi) { cvt_f32x2 v; v.x = lo; v.y = hi; const cvt_bf16x2 b = __builtin_convertvector(v, cvt_bf16x2); return __builtin_bit_cast(unsigned, b); }
typedef unsigned u32x2 __attribute__((ext_vector_type(2)));
constexpr size_t MROWS = 16896;
constexpr size_t SEC_STRIDE = (size_t)16896 * 2048;
typedef float f32x2 __attribute__((ext_vector_type(2)));
typedef _Float16 f16x2 __attribute__((ext_vector_type(2)));
__device__ __forceinline__ float silu_f(float x) { return x * __builtin_amdgcn_rcpf(1.0f + __expf(-x)); }
__device__ __forceinline__ float gelu_tanh_f(float x) { const float u = 1.5957691216057308f * (x + 0.044715f * x * x * x); return x * __builtin_amdgcn_rcpf(1.0f + __expf(-u)); }
__device__ __forceinline__ unsigned pk_f16(float lo, float hi) { f16x2 p; p.x = (_Float16)lo; p.y = (_Float16)hi; return __builtin_bit_cast(unsigned, p); }

struct EpiHgrnIn {
    static constexpr bool PERM = true, AFTER_DRAIN = false;
    bf16_t* B0; const float* lb;
    __device__ __forceinline__ void operator()(const f32x4 (&acc)[2][2][4][2], const Unit& u, int wr, int wc, int fr, int fq) const {
        const int sec = u.pn >> 3;
        const int row0 = u.pm * BM + wr * 64 + fr, col0 = (u.pn & 7) * BM + wc * 32 + 8 * fq;
        bf16_t* base = B0 + (size_t)sec * SEC_STRIDE;
        f32x4 l0[2], l1[2];
#pragma unroll
        for (int bj = 0; bj < 2; ++bj) { l0[bj] = (f32x4){0.f, 0.f, 0.f, 0.f}; l1[bj] = l0[bj]; }
        if (sec == 1) {
#pragma unroll
            for (int bj = 0; bj < 2; ++bj) { l0[bj] = *(const f32x4*)(lb + col0 + bj * HALF); l1[bj] = *(const f32x4*)(lb + col0 + bj * HALF + 4); }
        }
#pragma unroll
        for (int ai = 0; ai < 2; ++ai)
#pragma unroll
            for (int m = 0; m < 4; ++m) { bf16_t* rowp = base + ((size_t)((u.pn & 7) * 2) * MROWS + (size_t)(row0 + ai * HALF + m * 16)) * 128 + wc * 32 + 8 * fq;
#pragma unroll
                for (int bj = 0; bj < 2; ++bj) { f32x4 v0 = acc[ai][bj][m][0], v1 = acc[ai][bj][m][1]; u32x4 w;
                    if (sec == 1) {
#pragma unroll
                        for (int j = 0; j < 4; ++j) { const float s0 = __builtin_amdgcn_rcpf(1.0f + __expf(-v0[j])), s1 = __builtin_amdgcn_rcpf(1.0f + __expf(-v1[j]));
                            v0[j] = __logf(l0[bj][j] + (1.0f - l0[bj][j]) * s0); v1[j] = __logf(l1[bj][j] + (1.0f - l1[bj][j]) * s1); }
                        w.x = pk_f16(v0[0], v0[1]); w.y = pk_f16(v0[2], v0[3]); w.z = pk_f16(v1[0], v1[1]); w.w = pk_f16(v1[2], v1[3]);
                    } else {
                        if (sec != 2) {
#pragma unroll
                            for (int j = 0; j < 4; ++j) { v0[j] = silu_f(v0[j]); v1[j] = silu_f(v1[j]); } }
                        w.x = cvt_pk_bf16(v0[0], v0[1]); w.y = cvt_pk_bf16(v0[2], v0[3]); w.z = cvt_pk_bf16(v1[0], v1[1]); w.w = cvt_pk_bf16(v1[2], v1[3]);
                    }
                    *(u32x4*)(rowp + (size_t)bj * MROWS * 128) = w; } }
    }
};
struct EpiGmlpIn {
    static constexpr bool PERM = true, AFTER_DRAIN = false;
    bf16_t* B0; float* part;
    __device__ __forceinline__ void operator()(const f32x4 (&acc)[2][2][4][2], const Unit& u, int wr, int wc, int fr, int fq) const {
        const int row0 = u.pm * BM + wr * 64 + fr;
        if (u.pn < 16) {
#pragma unroll
            for (int ai = 0; ai < 2; ++ai)
#pragma unroll
                for (int m = 0; m < 4; ++m) { const int row = row0 + ai * HALF + m * 16; bf16_t* rowp = B0 + ((size_t)u.pn * MROWS + (size_t)row) * 128 + wc * 32 + 8 * fq;
                    f32x4 v0 = acc[ai][0][m][0], v1 = acc[ai][0][m][1]; const f32x4 z0 = acc[ai][1][m][0], z1 = acc[ai][1][m][1]; u32x4 w;
#pragma unroll
                    for (int j = 0; j < 4; ++j) { v0[j] = gelu_tanh_f(v0[j]) * silu_f(z0[j]); v1[j] = gelu_tanh_f(v1[j]) * silu_f(z1[j]); }
                    w.x = cvt_pk_bf16(v0[0], v0[1]); w.y = cvt_pk_bf16(v0[2], v0[3]); w.z = cvt_pk_bf16(v1[0], v1[1]); w.w = cvt_pk_bf16(v1[2], v1[3]);
                    *(u32x4*)rowp = w; }
        } else {
            const int g0 = (u.pn - 16) * 2;
#pragma unroll
            for (int ai = 0; ai < 2; ++ai)
#pragma unroll
                for (int m = 0; m < 4; ++m) { const int row = row0 + ai * HALF + m * 16; bf16_t* rowp = B0 + SEC_STRIDE + ((size_t)g0 * MROWS + (size_t)row) * 128 + wc * 32 + 8 * fq; float s = 0.f, ss = 0.f;
#pragma unroll
                    for (int bj = 0; bj < 2; ++bj) { f32x4 v0 = acc[ai][bj][m][0], v1 = acc[ai][bj][m][1]; u32x4 w;
#pragma unroll
                        for (int j = 0; j < 4; ++j) { v0[j] = gelu_tanh_f(v0[j]); v1[j] = gelu_tanh_f(v1[j]); s += v0[j] + v1[j]; ss += v0[j] * v0[j] + v1[j] * v1[j]; }
                        w.x = cvt_pk_bf16(v0[0], v0[1]); w.y = cvt_pk_bf16(v0[2], v0[3]); w.z = cvt_pk_bf16(v1[0], v1[1]); w.w = cvt_pk_bf16(v1[2], v1[3]);
                        *(u32x4*)(rowp + (size_t)bj * MROWS * 128) = w; }
                    s += __shfl_xor(s, 16); s += __shfl_xor(s, 32); ss += __shfl_xor(ss, 16); ss += __shfl_xor(ss, 32);
                    if (fq == 0) { f32x2 o; o.x = s; o.y = ss; *(f32x2*)(part + (size_t)row * 64 + ((u.pn - 16) * 4 + wc) * 2) = o; } }
        }
    }
};
struct EpiF32 {
    static constexpr bool PERM = false, AFTER_DRAIN = false;
    float* C; int ldc;
    __device__ __forceinline__ void operator()(const f32x4 (&acc)[2][2][4][2], const Unit& u, int wr, int wc, int fr, int fq) const {
        const int row0 = u.pm * BM + wr * 64 + fr, col0 = u.pn * BM + wc * 32 + 4 * fq;
#pragma unroll
        for (int ai = 0; ai < 2; ++ai)
#pragma unroll
            for (int m = 0; m < 4; ++m) { float* rowp = C + (size_t)(row0 + ai * HALF + m * 16) * ldc + col0;
#pragma unroll
                for (int bj = 0; bj < 2; ++bj)
#pragma unroll
                    for (int n = 0; n < 2; ++n) *(f32x4*)(rowp + bj * HALF + n * 16) = acc[ai][bj][m][n]; }
    }
};
struct EpiBf16Plain {
    static constexpr bool PERM = true, AFTER_DRAIN = false;
    bf16_t* C; int ldc;
    __device__ __forceinline__ void operator()(const f32x4 (&acc)[2][2][4][2], const Unit& u, int wr, int wc, int fr, int fq) const {
        const int row0 = u.pm * BM + wr * 64 + fr, col0 = u.pn * BM + wc * 32 + 8 * fq;
#pragma unroll
        for (int ai = 0; ai < 2; ++ai)
#pragma unroll
            for (int m = 0; m < 4; ++m) { bf16_t* rowp = C + (size_t)(row0 + ai * HALF + m * 16) * ldc + col0;
#pragma unroll
                for (int bj = 0; bj < 2; ++bj) { const f32x4 v0 = acc[ai][bj][m][0], v1 = acc[ai][bj][m][1]; u32x4 w;
                    w.x = cvt_pk_bf16(v0[0], v0[1]); w.y = cvt_pk_bf16(v0[2], v0[3]); w.z = cvt_pk_bf16(v1[0], v1[1]); w.w = cvt_pk_bf16(v1[2], v1[3]);
                    *(u32x4*)(rowp + bj * HALF) = w; } }
    }
};
template <class Epi, class Sched, bool ALIGN_EPI = false, bool SP2 = false>
__device__ __forceinline__ void gemm_phase(PG8_LAS unsigned char* lds, const Gemm g, const Sched& S, const Epi& E) {
    const int tid = threadIdx.x, wid = __builtin_amdgcn_readfirstlane(tid >> 6), lane = tid & 63, wr = wid >> 2, wc = wid & 3, fr = lane & 15, fq = lane >> 4;
    const int K = g.K, nt = g.nt ? g.nt : K / BK;
    unsigned voffA[2], voffB[2];
#pragma unroll
    for (int i = 0; i < 2; ++i) { int R, C; stage_rc(tid * 16 + i * 8192, R, C); const int Rb = Epi::PERM ? ((R & ~31) + perm32(R & 31)) : R;
        voffA[i] = (unsigned)(R * K + C) * 2u; voffB[i] = (unsigned)(Rb * K + C) * 2u; }
    const size_t kstep = (size_t)(BK * 2);
    const size_t hstep = (size_t)HALF * K * 2;
    const size_t tstep = 2 * hstep;
    const unsigned ldsw = (unsigned)wid * 1024u;
    const int aoff = lds_byte(wr * 64 + fr, fq * 8), boff = lds_byte(wc * 32 + fr, fq * 8);
#define PG8_SA(b, h) (((b) * 2 + (h)) * HTB)
#define PG8_SB(b, h) ((4 + (b) * 2 + (h)) * HTB)
#define PG8_STAGE(bufoff, gbase, voff) do { _Pragma("unroll") for (int _i = 0; _i < 2; ++_i) \
        __builtin_amdgcn_global_load_lds((const unsigned*)((const char*)(gbase) + (voff)[_i]), (PG8_LAS unsigned*)(lds + (bufoff) + ldsw + _i * 8192), 16, 0, 0); } while (0)
#define PG8_LDA(dst, b, h) do { _Pragma("unroll") for (int m = 0; m < 4; ++m) _Pragma("unroll") for (int k = 0; k < 2; ++k) dst[m][k] = *(const PG8_LAS bf16x8*)(lds + PG8_SA(b, h) + aoff + m * 2048 + k * 1024); } while (0)
#define PG8_LDB(dst, b, h) do { _Pragma("unroll") for (int n = 0; n < 2; ++n) _Pragma("unroll") for (int k = 0; k < 2; ++k) dst[n][k] = *(const PG8_LAS bf16x8*)(lds + PG8_SB(b, h) + boff + n * 2048 + k * 1024); } while (0)
#define PG8_MMA(ai, bj, At, Bt) do { __builtin_amdgcn_s_setprio(1); _Pragma("unroll") for (int m = 0; m < 4; ++m) _Pragma("unroll") for (int n = 0; n < 2; ++n) _Pragma("unroll") for (int k = 0; k < 2; ++k) \
        acc[ai][bj][m][n] = __builtin_amdgcn_mfma_f32_16x16x32_bf16(Bt[n][k], At[m][k], acc[ai][bj][m][n], 0, 0, 0); __builtin_amdgcn_s_setprio(0); } while (0)
#define PG8_WAIT_V(n) asm volatile("s_waitcnt vmcnt(" #n ")" ::: "memory")
#define PG8_WAIT_L(n) asm volatile("s_waitcnt lgkmcnt(" #n ")" ::: "memory")
#define PG8_BAR __builtin_amdgcn_s_barrier()
#define PG8_SCHED __builtin_amdgcn_sched_barrier(0)
    Unit cur, nxt; int ui = 0;
    if (!S.next(0, cur)) return;
    f32x4 acc[2][2][4][2];
#pragma unroll
    for (int a = 0; a < 2; ++a)
#pragma unroll
        for (int b = 0; b < 2; ++b)
#pragma unroll
            for (int m = 0; m < 4; ++m)
#pragma unroll
                for (int n = 0; n < 2; ++n) acc[a][b][m][n] = (f32x4){0.f, 0.f, 0.f, 0.f};
    bf16x8 At[4][2], B0[2][2], B1[2][2];
    const char* cA = (const char*)g.A + (size_t)cur.pm * tstep; const char* cB = (const char*)g.Bt + (size_t)cur.pn * tstep;
    S.a_ready(cur);
    if constexpr (SP2) {
        PG8_STAGE(PG8_SB(0, 0), cB, voffB); PG8_STAGE(PG8_SB(0, 1), cB + hstep, voffB); PG8_STAGE(PG8_SA(0, 0), cA, voffA); PG8_STAGE(PG8_SA(0, 1), cA + hstep, voffA);
        if (wr == 1) PG8_BAR;
        PG8_WAIT_V(2); PG8_BAR;
        PG8_STAGE(PG8_SB(1, 0), cB + kstep, voffB); PG8_STAGE(PG8_SA(1, 0), cA + kstep, voffA); PG8_STAGE(PG8_SB(1, 1), cB + hstep + kstep, voffB);
        PG8_WAIT_V(6); PG8_BAR;
    } else {
        PG8_STAGE(PG8_SB(0, 0), cB, voffB); PG8_STAGE(PG8_SA(0, 0), cA, voffA); PG8_STAGE(PG8_SB(0, 1), cB + hstep, voffB); PG8_STAGE(PG8_SA(0, 1), cA + hstep, voffA);
        if (wr == 1) PG8_BAR;
        PG8_WAIT_V(4); PG8_BAR;
        PG8_STAGE(PG8_SB(1, 0), cB + kstep, voffB); PG8_STAGE(PG8_SA(1, 0), cA + kstep, voffA); PG8_STAGE(PG8_SB(1, 1), cB + hstep + kstep, voffB);
        PG8_WAIT_V(6); PG8_BAR;
    }
    for (;;) {
        const bool has_next = S.next(ui + 1, nxt);
        const char* nA = has_next ? (const char*)g.A + (size_t)nxt.pm * tstep : cA; const char* nB = has_next ? (const char*)g.Bt + (size_t)nxt.pn * tstep : cB;
        for (int t = 0; t < nt; t += 2) {
            const bool last = (t == nt - 2);
            const char* a1 = cA + (size_t)(t + 1) * kstep;
            const char* a2 = last ? nA : cA + (size_t)(t + 2) * kstep; const char* b2 = last ? nB : cB + (size_t)(t + 2) * kstep;
            const char* a3 = a2 + kstep; const char* b3 = b2 + kstep;
            if (last && has_next) S.a_ready(nxt);
            if constexpr (SP2) {
            PG8_LDB(B0, 0, 0); PG8_LDB(B1, 0, 1); PG8_SCHED; PG8_LDA(At, 0, 0); PG8_STAGE(PG8_SA(1, 1), a1 + hstep, voffA);
            PG8_WAIT_V(8); PG8_WAIT_L(0); PG8_BAR; PG8_MMA(0, 0, At, B0); PG8_MMA(0, 1, At, B1); PG8_BAR; PG8_SCHED;
            PG8_LDA(At, 0, 1); PG8_STAGE(PG8_SB(0, 0), b2, voffB); PG8_STAGE(PG8_SB(0, 1), b2 + hstep, voffB); PG8_STAGE(PG8_SA(0, 0), a2, voffA);
            PG8_WAIT_V(8); PG8_WAIT_L(0); PG8_BAR; PG8_MMA(1, 0, At, B0); PG8_MMA(1, 1, At, B1); PG8_BAR; PG8_SCHED;
            PG8_LDB(B0, 1, 0); PG8_LDB(B1, 1, 1); PG8_SCHED; PG8_LDA(At, 1, 0); PG8_STAGE(PG8_SA(0, 1), a2 + hstep, voffA);
            PG8_WAIT_V(8); PG8_WAIT_L(0); PG8_BAR; PG8_MMA(0, 0, At, B0); PG8_MMA(0, 1, At, B1); PG8_BAR; PG8_SCHED;
            PG8_LDA(At, 1, 1); PG8_STAGE(PG8_SB(1, 0), b3, voffB); PG8_STAGE(PG8_SB(1, 1), b3 + hstep, voffB); PG8_STAGE(PG8_SA(1, 0), a3, voffA);
            PG8_WAIT_V(8); PG8_WAIT_L(0); PG8_BAR; PG8_MMA(1, 0, At, B0); PG8_MMA(1, 1, At, B1); PG8_BAR; PG8_SCHED;
            } else {
            PG8_LDB(B0, 0, 0); PG8_SCHED; PG8_LDA(At, 0, 0); PG8_STAGE(PG8_SA(1, 1), a1 + hstep, voffA);
            PG8_WAIT_L(8); PG8_BAR; PG8_WAIT_L(0); PG8_MMA(0, 0, At, B0); PG8_BAR; PG8_SCHED;
            PG8_LDB(B1, 0, 1); PG8_STAGE(PG8_SB(0, 0), b2, voffB);
            PG8_BAR; PG8_WAIT_L(0); PG8_MMA(0, 1, At, B1); PG8_BAR;
            PG8_LDA(At, 0, 1); PG8_STAGE(PG8_SA(0, 0), a2, voffA);
            PG8_BAR; PG8_WAIT_L(0); PG8_MMA(1, 0, At, B0); PG8_BAR; PG8_SCHED;
            PG8_STAGE(PG8_SB(0, 1), b2 + hstep, voffB);
            PG8_WAIT_V(6); PG8_BAR; PG8_MMA(1, 1, At, B1); PG8_BAR;
            PG8_LDB(B0, 1, 0); PG8_SCHED; PG8_LDA(At, 1, 0); PG8_STAGE(PG8_SA(0, 1), a2 + hstep, voffA);
            PG8_WAIT_L(8); PG8_BAR; PG8_WAIT_L(0); PG8_MMA(0, 0, At, B0); PG8_BAR; PG8_SCHED;
            PG8_LDB(B1, 1, 1); PG8_STAGE(PG8_SB(1, 0), b3, voffB);
            PG8_BAR; PG8_WAIT_L(0); PG8_MMA(0, 1, At, B1); PG8_BAR;
            PG8_LDA(At, 1, 1); PG8_STAGE(PG8_SA(1, 0), a3, voffA);
            PG8_BAR; PG8_WAIT_L(0); PG8_MMA(1, 0, At, B0); PG8_BAR; PG8_SCHED;
            PG8_STAGE(PG8_SB(1, 1), b3 + hstep, voffB);
            PG8_WAIT_V(6); PG8_BAR; PG8_MMA(1, 1, At, B1); PG8_BAR;
            }
        }
        if constexpr (ALIGN_EPI) { if (wr == 0) PG8_BAR; }
        if constexpr (!Epi::AFTER_DRAIN) { E(acc, cur, wr, wc, fr, fq); S.done(cur); }
        if (!has_next) break;
#pragma unroll
        for (int a = 0; a < 2; ++a)
#pragma unroll
            for (int b = 0; b < 2; ++b)
#pragma unroll
                for (int m = 0; m < 4; ++m)
#pragma unroll
                    for (int n = 0; n < 2; ++n) acc[a][b][m][n] = (f32x4){0.f, 0.f, 0.f, 0.f};
        cur = nxt; cA = nA; cB = nB; ++ui;
        if constexpr (ALIGN_EPI) { if (wr == 1) PG8_BAR; }
    }
    PG8_WAIT_V(0);
    if constexpr (!ALIGN_EPI) { if (wr == 0) PG8_BAR; }
    PG8_BAR;
    if constexpr (Epi::AFTER_DRAIN) { E.fused(acc, cur, wr, wc, fr, fq, lds, wid, lane); S.done(cur); }
#undef PG8_SA
#undef PG8_SB
#undef PG8_STAGE
#undef PG8_LDA
#undef PG8_LDB
#undef PG8_MMA
#undef PG8_WAIT_V
#undef PG8_WAIT_L
#undef PG8_BAR
#undef PG8_SCHED
}
}

#define GAS __attribute__((address_space(1)))
#define LAS __attribute__((address_space(3)))
typedef unsigned short bf16;
typedef unsigned v4u __attribute__((ext_vector_type(4)));
typedef unsigned v2u __attribute__((ext_vector_type(2)));
typedef float f32x4 __attribute__((ext_vector_type(4)));
typedef float f32x2 __attribute__((ext_vector_type(2)));
typedef short bf16x8 __attribute__((ext_vector_type(8)));
typedef _Float16 f16x2 __attribute__((ext_vector_type(2)));

#ifndef MK_MULTI
#define MK_MULTI 0
#endif
constexpr int NPHASE = 9;
constexpr int MP = 16384, MS = 512, MT = MP + MS, DM = 1024, EA = 2048;
constexpr float LN_EPS = 1e-5f, ALPHA = 1.4142135623730951f;
constexpr size_t MiB = 1u << 20;
constexpr size_t WS_CTL = 0, WS_LB = 64 * 1024, WS_WSB = 1 * MiB, WS_WINA = 2 * MiB, WS_WOUTA = 18 * MiB, WS_WINB = 22 * MiB, WS_WOUTB = 34 * MiB, WS_PART = 38 * MiB;
constexpr size_t WS_XB = 44 * MiB;
constexpr size_t WS_Q = 78 * MiB, WS_LF = 144 * MiB, WS_V = 210 * MiB, WS_G = 276 * MiB, WS_O = 342 * MiB, WS_D = 408 * MiB, WS_DP = 474 * MiB, WS_END = 482 * MiB;
constexpr size_t WS_U = WS_Q, WS_VB = WS_LF, WS_Z = WS_V, WS_H1F = WS_G;
static_assert(WS_LF - WS_Q == pg8::SEC_STRIDE * 2 && WS_V - WS_LF == pg8::SEC_STRIDE * 2 && WS_G - WS_V == pg8::SEC_STRIDE * 2 && WS_O - WS_G == pg8::SEC_STRIDE * 2, "section stride");
constexpr size_t OUT_Y = 0, OUT_HP = 17301504, OUT_HS = 19398656, OUT_CV = 52953088;
constexpr int LDS_BYTES = 131072 + 1024;
constexpr size_t WS_BAR = 32 * 1024;

__device__ __forceinline__ unsigned pkbf(float lo, float hi) { return pg8::cvt_pk_bf16(lo, hi); }
__device__ __forceinline__ float bf_lo(unsigned w) { return __builtin_bit_cast(float, w << 16); }
__device__ __forceinline__ float bf_hi(unsigned w) { return __builtin_bit_cast(float, w & 0xffff0000u); }
__device__ __forceinline__ float wave_sum(float v) {
#pragma unroll
    for (int o = 1; o < 64; o <<= 1) v += __shfl_xor(v, o);
    return v;
}
#define LDS_WAIT() asm volatile("s_waitcnt lgkmcnt(0)" ::: "memory")

__device__ __forceinline__ void p0_transpose_item(const float* W, int K, int N, bf16* WT, LAS float* scr, int item, int lane, bool gmlp = false) {
    const int nblk = N / 32, kb = item / nblk, nb = item % nblk, k0 = 64 * kb, nd = 32 * nb;
    int n0 = nd;
    if (gmlp) { if (nd < 4096) { const int tile = nd >> 8, half = (nd >> 7) & 1, cc = nd & 127; n0 = (half ? 4096 : 0) + tile * 128 + cc; } else n0 = 2048 + (nd - 4096); }
    float wv[32];
#pragma unroll
    for (int i = 0; i < 32; ++i) { const int kk = 2 * i + (lane >> 5); wv[i] = __builtin_nontemporal_load(W + (size_t)(k0 + kk) * N + n0 + (lane & 31)); }
#pragma unroll
    for (int i = 0; i < 32; ++i) { const int kk = 2 * i + (lane >> 5); scr[kk * 33 + (lane & 31)] = wv[i]; }
    LDS_WAIT(); asm volatile("" ::: "memory");
    const int c = lane & 7;
#pragma unroll
    for (int j = 0; j < 4; ++j) { const int n = (lane >> 3) + 8 * j; const LAS float* s = scr + (8 * c) * 33 + n;
        v4u o; o.x = pkbf(s[0 * 33], s[1 * 33]); o.y = pkbf(s[2 * 33], s[3 * 33]); o.z = pkbf(s[4 * 33], s[5 * 33]); o.w = pkbf(s[6 * 33], s[7 * 33]);
        *(v4u*)(WT + (size_t)(nd + n) * K + k0 + 8 * c) = o; }
    LDS_WAIT(); asm volatile("" ::: "memory");
}

typedef GAS unsigned gu32;
#define XB_TMO      128
#define XB_XCNT(j)  (256  + 64 * (j))
#define XB_XSUB(j)  (1280 + 64 * (j))
#define XB_XGEN(j)  (2304 + 64 * (j))
#define XB_TOP      3328
#define XB_TOPGEN   3392
#define XCD_BAR_WORDS 3456
#define XB_SPIN_CAP (1u << 18)

__device__ __forceinline__ unsigned xb_ld(unsigned* p)              { return __hip_atomic_load(p, __ATOMIC_RELAXED, __HIP_MEMORY_SCOPE_AGENT); }
__device__ __forceinline__ unsigned xb_add(unsigned* p, unsigned v) { return __hip_atomic_fetch_add(p, v, __ATOMIC_RELAXED, __HIP_MEMORY_SCOPE_AGENT); }
__device__ __forceinline__ unsigned xb_xcc_id() { return (unsigned)__builtin_amdgcn_s_getreg((3 << 11) | 20) & 0xFu; }
#define XB_SPIN(cond, bar) do { unsigned _sp = 0; while (cond) { __builtin_amdgcn_s_sleep(1); \
    if ((++_sp & 255u) == 0u) { if (xb_ld(&(bar)[XB_TMO])) break; if (_sp > XB_SPIN_CAP) { atomicAdd(&(bar)[XB_TMO], 1u); break; } } } } while (0)

struct XcdBarrier {
    unsigned* bar; unsigned x;
    volatile LAS unsigned* st;
};

__device__ __forceinline__ XcdBarrier xcd_barrier_post(unsigned* bar, volatile LAS unsigned* st) {
    XcdBarrier b; b.bar = bar; b.x = xb_xcc_id(); b.st = st;
    if (threadIdx.x == 0) (void)xb_add(&bar[XB_XCNT(b.x)], 1u);
    return b;
}
__device__ __forceinline__ void xcd_barrier_complete(unsigned* bar, unsigned x, unsigned& nloc, unsigned& nx) {
    const unsigned G = gridDim.x * gridDim.y * gridDim.z;
    unsigned sum, cnt, mine, sp = 0u;
    for (;;) {
        sum = 0u; cnt = 0u; mine = 0u;
#pragma unroll
        for (unsigned j = 0; j < 16; ++j) { const unsigned c = xb_ld(&bar[XB_XCNT(j)]); sum += c; cnt += (c > 0u) ? 1u : 0u; mine = (j == x) ? c : mine; }
        if (sum == G) break;
        __builtin_amdgcn_s_sleep(1);
        if ((++sp & 255u) == 0u) { if (xb_ld(&bar[XB_TMO])) break; if (sp > XB_SPIN_CAP) { atomicAdd(&bar[XB_TMO], 1u); break; } }
    }
    nloc = mine > 0u ? mine : 1u; nx = cnt > 0u ? cnt : 1u;
}

__device__ __forceinline__ void xcd_barrier(const XcdBarrier& b) {
    asm volatile("s_waitcnt vmcnt(0)" ::: "memory");
    __syncthreads();
    if (threadIdx.x == 0) {
        unsigned* bar = b.bar;
        __builtin_amdgcn_s_waitcnt(0);
        unsigned nloc = b.st[0], nx = b.st[1];
        if (nloc == 0u) { xcd_barrier_complete(bar, b.x, nloc, nx); b.st[0] = nloc; b.st[1] = nx; }
        const unsigned old = xb_add(&bar[XB_XSUB(b.x)], 1u);
        const unsigned gen = old / nloc;
        if (old + 1u == (gen + 1u) * nloc) {
            __builtin_amdgcn_fence(__ATOMIC_RELEASE, "agent");
            asm volatile("s_waitcnt vmcnt(0)" ::: "memory");
            const unsigned og = xb_add(&bar[XB_TOP], 1u);
            const unsigned tg = og / nx;
            if (og + 1u == (tg + 1u) * nx) xb_add(&bar[XB_TOPGEN], 1u);
            else XB_SPIN(xb_ld(&bar[XB_TOPGEN]) == tg, bar);
            __builtin_amdgcn_fence(__ATOMIC_ACQUIRE, "agent");
            xb_add(&bar[XB_XGEN(b.x)], 1u);
            asm volatile("s_waitcnt vmcnt(0)" ::: "memory");
        } else {
            XB_SPIN(xb_ld(&bar[XB_XGEN(b.x)]) == gen, bar);
            __builtin_amdgcn_fence(__ATOMIC_ACQUIRE, "agent");
            asm volatile("s_waitcnt vmcnt(0)" ::: "memory");
        }
    }
    __syncthreads();
}

struct Ptrs {
    const float *xp, *xs, *state, *w_in_a, *lb_logits, *gnorm, *w_out_a, *w_in_b, *lnv_g, *lnv_b, *w_s, *b_s, *w_out_b, *ln_g, *ln_b;
    float* out; unsigned char* ws;
};

__device__ __forceinline__ void p0_prologue(const Ptrs& P, LAS unsigned char* lds) {
    const int tid = threadIdx.x, lane = tid & 63, wave = __builtin_amdgcn_readfirstlane(tid >> 6);
    LAS float* scr = (LAS float*)(lds + wave * 16384);
    const int gw = blockIdx.x * 8 + wave, NGW = gridDim.x * 8;
    constexpr int I_A = (DM / 64) * (4 * EA / 32), I_OA = (EA / 64) * (DM / 32), I_B = (DM / 64) * (3 * EA / 32), I_OB = I_OA, NITEMS = I_A + I_OA + I_B + I_OB;
    const int n_early = (gridDim.x >= 128) ? I_A : NITEMS;
    for (int it = gw; it < n_early; it += NGW) {
        int r = it;
        if (r < I_A) { p0_transpose_item(P.w_in_a, DM, 4 * EA, (bf16*)(P.ws + WS_WINA), scr, r, lane); continue; } r -= I_A;
        if (r < I_OA) { p0_transpose_item(P.w_out_a, EA, DM, (bf16*)(P.ws + WS_WOUTA), scr, r, lane); continue; } r -= I_OA;
        if (r < I_B) { p0_transpose_item(P.w_in_b, DM, 3 * EA, (bf16*)(P.ws + WS_WINB), scr, r, lane, true); continue; } r -= I_B;
        p0_transpose_item(P.w_out_b, EA, DM, (bf16*)(P.ws + WS_WOUTB), scr, r, lane);
    }
    const size_t gtid = (size_t)blockIdx.x * 512 + tid, GT = (size_t)gridDim.x * 512;
    {
        const f32x4* xp4 = (const f32x4*)P.xp; const f32x4* xs4 = (const f32x4*)P.xs; v2u* xb = (v2u*)(P.ws + WS_XB);
        constexpr size_t NP4 = (size_t)MP * DM / 4, NT4 = (size_t)MT * DM / 4;
        for (size_t q = gtid; q < NT4; q += 4 * GT) { f32x4 v[4];
#pragma unroll
            for (int k = 0; k < 4; ++k) { size_t qq = q + k * GT; qq = qq < NT4 ? qq : NT4 - 1; v[k] = __builtin_nontemporal_load(qq < NP4 ? xp4 + qq : xs4 + (qq - NP4)); }
#pragma unroll
            for (int k = 0; k < 4; ++k) { const size_t qq = q + k * GT; if (qq < NT4) { v2u o; o.x = pkbf(v[k].x, v[k].y); o.y = pkbf(v[k].z, v[k].w); xb[qq] = o; } } }
    }
    {
        const f32x4* w4 = (const f32x4*)P.w_s; v2u* wb = (v2u*)(P.ws + WS_WSB);
        for (size_t q = gtid; q < (size_t)16 * 128 * 128 / 4; q += GT) { const int e = (int)(q * 4), s = e & 127, t = (e >> 7) & 127; const f32x4 v = w4[q];
            v2u o; o.x = pkbf(s <= t ? v.x : 0.f, s + 1 <= t ? v.y : 0.f); o.y = pkbf(s + 2 <= t ? v.z : 0.f, s + 3 <= t ? v.w : 0.f); wb[q] = o; }
    }
    if (gtid < 2048) { float* lb = (float*)(P.ws + WS_LB); lb[gtid] = 1.0f / (1.0f + expf(P.lb_logits[2048 + gtid] - P.lb_logits[gtid])); }
    if (gtid < 4) { ((unsigned*)(P.ws + WS_CTL))[64 * gtid] = 0u; }
}

__device__ __forceinline__ void p0_late_weights(const Ptrs& P, LAS unsigned char* lds, int widx, int nw) {
    const int tid = threadIdx.x, lane = tid & 63, wave = __builtin_amdgcn_readfirstlane(tid >> 6);
    LAS float* scr = (LAS float*)(lds + wave * 16384);
    constexpr int I_OA = (EA / 64) * (DM / 32), I_B = (DM / 64) * (3 * EA / 32), I_OB = I_OA, NLATE = I_OA + I_B + I_OB;
    for (int it = widx * 8 + wave; it < NLATE; it += nw * 8) {
        int r = it;
        if (r < I_OA) { p0_transpose_item(P.w_out_a, EA, DM, (bf16*)(P.ws + WS_WOUTA), scr, r, lane); continue; } r -= I_OA;
        if (r < I_B) { p0_transpose_item(P.w_in_b, DM, 3 * EA, (bf16*)(P.ws + WS_WINB), scr, r, lane, true); continue; } r -= I_B;
        p0_transpose_item(P.w_out_b, EA, DM, (bf16*)(P.ws + WS_WOUTB), scr, r, lane);
    }
}

struct OneUnit {
    pg8::Unit u0;
    __device__ __forceinline__ bool next(int i, pg8::Unit& u) const { if (i != 0) return false; u = u0; return true; }
    __device__ __forceinline__ void a_ready(const pg8::Unit&) const {}
    __device__ __forceinline__ void done(const pg8::Unit&) const {}
};
template <bool FINAL, int NR, bool PARTS = false>
__device__ __forceinline__ void ln_rows(const Ptrs& P, const f32x4* g4, const f32x4* b4, int mbase, int mstride, int mend, int lane) {
    const bf16* D = (const bf16*)(P.ws + WS_D); bf16* H1B = (bf16*)(P.ws + WS_XB);
    f32x4 v[NR][4]; float s[NR];
#pragma unroll
    for (int k = 0; k < NR; ++k) { int m = mbase + k * mstride; m = m < mend ? m : mend - 1;
        f32x4 x[4];
        if (FINAL) { const v2u* h4 = (const v2u*)(H1B + (size_t)m * DM);
#pragma unroll
            for (int j = 0; j < 4; ++j) { const v2u r = __builtin_nontemporal_load(h4 + 64 * j + lane); x[j].x = bf_lo(r.x); x[j].y = bf_hi(r.x); x[j].z = bf_lo(r.y); x[j].w = bf_hi(r.y); } }
        else { const f32x4* x4 = (const f32x4*)(m < MP ? P.xp + (size_t)m * DM : P.xs + (size_t)(m - MP) * DM);
#pragma unroll
            for (int j = 0; j < 4; ++j) x[j] = __builtin_nontemporal_load(x4 + 64 * j + lane); }
        if (PARTS) { const f32x4* d4 = (const f32x4*)(P.ws + WS_DP) + (size_t)(m - MP) * (DM / 4);
#pragma unroll
            for (int j = 0; j < 4; ++j) v[k][j] = x[j] * ALPHA + ((d4[64 * j + lane] + d4[64 * j + lane + 512 * DM / 4]) + (d4[64 * j + lane + 2 * 512 * DM / 4] + d4[64 * j + lane + 3 * 512 * DM / 4])); }
        else { const v2u* d4 = (const v2u*)(D + (size_t)m * DM);
#pragma unroll
            for (int j = 0; j < 4; ++j) { const v2u r = __builtin_nontemporal_load(d4 + 64 * j + lane); f32x4 d; d.x = bf_lo(r.x); d.y = bf_hi(r.x); d.z = bf_lo(r.y); d.w = bf_hi(r.y); v[k][j] = x[j] * ALPHA + d; } } }
#pragma unroll
    for (int k = 0; k < NR; ++k) { s[k] = 0.f;
#pragma unroll
        for (int j = 0; j < 4; ++j) s[k] += (v[k][j].x + v[k][j].y) + (v[k][j].z + v[k][j].w); }
#pragma unroll
    for (int o = 1; o < 64; o <<= 1) {
#pragma unroll
        for (int k = 0; k < NR; ++k) s[k] += __shfl_xor(s[k], o); }
#pragma unroll
    for (int k = 0; k < NR; ++k) { const float mean = s[k] * (1.0f / DM); s[k] = 0.f;
#pragma unroll
        for (int j = 0; j < 4; ++j) { v[k][j] = v[k][j] - mean; s[k] += (v[k][j].x * v[k][j].x + v[k][j].y * v[k][j].y) + (v[k][j].z * v[k][j].z + v[k][j].w * v[k][j].w); } }
#pragma unroll
    for (int o = 1; o < 64; o <<= 1) {
#pragma unroll
        for (int k = 0; k < NR; ++k) s[k] += __shfl_xor(s[k], o); }
#pragma unroll
    for (int j = 0; j < 4; ++j) { const f32x4 gg = g4[64 * j + lane], bb = b4[64 * j + lane];
#pragma unroll
        for (int k = 0; k < NR; ++k) { const int m = mbase + k * mstride; if (m < mend) { const float rstd = __builtin_amdgcn_rsqf(s[k] * (1.0f / DM) + LN_EPS); const f32x4 y = v[k][j] * rstd * gg + bb;
            if (FINAL) { __builtin_nontemporal_store(y, (f32x4*)(P.out + OUT_Y + (size_t)m * DM) + 64 * j + lane); }
            else { v2u o; o.x = pkbf(y.x, y.y); o.y = pkbf(y.z, y.w); ((v2u*)(H1B + (size_t)m * DM))[64 * j + lane] = o; } } } }
}
template <bool FINAL>
__device__ __forceinline__ void ln_phase(const Ptrs& P, LAS unsigned char* lds, int layer) {
    const int tid = threadIdx.x, lane = tid & 63, wave = tid >> 6;
    const int G = (int)gridDim.x, bx = (int)blockIdx.x;
    const f32x4* g4 = (const f32x4*)(P.ln_g + layer * DM); const f32x4* b4 = (const f32x4*)(P.ln_b + layer * DM);
    if (G <= 32) {
        for (int m = bx * 8 + wave; m < MT; m += G * 8) ln_rows<FINAL, 1>(P, g4, b4, m, 0, MT, lane);
        return;
    }
    if (bx < 32) {
        unsigned* cnt = (unsigned*)(P.ws + WS_CTL) + 64 * (2 + layer);
        const int unit = bx >> 2, ks = bx & 3;
        pg8::Gemm g{(const bf16*)(P.ws + WS_O) + ks * 512, (const bf16*)(P.ws + (FINAL ? WS_WOUTB : WS_WOUTA)) + ks * 512, MT, DM, EA, 8};
        OneUnit S; S.u0.pm = MP / 256 + (unit >> 2); S.u0.pn = unit & 3;
        pg8::EpiF32 E{(float*)(P.ws + WS_DP) + (size_t)ks * 512 * DM - (size_t)MP * DM, DM};
        pg8::gemm_phase<pg8::EpiF32, OneUnit, true, true>(lds, g, S, E);
        asm volatile("s_waitcnt vmcnt(0)" ::: "memory");
        __syncthreads();
        if (tid == 0) {
            __builtin_amdgcn_fence(__ATOMIC_RELEASE, "agent"); asm volatile("s_waitcnt vmcnt(0)" ::: "memory");
            __hip_atomic_fetch_add(cnt, 1u, __ATOMIC_RELAXED, __HIP_MEMORY_SCOPE_AGENT);
            while (__hip_atomic_load(cnt, __ATOMIC_RELAXED, __HIP_MEMORY_SCOPE_AGENT) < 32u) __builtin_amdgcn_s_sleep(4);
            __builtin_amdgcn_fence(__ATOMIC_ACQUIRE, "agent"); asm volatile("s_waitcnt vmcnt(0)" ::: "memory");
        }
        __syncthreads();
        __builtin_amdgcn_fence(__ATOMIC_ACQUIRE, "agent");
        ln_rows<FINAL, 2, true>(P, g4, b4, MP + bx * 16 + wave * 2, 1, MT, lane);
    } else {
        const int nw = (G - 32) * 8;
        for (int m = (bx - 32) * 8 + wave; m < MP; m += 3 * nw) ln_rows<FINAL, 3>(P, g4, b4, m, nw, MP, lane);
    }
}

#define MFMA16(a, b, c) __builtin_amdgcn_mfma_f32_16x16x32_bf16((a), (b), (c), 0, 0, 0)
__device__ __forceinline__ void hgrn_unit(LAS unsigned char* lds, const bf16* Q, const bf16* LF, const bf16* V, const bf16* G, bf16* O, const float* gnorm,
                                          int m0, int h, float* s_out, int nb, int ne, bool store_state) {
    const int tid = threadIdx.x, lane = tid & 63, wid = __builtin_amdgcn_readfirstlane(tid >> 6);
    const int i = lane & 15, g = lane >> 4, wq = wid & 3, hc = h * 128;
    constexpr int SQ = 136, SK = 72, nch = 32;
    LAS unsigned char* QD = lds; LAS unsigned char* KI = lds + 17408; LAS unsigned char* KET = lds + 34816; LAS unsigned char* VT = lds + 53248; LAS unsigned char* ST = lds + 71680;
    LAS float* DEC = (LAS float*)(lds + 106496); LAS float* GN = (LAS float*)(lds + 111104);
    if (tid < 128) GN[tid] = gnorm[hc + tid];
    if (wid < 4) {
        const int t0 = 16 * wid;
        v4u gq_n[4], gq_c[4];
        LAS unsigned char* OT = lds + 111616;
        const bf16* gp = G + ((size_t)h * MT + (size_t)(m0 + t0 + g)) * 128 + 8 * i;
        bf16* orow = O + (size_t)(m0 + t0 + g) * 2048 + hc + 8 * i;
        bf16* prow = orow;
#define LOAD_GATE(nn) do { const int nc_ = (nn) < nch ? (nn) : nch - 1; const bf16* gb_ = gp + (size_t)nc_ * 8192; \
        _Pragma("unroll") for (int j = 0; j < 4; ++j) gq_n[j] = __builtin_nontemporal_load((const v4u*)(gb_ + (size_t)j * 4 * 128)); } while (0)
#define STORE_PREV() do { _Pragma("unroll") for (int j = 0; j < 4; ++j) { const v4u ot_ = *(const LAS v4u*)(OT + ((t0 + g + 4 * j) * 136 + 8 * i) * 2); const v4u gg_ = gq_c[j]; v4u w_; \
        w_.x = pkbf(bf_lo(ot_.x) * bf_lo(gg_.x), bf_hi(ot_.x) * bf_hi(gg_.x)); w_.y = pkbf(bf_lo(ot_.y) * bf_lo(gg_.y), bf_hi(ot_.y) * bf_hi(gg_.y)); \
        w_.z = pkbf(bf_lo(ot_.z) * bf_lo(gg_.z), bf_hi(ot_.z) * bf_hi(gg_.z)); w_.w = pkbf(bf_lo(ot_.w) * bf_lo(gg_.w), bf_hi(ot_.w) * bf_hi(gg_.w)); \
        *(v4u*)(prow + (size_t)j * 4 * 2048) = w_; } } while (0)
        if (nb > 0) {
            const size_t so_ = ((size_t)h * MT + (size_t)(m0 + 16 * wid + (lane >> 4))) * 128 + 8 * (lane & 15);
            const bf16* sl_ = LF + so_; const bf16* sv_ = V + so_;
            LAS unsigned char* RLs = lds + ((16 * wid + (lane >> 4)) * 128 + 8 * (lane & 15)) * 2; LAS unsigned char* RVs = RLs + 16384;
            v4u r0[8], r1[8], r2[8];
#define WU_LOAD(R, cc) do { const int nc_ = (cc) < nch ? (cc) : nch - 1; const size_t co_ = (size_t)nc_ * 8192; \
            _Pragma("unroll") for (int j = 0; j < 4; ++j) { R[j] = *(const v4u*)(sl_ + co_ + (size_t)j * 4 * 128); R[4 + j] = *(const v4u*)(sv_ + co_ + (size_t)j * 4 * 128); } } while (0)
#define WU_STAGE(R) do { _Pragma("unroll") for (int j = 0; j < 4; ++j) { *(LAS v4u*)(RLs + j * 4 * 256) = R[j]; *(LAS v4u*)(RVs + j * 4 * 256) = R[4 + j]; } } while (0)
            WU_LOAD(r0, 1); WU_LOAD(r1, 2); WU_LOAD(r2, 3);
            for (int n = 0; n < nb; n += 3) {
                WU_STAGE(r0); WU_LOAD(r0, n + 4); __syncthreads(); __syncthreads();
                WU_STAGE(r1); WU_LOAD(r1, n + 5); __syncthreads(); __syncthreads();
                WU_STAGE(r2); WU_LOAD(r2, n + 6); __syncthreads(); __syncthreads();
            }
#undef WU_LOAD
#undef WU_STAGE
        }
        LOAD_GATE(nb);
        __builtin_amdgcn_s_setprio(2);
        for (int n = nb; n < ne; ++n) {
            int i_ = i, g_ = g; asm volatile("" : "+v"(i_), "+v"(g_));
            if (n > nb) STORE_PREV();
#pragma unroll
            for (int j = 0; j < 4; ++j) gq_c[j] = gq_n[j];
            LOAD_GATE(n + 1);
            __syncthreads();
            {
                bf16x8 bq[4];
#pragma unroll
                for (int kk = 0; kk < 4; ++kk) bq[kk] = *(const LAS bf16x8*)(QD + ((t0 + i_) * SQ + 32 * kk + 8 * g_) * 2);
                bf16x8 pc[2];
                {
                    f32x4 sT[4];
#pragma unroll
                    for (int st = 0; st < 4; ++st) {
                        f32x4 a4 = (f32x4){0.f, 0.f, 0.f, 0.f};
#pragma unroll
                        for (int kk = 0; kk < 4; ++kk) { const bf16x8 a = *(const LAS bf16x8*)(KI + ((16 * st + i_) * SQ + 32 * kk + 8 * g_) * 2); a4 = MFMA16(a, bq[kk], a4); }
#pragma unroll
                        for (int r = 0; r < 4; ++r) if (16 * st + 4 * g_ + r > t0 + i_) a4[r] = 0.f;
                        sT[st] = a4;
                    }
#pragma unroll
                    for (int c = 0; c < 2; ++c) { v4u w; w.x = pkbf(sT[2 * c][0], sT[2 * c][1]); w.y = pkbf(sT[2 * c][2], sT[2 * c][3]); w.z = pkbf(sT[2 * c + 1][0], sT[2 * c + 1][1]); w.w = pkbf(sT[2 * c + 1][2], sT[2 * c + 1][3]);
                        pc[c] = __builtin_bit_cast(bf16x8, w); }
                }
                f32x4 oa[8]; float ss = 0.f;
#pragma unroll
                for (int vt = 0; vt < 8; ++vt) {
                    f32x4 acc = (f32x4){0.f, 0.f, 0.f, 0.f};
#pragma unroll
                    for (int c = 0; c < 2; ++c) {
                        const v2u lo = *(const LAS v2u*)(VT + ((16 * vt + i_) * SK + 32 * c + 4 * g_) * 2), hi = *(const LAS v2u*)(VT + ((16 * vt + i_) * SK + 32 * c + 16 + 4 * g_) * 2);
                        v4u w; w.x = lo.x; w.y = lo.y; w.z = hi.x; w.w = hi.y; acc = MFMA16(__builtin_bit_cast(bf16x8, w), pc[c], acc); }
#pragma unroll
                    for (int kk = 0; kk < 4; ++kk) { const bf16x8 a = *(const LAS bf16x8*)(ST + ((16 * vt + i_) * SQ + 32 * kk + 8 * g_) * 2); acc = MFMA16(a, bq[kk], acc); }
                    oa[vt] = acc; ss += (acc[0] * acc[0] + acc[1] * acc[1]) + (acc[2] * acc[2] + acc[3] * acc[3]);
                }
                ss += __shfl_xor(ss, 16); ss += __shfl_xor(ss, 32);
                const float sc = __builtin_amdgcn_rsqf(ss * (1.0f / 128.0f) + LN_EPS);
#pragma unroll
                for (int vt = 0; vt < 8; ++vt) { const f32x4 gn = *(const LAS f32x4*)(GN + 16 * vt + 4 * g_) * sc; v2u w_;
                    w_.x = pkbf(oa[vt][0] * gn[0], oa[vt][1] * gn[1]); w_.y = pkbf(oa[vt][2] * gn[2], oa[vt][3] * gn[3]);
                    *(LAS v2u*)(OT + ((t0 + i_) * 136 + 16 * vt + 4 * g_) * 2) = w_; }
                prow = orow + (size_t)n * (64 * 2048);
            }
            __syncthreads();
        }
        STORE_PREV();
        __builtin_amdgcn_s_setprio(0);
#undef STORE_PREV
#undef LOAD_GATE
    } else {
        const int cp = i, rg = g, c0 = 32 * wq + 2 * cp;
        const size_t pofs = ((size_t)h * MT + (size_t)(m0 + 16 * rg)) * 128 + c0;
        const bf16* qp = Q + pofs; const bf16* lp = LF + pofs; const bf16* vp = V + pofs;
        unsigned rq[16], rl[16], rv[16];
        unsigned sq[16], sk[16], ske0[8], ske1[8]; float det0, det1;
#define LOAD_RAW(nn) do { const int nc_ = (nn) < nch ? (nn) : nch - 1; const bf16* qb_ = qp + (size_t)nc_ * 8192; const bf16* lb_ = lp + (size_t)nc_ * 8192; const bf16* vb_ = vp + (size_t)nc_ * 8192; \
        _Pragma("unroll") for (int r = 0; r < 16; ++r) { rl[r] = *(const unsigned*)(lb_ + r * 128); rq[r] = *(const unsigned*)(qb_ + r * 128); } (void)vb_; } while (0)
#define LOAD_V(nn) do { const int nc_ = (nn) < nch ? (nn) : nch - 1; const bf16* vb_ = vp + (size_t)nc_ * 8192; _Pragma("unroll") for (int r = 0; r < 16; ++r) rv[r] = *(const unsigned*)(vb_ + r * 128); } while (0)
#define PREP_REGS(full_) do { \
        float su0 = 0.f, su1 = 0.f; \
        _Pragma("unroll") for (int r = 0; r < 16; ++r) { const f16x2 hh = __builtin_bit_cast(f16x2, rl[r]); su0 += (float)hh.x; su1 += (float)hh.y; } \
        float off0 = 0.f, off1 = 0.f, tot0 = 0.f, tot1 = 0.f; \
        _Pragma("unroll") for (int j = 0; j < 4; ++j) { const float a_ = __shfl(su0, cpx + 16 * j), b_ = __shfl(su1, cpx + 16 * j); if (j < rgx) { off0 += a_; off1 += b_; } tot0 += a_; tot1 += b_; } \
        const float et0 = __expf(tot0), et1 = __expf(tot1); float p0 = __expf(off0), p1 = __expf(off1); det0 = et0; det1 = et1; \
        float kp0 = 0.f, kp1 = 0.f; \
        _Pragma("unroll") for (int r = 0; r < 16; ++r) { const f16x2 hh = __builtin_bit_cast(f16x2, rl[r]); const float f0 = __expf((float)hh.x), f1 = __expf((float)hh.y); \
            p0 *= f0; p1 *= f1; \
            const float ki0 = (1.0f - f0) * __builtin_amdgcn_rcpf(p0), ki1 = (1.0f - f1) * __builtin_amdgcn_rcpf(p1); const float ke0 = ki0 * et0, ke1 = ki1 * et1; \
            if (full_) { sq[r] = pkbf(bf_lo(rq[r]) * p0, bf_hi(rq[r]) * p1); sk[r] = pkbf(ki0, ki1); } \
            if (r & 1) { ske0[r >> 1] = pkbf(kp0, ke0); ske1[r >> 1] = pkbf(kp1, ke1); } \
            kp0 = ke0; kp1 = ke1; } } while (0)
#define DUMP_REGS(full_) do { \
        if (full_) _Pragma("unroll") for (int r = 0; r < 16; ++r) { *(LAS unsigned*)(QD + ((16 * rgx + r) * SQ + c0x) * 2) = sq[r]; *(LAS unsigned*)(KI + ((16 * rgx + r) * SQ + c0x) * 2) = sk[r]; } \
        { v4u w_; w_.x = ske0[0]; w_.y = ske0[1]; w_.z = ske0[2]; w_.w = ske0[3]; *(LAS v4u*)(KET + (c0x * SK + 16 * rgx) * 2) = w_; w_.x = ske0[4]; w_.y = ske0[5]; w_.z = ske0[6]; w_.w = ske0[7]; *(LAS v4u*)(KET + (c0x * SK + 16 * rgx + 8) * 2) = w_; \
          w_.x = ske1[0]; w_.y = ske1[1]; w_.z = ske1[2]; w_.w = ske1[3]; *(LAS v4u*)(KET + ((c0x + 1) * SK + 16 * rgx) * 2) = w_; w_.x = ske1[4]; w_.y = ske1[5]; w_.z = ske1[6]; w_.w = ske1[7]; *(LAS v4u*)(KET + ((c0x + 1) * SK + 16 * rgx + 8) * 2) = w_; \
          _Pragma("unroll") for (int hh_ = 0; hh_ < 2; ++hh_) { \
            w_.x = (rv[8 * hh_ + 0] & 0xffffu) | (rv[8 * hh_ + 1] << 16); w_.y = (rv[8 * hh_ + 2] & 0xffffu) | (rv[8 * hh_ + 3] << 16); w_.z = (rv[8 * hh_ + 4] & 0xffffu) | (rv[8 * hh_ + 5] << 16); w_.w = (rv[8 * hh_ + 6] & 0xffffu) | (rv[8 * hh_ + 7] << 16); \
            *(LAS v4u*)(VT + (c0x * SK + 16 * rgx + 8 * hh_) * 2) = w_; \
            w_.x = (rv[8 * hh_ + 0] >> 16) | (rv[8 * hh_ + 1] & 0xffff0000u); w_.y = (rv[8 * hh_ + 2] >> 16) | (rv[8 * hh_ + 3] & 0xffff0000u); w_.z = (rv[8 * hh_ + 4] >> 16) | (rv[8 * hh_ + 5] & 0xffff0000u); w_.w = (rv[8 * hh_ + 6] >> 16) | (rv[8 * hh_ + 7] & 0xffff0000u); \
            *(LAS v4u*)(VT + ((c0x + 1) * SK + 16 * rgx + 8 * hh_) * 2) = w_; } } \
        if (rgx == 0) { f32x2 p_; p_.x = det0; p_.y = det1; *(LAS f32x2*)(DEC + c0x) = p_; } } while (0)
        f32x4 S[8][2];
#define WRITE_ST() do { _Pragma("unroll") for (int kt = 0; kt < 8; ++kt) _Pragma("unroll") for (int j = 0; j < 2; ++j) { v2u w_; w_.x = pkbf(S[kt][j][0], S[kt][j][1]); w_.y = pkbf(S[kt][j][2], S[kt][j][3]); \
        *(LAS v2u*)(ST + ((16 * (2 * wq + j) + i) * SQ + 16 * kt + 4 * g) * 2) = w_; } } while (0)
#pragma unroll
        for (int kt = 0; kt < 8; ++kt)
#pragma unroll
            for (int j = 0; j < 2; ++j) S[kt][j] = (f32x4){0.f, 0.f, 0.f, 0.f};
        LOAD_RAW(0); LOAD_V(0);
        WRITE_ST();
        { const int cpx = cp, rgx = rg, c0x = c0; PREP_REGS(nb == 0); (void)c0x; }
        if (nb > 0) {
            { const int nc_ = nb < nch ? nb : nch - 1; const bf16* qb_ = qp + (size_t)nc_ * 8192;
#pragma unroll
              for (int r = 0; r < 16; ++r) rq[r] = *(const unsigned*)(qb_ + r * 128); }
            for (int n = 0; n < nb; ++n) {
                int i_ = i, g_ = g; asm volatile("" : "+v"(i_), "+v"(g_));
                const int cpx = i_, rgx = g_, c0x = 32 * wq + 2 * i_;
                DUMP_REGS(false);
                __syncthreads();
                {
                    bf16x8 bv[2][2];
#pragma unroll
                    for (int j = 0; j < 2; ++j)
#pragma unroll
                        for (int c = 0; c < 2; ++c) bv[j][c] = *(const LAS bf16x8*)(VT + ((16 * (2 * wq + j) + i_) * SK + 32 * c + 8 * g_) * 2);
#pragma unroll
                    for (int kt = 0; kt < 8; ++kt) {
                        const f32x4 d = *(const LAS f32x4*)(DEC + 16 * kt + 4 * g_);
                        const bf16x8 a0 = *(const LAS bf16x8*)(KET + ((16 * kt + i_) * SK + 8 * g_) * 2), a1 = *(const LAS bf16x8*)(KET + ((16 * kt + i_) * SK + 32 + 8 * g_) * 2);
#pragma unroll
                        for (int j = 0; j < 2; ++j) { f32x4 acc = S[kt][j] * d; acc = MFMA16(a0, bv[j][0], acc); acc = MFMA16(a1, bv[j][1], acc); S[kt][j] = acc; }
                    }
                }
#pragma unroll
                for (int r = 0; r < 16; ++r) { rl[r] = *(const LAS unsigned*)(lds + ((16 * rgx + r) * 128 + c0x) * 2); rv[r] = *(const LAS unsigned*)(lds + 16384 + ((16 * rgx + r) * 128 + c0x) * 2); }
                PREP_REGS(n + 1 == nb);
                __syncthreads();
            }
            WRITE_ST();
            LOAD_RAW(nb + 1);
        } else { LOAD_RAW(1); }
        for (int n = nb; n < ne; ++n) {
            int i_ = i, g_ = g; asm volatile("" : "+v"(i_), "+v"(g_));
            const int cpx = i_, rgx = g_, c0x = 32 * wq + 2 * i_;
            DUMP_REGS(true);
            asm volatile("" ::: "memory");
            LOAD_V(n + 1);
            __syncthreads();
            {
                bf16x8 bv[2][2];
#pragma unroll
                for (int j = 0; j < 2; ++j)
#pragma unroll
                    for (int c = 0; c < 2; ++c) bv[j][c] = *(const LAS bf16x8*)(VT + ((16 * (2 * wq + j) + i_) * SK + 32 * c + 8 * g_) * 2);
#pragma unroll
                for (int kt = 0; kt < 8; ++kt) {
                    const f32x4 d = *(const LAS f32x4*)(DEC + 16 * kt + 4 * g_);
                    const bf16x8 a0 = *(const LAS bf16x8*)(KET + ((16 * kt + i_) * SK + 8 * g_) * 2), a1 = *(const LAS bf16x8*)(KET + ((16 * kt + i_) * SK + 32 + 8 * g_) * 2);
#pragma unroll
                    for (int j = 0; j < 2; ++j) { f32x4 acc = S[kt][j] * d; acc = MFMA16(a0, bv[j][0], acc); acc = MFMA16(a1, bv[j][1], acc); S[kt][j] = acc; }
                }
            }
            PREP_REGS(true);
            LOAD_RAW(n + 2);
            __syncthreads();
            WRITE_ST();
        }
        if (store_state) {
            float* op = s_out + (4 * g) * 128 + 32 * wq + i;
#pragma unroll
            for (int kt = 0; kt < 8; ++kt) {
#pragma unroll
                for (int j = 0; j < 2; ++j)
#pragma unroll
                    for (int r = 0; r < 4; ++r) __builtin_nontemporal_store(S[kt][j][r], op + r * 128 + 16 * j);
                op += 2048; asm volatile("" : "+v"(op));
            }
        }
#undef WRITE_ST
#undef DUMP_REGS
#undef PREP_REGS
#undef LOAD_RAW
#undef LOAD_V
    }
}

__device__ __forceinline__ void hgrn_sample_units(LAS unsigned char* lds, const bf16* Q, const bf16* LF, const bf16* V, const bf16* G, bf16* O, const float* gnorm,
                                                  const float* state, float* out_hs, int su0, int stride, int su_end) {
    int tid_ = threadIdx.x; asm volatile("" : "+v"(tid_));
    const int tid = tid_, lane = tid & 63, wid = tid >> 6, kr = tid >> 5, vc = tid & 31;
    LAS float* SQv = (LAS float*)lds; LAS float* SFv = SQv + 512; LAS float* SKv = SQv + 1024; LAS float* SVv = SQv + 1536; LAS float* RED = SQv + 2048;
    if (su0 >= su_end) return;
    f32x4 S[8], Sn[8]; unsigned short nq, nl, nv;
    const int tt = tid >> 7, tk = tid & 127;
#define SU_LOAD(su_) do { const int b_ = (su_) >> 4, h_ = (su_) & 15; const f32x4* sp_ = (const f32x4*)(state + (size_t)(su_) * 16384 + kr * 128 + 4 * vc); \
        _Pragma("unroll") for (int p = 0; p < 8; ++p) Sn[p] = __builtin_nontemporal_load(sp_ + p * 512); \
        const size_t idx_ = ((size_t)h_ * MT + (size_t)(MP + 4 * b_ + tt)) * 128 + tk; nq = Q[idx_]; nl = LF[idx_]; nv = V[idx_]; } while (0)
    SU_LOAD(su0);
    for (int su = su0; su < su_end; su += stride) {
        const int b = su >> 4, h = su & 15;
#pragma unroll
        for (int p = 0; p < 8; ++p) S[p] = Sn[p];
        { const float q = __builtin_bit_cast(float, (unsigned)nq << 16), v = __builtin_bit_cast(float, (unsigned)nv << 16);
          const float f = __expf((float)__builtin_bit_cast(_Float16, nl));
          SQv[tid] = q; SFv[tid] = f; SKv[tid] = 1.0f - f; SVv[tid] = v; }
        { const int sn = (su + stride) < su_end ? (su + stride) : su; SU_LOAD(sn); }
        __syncthreads();
        f32x4 o[4];
#pragma unroll
        for (int t = 0; t < 4; ++t) {
            const f32x4 vv = *(const LAS f32x4*)(SVv + t * 128 + 4 * vc); f32x4 acc = (f32x4){0.f, 0.f, 0.f, 0.f};
#pragma unroll
            for (int p = 0; p < 8; ++p) { const int k = t * 128 + kr + 16 * p; const float f = SFv[k], kn = SKv[k], q = SQv[k]; S[p] = S[p] * f + vv * kn; acc += S[p] * q; }
            o[t] = acc;
        }
        { f32x4* op = (f32x4*)(out_hs + (size_t)su * 16384 + kr * 128 + 4 * vc);
#pragma unroll
          for (int p = 0; p < 8; ++p) __builtin_nontemporal_store(S[p], op + p * 512); }
#pragma unroll
        for (int t = 0; t < 4; ++t) { o[t].x += __shfl_xor(o[t].x, 32); o[t].y += __shfl_xor(o[t].y, 32); o[t].z += __shfl_xor(o[t].z, 32); o[t].w += __shfl_xor(o[t].w, 32); }
        if (lane < 32) {
#pragma unroll
            for (int t = 0; t < 4; ++t) *(LAS f32x4*)(RED + (wid * 4 + t) * 128 + 4 * vc) = o[t];
        }
        __syncthreads();
        if (wid < 4) {
            const int t = wid; float a0 = 0.f, a1 = 0.f;
#pragma unroll
            for (int w2 = 0; w2 < 8; ++w2) { a0 += RED[(w2 * 4 + t) * 128 + lane]; a1 += RED[(w2 * 4 + t) * 128 + lane + 64]; }
            const float ss = wave_sum(a0 * a0 + a1 * a1); const float sc = __builtin_amdgcn_rsqf(ss * (1.0f / 128.0f) + LN_EPS);
            const int row = MP + 4 * b + t; const size_t gi = ((size_t)h * MT + (size_t)row) * 128;
            const float g0 = __builtin_bit_cast(float, (unsigned)G[gi + lane] << 16), g1 = __builtin_bit_cast(float, (unsigned)G[gi + lane + 64] << 16);
            bf16* orow = O + (size_t)row * 2048 + h * 128;
            orow[lane] = (bf16)(pkbf(a0 * sc * gnorm[h * 128 + lane] * g0, 0.f) & 0xffffu); orow[lane + 64] = (bf16)(pkbf(a1 * sc * gnorm[h * 128 + lane + 64] * g1, 0.f) & 0xffffu);
        }
        __syncthreads();
    }
#undef SU_LOAD
}

__device__ __forceinline__ void hgrn_phase(const Ptrs& P, LAS unsigned char* lds, int ctr_idx) {
    const bf16* Q = (const bf16*)(P.ws + WS_Q); const bf16* LF = (const bf16*)(P.ws + WS_LF); const bf16* V = (const bf16*)(P.ws + WS_V); const bf16* G = (const bf16*)(P.ws + WS_G);
    bf16* O = (bf16*)(P.ws + WS_O);
    const int Gd = (int)gridDim.x, bx = (int)blockIdx.x;
    if (Gd >= 256) {
        constexpr int SPLIT = 15; static_assert(SPLIT % 3 == 0, "the warm-up loader's register ring has three slots");
        if (bx < 256) { const int pu = bx & 127; const bool late = bx >= 128;
            hgrn_unit(lds, Q, LF, V, G, O, P.gnorm, (pu >> 4) * 2048, pu & 15, P.out + OUT_HP + (size_t)pu * 16384, late ? SPLIT : 0, late ? 32 : SPLIT, late); }
        if (bx < 128) hgrn_sample_units(lds, Q, LF, V, G, O, P.gnorm, P.state, P.out + OUT_HS, bx, 128, 1920);
        else if (bx < 256) hgrn_sample_units(lds, Q, LF, V, G, O, P.gnorm, P.state, P.out + OUT_HS, 1920 + (bx - 128), 128, 2048);
    } else {
        const bool split = Gd > 128;
        if (!split || bx < 128) {
            for (int pu = bx; pu < 128; pu += (split ? 128 : Gd)) hgrn_unit(lds, Q, LF, V, G, O, P.gnorm, (pu >> 4) * 2048, pu & 15, P.out + OUT_HP + (size_t)pu * 16384, 0, 32, true);
        }
        if (!split || bx >= 128) { const int sid = split ? bx - 128 : bx, ns = split ? Gd - 128 : Gd; __syncthreads(); hgrn_sample_units(lds, Q, LF, V, G, O, P.gnorm, P.state, P.out + OUT_HS, sid, ns, 2048); }
    }
    (void)ctr_idx;
}

__device__ __forceinline__ void gate_phase(const Ptrs& P, LAS unsigned char* lds) {
    const int tid = threadIdx.x, lane = tid & 63, wid = __builtin_amdgcn_readfirstlane(tid >> 6);
    const int i = lane & 15, g = lane >> 4;
    constexpr int SW = 136;
    const bf16* U = (const bf16*)(P.ws + WS_U); const bf16* Vb = (const bf16*)(P.ws + WS_VB); bf16* GT = (bf16*)(P.ws + WS_O);
    const float* part = (const float*)(P.ws + WS_PART); const bf16* WSB = (const bf16*)(P.ws + WS_WSB);
    LAS unsigned char* WT = lds; LAS unsigned char* VNT = lds + 34816; LAS f32x2* STT = (LAS f32x2*)(lds + 69632); LAS unsigned char* OT = lds + 70656;
    int cur_grp = -1;
    for (int u = blockIdx.x; u < 2048; u += gridDim.x) {
        const int grp = u & 15, m0 = (u >> 4) * 128;
        float bq_[8]; v4u uzq[4];
#pragma unroll
        for (int tt = 0; tt < 8; ++tt) bq_[tt] = P.b_s[grp * 128 + 16 * tt + i];
#pragma unroll
        for (int it = 0; it < 4; ++it) { const int idx = tid + 512 * it, row = idx >> 4, c16 = idx & 15; uzq[it] = __builtin_nontemporal_load((const v4u*)(U + ((size_t)grp * MT + (size_t)(m0 + row)) * 128 + c16 * 8)); }
        __syncthreads();
        if (grp != cur_grp) {
#pragma unroll
            for (int it = 0; it < 4; ++it) { const int idx = tid + 512 * it, row = idx >> 4, c16 = idx & 15;
                *(LAS v4u*)(WT + (row * SW) * 2 + c16 * 16) = *(const v4u*)(WSB + (size_t)grp * 16384 + row * 128 + c16 * 8); }
            cur_grp = grp;
        }
        unsigned vraw[16];
#pragma unroll
        for (int r = 0; r < 16; ++r) vraw[r] = __builtin_nontemporal_load((const unsigned*)(Vb + ((size_t)grp * MT + (size_t)(m0 + 16 * wid + r)) * 128 + 2 * lane));
        if (tid < 128) { const f32x2* pr = (const f32x2*)(part + (size_t)(m0 + tid) * 64); float s = 0.f, ss = 0.f;
#pragma unroll
            for (int j = 0; j < 32; ++j) { const f32x2 p = pr[j]; s += p.x; ss += p.y; }
            const float mean = s * (1.0f / 2048.0f), var = ss * (1.0f / 2048.0f) - mean * mean; f32x2 o; o.x = mean; o.y = 1.0f / sqrtf(var + LN_EPS); STT[tid] = o; }
        __syncthreads();
        {
            const int c0 = grp * 128 + 2 * lane; const float g0 = P.lnv_g[c0], g1 = P.lnv_g[c0 + 1], b0 = P.lnv_b[c0], b1 = P.lnv_b[c0 + 1];
            float y0[16], y1[16];
#pragma unroll
            for (int r = 0; r < 16; ++r) { const int row = 16 * wid + r; const unsigned raw = vraw[r]; const f32x2 st = STT[row];
                y0[r] = (bf_lo(raw) - st.x) * st.y * g0 + b0; y1[r] = (bf_hi(raw) - st.x) * st.y * g1 + b1; }
#pragma unroll
            for (int hh = 0; hh < 2; ++hh) { v4u w0, w1;
                w0.x = pkbf(y0[8 * hh + 0], y0[8 * hh + 1]); w0.y = pkbf(y0[8 * hh + 2], y0[8 * hh + 3]); w0.z = pkbf(y0[8 * hh + 4], y0[8 * hh + 5]); w0.w = pkbf(y0[8 * hh + 6], y0[8 * hh + 7]);
                w1.x = pkbf(y1[8 * hh + 0], y1[8 * hh + 1]); w1.y = pkbf(y1[8 * hh + 2], y1[8 * hh + 3]); w1.z = pkbf(y1[8 * hh + 4], y1[8 * hh + 5]); w1.w = pkbf(y1[8 * hh + 6], y1[8 * hh + 7]);
                *(LAS v4u*)(VNT + ((2 * lane) * SW + 16 * wid + 8 * hh) * 2) = w0; *(LAS v4u*)(VNT + ((2 * lane + 1) * SW + 16 * wid + 8 * hh) * 2) = w1; }
        }
        __syncthreads();
        {
            bf16x8 av[4];
#pragma unroll
            for (int kk = 0; kk < 4; ++kk) av[kk] = *(const LAS bf16x8*)(VNT + ((16 * wid + i) * SW + 32 * kk + 8 * g) * 2);
#pragma unroll
            for (int tt = 0; tt < 8; ++tt) {
                f32x4 acc = (f32x4){0.f, 0.f, 0.f, 0.f};
#pragma unroll
                for (int kk = 0; kk < 4; ++kk) if (kk <= (tt >> 1)) { const bf16x8 b = *(const LAS bf16x8*)(WT + ((16 * tt + i) * SW + 32 * kk + 8 * g) * 2); acc = MFMA16(av[kk], b, acc); }
                const int t = 16 * tt + i; const float bias = bq_[tt];
                v2u w; w.x = pkbf(acc[0] + bias, acc[1] + bias); w.y = pkbf(acc[2] + bias, acc[3] + bias);
                *(LAS v2u*)(OT + (t * SW + 16 * wid + 4 * g) * 2) = w;
            }
        }
        __syncthreads();
#pragma unroll
        for (int it = 0; it < 4; ++it) { const int idx = tid + 512 * it, row = idx >> 4, c16 = idx & 15;
            const v4u mx = *(const LAS v4u*)(OT + (row * SW) * 2 + c16 * 16); const v4u uu = uzq[it]; v4u w;
            w.x = pkbf(bf_lo(uu.x) * bf_lo(mx.x), bf_hi(uu.x) * bf_hi(mx.x)); w.y = pkbf(bf_lo(uu.y) * bf_lo(mx.y), bf_hi(uu.y) * bf_hi(mx.y));
            w.z = pkbf(bf_lo(uu.z) * bf_lo(mx.z), bf_hi(uu.z) * bf_hi(mx.z)); w.w = pkbf(bf_lo(uu.w) * bf_lo(mx.w), bf_hi(uu.w) * bf_hi(mx.w));
            *(v4u*)(GT + (size_t)(m0 + row) * 2048 + grp * 128 + c16 * 8) = w; }
    }
    for (int sb = (int)gridDim.x - 1 - (int)blockIdx.x; sb < 128; sb += gridDim.x) {
        __syncthreads();
        const int mrow = MP + 4 * sb;
        if (tid < 4) { const f32x2* pr = (const f32x2*)(part + (size_t)(mrow + tid) * 64); float s = 0.f, ss = 0.f;
            for (int j = 0; j < 32; ++j) { const f32x2 p = pr[j]; s += p.x; ss += p.y; }
            const float mean = s * (1.0f / 2048.0f), var = ss * (1.0f / 2048.0f) - mean * mean; f32x2 o; o.x = mean; o.y = 1.0f / sqrtf(var + LN_EPS); STT[tid] = o; }
        __syncthreads();
        const int c = 4 * tid, grp = c >> 7;
        const f32x4 lg = *(const f32x4*)(P.lnv_g + c), lb = *(const f32x4*)(P.lnv_b + c);
        f32x4 vn[4];
#pragma unroll
        for (int t = 0; t < 4; ++t) { const v2u raw = *(const v2u*)(Vb + ((size_t)grp * MT + (size_t)(mrow + t)) * 128 + (c & 127)); const f32x2 st = STT[t];
            f32x4 x; x.x = bf_lo(raw.x); x.y = bf_hi(raw.x); x.z = bf_lo(raw.y); x.w = bf_hi(raw.y);
            vn[t] = (x - st.x) * st.y * lg + lb;
            __builtin_nontemporal_store(vn[t], (f32x4*)(P.out + OUT_CV + (size_t)(4 * sb + t) * 2048 + c)); }
#pragma unroll
        for (int t = 0; t < 4; ++t) { const float bias = P.b_s[grp * 128 + t]; f32x4 mx = (f32x4){bias, bias, bias, bias};
#pragma unroll
            for (int s = 0; s < 4; ++s) if (s <= t) mx += vn[s] * P.w_s[(size_t)grp * 16384 + t * 128 + s];
            const size_t off = (size_t)(mrow + t) * 2048 + c; const size_t offg = ((size_t)grp * MT + (size_t)(mrow + t)) * 128 + (c & 127); const v2u uu = *(const v2u*)(U + offg);
            v2u w; w.x = pkbf(bf_lo(uu.x) * mx.x, bf_hi(uu.x) * mx.y); w.y = pkbf(bf_lo(uu.y) * mx.z, bf_hi(uu.y) * mx.w);
            *(v2u*)(GT + off) = w; }
    }
}

struct Args { const float* in[15]; float* out; unsigned char* ws; int ph_lo, ph_hi; };
__global__ void __launch_bounds__(512, 2) mk_fwd(Args a) {
    extern __shared__ __attribute__((aligned(16))) unsigned char lds_raw[];
    LAS unsigned char* lds = (LAS unsigned char*)lds_raw;
    Ptrs P;
    P.xp = a.in[0]; P.xs = a.in[1]; P.state = a.in[2]; P.w_in_a = a.in[3]; P.lb_logits = a.in[4]; P.gnorm = a.in[5]; P.w_out_a = a.in[6]; P.w_in_b = a.in[7];
    P.lnv_g = a.in[8]; P.lnv_b = a.in[9]; P.w_s = a.in[10]; P.b_s = a.in[11]; P.w_out_b = a.in[12]; P.ln_g = a.in[13]; P.ln_b = a.in[14]; P.out = a.out; P.ws = a.ws;
    const int lo = a.ph_lo, hi = a.ph_hi;
    volatile LAS unsigned* bst = (volatile LAS unsigned*)(lds + 131072 + 64);
    if (threadIdx.x == 0) { bst[0] = 0u; bst[1] = 0u; }
    __syncthreads();
    XcdBarrier bar = xcd_barrier_post((unsigned*)(P.ws + WS_BAR), bst);
    if (lo < 0) cg::this_grid().sync();
#define IN(k) (lo <= (k) && (k) < hi)
#define SEAM(k) do { if (IN(k) && IN((k) + 1)) { xcd_barrier(bar); } } while (0)
#ifndef PROBE_REP
#define PROBE_REP -1
#endif
#define REP(k) for (int rep_ = 0; rep_ < ((PROBE_REP == (k)) ? 2 : 1); ++rep_, (void)((PROBE_REP == (k) && rep_ == 1) ? (cg::this_grid().sync(), 0) : 0))
    const int G = (int)gridDim.x, c = (int)blockIdx.x;
    if (IN(0)) REP(0) { p0_prologue(P, lds); }
    SEAM(0);
    if (IN(1)) REP(1) {
        pg8::Gemm g{(const bf16*)(P.ws + WS_XB), (const bf16*)(P.ws + WS_WINA), MT, 4 * EA, DM}; pg8::StaticOrder S; S.init(MT, 4 * EA, G, c);
        pg8::EpiHgrnIn E{(bf16*)(P.ws + WS_Q), (const float*)(P.ws + WS_LB)};
        pg8::gemm_phase<pg8::EpiHgrnIn, pg8::StaticOrder, true, true>(lds, g, S, E);
        if (G >= 128) {
            const int nfull = S.nwg / G, nlast = S.nwg - nfull * G;
            __syncthreads();
            if (nlast == 0 || nlast >= G) p0_late_weights(P, lds, c, G);
            else if (c >= nlast) p0_late_weights(P, lds, c - nlast, G - nlast);
        }
    }
    SEAM(1);
    if (IN(2)) REP(2) { hgrn_phase(P, lds, rep_); }
    SEAM(2);
    if (IN(3)) REP(3) {
        const int Mo = G > 32 ? MP : MT;
        pg8::Gemm g{(const bf16*)(P.ws + WS_O), (const bf16*)(P.ws + WS_WOUTA), Mo, DM, EA}; pg8::StaticOrder S; S.init(Mo, DM, G, c);
        pg8::EpiBf16Plain E{(bf16*)(P.ws + WS_D), DM};
        pg8::gemm_phase<pg8::EpiBf16Plain, pg8::StaticOrder, true, true>(lds, g, S, E);
    }
    SEAM(3);
    if (IN(4)) REP(4) { ln_phase<false>(P, lds, 0); }
    SEAM(4);
    if (IN(5)) REP(5) {
        pg8::Gemm g{(const bf16*)(P.ws + WS_XB), (const bf16*)(P.ws + WS_WINB), MT, 3 * EA, DM}; pg8::StaticOrder S; S.init(MT, 3 * EA, G, c);
        pg8::EpiGmlpIn E{(bf16*)(P.ws + WS_U), (float*)(P.ws + WS_PART)};
        pg8::gemm_phase<pg8::EpiGmlpIn, pg8::StaticOrder, true, true>(lds, g, S, E);
    }
    SEAM(5);
    if (IN(6)) REP(6) { gate_phase(P, lds); }
    SEAM(6);
    if (IN(7)) REP(7) {
        const int Mo = G > 32 ? MP : MT;
        pg8::Gemm g{(const bf16*)(P.ws + WS_O), (const bf16*)(P.ws + WS_WOUTB), Mo, DM, EA}; pg8::StaticOrder S; S.init(Mo, DM, G, c);
        pg8::EpiBf16Plain E{(bf16*)(P.ws + WS_D), DM};
        pg8::gemm_phase<pg8::EpiBf16Plain, pg8::StaticOrder, true, true>(lds, g, S, E);
    }
    SEAM(7);
    if (IN(8)) REP(8) { ln_phase<true>(P, lds, 1); }
#undef IN
#undef SEAM
}

extern "C" void kernel_launch(void* const* d_in, const int* in_sizes, int n_in, void* d_out, int out_size, void* d_ws, size_t ws_size, hipStream_t stream) {
    static int grid = 0;
    if (grid == 0) {
        if (n_in != 15 || ws_size < WS_END || out_size != 54001664) { fprintf(stderr, "kernel_launch: unexpected problem (n_in %d, out %d, ws %zu)\n", n_in, out_size, ws_size); grid = -1; return; }
        int dev = 0, cus = 0, per_cu = 0;
        if (hipGetDevice(&dev) != hipSuccess || hipDeviceGetAttribute(&cus, hipDeviceAttributeMultiprocessorCount, dev) != hipSuccess) { grid = -1; return; }
        if (hipFuncSetAttribute((const void*)mk_fwd, hipFuncAttributeMaxDynamicSharedMemorySize, LDS_BYTES) != hipSuccess) { fprintf(stderr, "kernel_launch: hipFuncSetAttribute failed\n"); grid = -1; return; }
        if (hipOccupancyMaxActiveBlocksPerMultiprocessor(&per_cu, (const void*)mk_fwd, 512, LDS_BYTES) != hipSuccess || per_cu < 1) { fprintf(stderr, "kernel_launch: occupancy query gave %d\n", per_cu); (void)hipGetLastError(); per_cu = 1; }
        grid = cus * 1;
        (void)in_sizes;
    }
    if (grid < 0) return;
    Args a{};
    for (int i = 0; i < 15; ++i) a.in[i] = (const float*)d_in[i];
    a.out = (float*)d_out; a.ws = (unsigned char*)d_ws;
#if MK_MULTI
    for (int p = 0; p < NPHASE; ++p) { a.ph_lo = p; a.ph_hi = p + 1; hipLaunchKernelGGL(mk_fwd, dim3(grid), dim3(512), LDS_BYTES, stream, a); }
#else
    a.ph_lo = 0; a.ph_hi = NPHASE;
    if (hipMemsetAsync((char*)d_ws + WS_BAR, 0, XCD_BAR_WORDS * 4, stream) != hipSuccess) { fprintf(stderr, "kernel_launch: memset of the barrier words failed\n"); return; }
    void* args[] = {&a};
    hipError_t e = hipLaunchCooperativeKernel((const void*)mk_fwd, dim3(grid), dim3(512), args, LDS_BYTES, stream);
    if (e != hipSuccess) fprintf(stderr, "kernel_launch: cooperative launch failed: %s (grid %d)\n", hipGetErrorString(e), grid);
#endif
}
```

```cpp
#include <hip/hip_runtime.h>
#include <hip/hip_cooperative_groups.h>
#include <cstdio>
#include <cstdint>
namespace cg = cooperative_groups;
#define MK_MULTI 0
namespace pg8 {
#define PG8_LAS __attribute__((address_space(3)))
typedef unsigned short bf16_t;
typedef short bf16x8 __attribute__((ext_vector_type(8)));
typedef float f32x4 __attribute__((ext_vector_type(4)));
typedef unsigned u32x4 __attribute__((ext_vector_type(4)));
constexpr int BM = 256, BK = 64, HALF = 128, HTB = HALF * BK * 2  , STAGE_BYTES = 8 * HTB, NXCD = 8, WGM = 8;

__host__ __device__ __forceinline__ int lds_byte(int r, int c) { const int st = (r >> 4) * 2 + (c >> 5), rr = r & 15, cc = c & 31, ob = rr * 64 + cc * 2; return st * 1024 + (ob ^ (((ob >> 9) & 1) << 5)); }
__host__ __device__ __forceinline__ void stage_rc(int b, int& R, int& C) { const int st = b / 1024, sb = b % 1024, swz = sb ^ (((sb >> 9) & 1) << 5); R = (st >> 1) * 16 + swz / 64; C = (st & 1) * 32 + (swz % 64) / 2; }
__host__ __device__ __forceinline__ int perm32(int rho) { const int n = rho >> 4, i = rho & 15; return 8 * (i >> 2) + 4 * n + (i & 3); }

struct Unit { int pm, pn; };
struct Gemm { const bf16_t* A; const bf16_t* Bt; int M, N, K; int nt = 0; };

struct StaticOrder {
    int nM, nN, nwg, G, c;
    __host__ __device__ void init(int M, int N, int G_, int c_) { nM = M / BM; nN = N / BM; nwg = nM * nN; G = G_; c = c_; }
    __host__ __device__ bool next(int i, Unit& u) const {
        const long L = (long)i * G + c; if (L >= nwg) return false;
        int wgid = (int)L; { const int q = nwg / NXCD, r = nwg % NXCD, xcd = wgid % NXCD, off = wgid / NXCD; wgid = (xcd < r ? xcd * (q + 1) : r * (q + 1) + (xcd - r) * q) + off; }
        const int nig = WGM * nN, gid = wgid / nig, fm = gid * WGM, gsz = (nM - fm) < WGM ? (nM - fm) : WGM;
        u.pm = fm + ((wgid % nig) % gsz); u.pn = (wgid % nig) / gsz; return true;
    }
    __device__ __forceinline__ void a_ready(const Unit&) const {}
    __device__ __forceinline__ void done(const Unit&) const {}
};

typedef float cvt_f32x2 __attribute__((ext_vector_type(2)));
typedef __bf16 cvt_bf16x2 __attribute__((ext_vector_type(2)));
__device__ __forceinline__ unsigned cvt_pk_bf16(float lo, float hi) { cvt_f32x2 v; v.x = lo; v.y = hi; const cvt_bf16x2 b = __builtin_convertvector(v, cvt_bf16x2); return __builtin_bit_cast(unsigned, b); }
typedef unsigned u32x2 __attribute__((ext_vector_type(2)));
constexpr size_t MROWS = 16896;
constexpr size_t SEC_STRIDE = (size_t)16896 * 2048;
typedef float f32x2 __attribute__((ext_vector_type(2)));
typedef _Float16 f16x2 __attribute__((ext_vector_type(2)));
__device__ __forceinline__ float silu_f(float x) { return x * __builtin_amdgcn_rcpf(1.0f + __expf(-x)); }
__device__ __forceinline__ float gelu_tanh_f(float x) { const float u = 1.5957691216057308f * (x + 0.044715f * x * x * x); return x * __builtin_amdgcn_rcpf(1.0f + __expf(-u)); }
__device__ __forceinline__ unsigned pk_f16(float lo, float hi) { f16x2 p; p.x = (_Float16)lo; p.y = (_Float16)hi; return __builtin_bit_cast(unsigned, p); }

struct EpiHgrnIn {
    static constexpr bool PERM = true, AFTER_DRAIN = false;
    bf16_t* B0; const float* lb;
    __device__ __forceinline__ void operator()(const f32x4 (&acc)[2][2][4][2], const Unit& u, int wr, int wc, int fr, int fq) const {
        const int sec = u.pn >> 3;
        const int row0 = u.pm * BM + wr * 64 + fr, col0 = (u.pn & 7) * BM + wc * 32 + 8 * fq;
        bf16_t* base = B0 + (size_t)sec * SEC_STRIDE;
        f32x4 l0[2], l1[2];
#pragma unroll
        for (int bj = 0; bj < 2; ++bj) { l0[bj] = (f32x4){0.f, 0.f, 0.f, 0.f}; l1[bj] = l0[bj]; }
        if (sec == 1) {
#pragma unroll
            for (int bj = 0; bj < 2; ++bj) { l0[bj] = *(const f32x4*)(lb + col0 + bj * HALF); l1[bj] = *(const f32x4*)(lb + col0 + bj * HALF + 4); }
        }
#pragma unroll
        for (int ai = 0; ai < 2; ++ai)
#pragma unroll
            for (int m = 0; m < 4; ++m) { bf16_t* rowp = base + ((size_t)((u.pn & 7) * 2) * MROWS + (size_t)(row0 + ai * HALF + m * 16)) * 128 + wc * 32 + 8 * fq;
#pragma unroll
                for (int bj = 0; bj < 2; ++bj) { f32x4 v0 = acc[ai][bj][m][0], v1 = acc[ai][bj][m][1]; u32x4 w;
                    if (sec == 1) {
#pragma unroll
                        for (int j = 0; j < 4; ++j) { const float s0 = __builtin_amdgcn_rcpf(1.0f + __expf(-v0[j])), s1 = __builtin_amdgcn_rcpf(1.0f + __expf(-v1[j]));
                            v0[j] = __logf(l0[bj][j] + (1.0f - l0[bj][j]) * s0); v1[j] = __logf(l1[bj][j] + (1.0f - l1[bj][j]) * s1); }
                        w.x = pk_f16(v0[0], v0[1]); w.y = pk_f16(v0[2], v0[3]); w.z = pk_f16(v1[0], v1[1]); w.w = pk_f16(v1[2], v1[3]);
                    } else {
                        if (sec != 2) {
#pragma unroll
                            for (int j = 0; j < 4; ++j) { v0[j] = silu_f(v0[j]); v1[j] = silu_f(v1[j]); } }
                        w.x = cvt_pk_bf16(v0[0], v0[1]); w.y = cvt_pk_bf16(v0[2], v0[3]); w.z = cvt_pk_bf16(v1[0], v1[1]); w.w = cvt_pk_bf16(v1[2], v1[3]);
                    }
                    *(u32x4*)(rowp + (size_t)bj * MROWS * 128) = w; } }
    }
};
struct EpiGmlpIn {
    static constexpr bool PERM = true, AFTER_DRAIN = false;
    bf16_t* B0; float* part;
    __device__ __forceinline__ void operator()(const f32x4 (&acc)[2][2][4][2], const Unit& u, int wr, int wc, int fr, int fq) const {
        const int row0 = u.pm * BM + wr * 64 + fr;
        if (u.pn < 16) {
#pragma unroll
            for (int ai = 0; ai < 2; ++ai)
#pragma unroll
                for (int m = 0; m < 4; ++m) { const int row = row0 + ai * HALF + m * 16; bf16_t* rowp = B0 + ((size_t)u.pn * MROWS + (size_t)row) * 128 + wc * 32 + 8 * fq;
                    f32x4 v0 = acc[ai][0][m][0], v1 = acc[ai][0][m][1]; const f32x4 z0 = acc[ai][1][m][0], z1 = acc[ai][1][m][1]; u32x4 w;
#pragma unroll
                    for (int j = 0; j < 4; ++j) { v0[j] = gelu_tanh_f(v0[j]) * silu_f(z0[j]); v1[j] = gelu_tanh_f(v1[j]) * silu_f(z1[j]); }
                    w.x = cvt_pk_bf16(v0[0], v0[1]); w.y = cvt_pk_bf16(v0[2], v0[3]); w.z = cvt_pk_bf16(v1[0], v1[1]); w.w = cvt_pk_bf16(v1[2], v1[3]);
                    *(u32x4*)rowp = w; }
        } else {
            const int g0 = (u.pn - 16) * 2;
#pragma unroll
            for (int ai = 0; ai < 2; ++ai)
#pragma unroll
                for (int m = 0; m < 4; ++m) { const int row = row0 + ai * HALF + m * 16; bf16_t* rowp = B0 + SEC_STRIDE + ((size_t)g0 * MROWS + (size_t)row) * 128 + wc * 32 + 8 * fq; float s = 0.f, ss = 0.f;
#pragma unroll
                    for (int bj = 0; bj < 2; ++bj) { f32x4 v0 = acc[ai][bj][m][0], v1 = acc[ai][bj][m][1]; u32x4 w;
#pragma unroll
                        for (int j = 0; j < 4; ++j) { v0[j] = gelu_tanh_f(v0[j]); v1[j] = gelu_tanh_f(v1[j]); s += v0[j] + v1[j]; ss += v0[j] * v0[j] + v1[j] * v1[j]; }
                        w.x = cvt_pk_bf16(v0[0], v0[1]); w.y = cvt_pk_bf16(v0[2], v0[3]); w.z = cvt_pk_bf16(v1[0], v1[1]); w.w = cvt_pk_bf16(v1[2], v1[3]);
                        *(u32x4*)(rowp + (size_t)bj * MROWS * 128) = w; }
                    s += __shfl_xor(s, 16); s += __shfl_xor(s, 32); ss += __shfl_xor(ss, 16); ss += __shfl_xor(ss, 32);
                    if (fq == 0) { f32x2 o; o.x = s; o.y = ss; *(f32x2*)(part + (size_t)row * 64 + ((u.pn - 16) * 4 + wc) * 2) = o; } }
        }
    }
};
struct EpiF32 {
    static constexpr bool PERM = false, AFTER_DRAIN = false;
    float* C; int ldc;
    __device__ __forceinline__ void operator()(const f32x4 (&acc)[2][2][4][2], const Unit& u, int wr, int wc, int fr, int fq) const {
        const int row0 = u.pm * BM + wr * 64 + fr, col0 = u.pn * BM + wc * 32 + 4 * fq;
#pragma unroll
        for (int ai = 0; ai < 2; ++ai)
#pragma unroll
            for (int m = 0; m < 4; ++m) { float* rowp = C + (size_t)(row0 + ai * HALF + m * 16) * ldc + col0;
#pragma unroll
                for (int bj = 0; bj < 2; ++bj)
#pragma unroll
                    for (int n = 0; n < 2; ++n) *(f32x4*)(rowp + bj * HALF + n * 16) = acc[ai][bj][m][n]; }
    }
};
struct EpiBf16Plain {
    static constexpr bool PERM = true, AFTER_DRAIN = false;
    bf16_t* C; int ldc;
    __device__ __forceinline__ void operator()(const f32x4 (&acc)[2][2][4][2], const Unit& u, int wr, int wc, int fr, int fq) const {
        const int row0 = u.pm * BM + wr * 64 + fr, col0 = u.pn * BM + wc * 32 + 8 * fq;
#pragma unroll
        for (int ai = 0; ai < 2; ++ai)
#pragma unroll
            for (int m = 0; m < 4; ++m) { bf16_t* rowp = C + (size_t)(row0 + ai * HALF + m * 16) * ldc + col0;
#pragma unroll
                for (int bj = 0; bj < 2; ++bj) { const f32x4 v0 = acc[ai][bj][m][0], v1 = acc[ai][bj][m][1]; u32x4 w;
                    w.x = cvt_pk_bf16(v0[0], v0[1]); w.y = cvt_pk_bf16(v0[2], v0[3]); w.z = cvt_pk_bf16(v1[0], v1[1]); w.w = cvt_pk_bf16(v1[2], v1[3]);
                    *(u32x4*)(rowp + bj * HALF) = w; } }
    }
};
template <class Epi, class Sched, bool ALIGN_EPI = false, bool SP2 = false>
__device__ __forceinline__ void gemm_phase(PG8_LAS unsigned char* lds, const Gemm g, const Sched& S, const Epi& E) {
    const int tid = threadIdx.x, wid = __builtin_amdgcn_readfirstlane(tid >> 6), lane = tid & 63, wr = wid >> 2, wc = wid & 3, fr = lane & 15, fq = lane >> 4;
    const int K = g.K, nt = g.nt ? g.nt : K / BK;
    unsigned voffA[2], voffB[2];
#pragma unroll
    for (int i = 0; i < 2; ++i) { int R, C; stage_rc(tid * 16 + i * 8192, R, C); const int Rb = Epi::PERM ? ((R & ~31) + perm32(R & 31)) : R;
        voffA[i] = (unsigned)(R * K + C) * 2u; voffB[i] = (unsigned)(Rb * K + C) * 2u; }
    const size_t kstep = (size_t)(BK * 2);
    const size_t hstep = (size_t)HALF * K * 2;
    const size_t tstep = 2 * hstep;
    const unsigned ldsw = (unsigned)wid * 1024u;
    const int aoff = lds_byte(wr * 64 + fr, fq * 8), boff = lds_byte(wc * 32 + fr, fq * 8);
#define PG8_SA(b, h) (((b) * 2 + (h)) * HTB)
#define PG8_SB(b, h) ((4 + (b) * 2 + (h)) * HTB)
#define PG8_STAGE(bufoff, gbase, voff) do { _Pragma("unroll") for (int _i = 0; _i < 2; ++_i) \
        __builtin_amdgcn_global_load_lds((const unsigned*)((const char*)(gbase) + (voff)[_i]), (PG8_LAS unsigned*)(lds + (bufoff) + ldsw + _i * 8192), 16, 0, 0); } while (0)
#define PG8_LDA(dst, b, h) do { _Pragma("unroll") for (int m = 0; m < 4; ++m) _Pragma("unroll") for (int k = 0; k < 2; ++k) dst[m][k] = *(const PG8_LAS bf16x8*)(lds + PG8_SA(b, h) + aoff + m * 2048 + k * 1024); } while (0)
#define PG8_LDB(dst, b, h) do { _Pragma("unroll") for (int n = 0; n < 2; ++n) _Pragma("unroll") for (int k = 0; k < 2; ++k) dst[n][k] = *(const PG8_LAS bf16x8*)(lds + PG8_SB(b, h) + boff + n * 2048 + k * 1024); } while (0)
#define PG8_MMA(ai, bj, At, Bt) do { __builtin_amdgcn_s_setprio(1); _Pragma("unroll") for (int m = 0; m < 4; ++m) _Pragma("unroll") for (int n = 0; n < 2; ++n) _Pragma("unroll") for (int k = 0; k < 2; ++k) \
        acc[ai][bj][m][n] = __builtin_amdgcn_mfma_f32_16x16x32_bf16(Bt[n][k], At[m][k], acc[ai][bj][m][n], 0, 0, 0); __builtin_amdgcn_s_setprio(0); } while (0)
#define PG8_WAIT_V(n) asm volatile("s_waitcnt vmcnt(" #n ")" ::: "memory")
#define PG8_WAIT_L(n) asm volatile("s_waitcnt lgkmcnt(" #n ")" ::: "memory")
#define PG8_BAR __builtin_amdgcn_s_barrier()
#define PG8_SCHED __builtin_amdgcn_sched_barrier(0)
    Unit cur, nxt; int ui = 0;
    if (!S.next(0, cur)) return;
    f32x4 acc[2][2][4][2];
#pragma unroll
    for (int a = 0; a < 2; ++a)
#pragma unroll
        for (int b = 0; b < 2; ++b)
#pragma unroll
            for (int m = 0; m < 4; ++m)
#pragma unroll
                for (int n = 0; n < 2; ++n) acc[a][b][m][n] = (f32x4){0.f, 0.f, 0.f, 0.f};
    bf16x8 At[4][2], B0[2][2], B1[2][2];
    const char* cA = (const char*)g.A + (size_t)cur.pm * tstep; const char* cB = (const char*)g.Bt + (size_t)cur.pn * tstep;
    S.a_ready(cur);
    if constexpr (SP2) {
        PG8_STAGE(PG8_SB(0, 0), cB, voffB); PG8_STAGE(PG8_SB(0, 1), cB + hstep, voffB); PG8_STAGE(PG8_SA(0, 0), cA, voffA); PG8_STAGE(PG8_SA(0, 1), cA + hstep, voffA);
        if (wr == 1) PG8_BAR;
        PG8_WAIT_V(2); PG8_BAR;
        PG8_STAGE(PG8_SB(1, 0), cB + kstep, voffB); PG8_STAGE(PG8_SA(1, 0), cA + kstep, voffA); PG8_STAGE(PG8_SB(1, 1), cB + hstep + kstep, voffB);
        PG8_WAIT_V(6); PG8_BAR;
    } else {
        PG8_STAGE(PG8_SB(0, 0), cB, voffB); PG8_STAGE(PG8_SA(0, 0), cA, voffA); PG8_STAGE(PG8_SB(0, 1), cB + hstep, voffB); PG8_STAGE(PG8_SA(0, 1), cA + hstep, voffA);
        if (wr == 1) PG8_BAR;
        PG8_WAIT_V(4); PG8_BAR;
        PG8_STAGE(PG8_SB(1, 0), cB + kstep, voffB); PG8_STAGE(PG8_SA(1, 0), cA + kstep, voffA); PG8_STAGE(PG8_SB(1, 1), cB + hstep + kstep, voffB);
        PG8_WAIT_V(6); PG8_BAR;
    }
    for (;;) {
        const bool has_next = S.next(ui + 1, nxt);
        const char* nA = has_next ? (const char*)g.A + (size_t)nxt.pm * tstep : cA; const char* nB = has_next ? (const char*)g.Bt + (size_t)nxt.pn * tstep : cB;
        for (int t = 0; t < nt; t += 2) {
            const bool last = (t == nt - 2);
            const char* a1 = cA + (size_t)(t + 1) * kstep;
            const char* a2 = last ? nA : cA + (size_t)(t + 2) * kstep; const char* b2 = last ? nB : cB + (size_t)(t + 2) * kstep;
            const char* a3 = a2 + kstep; const char* b3 = b2 + kstep;
            if (last && has_next) S.a_ready(nxt);
            if constexpr (SP2) {
            PG8_LDB(B0, 0, 0); PG8_LDB(B1, 0, 1); PG8_SCHED; PG8_LDA(At, 0, 0); PG8_STAGE(PG8_SA(1, 1), a1 + hstep, voffA);
            PG8_WAIT_V(8); PG8_WAIT_L(0); PG8_BAR; PG8_MMA(0, 0, At, B0); PG8_MMA(0, 1, At, B1); PG8_BAR; PG8_SCHED;
            PG8_LDA(At, 0, 1); PG8_STAGE(PG8_SB(0, 0), b2, voffB); PG8_STAGE(PG8_SB(0, 1), b2 + hstep, voffB); PG8_STAGE(PG8_SA(0, 0), a2, voffA);
            PG8_WAIT_V(8); PG8_WAIT_L(0); PG8_BAR; PG8_MMA(1, 0, At, B0); PG8_MMA(1, 1, At, B1); PG8_BAR; PG8_SCHED;
            PG8_LDB(B0, 1, 0); PG8_LDB(B1, 1, 1); PG8_SCHED; PG8_LDA(At, 1, 0); PG8_STAGE(PG8_SA(0, 1), a2 + hstep, voffA);
            PG8_WAIT_V(8); PG8_WAIT_L(0); PG8_BAR; PG8_MMA(0, 0, At, B0); PG8_MMA(0, 1, At, B1); PG8_BAR; PG8_SCHED;
            PG8_LDA(At, 1, 1); PG8_STAGE(PG8_SB(1, 0), b3, voffB); PG8_STAGE(PG8_SB(1, 1), b3 + hstep, voffB); PG8_STAGE(PG8_SA(1, 0), a3, voffA);
            PG8_WAIT_V(8); PG8_WAIT_L(0); PG8_BAR; PG8_MMA(1, 0, At, B0); PG8_MMA(1, 1, At, B1); PG8_BAR; PG8_SCHED;
            } else {
            PG8_LDB(B0, 0, 0); PG8_SCHED; PG8_LDA(At, 0, 0); PG8_STAGE(PG8_SA(1, 1), a1 + hstep, voffA);
            PG8_WAIT_L(8); PG8_BAR; PG8_WAIT_L(0); PG8_MMA(0, 0, At, B0); PG8_BAR; PG8_SCHED;
            PG8_LDB(B1, 0, 1); PG8_STAGE(PG8_SB(0, 0), b2, voffB);
            PG8_BAR; PG8_WAIT_L(0); PG8_MMA(0, 1, At, B1); PG8_BAR;
            PG8_LDA(At, 0, 1); PG8_STAGE(PG8_SA(0, 0), a2, voffA);
            PG8_BAR; PG8_WAIT_L(0); PG8_MMA(1, 0, At, B0); PG8_BAR; PG8_SCHED;
            PG8_STAGE(PG8_SB(0, 1), b2 + hstep, voffB);
            PG8_WAIT_V(6); PG8_BAR; PG8_MMA(1, 1, At, B1); PG8_BAR;
            PG8_LDB(B0, 1, 0); PG8_SCHED; PG8_LDA(At, 1, 0); PG8_STAGE(PG8_SA(0, 1), a2 + hstep, voffA);
            PG8_WAIT_L(8); PG8_BAR; PG8_WAIT_L(0); PG8_MMA(0, 0, At, B0); PG8_BAR; PG8_SCHED;
            PG8_LDB(B1, 1, 1); PG8_STAGE(PG8_SB(1, 0), b3, voffB);
            PG8_BAR; PG8_WAIT_L(0); PG8_MMA(0, 1, At, B1); PG8_BAR;
            PG8_LDA(At, 1, 1); PG8_STAGE(PG8_SA(1, 0), a3, voffA);
            PG8_BAR; PG8_WAIT_L(0); PG8_MMA(1, 0, At, B0); PG8_BAR; PG8_SCHED;
            PG8_STAGE(PG8_SB(1, 1), b3 + hstep, voffB);
            PG8_WAIT_V(6); PG8_BAR; PG8_MMA(1, 1, At, B1); PG8_BAR;
            }
        }
        if constexpr (ALIGN_EPI) { if (wr == 0) PG8_BAR; }
        if constexpr (!Epi::AFTER_DRAIN) { E(acc, cur, wr, wc, fr, fq); S.done(cur); }
        if (!has_next) break;
#pragma unroll
        for (int a = 0; a < 2; ++a)
#pragma unroll
            for (int b = 0; b < 2; ++b)
#pragma unroll
                for (int m = 0; m < 4; ++m)
#pragma unroll
                    for (int n = 0; n < 2; ++n) acc[a][b][m][n] = (f32x4){0.f, 0.f, 0.f, 0.f};
        cur = nxt; cA = nA; cB = nB; ++ui;
        if constexpr (ALIGN_EPI) { if (wr == 1) PG8_BAR; }
    }
    PG8_WAIT_V(0);
    if constexpr (!ALIGN_EPI) { if (wr == 0) PG8_BAR; }
    PG8_BAR;
    if constexpr (Epi::AFTER_DRAIN) { E.fused(acc, cur, wr, wc, fr, fq, lds, wid, lane); S.done(cur); }
#undef PG8_SA
#undef PG8_SB
#undef PG8_STAGE
#undef PG8_LDA
#undef PG8_LDB
#undef PG8_MMA
#undef PG8_WAIT_V
#undef PG8_WAIT_L
#undef PG8_BAR
#undef PG8_SCHED
}
}

#define GAS __attribute__((address_space(1)))
#define LAS __attribute__((address_space(3)))
typedef unsigned short bf16;
typedef unsigned v4u __attribute__((ext_vector_type(4)));
typedef unsigned v2u __attribute__((ext_vector_type(2)));
typedef float f32x4 __attribute__((ext_vector_type(4)));
typedef float f32x2 __attribute__((ext_vector_type(2)));
typedef short bf16x8 __attribute__((ext_vector_type(8)));
typedef _Float16 f16x2 __attribute__((ext_vector_type(2)));

#ifndef MK_MULTI
#define MK_MULTI 0
#endif
constexpr int NPHASE = 9;
constexpr int MP = 16384, MS = 512, MT = MP + MS, DM = 1024, EA = 2048;
constexpr float LN_EPS = 1e-5f, ALPHA = 1.4142135623730951f;
constexpr size_t MiB = 1u << 20;
constexpr size_t WS_CTL = 0, WS_LB = 64 * 1024, WS_WSB = 1 * MiB, WS_WINA = 2 * MiB, WS_WOUTA = 18 * MiB, WS_WINB = 22 * MiB, WS_WOUTB = 34 * MiB, WS_PART = 38 * MiB;
constexpr size_t WS_XB = 44 * MiB;
constexpr size_t WS_Q = 78 * MiB, WS_LF = 144 * MiB, WS_V = 210 * MiB, WS_G = 276 * MiB, WS_O = 342 * MiB, WS_D = 408 * MiB, WS_DP = 474 * MiB, WS_END = 482 * MiB;
constexpr size_t WS_U = WS_Q, WS_VB = WS_LF, WS_Z = WS_V, WS_H1F = WS_G;
static_assert(WS_LF - WS_Q == pg8::SEC_STRIDE * 2 && WS_V - WS_LF == pg8::SEC_STRIDE * 2 && WS_G - WS_V == pg8::SEC_STRIDE * 2 && WS_O - WS_G == pg8::SEC_STRIDE * 2, "section stride");
constexpr size_t OUT_Y = 0, OUT_HP = 17301504, OUT_HS = 19398656, OUT_CV = 52953088;
constexpr int LDS_BYTES = 131072 + 1024;
constexpr size_t WS_BAR = 32 * 1024;

__device__ __forceinline__ unsigned pkbf(float lo, float hi) { return pg8::cvt_pk_bf16(lo, hi); }
__device__ __forceinline__ float bf_lo(unsigned w) { return __builtin_bit_cast(float, w << 16); }
__device__ __forceinline__ float bf_hi(unsigned w) { return __builtin_bit_cast(float, w & 0xffff0000u); }
__device__ __forceinline__ float wave_sum(float v) {
#pragma unroll
    for (int o = 1; o < 64; o <<= 1) v += __shfl_xor(v, o);
    return v;
}
#define LDS_WAIT() asm volatile("s_waitcnt lgkmcnt(0)" ::: "memory")

__device__ __forceinline__ void p0_transpose_item(const float* W, int K, int N, bf16* WT, LAS float* scr, int item, int lane, bool gmlp = false) {
    const int nblk = N / 32, kb = item / nblk, nb = item % nblk, k0 = 64 * kb, nd = 32 * nb;
    int n0 = nd;
    if (gmlp) { if (nd < 4096) { const int tile = nd >> 8, half = (nd >> 7) & 1, cc = nd & 127; n0 = (half ? 4096 : 0) + tile * 128 + cc; } else n0 = 2048 + (nd - 4096); }
    float wv[32];
#pragma unroll
    for (int i = 0; i < 32; ++i) { const int kk = 2 * i + (lane >> 5); wv[i] = __builtin_nontemporal_load(W + (size_t)(k0 + kk) * N + n0 + (lane & 31)); }
#pragma unroll
    for (int i = 0; i < 32; ++i) { const int kk = 2 * i + (lane >> 5); scr[kk * 33 + (lane & 31)] = wv[i]; }
    LDS_WAIT(); asm volatile("" ::: "memory");
    const int c = lane & 7;
#pragma unroll
    for (int j = 0; j < 4; ++j) { const int n = (lane >> 3) + 8 * j; const LAS float* s = scr + (8 * c) * 33 + n;
        v4u o; o.x = pkbf(s[0 * 33], s[1 * 33]); o.y = pkbf(s[2 * 33], s[3 * 33]); o.z = pkbf(s[4 * 33], s[5 * 33]); o.w = pkbf(s[6 * 33], s[7 * 33]);
        *(v4u*)(WT + (size_t)(nd + n) * K + k0 + 8 * c) = o; }
    LDS_WAIT(); asm volatile("" ::: "memory");
}

typedef GAS unsigned gu32;
#define XB_TMO      128
#define XB_XCNT(j)  (256  + 64 * (j))
#define XB_XSUB(j)  (1280 + 64 * (j))
#define XB_XGEN(j)  (2304 + 64 * (j))
#define XB_TOP      3328
#define XB_TOPGEN   3392
#define XCD_BAR_WORDS 3456
#define XB_SPIN_CAP (1u << 18)

__device__ __forceinline__ unsigned xb_ld(unsigned* p)              { return __hip_atomic_load(p, __ATOMIC_RELAXED, __HIP_MEMORY_SCOPE_AGENT); }
__device__ __forceinline__ unsigned xb_add(unsigned* p, unsigned v) { return __hip_atomic_fetch_add(p, v, __ATOMIC_RELAXED, __HIP_MEMORY_SCOPE_AGENT); }
__device__ __forceinline__ unsigned xb_xcc_id() { return (unsigned)__builtin_amdgcn_s_getreg((3 << 11) | 20) & 0xFu; }
#define XB_SPIN(cond, bar) do { unsigned _sp = 0; while (cond) { __builtin_amdgcn_s_sleep(1); \
    if ((++_sp & 255u) == 0u) { if (xb_ld(&(bar)[XB_TMO])) break; if (_sp > XB_SPIN_CAP) { atomicAdd(&(bar)[XB_TMO], 1u); break; } } } } while (0)

struct XcdBarrier {
    unsigned* bar; unsigned x;
    volatile LAS unsigned* st;
};

__device__ __forceinline__ XcdBarrier xcd_barrier_post(unsigned* bar, volatile LAS unsigned* st) {
    XcdBarrier b; b.bar = bar; b.x = xb_xcc_id(); b.st = st;
    if (threadIdx.x == 0) (void)xb_add(&bar[XB_XCNT(b.x)], 1u);
    return b;
}
__device__ __forceinline__ void xcd_barrier_complete(unsigned* bar, unsigned x, unsigned& nloc, unsigned& nx) {
    const unsigned G = gridDim.x * gridDim.y * gridDim.z;
    unsigned sum, cnt, mine, sp = 0u;
    for (;;) {
        sum = 0u; cnt = 0u; mine = 0u;
#pragma unroll
        for (unsigned j = 0; j < 16; ++j) { const unsigned c = xb_ld(&bar[XB_XCNT(j)]); sum += c; cnt += (c > 0u) ? 1u : 0u; mine = (j == x) ? c : mine; }
        if (sum == G) break;
        __builtin_amdgcn_s_sleep(1);
        if ((++sp & 255u) == 0u) { if (xb_ld(&bar[XB_TMO])) break; if (sp > XB_SPIN_CAP) { atomicAdd(&bar[XB_TMO], 1u); break; } }
    }
    nloc = mine > 0u ? mine : 1u; nx = cnt > 0u ? cnt : 1u;
}

__device__ __forceinline__ void xcd_barrier(const XcdBarrier& b) {
    asm volatile("s_waitcnt vmcnt(0)" ::: "memory");
    __syncthreads();
    if (threadIdx.x == 0) {
        unsigned* bar = b.bar;
        __builtin_amdgcn_s_waitcnt(0);
        unsigned nloc = b.st[0], nx = b.st[1];
        if (nloc == 0u) { xcd_barrier_complete(bar, b.x, nloc, nx); b.st[0] = nloc; b.st[1] = nx; }
        const unsigned old = xb_add(&bar[XB_XSUB(b.x)], 1u);
        const unsigned gen = old / nloc;
        if (old + 1u == (gen + 1u) * nloc) {
            __builtin_amdgcn_fence(__ATOMIC_RELEASE, "agent");
            asm volatile("s_waitcnt vmcnt(0)" ::: "memory");
            const unsigned og = xb_add(&bar[XB_TOP], 1u);
            const unsigned tg = og / nx;
            if (og + 1u == (tg + 1u) * nx) xb_add(&bar[XB_TOPGEN], 1u);
            else XB_SPIN(xb_ld(&bar[XB_TOPGEN]) == tg, bar);
            __builtin_amdgcn_fence(__ATOMIC_ACQUIRE, "agent");
            xb_add(&bar[XB_XGEN(b.x)], 1u);
            asm volatile("s_waitcnt vmcnt(0)" ::: "memory");
        } else {
            XB_SPIN(xb_ld(&bar[XB_XGEN(b.x)]) == gen, bar);
            __builtin_amdgcn_fence(__ATOMIC_ACQUIRE, "agent");
            asm volatile("s_waitcnt vmcnt(0)" ::: "memory");
        }
    }
    __syncthreads();
}

struct Ptrs {
    const float *xp, *xs, *state, *w_in_a, *lb_logits, *gnorm, *w_out_a, *w_in_b, *lnv_g, *lnv_b, *w_s, *b_s, *w_out_b, *ln_g, *ln_b;
    float* out; unsigned char* ws;
};

__device__ __forceinline__ void p0_prologue(const Ptrs& P, LAS unsigned char* lds) {
    const int tid = threadIdx.x, lane = tid & 63, wave = __builtin_amdgcn_readfirstlane(tid >> 6);
    LAS float* scr = (LAS float*)(lds + wave * 16384);
    const int gw = blockIdx.x * 8 + wave, NGW = gridDim.x * 8;
    constexpr int I_A = (DM / 64) * (4 * EA / 32), I_OA = (EA / 64) * (DM / 32), I_B = (DM / 64) * (3 * EA / 32), I_OB = I_OA, NITEMS = I_A + I_OA + I_B + I_OB;
    const int n_early = (gridDim.x >= 128) ? I_A : NITEMS;
    for (int it = gw; it < n_early; it += NGW) {
        int r = it;
        if (r < I_A) { p0_transpose_item(P.w_in_a, DM, 4 * EA, (bf16*)(P.ws + WS_WINA), scr, r, lane); continue; } r -= I_A;
        if (r < I_OA) { p0_transpose_item(P.w_out_a, EA, DM, (bf16*)(P.ws + WS_WOUTA), scr, r, lane); continue; } r -= I_OA;
        if (r < I_B) { p0_transpose_item(P.w_in_b, DM, 3 * EA, (bf16*)(P.ws + WS_WINB), scr, r, lane, true); continue; } r -= I_B;
        p0_transpose_item(P.w_out_b, EA, DM, (bf16*)(P.ws + WS_WOUTB), scr, r, lane);
    }
    const size_t gtid = (size_t)blockIdx.x * 512 + tid, GT = (size_t)gridDim.x * 512;
    {
        const f32x4* xp4 = (const f32x4*)P.xp; const f32x4* xs4 = (const f32x4*)P.xs; v2u* xb = (v2u*)(P.ws + WS_XB);
        constexpr size_t NP4 = (size_t)MP * DM / 4, NT4 = (size_t)MT * DM / 4;
        for (size_t q = gtid; q < NT4; q += 4 * GT) { f32x4 v[4];
#pragma unroll
            for (int k = 0; k < 4; ++k) { size_t qq = q + k * GT; qq = qq < NT4 ? qq : NT4 - 1; v[k] = __builtin_nontemporal_load(qq < NP4 ? xp4 + qq : xs4 + (qq - NP4)); }
#pragma unroll
            for (int k = 0; k < 4; ++k) { const size_t qq = q + k * GT; if (qq < NT4) { v2u o; o.x = pkbf(v[k].x, v[k].y); o.y = pkbf(v[k].z, v[k].w); xb[qq] = o; } } }
    }
    {
        const f32x4* w4 = (const f32x4*)P.w_s; v2u* wb = (v2u*)(P.ws + WS_WSB);
        for (size_t q = gtid; q < (size_t)16 * 128 * 128 / 4; q += GT) { const int e = (int)(q * 4), s = e & 127, t = (e >> 7) & 127; const f32x4 v = w4[q];
            v2u o; o.x = pkbf(s <= t ? v.x : 0.f, s + 1 <= t ? v.y : 0.f); o.y = pkbf(s + 2 <= t ? v.z : 0.f, s + 3 <= t ? v.w : 0.f); wb[q] = o; }
    }
    if (gtid < 2048) { float* lb = (float*)(P.ws + WS_LB); lb[gtid] = 1.0f / (1.0f + expf(P.lb_logits[2048 + gtid] - P.lb_logits[gtid])); }
    if (gtid < 4) { ((unsigned*)(P.ws + WS_CTL))[64 * gtid] = 0u; }
}

__device__ __forceinline__ void p0_late_weights(const Ptrs& P, LAS unsigned char* lds, int widx, int nw) {
    const int tid = threadIdx.x, lane = tid & 63, wave = __builtin_amdgcn_readfirstlane(tid >> 6);
    LAS float* scr = (LAS float*)(lds + wave * 16384);
    constexpr int I_OA = (EA / 64) * (DM / 32), I_B = (DM / 64) * (3 * EA / 32), I_OB = I_OA, NLATE = I_OA + I_B + I_OB;
    for (int it = widx * 8 + wave; it < NLATE; it += nw * 8) {
        int r = it;
        if (r < I_OA) { p0_transpose_item(P.w_out_a, EA, DM, (bf16*)(P.ws + WS_WOUTA), scr, r, lane); continue; } r -= I_OA;
        if (r < I_B) { p0_transpose_item(P.w_in_b, DM, 3 * EA, (bf16*)(P.ws + WS_WINB), scr, r, lane, true); continue; } r -= I_B;
        p0_transpose_item(P.w_out_b, EA, DM, (bf16*)(P.ws + WS_WOUTB), scr, r, lane);
    }
}

struct OneUnit {
    pg8::Unit u0;
    __device__ __forceinline__ bool next(int i, pg8::Unit& u) const { if (i != 0) return false; u = u0; return true; }
    __device__ __forceinline__ void a_ready(const pg8::Unit&) const {}
    __device__ __forceinline__ void done(const pg8::Unit&) const {}
};
template <bool FINAL, int NR, bool PARTS = false>
__device__ __forceinline__ void ln_rows(const Ptrs& P, const f32x4* g4, const f32x4* b4, int mbase, int mstride, int mend, int lane) {
    const bf16* D = (const bf16*)(P.ws + WS_D); bf16* H1B = (bf16*)(P.ws + WS_XB);
    f32x4 v[NR][4]; float s[NR];
#pragma unroll
    for (int k = 0; k < NR; ++k) { int m = mbase + k * mstride; m = m < mend ? m : mend - 1;
        f32x4 x[4];
        if (FINAL) { const v2u* h4 = (const v2u*)(H1B + (size_t)m * DM);
#pragma unroll
            for (int j = 0; j < 4; ++j) { const v2u r = __builtin_nontemporal_load(h4 + 64 * j + lane); x[j].x = bf_lo(r.x); x[j].y = bf_hi(r.x); x[j].z = bf_lo(r.y); x[j].w = bf_hi(r.y); } }
        else { const f32x4* x4 = (const f32x4*)(m < MP ? P.xp + (size_t)m * DM : P.xs + (size_t)(m - MP) * DM);
#pragma unroll
            for (int j = 0; j < 4; ++j) x[j] = __builtin_nontemporal_load(x4 + 64 * j + lane); }
        if (PARTS) { const f32x4* d4 = (const f32x4*)(P.ws + WS_DP) + (size_t)(m - MP) * (DM / 4);
#pragma unroll
            for (int j = 0; j < 4; ++j) v[k][j] = x[j] * ALPHA + ((d4[64 * j + lane] + d4[64 * j + lane + 512 * DM / 4]) + (d4[64 * j + lane + 2 * 512 * DM / 4] + d4[64 * j + lane + 3 * 512 * DM / 4])); }
        else { const v2u* d4 = (const v2u*)(D + (size_t)m * DM);
#pragma unroll
            for (int j = 0; j < 4; ++j) { const v2u r = __builtin_nontemporal_load(d4 + 64 * j + lane); f32x4 d; d.x = bf_lo(r.x); d.y = bf_hi(r.x); d.z = bf_lo(r.y); d.w = bf_hi(r.y); v[k][j] = x[j] * ALPHA + d; } } }
#pragma unroll
    for (int k = 0; k < NR; ++k) { s[k] = 0.f;
#pragma unroll
        for (int j = 0; j < 4; ++j) s[k] += (v[k][j].x + v[k][j].y) + (v[k][j].z + v[k][j].w); }
#pragma unroll
    for (int o = 1; o < 64; o <<= 1) {
#pragma unroll
        for (int k = 0; k < NR; ++k) s[k] += __shfl_xor(s[k], o); }
#pragma unroll
    for (int k = 0; k < NR; ++k) { const float mean = s[k] * (1.0f / DM); s[k] = 0.f;
#pragma unroll
        for (int j = 0; j < 4; ++j) { v[k][j] = v[k][j] - mean; s[k] += (v[k][j].x * v[k][j].x + v[k][j].y * v[k][j].y) + (v[k][j].z * v[k][j].z + v[k][j].w * v[k][j].w); } }
#pragma unroll
    for (int o = 1; o < 64; o <<= 1) {
#pragma unroll
        for (int k = 0; k < NR; ++k) s[k] += __shfl_xor(s[k], o); }
#pragma unroll
    for (int j = 0; j < 4; ++j) { const f32x4 gg = g4[64 * j + lane], bb = b4[64 * j + lane];
#pragma unroll
        for (int k = 0; k < NR; ++k) { const int m = mbase + k * mstride; if (m < mend) { const float rstd = __builtin_amdgcn_rsqf(s[k] * (1.0f / DM) + LN_EPS); const f32x4 y = v[k][j] * rstd * gg + bb;
            if (FINAL) { __builtin_nontemporal_store(y, (f32x4*)(P.out + OUT_Y + (size_t)m * DM) + 64 * j + lane); }
            else { v2u o; o.x = pkbf(y.x, y.y); o.y = pkbf(y.z, y.w); ((v2u*)(H1B + (size_t)m * DM))[64 * j + lane] = o; } } } }
}
template <bool FINAL>
__device__ __forceinline__ void ln_phase(const Ptrs& P, LAS unsigned char* lds, int layer) {
    const int tid = threadIdx.x, lane = tid & 63, wave = tid >> 6;
    const int G = (int)gridDim.x, bx = (int)blockIdx.x;
    const f32x4* g4 = (const f32x4*)(P.ln_g + layer * DM); const f32x4* b4 = (const f32x4*)(P.ln_b + layer * DM);
    if (G <= 32) {
        for (int m = bx * 8 + wave; m < MT; m += G * 8) ln_rows<FINAL, 1>(P, g4, b4, m, 0, MT, lane);
        return;
    }
    if (bx < 32) {
        unsigned* cnt = (unsigned*)(P.ws + WS_CTL) + 64 * (2 + layer);
        const int unit = bx >> 2, ks = bx & 3;
        pg8::Gemm g{(const bf16*)(P.ws + WS_O) + ks * 512, (const bf16*)(P.ws + (FINAL ? WS_WOUTB : WS_WOUTA)) + ks * 512, MT, DM, EA, 8};
        OneUnit S; S.u0.pm = MP / 256 + (unit >> 2); S.u0.pn = unit & 3;
        pg8::EpiF32 E{(float*)(P.ws + WS_DP) + (size_t)ks * 512 * DM - (size_t)MP * DM, DM};
        pg8::gemm_phase<pg8::EpiF32, OneUnit, true, true>(lds, g, S, E);
        asm volatile("s_waitcnt vmcnt(0)" ::: "memory");
        __syncthreads();
        if (tid == 0) {
            __builtin_amdgcn_fence(__ATOMIC_RELEASE, "agent"); asm volatile("s_waitcnt vmcnt(0)" ::: "memory");
            __hip_atomic_fetch_add(cnt, 1u, __ATOMIC_RELAXED, __HIP_MEMORY_SCOPE_AGENT);
            while (__hip_atomic_load(cnt, __ATOMIC_RELAXED, __HIP_MEMORY_SCOPE_AGENT) < 32u) __builtin_amdgcn_s_sleep(4);
            __builtin_amdgcn_fence(__ATOMIC_ACQUIRE, "agent"); asm volatile("s_waitcnt vmcnt(0)" ::: "memory");
        }
        __syncthreads();
        __builtin_amdgcn_fence(__ATOMIC_ACQUIRE, "agent");
        ln_rows<FINAL, 2, true>(P, g4, b4, MP + bx * 16 + wave * 2, 1, MT, lane);
    } else {
        const int nw = (G - 32) * 8;
        for (int m = (bx - 32) * 8 + wave; m < MP; m += 3 * nw) ln_rows<FINAL, 3>(P, g4, b4, m, nw, MP, lane);
    }
}

#define MFMA16(a, b, c) __builtin_amdgcn_mfma_f32_16x16x32_bf16((a), (b), (c), 0, 0, 0)
__device__ __forceinline__ void hgrn_unit(LAS unsigned char* lds, const bf16* Q, const bf16* LF, const bf16* V, const bf16* G, bf16* O, const float* gnorm,
                                          int m0, int h, float* s_out, int nb, int ne, bool store_state) {
    const int tid = threadIdx.x, lane = tid & 63, wid = __builtin_amdgcn_readfirstlane(tid >> 6);
    const int i = lane & 15, g = lane >> 4, wq = wid & 3, hc = h * 128;
    constexpr int SQ = 136, SK = 72, nch = 32;
    LAS unsigned char* QD = lds; LAS unsigned char* KI = lds + 17408; LAS unsigned char* KET = lds + 34816; LAS unsigned char* VT = lds + 53248; LAS unsigned char* ST = lds + 71680;
    LAS float* DEC = (LAS float*)(lds + 106496); LAS float* GN = (LAS float*)(lds + 111104);
    if (tid < 128) GN[tid] = gnorm[hc + tid];
    if (wid < 4) {
        const int t0 = 16 * wid;
        v4u gq_n[4], gq_c[4];
        LAS unsigned char* OT = lds + 111616;
        const bf16* gp = G + ((size_t)h * MT + (size_t)(m0 + t0 + g)) * 128 + 8 * i;
        bf16* orow = O + (size_t)(m0 + t0 + g) * 2048 + hc + 8 * i;
        bf16* prow = orow;
#define LOAD_GATE(nn) do { const int nc_ = (nn) < nch ? (nn) : nch - 1; const bf16* gb_ = gp + (size_t)nc_ * 8192; \
        _Pragma("unroll") for (int j = 0; j < 4; ++j) gq_n[j] = __builtin_nontemporal_load((const v4u*)(gb_ + (size_t)j * 4 * 128)); } while (0)
#define STORE_PREV() do { _Pragma("unroll") for (int j = 0; j < 4; ++j) { const v4u ot_ = *(const LAS v4u*)(OT + ((t0 + g + 4 * j) * 136 + 8 * i) * 2); const v4u gg_ = gq_c[j]; v4u w_; \
        w_.x = pkbf(bf_lo(ot_.x) * bf_lo(gg_.x), bf_hi(ot_.x) * bf_hi(gg_.x)); w_.y = pkbf(bf_lo(ot_.y) * bf_lo(gg_.y), bf_hi(ot_.y) * bf_hi(gg_.y)); \
        w_.z = pkbf(bf_lo(ot_.z) * bf_lo(gg_.z), bf_hi(ot_.z) * bf_hi(gg_.z)); w_.w = pkbf(bf_lo(ot_.w) * bf_lo(gg_.w), bf_hi(ot_.w) * bf_hi(gg_.w)); \
        *(v4u*)(prow + (size_t)j * 4 * 2048) = w_; } } while (0)
        if (nb > 0) {
            const size_t so_ = ((size_t)h * MT + (size_t)(m0 + 16 * wid + (lane >> 4))) * 128 + 8 * (lane & 15);
            const bf16* sl_ = LF + so_; const bf16* sv_ = V + so_;
            LAS unsigned char* RLs = lds + ((16 * wid + (lane >> 4)) * 128 + 8 * (lane & 15)) * 2; LAS unsigned char* RVs = RLs + 16384;
            v4u r0[8], r1[8], r2[8];
#define WU_LOAD(R, cc) do { const int nc_ = (cc) < nch ? (cc) : nch - 1; const size_t co_ = (size_t)nc_ * 8192; \
            _Pragma("unroll") for (int j = 0; j < 4; ++j) { R[j] = *(const v4u*)(sl_ + co_ + (size_t)j * 4 * 128); R[4 + j] = *(const v4u*)(sv_ + co_ + (size_t)j * 4 * 128); } } while (0)
#define WU_STAGE(R) do { _Pragma("unroll") for (int j = 0; j < 4; ++j) { *(LAS v4u*)(RLs + j * 4 * 256) = R[j]; *(LAS v4u*)(RVs + j * 4 * 256) = R[4 + j]; } } while (0)
            WU_LOAD(r0, 1); WU_LOAD(r1, 2); WU_LOAD(r2, 3);
            for (int n = 0; n < nb; n += 3) {
                WU_STAGE(r0); WU_LOAD(r0, n + 4); __syncthreads(); __syncthreads();
                WU_STAGE(r1); WU_LOAD(r1, n + 5); __syncthreads(); __syncthreads();
                WU_STAGE(r2); WU_LOAD(r2, n + 6); __syncthreads(); __syncthreads();
            }
#undef WU_LOAD
#undef WU_STAGE
        }
        LOAD_GATE(nb);
        __builtin_amdgcn_s_setprio(2);
        for (int n = nb; n < ne; ++n) {
            int i_ = i, g_ = g; asm volatile("" : "+v"(i_), "+v"(g_));
            if (n > nb) STORE_PREV();
#pragma unroll
            for (int j = 0; j < 4; ++j) gq_c[j] = gq_n[j];
            LOAD_GATE(n + 1);
            __syncthreads();
            {
                bf16x8 bq[4];
#pragma unroll
                for (int kk = 0; kk < 4; ++kk) bq[kk] = *(const LAS bf16x8*)(QD + ((t0 + i_) * SQ + 32 * kk + 8 * g_) * 2);
                bf16x8 pc[2];
                {
                    f32x4 sT[4];
#pragma unroll
                    for (int st = 0; st < 4; ++st) {
                        f32x4 a4 = (f32x4){0.f, 0.f, 0.f, 0.f};
#pragma unroll
                        for (int kk = 0; kk < 4; ++kk) { const bf16x8 a = *(const LAS bf16x8*)(KI + ((16 * st + i_) * SQ + 32 * kk + 8 * g_) * 2); a4 = MFMA16(a, bq[kk], a4); }
#pragma unroll
                        for (int r = 0; r < 4; ++r) if (16 * st + 4 * g_ + r > t0 + i_) a4[r] = 0.f;
                        sT[st] = a4;
                    }
#pragma unroll
                    for (int c = 0; c < 2; ++c) { v4u w; w.x = pkbf(sT[2 * c][0], sT[2 * c][1]); w.y = pkbf(sT[2 * c][2], sT[2 * c][3]); w.z = pkbf(sT[2 * c + 1][0], sT[2 * c + 1][1]); w.w = pkbf(sT[2 * c + 1][2], sT[2 * c + 1][3]);
                        pc[c] = __builtin_bit_cast(bf16x8, w); }
                }
                f32x4 oa[8]; float ss = 0.f;
#pragma unroll
                for (int vt = 0; vt < 8; ++vt) {
                    f32x4 acc = (f32x4){0.f, 0.f, 0.f, 0.f};
#pragma unroll
                    for (int c = 0; c < 2; ++c) {
                        const v2u lo = *(const LAS v2u*)(VT + ((16 * vt + i_) * SK + 32 * c + 4 * g_) * 2), hi = *(const LAS v2u*)(VT + ((16 * vt + i_) * SK + 32 * c + 16 + 4 * g_) * 2);
                        v4u w; w.x = lo.x; w.y = lo.y; w.z = hi.x; w.w = hi.y; acc = MFMA16(__builtin_bit_cast(bf16x8, w), pc[c], acc); }
#pragma unroll
                    for (int kk = 0; kk < 4; ++kk) { const bf16x8 a = *(const LAS bf16x8*)(ST + ((16 * vt + i_) * SQ + 32 * kk + 8 * g_) * 2); acc = MFMA16(a, bq[kk], acc); }
                    oa[vt] = acc; ss += (acc[0] * acc[0] + acc[1] * acc[1]) + (acc[2] * acc[2] + acc[3] * acc[3]);
                }
                ss += __shfl_xor(ss, 16); ss += __shfl_xor(ss, 32);
                const float sc = __builtin_amdgcn_rsqf(ss * (1.0f / 128.0f) + LN_EPS);
#pragma unroll
                for (int vt = 0; vt < 8; ++vt) { const f32x4 gn = *(const LAS f32x4*)(GN + 16 * vt + 4 * g_) * sc; v2u w_;
                    w_.x = pkbf(oa[vt][0] * gn[0], oa[vt][1] * gn[1]); w_.y = pkbf(oa[vt][2] * gn[2], oa[vt][3] * gn[3]);
                    *(LAS v2u*)(OT + ((t0 + i_) * 136 + 16 * vt + 4 * g_) * 2) = w_; }
                prow = orow + (size_t)n * (64 * 2048);
            }
            __syncthreads();
        }
        STORE_PREV();
        __builtin_amdgcn_s_setprio(0);
#undef STORE_PREV
#undef LOAD_GATE
    } else {
        const int cp = i, rg = g, c0 = 32 * wq + 2 * cp;
        const size_t pofs = ((size_t)h * MT + (size_t)(m0 + 16 * rg)) * 128 + c0;
        const bf16* qp = Q + pofs; const bf16* lp = LF + pofs; const bf16* vp = V + pofs;
        unsigned rq[16], rl[16], rv[16];
        unsigned sq[16], sk[16], ske0[8], ske1[8]; float det0, det1;
#define LOAD_RAW(nn) do { const int nc_ = (nn) < nch ? (nn) : nch - 1; const bf16* qb_ = qp + (size_t)nc_ * 8192; const bf16* lb_ = lp + (size_t)nc_ * 8192; const bf16* vb_ = vp + (size_t)nc_ * 8192; \
        _Pragma("unroll") for (int r = 0; r < 16; ++r) { rl[r] = *(const unsigned*)(lb_ + r * 128); rq[r] = *(const unsigned*)(qb_ + r * 128); } (void)vb_; } while (0)
#define LOAD_V(nn) do { const int nc_ = (nn) < nch ? (nn) : nch - 1; const bf16* vb_ = vp + (size_t)nc_ * 8192; _Pragma("unroll") for (int r = 0; r < 16; ++r) rv[r] = *(const unsigned*)(vb_ + r * 128); } while (0)
#define PREP_REGS(full_) do { \
        float su0 = 0.f, su1 = 0.f; \
        _Pragma("unroll") for (int r = 0; r < 16; ++r) { const f16x2 hh = __builtin_bit_cast(f16x2, rl[r]); su0 += (float)hh.x; su1 += (float)hh.y; } \
        float off0 = 0.f, off1 = 0.f, tot0 = 0.f, tot1 = 0.f; \
        _Pragma("unroll") for (int j = 0; j < 4; ++j) { const float a_ = __shfl(su0, cpx + 16 * j), b_ = __shfl(su1, cpx + 16 * j); if (j < rgx) { off0 += a_; off1 += b_; } tot0 += a_; tot1 += b_; } \
        const float et0 = __expf(tot0), et1 = __expf(tot1); float p0 = __expf(off0), p1 = __expf(off1); det0 = et0; det1 = et1; \
        float kp0 = 0.f, kp1 = 0.f; \
        _Pragma("unroll") for (int r = 0; r < 16; ++r) { const f16x2 hh = __builtin_bit_cast(f16x2, rl[r]); const float f0 = __expf((float)hh.x), f1 = __expf((float)hh.y); \
            p0 *= f0; p1 *= f1; \
            const float ki0 = (1.0f - f0) * __builtin_amdgcn_rcpf(p0), ki1 = (1.0f - f1) * __builtin_amdgcn_rcpf(p1); const float ke0 = ki0 * et0, ke1 = ki1 * et1; \
            if (full_) { sq[r] = pkbf(bf_lo(rq[r]) * p0, bf_hi(rq[r]) * p1); sk[r] = pkbf(ki0, ki1); } \
            if (r & 1) { ske0[r >> 1] = pkbf(kp0, ke0); ske1[r >> 1] = pkbf(kp1, ke1); } \
            kp0 = ke0; kp1 = ke1; } } while (0)
#define DUMP_REGS(full_) do { \
        if (full_) _Pragma("unroll") for (int r = 0; r < 16; ++r) { *(LAS unsigned*)(QD + ((16 * rgx + r) * SQ + c0x) * 2) = sq[r]; *(LAS unsigned*)(KI + ((16 * rgx + r) * SQ + c0x) * 2) = sk[r]; } \
        { v4u w_; w_.x = ske0[0]; w_.y = ske0[1]; w_.z = ske0[2]; w_.w = ske0[3]; *(LAS v4u*)(KET + (c0x * SK + 16 * rgx) * 2) = w_; w_.x = ske0[4]; w_.y = ske0[5]; w_.z = ske0[6]; w_.w = ske0[7]; *(LAS v4u*)(KET + (c0x * SK + 16 * rgx + 8) * 2) = w_; \
          w_.x = ske1[0]; w_.y = ske1[1]; w_.z = ske1[2]; w_.w = ske1[3]; *(LAS v4u*)(KET + ((c0x + 1) * SK + 16 * rgx) * 2) = w_; w_.x = ske1[4]; w_.y = ske1[5]; w_.z = ske1[6]; w_.w = ske1[7]; *(LAS v4u*)(KET + ((c0x + 1) * SK + 16 * rgx + 8) * 2) = w_; \
          _Pragma("unroll") for (int hh_ = 0; hh_ < 2; ++hh_) { \
            w_.x = (rv[8 * hh_ + 0] & 0xffffu) | (rv[8 * hh_ + 1] << 16); w_.y = (rv[8 * hh_ + 2] & 0xffffu) | (rv[8 * hh_ + 3] << 16); w_.z = (rv[8 * hh_ + 4] & 0xffffu) | (rv[8 * hh_ + 5] << 16); w_.w = (rv[8 * hh_ + 6] & 0xffffu) | (rv[8 * hh_ + 7] << 16); \
            *(LAS v4u*)(VT + (c0x * SK + 16 * rgx + 8 * hh_) * 2) = w_; \
            w_.x = (rv[8 * hh_ + 0] >> 16) | (rv[8 * hh_ + 1] & 0xffff0000u); w_.y = (rv[8 * hh_ + 2] >> 16) | (rv[8 * hh_ + 3] & 0xffff0000u); w_.z = (rv[8 * hh_ + 4] >> 16) | (rv[8 * hh_ + 5] & 0xffff0000u); w_.w = (rv[8 * hh_ + 6] >> 16) | (rv[8 * hh_ + 7] & 0xffff0000u); \
            *(LAS v4u*)(VT + ((c0x + 1) * SK + 16 * rgx + 8 * hh_) * 2) = w_; } } \
        if (rgx == 0) { f32x2 p_; p_.x = det0; p_.y = det1; *(LAS f32x2*)(DEC + c0x) = p_; } } while (0)
        f32x4 S[8][2];
#define WRITE_ST() do { _Pragma("unroll") for (int kt = 0; kt < 8; ++kt) _Pragma("unroll") for (int j = 0; j < 2; ++j) { v2u w_; w_.x = pkbf(S[kt][j][0], S[kt][j][1]); w_.y = pkbf(S[kt][j][2], S[kt][j][3]); \
        *(LAS v2u*)(ST + ((16 * (2 * wq + j) + i) * SQ + 16 * kt + 4 * g) * 2) = w_; } } while (0)
#pragma unroll
        for (int kt = 0; kt < 8; ++kt)
#pragma unroll
            for (int j = 0; j < 2; ++j) S[kt][j] = (f32x4){0.f, 0.f, 0.f, 0.f};
        LOAD_RAW(0); LOAD_V(0);
        WRITE_ST();
        { const int cpx = cp, rgx = rg, c0x = c0; PREP_REGS(nb == 0); (void)c0x; }
        if (nb > 0) {
            { const int nc_ = nb < nch ? nb : nch - 1; const bf16* qb_ = qp + (size_t)nc_ * 8192;
#pragma unroll
              for (int r = 0; r < 16; ++r) rq[r] = *(const unsigned*)(qb_ + r * 128); }
            for (int n = 0; n < nb; ++n) {
                int i_ = i, g_ = g; asm volatile("" : "+v"(i_), "+v"(g_));
                const int cpx = i_, rgx = g_, c0x = 32 * wq + 2 * i_;
                DUMP_REGS(false);
                __syncthreads();
                {
                    bf16x8 bv[2][2];
#pragma unroll
                    for (int j = 0; j < 2; ++j)
#pragma unroll
                        for (int c = 0; c < 2; ++c) bv[j][c] = *(const LAS bf16x8*)(VT + ((16 * (2 * wq + j) + i_) * SK + 32 * c + 8 * g_) * 2);
#pragma unroll
                    for (int kt = 0; kt < 8; ++kt) {
                        const f32x4 d = *(const LAS f32x4*)(DEC + 16 * kt + 4 * g_);
                        const bf16x8 a0 = *(const LAS bf16x8*)(KET + ((16 * kt + i_) * SK + 8 * g_) * 2), a1 = *(const LAS bf16x8*)(KET + ((16 * kt + i_) * SK + 32 + 8 * g_) * 2);
#pragma unroll
                        for (int j = 0; j < 2; ++j) { f32x4 acc = S[kt][j] * d; acc = MFMA16(a0, bv[j][0], acc); acc = MFMA16(a1, bv[j][1], acc); S[kt][j] = acc; }
                    }
                }
#pragma unroll
                for (int r = 0; r < 16; ++r) { rl[r] = *(const LAS unsigned*)(lds + ((16 * rgx + r) * 128 + c0x) * 2); rv[r] = *(const LAS unsigned*)(lds + 16384 + ((16 * rgx + r) * 128 + c0x) * 2); }
                PREP_REGS(n + 1 == nb);
                __syncthreads();
            }
            WRITE_ST();
            LOAD_RAW(nb + 1);
        } else { LOAD_RAW(1); }
        for (int n = nb; n < ne; ++n) {
            int i_ = i, g_ = g; asm volatile("" : "+v"(i_), "+v"(g_));
            const int cpx = i_, rgx = g_, c0x = 32 * wq + 2 * i_;
            DUMP_REGS(true);
            asm volatile("" ::: "memory");
            LOAD_V(n + 1);
            __syncthreads();
            {
                bf16x8 bv[2][2];
#pragma unroll
                for (int j = 0; j < 2; ++j)
#pragma unroll
                    for (int c = 0; c < 2; ++c) bv[j][c] = *(const LAS bf16x8*)(VT + ((16 * (2 * wq + j) + i_) * SK + 32 * c + 8 * g_) * 2);
#pragma unroll
                for (int kt = 0; kt < 8; ++kt) {
                    const f32x4 d = *(const LAS f32x4*)(DEC + 16 * kt + 4 * g_);
                    const bf16x8 a0 = *(const LAS bf16x8*)(KET + ((16 * kt + i_) * SK + 8 * g_) * 2), a1 = *(const LAS bf16x8*)(KET + ((16 * kt + i_) * SK + 32 + 8 * g_) * 2);
#pragma unroll
                    for (int j = 0; j < 2; ++j) { f32x4 acc = S[kt][j] * d; acc = MFMA16(a0, bv[j][0], acc); acc = MFMA16(a1, bv[j][1], acc); S[kt][j] = acc; }
                }
            }
            PREP_REGS(true);
            LOAD_RAW(n + 2);
            __syncthreads();
            WRITE_ST();
        }
        if (store_state) {
            float* op = s_out + (4 * g) * 128 + 32 * wq + i;
#pragma unroll
            for (int kt = 0; kt < 8; ++kt) {
#pragma unroll
                for (int j = 0; j < 2; ++j)
#pragma unroll
                    for (int r = 0; r < 4; ++r) __builtin_nontemporal_store(S[kt][j][r], op + r * 128 + 16 * j);
                op += 2048; asm volatile("" : "+v"(op));
            }
        }
#undef WRITE_ST
#undef DUMP_REGS
#undef PREP_REGS
#undef LOAD_RAW
#undef LOAD_V
    }
}

__device__ __forceinline__ void hgrn_sample_units(LAS unsigned char* lds, const bf16* Q, const bf16* LF, const bf16* V, const bf16* G, bf16* O, const float* gnorm,
                                                  const float* state, float* out_hs, int su0, int stride, int su_end) {
    int tid_ = threadIdx.x; asm volatile("" : "+v"(tid_));
    const int tid = tid_, lane = tid & 63, wid = tid >> 6, kr = tid >> 5, vc = tid & 31;
    LAS float* SQv = (LAS float*)lds; LAS float* SFv = SQv + 512; LAS float* SKv = SQv + 1024; LAS float* SVv = SQv + 1536; LAS float* RED = SQv + 2048;
    if (su0 >= su_end) return;
    f32x4 S[8], Sn[8]; unsigned short nq, nl, nv;
    const int tt = tid >> 7, tk = tid & 127;
#define SU_LOAD(su_) do { const int b_ = (su_) >> 4, h_ = (su_) & 15; const f32x4* sp_ = (const f32x4*)(state + (size_t)(su_) * 16384 + kr * 128 + 4 * vc); \
        _Pragma("unroll") for (int p = 0; p < 8; ++p) Sn[p] = __builtin_nontemporal_load(sp_ + p * 512); \
        const size_t idx_ = ((size_t)h_ * MT + (size_t)(MP + 4 * b_ + tt)) * 128 + tk; nq = Q[idx_]; nl = LF[idx_]; nv = V[idx_]; } while (0)
    SU_LOAD(su0);
    for (int su = su0; su < su_end; su += stride) {
        const int b = su >> 4, h = su & 15;
#pragma unroll
        for (int p = 0; p < 8; ++p) S[p] = Sn[p];
        { const float q = __builtin_bit_cast(float, (unsigned)nq << 16), v = __builtin_bit_cast(float, (unsigned)nv << 16);
          const float f = __expf((float)__builtin_bit_cast(_Float16, nl));
          SQv[tid] = q; SFv[tid] = f; SKv[tid] = 1.0f - f; SVv[tid] = v; }
        { const int sn = (su + stride) < su_end ? (su + stride) : su; SU_LOAD(sn); }
        __syncthreads();
        f32x4 o[4];
#pragma unroll
        for (int t = 0; t < 4; ++t) {
            const f32x4 vv = *(const LAS f32x4*)(SVv + t * 128 + 4 * vc); f32x4 acc = (f32x4){0.f, 0.f, 0.f, 0.f};
#pragma unroll
            for (int p = 0; p < 8; ++p) { const int k = t * 128 + kr + 16 * p; const float f = SFv[k], kn = SKv[k], q = SQv[k]; S[p] = S[p] * f + vv * kn; acc += S[p] * q; }
            o[t] = acc;
        }
        { f32x4* op = (f32x4*)(out_hs + (size_t)su * 16384 + kr * 128 + 4 * vc);
#pragma unroll
          for (int p = 0; p < 8; ++p) __builtin_nontemporal_store(S[p], op + p * 512); }
#pragma unroll
        for (int t = 0; t < 4; ++t) { o[t].x += __shfl_xor(o[t].x, 32); o[t].y += __shfl_xor(o[t].y, 32); o[t].z += __shfl_xor(o[t].z, 32); o[t].w += __shfl_xor(o[t].w, 32); }
        if (lane < 32) {
#pragma unroll
            for (int t = 0; t < 4; ++t) *(LAS f32x4*)(RED + (wid * 4 + t) * 128 + 4 * vc) = o[t];
        }
        __syncthreads();
        if (wid < 4) {
            const int t = wid; float a0 = 0.f, a1 = 0.f;
#pragma unroll
            for (int w2 = 0; w2 < 8; ++w2) { a0 += RED[(w2 * 4 + t) * 128 + lane]; a1 += RED[(w2 * 4 + t) * 128 + lane + 64]; }
            const float ss = wave_sum(a0 * a0 + a1 * a1); const float sc = __builtin_amdgcn_rsqf(ss * (1.0f / 128.0f) + LN_EPS);
            const int row = MP + 4 * b + t; const size_t gi = ((size_t)h * MT + (size_t)row) * 128;
            const float g0 = __builtin_bit_cast(float, (unsigned)G[gi + lane] << 16), g1 = __builtin_bit_cast(float, (unsigned)G[gi + lane + 64] << 16);
            bf16* orow = O + (size_t)row * 2048 + h * 128;
            orow[lane] = (bf16)(pkbf(a0 * sc * gnorm[h * 128 + lane] * g0, 0.f) & 0xffffu); orow[lane + 64] = (bf16)(pkbf(a1 * sc * gnorm[h * 128 + lane + 64] * g1, 0.f) & 0xffffu);
        }
        __syncthreads();
    }
#undef SU_LOAD
}

__device__ __forceinline__ void hgrn_phase(const Ptrs& P, LAS unsigned char* lds, int ctr_idx) {
    const bf16* Q = (const bf16*)(P.ws + WS_Q); const bf16* LF = (const bf16*)(P.ws + WS_LF); const bf16* V = (const bf16*)(P.ws + WS_V); const bf16* G = (const bf16*)(P.ws + WS_G);
    bf16* O = (bf16*)(P.ws + WS_O);
    const int Gd = (int)gridDim.x, bx = (int)blockIdx.x;
    if (Gd >= 256) {
        constexpr int SPLIT = 15; static_assert(SPLIT % 3 == 0, "the warm-up loader's register ring has three slots");
        if (bx < 256) { const int pu = bx & 127; const bool late = bx >= 128;
            hgrn_unit(lds, Q, LF, V, G, O, P.gnorm, (pu >> 4) * 2048, pu & 15, P.out + OUT_HP + (size_t)pu * 16384, late ? SPLIT : 0, late ? 32 : SPLIT, late); }
        if (bx < 128) hgrn_sample_units(lds, Q, LF, V, G, O, P.gnorm, P.state, P.out + OUT_HS, bx, 128, 1792);
        else if (bx < 256) hgrn_sample_units(lds, Q, LF, V, G, O, P.gnorm, P.state, P.out + OUT_HS, 1792 + (bx - 128), 128, 2048);
    } else {
        const bool split = Gd > 128;
        if (!split || bx < 128) {
            for (int pu = bx; pu < 128; pu += (split ? 128 : Gd)) hgrn_unit(lds, Q, LF, V, G, O, P.gnorm, (pu >> 4) * 2048, pu & 15, P.out + OUT_HP + (size_t)pu * 16384, 0, 32, true);
        }
        if (!split || bx >= 128) { const int sid = split ? bx - 128 : bx, ns = split ? Gd - 128 : Gd; __syncthreads(); hgrn_sample_units(lds, Q, LF, V, G, O, P.gnorm, P.state, P.out + OUT_HS, sid, ns, 2048); }
    }
    (void)ctr_idx;
}

__device__ __forceinline__ void gate_phase(const Ptrs& P, LAS unsigned char* lds) {
    const int tid = threadIdx.x, lane = tid & 63, wid = __builtin_amdgcn_readfirstlane(tid >> 6);
    const int i = lane & 15, g = lane >> 4;
    constexpr int SW = 136;
    const bf16* U = (const bf16*)(P.ws + WS_U); const bf16* Vb = (const bf16*)(P.ws + WS_VB); bf16* GT = (bf16*)(P.ws + WS_O);
    const float* part = (const float*)(P.ws + WS_PART); const bf16* WSB = (const bf16*)(P.ws + WS_WSB);
    LAS unsigned char* WT = lds; LAS unsigned char* VNT = lds + 34816; LAS f32x2* STT = (LAS f32x2*)(lds + 69632); LAS unsigned char* OT = lds + 70656;
    int cur_grp = -1;
    for (int u = blockIdx.x; u < 2048; u += gridDim.x) {
        const int grp = u & 15, m0 = (u >> 4) * 128;
        float bq_[8]; v4u uzq[4];
#pragma unroll
        for (int tt = 0; tt < 8; ++tt) bq_[tt] = P.b_s[grp * 128 + 16 * tt + i];
#pragma unroll
        for (int it = 0; it < 4; ++it) { const int idx = tid + 512 * it, row = idx >> 4, c16 = idx & 15; uzq[it] = __builtin_nontemporal_load((const v4u*)(U + ((size_t)grp * MT + (size_t)(m0 + row)) * 128 + c16 * 8)); }
        __syncthreads();
        if (grp != cur_grp) {
#pragma unroll
            for (int it = 0; it < 4; ++it) { const int idx = tid + 512 * it, row = idx >> 4, c16 = idx & 15;
                *(LAS v4u*)(WT + (row * SW) * 2 + c16 * 16) = *(const v4u*)(WSB + (size_t)grp * 16384 + row * 128 + c16 * 8); }
            cur_grp = grp;
        }
        unsigned vraw[16];
#pragma unroll
        for (int r = 0; r < 16; ++r) vraw[r] = __builtin_nontemporal_load((const unsigned*)(Vb + ((size_t)grp * MT + (size_t)(m0 + 16 * wid + r)) * 128 + 2 * lane));
        if (tid < 128) { const f32x2* pr = (const f32x2*)(part + (size_t)(m0 + tid) * 64); float s = 0.f, ss = 0.f;
#pragma unroll
            for (int j = 0; j < 32; ++j) { const f32x2 p = pr[j]; s += p.x; ss += p.y; }
            const float mean = s * (1.0f / 2048.0f), var = ss * (1.0f / 2048.0f) - mean * mean; f32x2 o; o.x = mean; o.y = 1.0f / sqrtf(var + LN_EPS); STT[tid] = o; }
        __syncthreads();
        {
            const int c0 = grp * 128 + 2 * lane; const float g0 = P.lnv_g[c0], g1 = P.lnv_g[c0 + 1], b0 = P.lnv_b[c0], b1 = P.lnv_b[c0 + 1];
            float y0[16], y1[16];
#pragma unroll
            for (int r = 0; r < 16; ++r) { const int row = 16 * wid + r; const unsigned raw = vraw[r]; const f32x2 st = STT[row];
                y0[r] = (bf_lo(raw) - st.x) * st.y * g0 + b0; y1[r] = (bf_hi(raw) - st.x) * st.y * g1 + b1; }
#pragma unroll
            for (int hh = 0; hh < 2; ++hh) { v4u w0, w1;
                w0.x = pkbf(y0[8 * hh + 0], y0[8 * hh + 1]); w0.y = pkbf(y0[8 * hh + 2], y0[8 * hh + 3]); w0.z = pkbf(y0[8 * hh + 4], y0[8 * hh + 5]); w0.w = pkbf(y0[8 * hh + 6], y0[8 * hh + 7]);
                w1.x = pkbf(y1[8 * hh + 0], y1[8 * hh + 1]); w1.y = pkbf(y1[8 * hh + 2], y1[8 * hh + 3]); w1.z = pkbf(y1[8 * hh + 4], y1[8 * hh + 5]); w1.w = pkbf(y1[8 * hh + 6], y1[8 * hh + 7]);
                *(LAS v4u*)(VNT + ((2 * lane) * SW + 16 * wid + 8 * hh) * 2) = w0; *(LAS v4u*)(VNT + ((2 * lane + 1) * SW + 16 * wid + 8 * hh) * 2) = w1; }
        }
        __syncthreads();
        {
            bf16x8 av[4];
#pragma unroll
            for (int kk = 0; kk < 4; ++kk) av[kk] = *(const LAS bf16x8*)(VNT + ((16 * wid + i) * SW + 32 * kk + 8 * g) * 2);
#pragma unroll
            for (int tt = 0; tt < 8; ++tt) {
                f32x4 acc = (f32x4){0.f, 0.f, 0.f, 0.f};
#pragma unroll
                for (int kk = 0; kk < 4; ++kk) if (kk <= (tt >> 1)) { const bf16x8 b = *(const LAS bf16x8*)(WT + ((16 * tt + i) * SW + 32 * kk + 8 * g) * 2); acc = MFMA16(av[kk], b, acc); }
                const int t = 16 * tt + i; const float bias = bq_[tt];
                v2u w; w.x = pkbf(acc[0] + bias, acc[1] + bias); w.y = pkbf(acc[2] + bias, acc[3] + bias);
                *(LAS v2u*)(OT + (t * SW + 16 * wid + 4 * g) * 2) = w;
            }
        }
        __syncthreads();
#pragma unroll
        for (int it = 0; it < 4; ++it) { const int idx = tid + 512 * it, row = idx >> 4, c16 = idx & 15;
            const v4u mx = *(const LAS v4u*)(OT + (row * SW) * 2 + c16 * 16); const v4u uu = uzq[it]; v4u w;
            w.x = pkbf(bf_lo(uu.x) * bf_lo(mx.x), bf_hi(uu.x) * bf_hi(mx.x)); w.y = pkbf(bf_lo(uu.y) * bf_lo(mx.y), bf_hi(uu.y) * bf_hi(mx.y));
            w.z = pkbf(bf_lo(uu.z) * bf_lo(mx.z), bf_hi(uu.z) * bf_hi(mx.z)); w.w = pkbf(bf_lo(uu.w) * bf_lo(mx.w), bf_hi(uu.w) * bf_hi(mx.w));
            *(v4u*)(GT + (size_t)(m0 + row) * 2048 + grp * 128 + c16 * 8) = w; }
    }
    for (int sb = (int)gridDim.x - 1 - (int)blockIdx.x; sb < 128; sb += gridDim.x) {
        __syncthreads();
        const int mrow = MP + 4 * sb;
        if (tid < 4) { const f32x2* pr = (const f32x2*)(part + (size_t)(mrow + tid) * 64); float s = 0.f, ss = 0.f;
            for (int j = 0; j < 32; ++j) { const f32x2 p = pr[j]; s += p.x; ss += p.y; }
            const float mean = s * (1.0f / 2048.0f), var = ss * (1.0f / 2048.0f) - mean * mean; f32x2 o; o.x = mean; o.y = 1.0f / sqrtf(var + LN_EPS); STT[tid] = o; }
        __syncthreads();
        const int c = 4 * tid, grp = c >> 7;
        const f32x4 lg = *(const f32x4*)(P.lnv_g + c), lb = *(const f32x4*)(P.lnv_b + c);
        f32x4 vn[4];
#pragma unroll
        for (int t = 0; t < 4; ++t) { const v2u raw = *(const v2u*)(Vb + ((size_t)grp * MT + (size_t)(mrow + t)) * 128 + (c & 127)); const f32x2 st = STT[t];
            f32x4 x; x.x = bf_lo(raw.x); x.y = bf_hi(raw.x); x.z = bf_lo(raw.y); x.w = bf_hi(raw.y);
            vn[t] = (x - st.x) * st.y * lg + lb;
            __builtin_nontemporal_store(vn[t], (f32x4*)(P.out + OUT_CV + (size_t)(4 * sb + t) * 2048 + c)); }
#pragma unroll
        for (int t = 0; t < 4; ++t) { const float bias = P.b_s[grp * 128 + t]; f32x4 mx = (f32x4){bias, bias, bias, bias};
#pragma unroll
            for (int s = 0; s < 4; ++s) if (s <= t) mx += vn[s] * P.w_s[(size_t)grp * 16384 + t * 128 + s];
            const size_t off = (size_t)(mrow + t) * 2048 + c; const size_t offg = ((size_t)grp * MT + (size_t)(mrow + t)) * 128 + (c & 127); const v2u uu = *(const v2u*)(U + offg);
            v2u w; w.x = pkbf(bf_lo(uu.x) * mx.x, bf_hi(uu.x) * mx.y); w.y = pkbf(bf_lo(uu.y) * mx.z, bf_hi(uu.y) * mx.w);
            *(v2u*)(GT + off) = w; }
    }
}

struct Args { const float* in[15]; float* out; unsigned char* ws; int ph_lo, ph_hi; };
__global__ void __launch_bounds__(512, 2) mk_fwd(Args a) {
    extern __shared__ __attribute__((aligned(16))) unsigned char lds_raw[];
    LAS unsigned char* lds = (LAS unsigned char*)lds_raw;
    Ptrs P;
    P.xp = a.in[0]; P.xs = a.in[1]; P.state = a.in[2]; P.w_in_a = a.in[3]; P.lb_logits = a.in[4]; P.gnorm = a.in[5]; P.w_out_a = a.in[6]; P.w_in_b = a.in[7];
    P.lnv_g = a.in[8]; P.lnv_b = a.in[9]; P.w_s = a.in[10]; P.b_s = a.in[11]; P.w_out_b = a.in[12]; P.ln_g = a.in[13]; P.ln_b = a.in[14]; P.out = a.out; P.ws = a.ws;
    const int lo = a.ph_lo, hi = a.ph_hi;
    volatile LAS unsigned* bst = (volatile LAS unsigned*)(lds + 131072 + 64);
    if (threadIdx.x == 0) { bst[0] = 0u; bst[1] = 0u; }
    __syncthreads();
    XcdBarrier bar = xcd_barrier_post((unsigned*)(P.ws + WS_BAR), bst);
    if (lo < 0) cg::this_grid().sync();
#define IN(k) (lo <= (k) && (k) < hi)
#define SEAM(k) do { if (IN(k) && IN((k) + 1)) { xcd_barrier(bar); } } while (0)
#ifndef PROBE_REP
#define PROBE_REP -1
#endif
#define REP(k) for (int rep_ = 0; rep_ < ((PROBE_REP == (k)) ? 2 : 1); ++rep_, (void)((PROBE_REP == (k) && rep_ == 1) ? (cg::this_grid().sync(), 0) : 0))
    const int G = (int)gridDim.x, c = (int)blockIdx.x;
    if (IN(0)) REP(0) { p0_prologue(P, lds); }
    SEAM(0);
    if (IN(1)) REP(1) {
        pg8::Gemm g{(const bf16*)(P.ws + WS_XB), (const bf16*)(P.ws + WS_WINA), MT, 4 * EA, DM}; pg8::StaticOrder S; S.init(MT, 4 * EA, G, c);
        pg8::EpiHgrnIn E{(bf16*)(P.ws + WS_Q), (const float*)(P.ws + WS_LB)};
        pg8::gemm_phase<pg8::EpiHgrnIn, pg8::StaticOrder, true, true>(lds, g, S, E);
        if (G >= 128) {
            const int nfull = S.nwg / G, nlast = S.nwg - nfull * G;
            __syncthreads();
            if (nlast == 0 || nlast >= G) p0_late_weights(P, lds, c, G);
            else if (c >= nlast) p0_late_weights(P, lds, c - nlast, G - nlast);
        }
    }
    SEAM(1);
    if (IN(2)) REP(2) { hgrn_phase(P, lds, rep_); }
    SEAM(2);
    if (IN(3)) REP(3) {
        const int Mo = G > 32 ? MP : MT;
        pg8::Gemm g{(const bf16*)(P.ws + WS_O), (const bf16*)(P.ws + WS_WOUTA), Mo, DM, EA}; pg8::StaticOrder S; S.init(Mo, DM, G, c);
        pg8::EpiBf16Plain E{(bf16*)(P.ws + WS_D), DM};
        pg8::gemm_phase<pg8::EpiBf16Plain, pg8::StaticOrder, true, true>(lds, g, S, E);
    }
    SEAM(3);
    if (IN(4)) REP(4) { ln_phase<false>(P, lds, 0); }
    SEAM(4);
    if (IN(5)) REP(5) {
        pg8::Gemm g{(const bf16*)(P.ws + WS_XB), (const bf16*)(P.ws + WS_WINB), MT, 3 * EA, DM}; pg8::StaticOrder S; S.init(MT, 3 * EA, G, c);
        pg8::EpiGmlpIn E{(bf16*)(P.ws + WS_U), (float*)(P.ws + WS_PART)};
        pg8::gemm_phase<pg8::EpiGmlpIn, pg8::StaticOrder, true, true>(lds, g, S, E);
    }
    SEAM(5);
    if (IN(6)) REP(6) { gate_phase(P, lds); }
    SEAM(6);
    if (IN(7)) REP(7) {
        const int Mo = G > 32 ? MP : MT;
        pg8::Gemm g{(const bf16*)(P.ws + WS_O), (const bf16*)(P.ws + WS_WOUTB), Mo, DM, EA}; pg8::StaticOrder S; S.init(Mo, DM, G, c);
        pg8::EpiBf16Plain E{(bf16*)(P.ws + WS_D), DM};
        pg8::gemm_phase<pg8::EpiBf16Plain, pg8::StaticOrder, true, true>(lds, g, S, E);
    }
    SEAM(7);
    if (IN(8)) REP(8) { ln_phase<true>(P, lds, 1); }
#undef IN
#undef SEAM
}

extern "C" void kernel_launch(void* const* d_in, const int* in_sizes, int n_in, void* d_out, int out_size, void* d_ws, size_t ws_size, hipStream_t stream) {
    static int grid = 0;
    if (grid == 0) {
        if (n_in != 15 || ws_size < WS_END || out_size != 54001664) { fprintf(stderr, "kernel_launch: unexpected problem (n_in %d, out %d, ws %zu)\n", n_in, out_size, ws_size); grid = -1; return; }
        int dev = 0, cus = 0, per_cu = 0;
        if (hipGetDevice(&dev) != hipSuccess || hipDeviceGetAttribute(&cus, hipDeviceAttributeMultiprocessorCount, dev) != hipSuccess) { grid = -1; return; }
        if (hipFuncSetAttribute((const void*)mk_fwd, hipFuncAttributeMaxDynamicSharedMemorySize, LDS_BYTES) != hipSuccess) { fprintf(stderr, "kernel_launch: hipFuncSetAttribute failed\n"); grid = -1; return; }
        if (hipOccupancyMaxActiveBlocksPerMultiprocessor(&per_cu, (const void*)mk_fwd, 512, LDS_BYTES) != hipSuccess || per_cu < 1) { fprintf(stderr, "kernel_launch: occupancy query gave %d\n", per_cu); (void)hipGetLastError(); per_cu = 1; }
        grid = cus * 1;
        (void)in_sizes;
    }
    if (grid < 0) return;
    Args a{};
    for (int i = 0; i < 15; ++i) a.in[i] = (const float*)d_in[i];
    a.out = (float*)d_out; a.ws = (unsigned char*)d_ws;
#if MK_MULTI
    for (int p = 0; p < NPHASE; ++p) { a.ph_lo = p; a.ph_hi = p + 1; hipLaunchKernelGGL(mk_fwd, dim3(grid), dim3(512), LDS_BYTES, stream, a); }
#else
    a.ph_lo = 0; a.ph_hi = NPHASE;
    if (hipMemsetAsync((char*)d_ws + WS_BAR, 0, XCD_BAR_WORDS * 4, stream) != hipSuccess) { fprintf(stderr, "kernel_launch: memset of the barrier words failed\n"); return; }
    void* args[] = {&a};
    hipError_t e = hipLaunchCooperativeKernel((const void*)mk_fwd, dim3(grid), dim3(512), args, LDS_BYTES, stream);
    if (e != hipSuccess) fprintf(stderr, "kernel_launch: cooperative launch failed: %s (grid %d)\n", hipGetErrorString(e), grid);
#endif
}
```

```cpp
#include <hip/hip_runtime.h>
#include <hip/hip_cooperative_groups.h>
#include <cstdio>
#include <cstdint>
namespace cg = cooperative_groups;
#define MK_MULTI 0
namespace pg8 {
#define PG8_LAS __attribute__((address_space(3)))
typedef unsigned short bf16_t;
typedef short bf16x8 __attribute__((ext_vector_type(8)));
typedef float f32x4 __attribute__((ext_vector_type(4)));
typedef unsigned u32x4 __attribute__((ext_vector_type(4)));
constexpr int BM = 256, BK = 64, HALF = 128, HTB = HALF * BK * 2  , STAGE_BYTES = 8 * HTB, NXCD = 8, WGM = 8;

__host__ __device__ __forceinline__ int lds_byte(int r, int c) { const int st = (r >> 4) * 2 + (c >> 5), rr = r & 15, cc = c & 31, ob = rr * 64 + cc * 2; return st * 1024 + (ob ^ (((ob >> 9) & 1) << 5)); }
__host__ __device__ __forceinline__ void stage_rc(int b, int& R, int& C) { const int st = b / 1024, sb = b % 1024, swz = sb ^ (((sb >> 9) & 1) << 5); R = (st >> 1) * 16 + swz / 64; C = (st & 1) * 32 + (swz % 64) / 2; }
__host__ __device__ __forceinline__ int perm32(int rho) { const int n = rho >> 4, i = rho & 15; return 8 * (i >> 2) + 4 * n + (i & 3); }

struct Unit { int pm, pn; };
struct Gemm { const bf16_t* A; const bf16_t* Bt; int M, N, K; int nt = 0; };

struct StaticOrder {
    int nM, nN, nwg, G, c;
    __host__ __device__ void init(int M, int N, int G_, int c_) { nM = M / BM; nN = N / BM; nwg = nM * nN; G = G_; c = c_; }
    __host__ __device__ bool next(int i, Unit& u) const {
        const long L = (long)i * G + c; if (L >= nwg) return false;
        int wgid = (int)L; { const int q = nwg / NXCD, r = nwg % NXCD, xcd = wgid % NXCD, off = wgid / NXCD; wgid = (xcd < r ? xcd * (q + 1) : r * (q + 1) + (xcd - r) * q) + off; }
        const int nig = WGM * nN, gid = wgid / nig, fm = gid * WGM, gsz = (nM - fm) < WGM ? (nM - fm) : WGM;
        u.pm = fm + ((wgid % nig) % gsz); u.pn = (wgid % nig) / gsz; return true;
    }
    __device__ __forceinline__ void a_ready(const Unit&) const {}
    __device__ __forceinline__ void done(const Unit&) const {}
};

typedef float cvt_f32x2 __attribute__((ext_vector_type(2)));
typedef __bf16 cvt_bf16x2 __attribute__((ext_vector_type(2)));
__device__ __forceinline__ unsigned cvt_pk_bf16(float lo, float hi) { cvt_f32x2 v; v.x = lo; v.y = hi; const cvt_bf16x2 b = __builtin_convertvector(v, cvt_bf16x2); return __builtin_bit_cast(unsigned, b); }
typedef unsigned u32x2 __attribute__((ext_vector_type(2)));
constexpr size_t MROWS = 16896;
constexpr size_t SEC_STRIDE = (size_t)16896 * 2048;
typedef float f32x2 __attribute__((ext_vector_type(2)));
typedef _Float16 f16x2 __attribute__((ext_vector_type(2)));
__device__ __forceinline__ float silu_f(float x) { return x * __builtin_amdgcn_rcpf(1.0f + __expf(-x)); }
__device__ __forceinline__ float gelu_tanh_f(float x) { const float u = 1.5957691216057308f * (x + 0.044715f * x * x * x); return x * __builtin_amdgcn_rcpf(1.0f + __expf(-u)); }
__device__ __forceinline__ unsigned pk_f16(float lo, float hi) { f16x2 p; p.x = (_Float16)lo; p.y = (_Float16)hi; return __builtin_bit_cast(unsigned, p); }

struct EpiHgrnIn {
    static constexpr bool PERM = true, AFTER_DRAIN = false;
    bf16_t* B0; const float* lb;
    __device__ __forceinline__ void operator()(const f32x4 (&acc)[2][2][4][2], const Unit& u, int wr, int wc, int fr, int fq) const {
        const int sec = u.pn >> 3;
        const int row0 = u.pm * BM + wr * 64 + fr, col0 = (u.pn & 7) * BM + wc * 32 + 8 * fq;
        bf16_t* base = B0 + (size_t)sec * SEC_STRIDE;
        f32x4 l0[2], l1[2];
#pragma unroll
        for (int bj = 0; bj < 2; ++bj) { l0[bj] = (f32x4){0.f, 0.f, 0.f, 0.f}; l1[bj] = l0[bj]; }
        if (sec == 1) {
#pragma unroll
            for (int bj = 0; bj < 2; ++bj) { l0[bj] = *(const f32x4*)(lb + col0 + bj * HALF); l1[bj] = *(const f32x4*)(lb + col0 + bj * HALF + 4); }
        }
#pragma unroll
        for (int ai = 0; ai < 2; ++ai)
#pragma unroll
            for (int m = 0; m < 4; ++m) { bf16_t* rowp = base + ((size_t)((u.pn & 7) * 2) * MROWS + (size_t)(row0 + ai * HALF + m * 16)) * 128 + wc * 32 + 8 * fq;
#pragma unroll
                for (int bj = 0; bj < 2; ++bj) { f32x4 v0 = acc[ai][bj][m][0], v1 = acc[ai][bj][m][1]; u32x4 w;
                    if (sec == 1) {
#pragma unroll
                        for (int j = 0; j < 4; ++j) { const float s0 = __builtin_amdgcn_rcpf(1.0f + __expf(-v0[j])), s1 = __builtin_amdgcn_rcpf(1.0f + __expf(-v1[j]));
                            v0[j] = __logf(l0[bj][j] + (1.0f - l0[bj][j]) * s0); v1[j] = __logf(l1[bj][j] + (1.0f - l1[bj][j]) * s1); }
                        w.x = pk_f16(v0[0], v0[1]); w.y = pk_f16(v0[2], v0[3]); w.z = pk_f16(v1[0], v1[1]); w.w = pk_f16(v1[2], v1[3]);
                    } else {
                        if (sec != 2) {
#pragma unroll
                            for (int j = 0; j < 4; ++j) { v0[j] = silu_f(v0[j]); v1[j] = silu_f(v1[j]); } }
                        w.x = cvt_pk_bf16(v0[0], v0[1]); w.y = cvt_pk_bf16(v0[2], v0[3]); w.z = cvt_pk_bf16(v1[0], v1[1]); w.w = cvt_pk_bf16(v1[2], v1[3]);
                    }
                    *(u32x4*)(rowp + (size_t)bj * MROWS * 128) = w; } }
    }
};
struct EpiGmlpIn {
    static constexpr bool PERM = true, AFTER_DRAIN = false;
    bf16_t* B0; float* part;
    __device__ __forceinline__ void operator()(const f32x4 (&acc)[2][2][4][2], const Unit& u, int wr, int wc, int fr, int fq) const {
        const int row0 = u.pm * BM + wr * 64 + fr;
        if (u.pn < 16) {
#pragma unroll
            for (int ai = 0; ai < 2; ++ai)
#pragma unroll
                for (int m = 0; m < 4; ++m) { const int row = row0 + ai * HALF + m * 16; bf16_t* rowp = B0 + ((size_t)u.pn * MROWS + (size_t)row) * 128 + wc * 32 + 8 * fq;
                    f32x4 v0 = acc[ai][0][m][0], v1 = acc[ai][0][m][1]; const f32x4 z0 = acc[ai][1][m][0], z1 = acc[ai][1][m][1]; u32x4 w;
#pragma unroll
                    for (int j = 0; j < 4; ++j) { v0[j] = gelu_tanh_f(v0[j]) * silu_f(z0[j]); v1[j] = gelu_tanh_f(v1[j]) * silu_f(z1[j]); }
                    w.x = cvt_pk_bf16(v0[0], v0[1]); w.y = cvt_pk_bf16(v0[2], v0[3]); w.z = cvt_pk_bf16(v1[0], v1[1]); w.w = cvt_pk_bf16(v1[2], v1[3]);
                    *(u32x4*)rowp = w; }
        } else {
            const int g0 = (u.pn - 16) * 2;
#pragma unroll
            for (int ai = 0; ai < 2; ++ai)
#pragma unroll
                for (int m = 0; m < 4; ++m) { const int row = row0 + ai * HALF + m * 16; bf16_t* rowp = B0 + SEC_STRIDE + ((size_t)g0 * MROWS + (size_t)row) * 128 + wc * 32 + 8 * fq; float s = 0.f, ss = 0.f;
#pragma unroll
                    for (int bj = 0; bj < 2; ++bj) { f32x4 v0 = acc[ai][bj][m][0], v1 = acc[ai][bj][m][1]; u32x4 w;
#pragma unroll
                        for (int j = 0; j < 4; ++j) { v0[j] = gelu_tanh_f(v0[j]); v1[j] = gelu_tanh_f(v1[j]); s += v0[j] + v1[j]; ss += v0[j] * v0[j] + v1[j] * v1[j]; }
                        w.x = cvt_pk_bf16(v0[0], v0[1]); w.y = cvt_pk_bf16(v0[2], v0[3]); w.z = cvt_pk_bf16(v1[0], v1[1]); w.w = cvt_pk_bf16(v1[2], v1[3]);
                        *(u32x4*)(rowp + (size_t)bj * MROWS * 128) = w; }
                    s += __shfl_xor(s, 16); s += __shfl_xor(s, 32); ss += __shfl_xor(ss, 16); ss += __shfl_xor(ss, 32);
                    if (fq == 0) { f32x2 o; o.x = s; o.y = ss; *(f32x2*)(part + (size_t)row * 64 + ((u.pn - 16) * 4 + wc) * 2) = o; } }
        }
    }
};
struct EpiF32 {
    static constexpr bool PERM = false, AFTER_DRAIN = false;
    float* C; int ldc;
    __device__ __forceinline__ void operator()(const f32x4 (&acc)[2][2][4][2], const Unit& u, int wr, int wc, int fr, int fq) const {
        const int row0 = u.pm * BM + wr * 64 + fr, col0 = u.pn * BM + wc * 32 + 4 * fq;
#pragma unroll
        for (int ai = 0; ai < 2; ++ai)
#pragma unroll
            for (int m = 0; m < 4; ++m) { float* rowp = C + (size_t)(row0 + ai * HALF + m * 16) * ldc + col0;
#pragma unroll
                for (int bj = 0; bj < 2; ++bj)
#pragma unroll
                    for (int n = 0; n < 2; ++n) *(f32x4*)(rowp + bj * HALF + n * 16) = acc[ai][bj][m][n]; }
    }
};
struct EpiBf16Plain {
    static constexpr bool PERM = true, AFTER_DRAIN = false;
    bf16_t* C; int ldc;
    __device__ __forceinline__ void operator()(const f32x4 (&acc)[2][2][4][2], const Unit& u, int wr, int wc, int fr, int fq) const {
        const int row0 = u.pm * BM + wr * 64 + fr, col0 = u.pn * BM + wc * 32 + 8 * fq;
#pragma unroll
        for (int ai = 0; ai < 2; ++ai)
#pragma unroll
            for (int m = 0; m < 4; ++m) { bf16_t* rowp = C + (size_t)(row0 + ai * HALF + m * 16) * ldc + col0;
#pragma unroll
                for (int bj = 0; bj < 2; ++bj) { const f32x4 v0 = acc[ai][bj][m][0], v1 = acc[ai][bj][m][1]; u32x4 w;
                    w.x = cvt_pk_bf16(v0[0], v0[1]); w.y = cvt_pk_bf16(v0[2], v0[3]); w.z = cvt_pk_bf16(v1[0], v1[1]); w.w = cvt_pk_bf16(v1[2], v1[3]);
                    *(u32x4*)(rowp + bj * HALF) = w; } }
    }
};
template <class Epi, class Sched, bool ALIGN_EPI = false, bool SP2 = false>
__device__ __forceinline__ void gemm_phase(PG8_LAS unsigned char* lds, const Gemm g, const Sched& S, const Epi& E) {
    const int tid = threadIdx.x, wid = __builtin_amdgcn_readfirstlane(tid >> 6), lane = tid & 63, wr = wid >> 2, wc = wid & 3, fr = lane & 15, fq = lane >> 4;
    const int K = g.K, nt = g.nt ? g.nt : K / BK;
    unsigned voffA[2], voffB[2];
#pragma unroll
    for (int i = 0; i < 2; ++i) { int R, C; stage_rc(tid * 16 + i * 8192, R, C); const int Rb = Epi::PERM ? ((R & ~31) + perm32(R & 31)) : R;
        voffA[i] = (unsigned)(R * K + C) * 2u; voffB[i] = (unsigned)(Rb * K + C) * 2u; }
    const size_t kstep = (size_t)(BK * 2);
    const size_t hstep = (size_t)HALF * K * 2;
    const size_t tstep = 2 * hstep;
    const unsigned ldsw = (unsigned)wid * 1024u;
    const int aoff = lds_byte(wr * 64 + fr, fq * 8), boff = lds_byte(wc * 32 + fr, fq * 8);
#define PG8_SA(b, h) (((b) * 2 + (h)) * HTB)
#define PG8_SB(b, h) ((4 + (b) * 2 + (h)) * HTB)
#define PG8_STAGE(bufoff, gbase, voff) do { _Pragma("unroll") for (int _i = 0; _i < 2; ++_i) \
        __builtin_amdgcn_global_load_lds((const unsigned*)((const char*)(gbase) + (voff)[_i]), (PG8_LAS unsigned*)(lds + (bufoff) + ldsw + _i * 8192), 16, 0, 0); } while (0)
#define PG8_LDA(dst, b, h) do { _Pragma("unroll") for (int m = 0; m < 4; ++m) _Pragma("unroll") for (int k = 0; k < 2; ++k) dst[m][k] = *(const PG8_LAS bf16x8*)(lds + PG8_SA(b, h) + aoff + m * 2048 + k * 1024); } while (0)
#define PG8_LDB(dst, b, h) do { _Pragma("unroll") for (int n = 0; n < 2; ++n) _Pragma("unroll") for (int k = 0; k < 2; ++k) dst[n][k] = *(const PG8_LAS bf16x8*)(lds + PG8_SB(b, h) + boff + n * 2048 + k * 1024); } while (0)
#define PG8_MMA(ai, bj, At, Bt) do { __builtin_amdgcn_s_setprio(1); _Pragma("unroll") for (int m = 0; m < 4; ++m) _Pragma("unroll") for (int n = 0; n < 2; ++n) _Pragma("unroll") for (int k = 0; k < 2; ++k) \
        acc[ai][bj][m][n] = __builtin_amdgcn_mfma_f32_16x16x32_bf16(Bt[n][k], At[m][k], acc[ai][bj][m][n], 0, 0, 0); __builtin_amdgcn_s_setprio(0); } while (0)
#define PG8_WAIT_V(n) asm volatile("s_waitcnt vmcnt(" #n ")" ::: "memory")
#define PG8_WAIT_L(n) asm volatile("s_waitcnt lgkmcnt(" #n ")" ::: "memory")
#define PG8_BAR __builtin_amdgcn_s_barrier()
#define PG8_SCHED __builtin_amdgcn_sched_barrier(0)
    Unit cur, nxt; int ui = 0;
    if (!S.next(0, cur)) return;
    f32x4 acc[2][2][4][2];
#pragma unroll
    for (int a = 0; a < 2; ++a)
#pragma unroll
        for (int b = 0; b < 2; ++b)
#pragma unroll
            for (int m = 0; m < 4; ++m)
#pragma unroll
                for (int n = 0; n < 2; ++n) acc[a][b][m][n] = (f32x4){0.f, 0.f, 0.f, 0.f};
    bf16x8 At[4][2], B0[2][2], B1[2][2];
    const char* cA = (const char*)g.A + (size_t)cur.pm * tstep; const char* cB = (const char*)g.Bt + (size_t)cur.pn * tstep;
    S.a_ready(cur);
    if constexpr (SP2) {
        PG8_STAGE(PG8_SB(0, 0), cB, voffB); PG8_STAGE(PG8_SB(0, 1), cB + hstep, voffB); PG8_STAGE(PG8_SA(0, 0), cA, voffA); PG8_STAGE(PG8_SA(0, 1), cA + hstep, voffA);
        if (wr == 1) PG8_BAR;
        PG8_WAIT_V(2); PG8_BAR;
        PG8_STAGE(PG8_SB(1, 0), cB + kstep, voffB); PG8_STAGE(PG8_SA(1, 0), cA + kstep, voffA); PG8_STAGE(PG8_SB(1, 1), cB + hstep + kstep, voffB);
        PG8_WAIT_V(6); PG8_BAR;
    } else {
        PG8_STAGE(PG8_SB(0, 0), cB, voffB); PG8_STAGE(PG8_SA(0, 0), cA, voffA); PG8_STAGE(PG8_SB(0, 1), cB + hstep, voffB); PG8_STAGE(PG8_SA(0, 1), cA + hstep, voffA);
        if (wr == 1) PG8_BAR;
        PG8_WAIT_V(4); PG8_BAR;
        PG8_STAGE(PG8_SB(1, 0), cB + kstep, voffB); PG8_STAGE(PG8_SA(1, 0), cA + kstep, voffA); PG8_STAGE(PG8_SB(1, 1), cB + hstep + kstep, voffB);
        PG8_WAIT_V(6); PG8_BAR;
    }
    for (;;) {
        const bool has_next = S.next(ui + 1, nxt);
        const char* nA = has_next ? (const char*)g.A + (size_t)nxt.pm * tstep : cA; const char* nB = has_next ? (const char*)g.Bt + (size_t)nxt.pn * tstep : cB;
        for (int t = 0; t < nt; t += 2) {
            const bool last = (t == nt - 2);
            const char* a1 = cA + (size_t)(t + 1) * kstep;
            const char* a2 = last ? nA : cA + (size_t)(t + 2) * kstep; const char* b2 = last ? nB : cB + (size_t)(t + 2) * kstep;
            const char* a3 = a2 + kstep; const char* b3 = b2 + kstep;
            if (last && has_next) S.a_ready(nxt);
            if constexpr (SP2) {
            PG8_LDB(B0, 0, 0); PG8_LDB(B1, 0, 1); PG8_SCHED; PG8_LDA(At, 0, 0); PG8_STAGE(PG8_SA(1, 1), a1 + hstep, voffA);
            PG8_WAIT_V(8); PG8_WAIT_L(0); PG8_BAR; PG8_MMA(0, 0, At, B0); PG8_MMA(0, 1, At, B1); PG8_BAR; PG8_SCHED;
            PG8_LDA(At, 0, 1); PG8_STAGE(PG8_SB(0, 0), b2, voffB); PG8_STAGE(PG8_SB(0, 1), b2 + hstep, voffB); PG8_STAGE(PG8_SA(0, 0), a2, voffA);
            PG8_WAIT_V(8); PG8_WAIT_L(0); PG8_BAR; PG8_MMA(1, 0, At, B0); PG8_MMA(1, 1, At, B1); PG8_BAR; PG8_SCHED;
            PG8_LDB(B0, 1, 0); PG8_LDB(B1, 1, 1); PG8_SCHED; PG8_LDA(At, 1, 0); PG8_STAGE(PG8_SA(0, 1), a2 + hstep, voffA);
            PG8_WAIT_V(8); PG8_WAIT_L(0); PG8_BAR; PG8_MMA(0, 0, At, B0); PG8_MMA(0, 1, At, B1); PG8_BAR; PG8_SCHED;
            PG8_LDA(At, 1, 1); PG8_STAGE(PG8_SB(1, 0), b3, voffB); PG8_STAGE(PG8_SB(1, 1), b3 + hstep, voffB); PG8_STAGE(PG8_SA(1, 0), a3, voffA);
            PG8_WAIT_V(8); PG8_WAIT_L(0); PG8_BAR; PG8_MMA(1, 0, At, B0); PG8_MMA(1, 1, At, B1); PG8_BAR; PG8_SCHED;
            } else {
            PG8_LDB(B0, 0, 0); PG8_SCHED; PG8_LDA(At, 0, 0); PG8_STAGE(PG8_SA(1, 1), a1 + hstep, voffA);
            PG8_WAIT_L(8); PG8_BAR; PG8_WAIT_L(0); PG8_MMA(0, 0, At, B0); PG8_BAR; PG8_SCHED;
            PG8_LDB(B1, 0, 1); PG8_STAGE(PG8_SB(0, 0), b2, voffB);
            PG8_BAR; PG8_WAIT_L(0); PG8_MMA(0, 1, At, B1); PG8_BAR;
            PG8_LDA(At, 0, 1); PG8_STAGE(PG8_SA(0, 0), a2, voffA);
            PG8_BAR; PG8_WAIT_L(0); PG8_MMA(1, 0, At, B0); PG8_BAR; PG8_SCHED;
            PG8_STAGE(PG8_SB(0, 1), b2 + hstep, voffB);
            PG8_WAIT_V(6); PG8_BAR; PG8_MMA(1, 1, At, B1); PG8_BAR;
            PG8_LDB(B0, 1, 0); PG8_SCHED; PG8_LDA(At, 1, 0); PG8_STAGE(PG8_SA(0, 1), a2 + hstep, voffA);
            PG8_WAIT_L(8); PG8_BAR; PG8_WAIT_L(0); PG8_MMA(0, 0, At, B0); PG8_BAR; PG8_SCHED;
            PG8_LDB(B1, 1, 1); PG8_STAGE(PG8_SB(1, 0), b3, voffB);
            PG8_BAR; PG8_WAIT_L(0); PG8_MMA(0, 1, At, B1); PG8_BAR;
            PG8_LDA(At, 1, 1); PG8_STAGE(PG8_SA(1, 0), a3, voffA);
            PG8_BAR; PG8_WAIT_L(0); PG8_MMA(1, 0, At, B0); PG8_BAR; PG8_SCHED;
            PG8_STAGE(PG8_SB(1, 1), b3 + hstep, voffB);
            PG8_WAIT_V(6); PG8_BAR; PG8_MMA(1, 1, At, B1); PG8_BAR;
            }
        }
        if constexpr (ALIGN_EPI) { if (wr == 0) PG8_BAR; }
        if constexpr (!Epi::AFTER_DRAIN) { E(acc, cur, wr, wc, fr, fq); S.done(cur); }
        if (!has_next) break;
#pragma unroll
        for (int a = 0; a < 2; ++a)
#pragma unroll
            for (int b = 0; b < 2; ++b)
#pragma unroll
                for (int m = 0; m < 4; ++m)
#pragma unroll
                    for (int n = 0; n < 2; ++n) acc[a][b][m][n] = (f32x4){0.f, 0.f, 0.f, 0.f};
        cur = nxt; cA = nA; cB = nB; ++ui;
        if constexpr (ALIGN_EPI) { if (wr == 1) PG8_BAR; }
    }
    PG8_WAIT_V(0);
    if constexpr (!ALIGN_EPI) { if (wr == 0) PG8_BAR; }
    PG8_BAR;
    if constexpr (Epi::AFTER_DRAIN) { E.fused(acc, cur, wr, wc, fr, fq, lds, wid, lane); S.done(cur); }
#undef PG8_SA
#undef PG8_SB
#undef PG8_STAGE
#undef PG8_LDA
#undef PG8_LDB
#undef PG8_MMA
#undef PG8_WAIT_V
#undef PG8_WAIT_L
#undef PG8_BAR
#undef PG8_SCHED
}
}

#define GAS __attribute__((address_space(1)))
#define LAS __attribute__((address_space(3)))
typedef unsigned short bf16;
typedef unsigned v4u __attribute__((ext_vector_type(4)));
typedef unsigned v2u __attribute__((ext_vector_type(2)));
typedef float f32x4 __attribute__((ext_vector_type(4)));
typedef float f32x2 __attribute__((ext_vector_type(2)));
typedef short bf16x8 __attribute__((ext_vector_type(8)));
typedef _Float16 f16x2 __attribute__((ext_vector_type(2)));

#ifndef MK_MULTI
#define MK_MULTI 0
#endif
constexpr int NPHASE = 9;
constexpr int MP = 16384, MS = 512, MT = MP + MS, DM = 1024, EA = 2048;
constexpr float LN_EPS = 1e-5f, ALPHA = 1.4142135623730951f;
constexpr size_t MiB = 1u << 20;
constexpr size_t WS_CTL = 0, WS_LB = 64 * 1024, WS_WSB = 1 * MiB, WS_WINA = 2 * MiB, WS_WOUTA = 18 * MiB, WS_WINB = 22 * MiB, WS_WOUTB = 34 * MiB, WS_PART = 38 * MiB;
constexpr size_t WS_XB = 44 * MiB;
constexpr size_t WS_Q = 78 * MiB, WS_LF = 144 * MiB, WS_V = 210 * MiB, WS_G = 276 * MiB, WS_O = 342 * MiB, WS_D = 408 * MiB, WS_DP = 474 * MiB, WS_END = 482 * MiB;
constexpr size_t WS_U = WS_Q, WS_VB = WS_LF, WS_Z = WS_V, WS_H1F = WS_G;
static_assert(WS_LF - WS_Q == pg8::SEC_STRIDE * 2 && WS_V - WS_LF == pg8::SEC_STRIDE * 2 && WS_G - WS_V == pg8::SEC_STRIDE * 2 && WS_O - WS_G == pg8::SEC_STRIDE * 2, "section stride");
constexpr size_t OUT_Y = 0, OUT_HP = 17301504, OUT_HS = 19398656, OUT_CV = 52953088;
constexpr int LDS_BYTES = 131072 + 1024;
constexpr size_t WS_BAR = 32 * 1024;

__device__ __forceinline__ unsigned pkbf(float lo, float hi) { return pg8::cvt_pk_bf16(lo, hi); }
__device__ __forceinline__ float bf_lo(unsigned w) { return __builtin_bit_cast(float, w << 16); }
__device__ __forceinline__ float bf_hi(unsigned w) { return __builtin_bit_cast(float, w & 0xffff0000u); }
__device__ __forceinline__ float wave_sum(float v) {
#pragma unroll
    for (int o = 1; o < 64; o <<= 1) v += __shfl_xor(v, o);
    return v;
}
#define LDS_WAIT() asm volatile("s_waitcnt lgkmcnt(0)" ::: "memory")

__device__ __forceinline__ void p0_transpose_item(const float* W, int K, int N, bf16* WT, LAS float* scr, int item, int lane, bool gmlp = false) {
    const int nblk = N / 32, kb = item / nblk, nb = item % nblk, k0 = 64 * kb, nd = 32 * nb;
    int n0 = nd;
    if (gmlp) { if (nd < 4096) { const int tile = nd >> 8, half = (nd >> 7) & 1, cc = nd & 127; n0 = (half ? 4096 : 0) + tile * 128 + cc; } else n0 = 2048 + (nd - 4096); }
    float wv[32];
#pragma unroll
    for (int i = 0; i < 32; ++i) { const int kk = 2 * i + (lane >> 5); wv[i] = __builtin_nontemporal_load(W + (size_t)(k0 + kk) * N + n0 + (lane & 31)); }
#pragma unroll
    for (int i = 0; i < 32; ++i) { const int kk = 2 * i + (lane >> 5); scr[kk * 33 + (lane & 31)] = wv[i]; }
    LDS_WAIT(); asm volatile("" ::: "memory");
    const int c = lane & 7;
#pragma unroll
    for (int j = 0; j < 4; ++j) { const int n = (lane >> 3) + 8 * j; const LAS float* s = scr + (8 * c) * 33 + n;
        v4u o; o.x = pkbf(s[0 * 33], s[1 * 33]); o.y = pkbf(s[2 * 33], s[3 * 33]); o.z = pkbf(s[4 * 33], s[5 * 33]); o.w = pkbf(s[6 * 33], s[7 * 33]);
        *(v4u*)(WT + (size_t)(nd + n) * K + k0 + 8 * c) = o; }
    LDS_WAIT(); asm volatile("" ::: "memory");
}

typedef GAS unsigned gu32;
#define XB_TMO      128
#define XB_XCNT(j)  (256  + 64 * (j))
#define XB_XSUB(j)  (1280 + 64 * (j))
#define XB_XGEN(j)  (2304 + 64 * (j))
#define XB_TOP      3328
#define XB_TOPGEN   3392
#define XCD_BAR_WORDS 3456
#define XB_SPIN_CAP (1u << 18)

__device__ __forceinline__ unsigned xb_ld(unsigned* p)              { return __hip_atomic_load(p, __ATOMIC_RELAXED, __HIP_MEMORY_SCOPE_AGENT); }
__device__ __forceinline__ unsigned xb_add(unsigned* p, unsigned v) { return __hip_atomic_fetch_add(p, v, __ATOMIC_RELAXED, __HIP_MEMORY_SCOPE_AGENT); }
__device__ __forceinline__ unsigned xb_xcc_id() { return (unsigned)__builtin_amdgcn_s_getreg((3 << 11) | 20) & 0xFu; }
#define XB_SPIN(cond, bar) do { unsigned _sp = 0; while (cond) { __builtin_amdgcn_s_sleep(1); \
    if ((++_sp & 255u) == 0u) { if (xb_ld(&(bar)[XB_TMO])) break; if (_sp > XB_SPIN_CAP) { atomicAdd(&(bar)[XB_TMO], 1u); break; } } } } while (0)

struct XcdBarrier {
    unsigned* bar; unsigned x;
    volatile LAS unsigned* st;
};

__device__ __forceinline__ XcdBarrier xcd_barrier_post(unsigned* bar, volatile LAS unsigned* st) {
    XcdBarrier b; b.bar = bar; b.x = xb_xcc_id(); b.st = st;
    if (threadIdx.x == 0) (void)xb_add(&bar[XB_XCNT(b.x)], 1u);
    return b;
}
__device__ __forceinline__ void xcd_barrier_complete(unsigned* bar, unsigned x, unsigned& nloc, unsigned& nx) {
    const unsigned G = gridDim.x * gridDim.y * gridDim.z;
    unsigned sum, cnt, mine, sp = 0u;
    for (;;) {
        sum = 0u; cnt = 0u; mine = 0u;
#pragma unroll
        for (unsigned j = 0; j < 16; ++j) { const unsigned c = xb_ld(&bar[XB_XCNT(j)]); sum += c; cnt += (c > 0u) ? 1u : 0u; mine = (j == x) ? c : mine; }
        if (sum == G) break;
        __builtin_amdgcn_s_sleep(1);
        if ((++sp & 255u) == 0u) { if (xb_ld(&bar[XB_TMO])) break; if (sp > XB_SPIN_CAP) { atomicAdd(&bar[XB_TMO], 1u); break; } }
    }
    nloc = mine > 0u ? mine : 1u; nx = cnt > 0u ? cnt : 1u;
}

__device__ __forceinline__ void xcd_barrier(const XcdBarrier& b) {
    asm volatile("s_waitcnt vmcnt(0)" ::: "memory");
    __syncthreads();
    if (threadIdx.x == 0) {
        unsigned* bar = b.bar;
        __builtin_amdgcn_s_waitcnt(0);
        unsigned nloc = b.st[0], nx = b.st[1];
        if (nloc == 0u) { xcd_barrier_complete(bar, b.x, nloc, nx); b.st[0] = nloc; b.st[1] = nx; }
        const unsigned old = xb_add(&bar[XB_XSUB(b.x)], 1u);
        const unsigned gen = old / nloc;
        if (old + 1u == (gen + 1u) * nloc) {
            __builtin_amdgcn_fence(__ATOMIC_RELEASE, "agent");
            asm volatile("s_waitcnt vmcnt(0)" ::: "memory");
            const unsigned og = xb_add(&bar[XB_TOP], 1u);
            const unsigned tg = og / nx;
            if (og + 1u == (tg + 1u) * nx) xb_add(&bar[XB_TOPGEN], 1u);
            else XB_SPIN(xb_ld(&bar[XB_TOPGEN]) == tg, bar);
            __builtin_amdgcn_fence(__ATOMIC_ACQUIRE, "agent");
            xb_add(&bar[XB_XGEN(b.x)], 1u);
            asm volatile("s_waitcnt vmcnt(0)" ::: "memory");
        } else {
            XB_SPIN(xb_ld(&bar[XB_XGEN(b.x)]) == gen, bar);
            __builtin_amdgcn_fence(__ATOMIC_ACQUIRE, "agent");
            asm volatile("s_waitcnt vmcnt(0)" ::: "memory");
        }
    }
    __syncthreads();
}

struct Ptrs {
    const float *xp, *xs, *state, *w_in_a, *lb_logits, *gnorm, *w_out_a, *w_in_b, *lnv_g, *lnv_b, *w_s, *b_s, *w_out_b, *ln_g, *ln_b;
    float* out; unsigned char* ws;
};

__device__ __forceinline__ void p0_prologue(const Ptrs& P, LAS unsigned char* lds) {
    const int tid = threadIdx.x, lane = tid & 63, wave = __builtin_amdgcn_readfirstlane(tid >> 6);
    LAS float* scr = (LAS float*)(lds + wave * 16384);
    const int gw = blockIdx.x * 8 + wave, NGW = gridDim.x * 8;
    constexpr int I_A = (DM / 64) * (4 * EA / 32), I_OA = (EA / 64) * (DM / 32), I_B = (DM / 64) * (3 * EA / 32), I_OB = I_OA, NITEMS = I_A + I_OA + I_B + I_OB;
    const int n_early = (gridDim.x >= 128) ? I_A : NITEMS;
    for (int it = gw; it < n_early; it += NGW) {
        int r = it;
        if (r < I_A) { p0_transpose_item(P.w_in_a, DM, 4 * EA, (bf16*)(P.ws + WS_WINA), scr, r, lane); continue; } r -= I_A;
        if (r < I_OA) { p0_transpose_item(P.w_out_a, EA, DM, (bf16*)(P.ws + WS_WOUTA), scr, r, lane); continue; } r -= I_OA;
        if (r < I_B) { p0_transpose_item(P.w_in_b, DM, 3 * EA, (bf16*)(P.ws + WS_WINB), scr, r, lane, true); continue; } r -= I_B;
        p0_transpose_item(P.w_out_b, EA, DM, (bf16*)(P.ws + WS_WOUTB), scr, r, lane);
    }
    const size_t gtid = (size_t)blockIdx.x * 512 + tid, GT = (size_t)gridDim.x * 512;
    {
        const f32x4* xp4 = (const f32x4*)P.xp; const f32x4* xs4 = (const f32x4*)P.xs; v2u* xb = (v2u*)(P.ws + WS_XB);
        constexpr size_t NP4 = (size_t)MP * DM / 4, NT4 = (size_t)MT * DM / 4;
        for (size_t q = gtid; q < NT4; q += 4 * GT) { f32x4 v[4];
#pragma unroll
            for (int k = 0; k < 4; ++k) { size_t qq = q + k * GT; qq = qq < NT4 ? qq : NT4 - 1; v[k] = __builtin_nontemporal_load(qq < NP4 ? xp4 + qq : xs4 + (qq - NP4)); }
#pragma unroll
            for (int k = 0; k < 4; ++k) { const size_t qq = q + k * GT; if (qq < NT4) { v2u o; o.x = pkbf(v[k].x, v[k].y); o.y = pkbf(v[k].z, v[k].w); xb[qq] = o; } } }
    }
    {
        const f32x4* w4 = (const f32x4*)P.w_s; v2u* wb = (v2u*)(P.ws + WS_WSB);
        for (size_t q = gtid; q < (size_t)16 * 128 * 128 / 4; q += GT) { const int e = (int)(q * 4), s = e & 127, t = (e >> 7) & 127; const f32x4 v = w4[q];
            v2u o; o.x = pkbf(s <= t ? v.x : 0.f, s + 1 <= t ? v.y : 0.f); o.y = pkbf(s + 2 <= t ? v.z : 0.f, s + 3 <= t ? v.w : 0.f); wb[q] = o; }
    }
    if (gtid < 2048) { float* lb = (float*)(P.ws + WS_LB); lb[gtid] = 1.0f / (1.0f + expf(P.lb_logits[2048 + gtid] - P.lb_logits[gtid])); }
    if (gtid < 4) { ((unsigned*)(P.ws + WS_CTL))[64 * gtid] = 0u; }
}

__device__ __forceinline__ void p0_late_weights(const Ptrs& P, LAS unsigned char* lds, int widx, int nw) {
    const int tid = threadIdx.x, lane = tid & 63, wave = __builtin_amdgcn_readfirstlane(tid >> 6);
    LAS float* scr = (LAS float*)(lds + wave * 16384);
    constexpr int I_OA = (EA / 64) * (DM / 32), I_B = (DM / 64) * (3 * EA / 32), I_OB = I_OA, NLATE = I_OA + I_B + I_OB;
    for (int it = widx * 8 + wave; it < NLATE; it += nw * 8) {
        int r = it;
        if (r < I_OA) { p0_transpose_item(P.w_out_a, EA, DM, (bf16*)(P.ws + WS_WOUTA), scr, r, lane); continue; } r -= I_OA;
        if (r < I_B) { p0_transpose_item(P.w_in_b, DM, 3 * EA, (bf16*)(P.ws + WS_WINB), scr, r, lane, true); continue; } r -= I_B;
        p0_transpose_item(P.w_out_b, EA, DM, (bf16*)(P.ws + WS_WOUTB), scr, r, lane);
    }
}

struct OneUnit {
    pg8::Unit u0;
    __device__ __forceinline__ bool next(int i, pg8::Unit& u) const { if (i != 0) return false; u = u0; return true; }
    __device__ __forceinline__ void a_ready(const pg8::Unit&) const {}
    __device__ __forceinline__ void done(const pg8::Unit&) const {}
};
template <bool FINAL, int NR, bool PARTS = false>
__device__ __forceinline__ void ln_rows(const Ptrs& P, const f32x4* g4, const f32x4* b4, int mbase, int mstride, int mend, int lane) {
    const bf16* D = (const bf16*)(P.ws + WS_D); bf16* H1B = (bf16*)(P.ws + WS_XB);
    f32x4 v[NR][4]; float s[NR];
#pragma unroll
    for (int k = 0; k < NR; ++k) { int m = mbase + k * mstride; m = m < mend ? m : mend - 1;
        f32x4 x[4];
        if (FINAL) { const v2u* h4 = (const v2u*)(H1B + (size_t)m * DM);
#pragma unroll
            for (int j = 0; j < 4; ++j) { const v2u r = __builtin_nontemporal_load(h4 + 64 * j + lane); x[j].x = bf_lo(r.x); x[j].y = bf_hi(r.x); x[j].z = bf_lo(r.y); x[j].w = bf_hi(r.y); } }
        else { const f32x4* x4 = (const f32x4*)(m < MP ? P.xp + (size_t)m * DM : P.xs + (size_t)(m - MP) * DM);
#pragma unroll
            for (int j = 0; j < 4; ++j) x[j] = __builtin_nontemporal_load(x4 + 64 * j + lane); }
        if (PARTS) { const f32x4* d4 = (const f32x4*)(P.ws + WS_DP) + (size_t)(m - MP) * (DM / 4);
#pragma unroll
            for (int j = 0; j < 4; ++j) v[k][j] = x[j] * ALPHA + ((d4[64 * j + lane] + d4[64 * j + lane + 512 * DM / 4]) + (d4[64 * j + lane + 2 * 512 * DM / 4] + d4[64 * j + lane + 3 * 512 * DM / 4])); }
        else { const v2u* d4 = (const v2u*)(D + (size_t)m * DM);
#pragma unroll
            for (int j = 0; j < 4; ++j) { const v2u r = __builtin_nontemporal_load(d4 + 64 * j + lane); f32x4 d; d.x = bf_lo(r.x); d.y = bf_hi(r.x); d.z = bf_lo(r.y); d.w = bf_hi(r.y); v[k][j] = x[j] * ALPHA + d; } } }
#pragma unroll
    for (int k = 0; k < NR; ++k) { s[k] = 0.f;
#pragma unroll
        for (int j = 0; j < 4; ++j) s[k] += (v[k][j].x + v[k][j].y) + (v[k][j].z + v[k][j].w); }
#pragma unroll
    for (int o = 1; o < 64; o <<= 1) {
#pragma unroll
        for (int k = 0; k < NR; ++k) s[k] += __shfl_xor(s[k], o); }
#pragma unroll
    for (int k = 0; k < NR; ++k) { const float mean = s[k] * (1.0f / DM); s[k] = 0.f;
#pragma unroll
        for (int j = 0; j < 4; ++j) { v[k][j] = v[k][j] - mean; s[k] += (v[k][j].x * v[k][j].x + v[k][j].y * v[k][j].y) + (v[k][j].z * v[k][j].z + v[k][j].w * v[k][j].w); } }
#pragma unroll
    for (int o = 1; o < 64; o <<= 1) {
#pragma unroll
        for (int k = 0; k < NR; ++k) s[k] += __shfl_xor(s[k], o); }
#pragma unroll
    for (int j = 0; j < 4; ++j) { const f32x4 gg = g4[64 * j + lane], bb = b4[64 * j + lane];
#pragma unroll
        for (int k = 0; k < NR; ++k) { const int m = mbase + k * mstride; if (m < mend) { const float rstd = __builtin_amdgcn_rsqf(s[k] * (1.0f / DM) + LN_EPS); const f32x4 y = v[k][j] * rstd * gg + bb;
            if (FINAL) { __builtin_nontemporal_store(y, (f32x4*)(P.out + OUT_Y + (size_t)m * DM) + 64 * j + lane); }
            else { v2u o; o.x = pkbf(y.x, y.y); o.y = pkbf(y.z, y.w); ((v2u*)(H1B + (size_t)m * DM))[64 * j + lane] = o; } } } }
}
template <bool FINAL>
__device__ __forceinline__ void ln_phase(const Ptrs& P, LAS unsigned char* lds, int layer) {
    const int tid = threadIdx.x, lane = tid & 63, wave = tid >> 6;
    const int G = (int)gridDim.x, bx = (int)blockIdx.x;
    const f32x4* g4 = (const f32x4*)(P.ln_g + layer * DM); const f32x4* b4 = (const f32x4*)(P.ln_b + layer * DM);
    if (G <= 32) {
        for (int m = bx * 8 + wave; m < MT; m += G * 8) ln_rows<FINAL, 1>(P, g4, b4, m, 0, MT, lane);
        return;
    }
    if (bx < 32) {
        unsigned* cnt = (unsigned*)(P.ws + WS_CTL) + 64 * (2 + layer);
        const int unit = bx >> 2, ks = bx & 3;
        pg8::Gemm g{(const bf16*)(P.ws + WS_O) + ks * 512, (const bf16*)(P.ws + (FINAL ? WS_WOUTB : WS_WOUTA)) + ks * 512, MT, DM, EA, 8};
        OneUnit S; S.u0.pm = MP / 256 + (unit >> 2); S.u0.pn = unit & 3;
        pg8::EpiF32 E{(float*)(P.ws + WS_DP) + (size_t)ks * 512 * DM - (size_t)MP * DM, DM};
        pg8::gemm_phase<pg8::EpiF32, OneUnit, true, true>(lds, g, S, E);
        asm volatile("s_waitcnt vmcnt(0)" ::: "memory");
        __syncthreads();
        if (tid == 0) {
            __builtin_amdgcn_fence(__ATOMIC_RELEASE, "agent"); asm volatile("s_waitcnt vmcnt(0)" ::: "memory");
            __hip_atomic_fetch_add(cnt, 1u, __ATOMIC_RELAXED, __HIP_MEMORY_SCOPE_AGENT);
            while (__hip_atomic_load(cnt, __ATOMIC_RELAXED, __HIP_MEMORY_SCOPE_AGENT) < 32u) __builtin_amdgcn_s_sleep(4);
            __builtin_amdgcn_fence(__ATOMIC_ACQUIRE, "agent"); asm volatile("s_waitcnt vmcnt(0)" ::: "memory");
        }
        __syncthreads();
        __builtin_amdgcn_fence(__ATOMIC_ACQUIRE, "agent");
        ln_rows<FINAL, 2, true>(P, g4, b4, MP + bx * 16 + wave * 2, 1, MT, lane);
    } else {
        const int nw = (G - 32) * 8;
        for (int m = (bx - 32) * 8 + wave; m < MP; m += 3 * nw) ln_rows<FINAL, 3>(P, g4, b4, m, nw, MP, lane);
    }
}

#define MFMA16(a, b, c) __builtin_amdgcn_mfma_f32_16x16x32_bf16((a), (b), (c), 0, 0, 0)
__device__ __forceinline__ void hgrn_unit(LAS unsigned char* lds, const bf16* Q, const bf16* LF, const bf16* V, const bf16* G, bf16* O, const float* gnorm,
                                          int m0, int h, float* s_out, int nb, int ne, bool store_state) {
    const int tid = threadIdx.x, lane = tid & 63, wid = __builtin_amdgcn_readfirstlane(tid >> 6);
    const int i = lane & 15, g = lane >> 4, wq = wid & 3, hc = h * 128;
    constexpr int SQ = 136, SK = 72, nch = 32;
    LAS unsigned char* QD = lds; LAS unsigned char* KI = lds + 17408; LAS unsigned char* KET = lds + 34816; LAS unsigned char* VT = lds + 53248; LAS unsigned char* ST = lds + 71680;
    LAS float* DEC = (LAS float*)(lds + 106496); LAS float* GN = (LAS float*)(lds + 111104);
    if (tid < 128) GN[tid] = gnorm[hc + tid];
    if (wid < 4) {
        const int t0 = 16 * wid;
        v4u gq_n[4], gq_c[4];
        LAS unsigned char* OT = lds + 111616;
        const bf16* gp = G + ((size_t)h * MT + (size_t)(m0 + t0 + g)) * 128 + 8 * i;
        bf16* orow = O + (size_t)(m0 + t0 + g) * 2048 + hc + 8 * i;
        bf16* prow = orow;
#define LOAD_GATE(nn) do { const int nc_ = (nn) < nch ? (nn) : nch - 1; const bf16* gb_ = gp + (size_t)nc_ * 8192; \
        _Pragma("unroll") for (int j = 0; j < 4; ++j) gq_n[j] = __builtin_nontemporal_load((const v4u*)(gb_ + (size_t)j * 4 * 128)); } while (0)
#define STORE_PREV() do { _Pragma("unroll") for (int j = 0; j < 4; ++j) { const v4u ot_ = *(const LAS v4u*)(OT + ((t0 + g + 4 * j) * 136 + 8 * i) * 2); const v4u gg_ = gq_c[j]; v4u w_; \
        w_.x = pkbf(bf_lo(ot_.x) * bf_lo(gg_.x), bf_hi(ot_.x) * bf_hi(gg_.x)); w_.y = pkbf(bf_lo(ot_.y) * bf_lo(gg_.y), bf_hi(ot_.y) * bf_hi(gg_.y)); \
        w_.z = pkbf(bf_lo(ot_.z) * bf_lo(gg_.z), bf_hi(ot_.z) * bf_hi(gg_.z)); w_.w = pkbf(bf_lo(ot_.w) * bf_lo(gg_.w), bf_hi(ot_.w) * bf_hi(gg_.w)); \
        *(v4u*)(prow + (size_t)j * 4 * 2048) = w_; } } while (0)
        if (nb > 0) {
            const size_t so_ = ((size_t)h * MT + (size_t)(m0 + 16 * wid + (lane >> 4))) * 128 + 8 * (lane & 15);
            const bf16* sl_ = LF + so_; const bf16* sv_ = V + so_;
            LAS unsigned char* RLs = lds + ((16 * wid + (lane >> 4)) * 128 + 8 * (lane & 15)) * 2; LAS unsigned char* RVs = RLs + 16384;
            v4u r0[8], r1[8], r2[8];
#define WU_LOAD(R, cc) do { const int nc_ = (cc) < nch ? (cc) : nch - 1; const size_t co_ = (size_t)nc_ * 8192; \
            _Pragma("unroll") for (int j = 0; j < 4; ++j) { R[j] = *(const v4u*)(sl_ + co_ + (size_t)j * 4 * 128); R[4 + j] = *(const v4u*)(sv_ + co_ + (size_t)j * 4 * 128); } } while (0)
#define WU_STAGE(R) do { _Pragma("unroll") for (int j = 0; j < 4; ++j) { *(LAS v4u*)(RLs + j * 4 * 256) = R[j]; *(LAS v4u*)(RVs + j * 4 * 256) = R[4 + j]; } } while (0)
            WU_LOAD(r0, 1); WU_LOAD(r1, 2); WU_LOAD(r2, 3);
            for (int n = 0; n < nb; n += 3) {
                WU_STAGE(r0); WU_LOAD(r0, n + 4); __syncthreads(); __syncthreads();
                WU_STAGE(r1); WU_LOAD(r1, n + 5); __syncthreads(); __syncthreads();
                WU_STAGE(r2); WU_LOAD(r2, n + 6); __syncthreads(); __syncthreads();
            }
#undef WU_LOAD
#undef WU_STAGE
        }
        LOAD_GATE(nb);
        __builtin_amdgcn_s_setprio(2);
        for (int n = nb; n < ne; ++n) {
            int i_ = i, g_ = g; asm volatile("" : "+v"(i_), "+v"(g_));
            if (n > nb) STORE_PREV();
#pragma unroll
            for (int j = 0; j < 4; ++j) gq_c[j] = gq_n[j];
            LOAD_GATE(n + 1);
            __syncthreads();
            {
                bf16x8 bq[4];
#pragma unroll
                for (int kk = 0; kk < 4; ++kk) bq[kk] = *(const LAS bf16x8*)(QD + ((t0 + i_) * SQ + 32 * kk + 8 * g_) * 2);
                bf16x8 pc[2];
                {
                    f32x4 sT[4];
#pragma unroll
                    for (int st = 0; st < 4; ++st) {
                        f32x4 a4 = (f32x4){0.f, 0.f, 0.f, 0.f};
#pragma unroll
                        for (int kk = 0; kk < 4; ++kk) { const bf16x8 a = *(const LAS bf16x8*)(KI + ((16 * st + i_) * SQ + 32 * kk + 8 * g_) * 2); a4 = MFMA16(a, bq[kk], a4); }
#pragma unroll
                        for (int r = 0; r < 4; ++r) if (16 * st + 4 * g_ + r > t0 + i_) a4[r] = 0.f;
                        sT[st] = a4;
                    }
#pragma unroll
                    for (int c = 0; c < 2; ++c) { v4u w; w.x = pkbf(sT[2 * c][0], sT[2 * c][1]); w.y = pkbf(sT[2 * c][2], sT[2 * c][3]); w.z = pkbf(sT[2 * c + 1][0], sT[2 * c + 1][1]); w.w = pkbf(sT[2 * c + 1][2], sT[2 * c + 1][3]);
                        pc[c] = __builtin_bit_cast(bf16x8, w); }
                }
                f32x4 oa[8]; float ss = 0.f;
#pragma unroll
                for (int vt = 0; vt < 8; ++vt) {
                    f32x4 acc = (f32x4){0.f, 0.f, 0.f, 0.f};
#pragma unroll
                    for (int c = 0; c < 2; ++c) {
                        const v2u lo = *(const LAS v2u*)(VT + ((16 * vt + i_) * SK + 32 * c + 4 * g_) * 2), hi = *(const LAS v2u*)(VT + ((16 * vt + i_) * SK + 32 * c + 16 + 4 * g_) * 2);
                        v4u w; w.x = lo.x; w.y = lo.y; w.z = hi.x; w.w = hi.y; acc = MFMA16(__builtin_bit_cast(bf16x8, w), pc[c], acc); }
#pragma unroll
                    for (int kk = 0; kk < 4; ++kk) { const bf16x8 a = *(const LAS bf16x8*)(ST + ((16 * vt + i_) * SQ + 32 * kk + 8 * g_) * 2); acc = MFMA16(a, bq[kk], acc); }
                    oa[vt] = acc; ss += (acc[0] * acc[0] + acc[1] * acc[1]) + (acc[2] * acc[2] + acc[3] * acc[3]);
                }
                ss += __shfl_xor(ss, 16); ss += __shfl_xor(ss, 32);
                const float sc = __builtin_amdgcn_rsqf(ss * (1.0f / 128.0f) + LN_EPS);
#pragma unroll
                for (int vt = 0; vt < 8; ++vt) { const f32x4 gn = *(const LAS f32x4*)(GN + 16 * vt + 4 * g_) * sc; v2u w_;
                    w_.x = pkbf(oa[vt][0] * gn[0], oa[vt][1] * gn[1]); w_.y = pkbf(oa[vt][2] * gn[2], oa[vt][3] * gn[3]);
                    *(LAS v2u*)(OT + ((t0 + i_) * 136 + 16 * vt + 4 * g_) * 2) = w_; }
                prow = orow + (size_t)n * (64 * 2048);
            }
            __syncthreads();
        }
        STORE_PREV();
        __builtin_amdgcn_s_setprio(0);
#undef STORE_PREV
#undef LOAD_GATE
    } else {
        const int cp = i, rg = g, c0 = 32 * wq + 2 * cp;
        const size_t pofs = ((size_t)h * MT + (size_t)(m0 + 16 * rg)) * 128 + c0;
        const bf16* qp = Q + pofs; const bf16* lp = LF + pofs; const bf16* vp = V + pofs;
        unsigned rq[16], rl[16], rv[16];
        unsigned sq[16], sk[16], ske0[8], ske1[8]; float det0, det1;
#define LOAD_RAW(nn) do { const int nc_ = (nn) < nch ? (nn) : nch - 1; const bf16* qb_ = qp + (size_t)nc_ * 8192; const bf16* lb_ = lp + (size_t)nc_ * 8192; const bf16* vb_ = vp + (size_t)nc_ * 8192; \
        _Pragma("unroll") for (int r = 0; r < 16; ++r) { rl[r] = *(const unsigned*)(lb_ + r * 128); rq[r] = *(const unsigned*)(qb_ + r * 128); } (void)vb_; } while (0)
#define LOAD_V(nn) do { const int nc_ = (nn) < nch ? (nn) : nch - 1; const bf16* vb_ = vp + (size_t)nc_ * 8192; _Pragma("unroll") for (int r = 0; r < 16; ++r) rv[r] = *(const unsigned*)(vb_ + r * 128); } while (0)
#define PREP_REGS(full_) do { \
        float su0 = 0.f, su1 = 0.f; \
        _Pragma("unroll") for (int r = 0; r < 16; ++r) { const f16x2 hh = __builtin_bit_cast(f16x2, rl[r]); su0 += (float)hh.x; su1 += (float)hh.y; } \
        float off0 = 0.f, off1 = 0.f, tot0 = 0.f, tot1 = 0.f; \
        _Pragma("unroll") for (int j = 0; j < 4; ++j) { const float a_ = __shfl(su0, cpx + 16 * j), b_ = __shfl(su1, cpx + 16 * j); if (j < rgx) { off0 += a_; off1 += b_; } tot0 += a_; tot1 += b_; } \
        const float et0 = __expf(tot0), et1 = __expf(tot1); float p0 = __expf(off0), p1 = __expf(off1); det0 = et0; det1 = et1; \
        float kp0 = 0.f, kp1 = 0.f; \
        _Pragma("unroll") for (int r = 0; r < 16; ++r) { const f16x2 hh = __builtin_bit_cast(f16x2, rl[r]); const float f0 = __expf((float)hh.x), f1 = __expf((float)hh.y); \
            p0 *= f0; p1 *= f1; \
            const float ki0 = (1.0f - f0) * __builtin_amdgcn_rcpf(p0), ki1 = (1.0f - f1) * __builtin_amdgcn_rcpf(p1); const float ke0 = ki0 * et0, ke1 = ki1 * et1; \
            if (full_) { sq[r] = pkbf(bf_lo(rq[r]) * p0, bf_hi(rq[r]) * p1); sk[r] = pkbf(ki0, ki1); } \
            if (r & 1) { ske0[r >> 1] = pkbf(kp0, ke0); ske1[r >> 1] = pkbf(kp1, ke1); } \
            kp0 = ke0; kp1 = ke1; } } while (0)
#define DUMP_REGS(full_) do { \
        if (full_) _Pragma("unroll") for (int r = 0; r < 16; ++r) { *(LAS unsigned*)(QD + ((16 * rgx + r) * SQ + c0x) * 2) = sq[r]; *(LAS unsigned*)(KI + ((16 * rgx + r) * SQ + c0x) * 2) = sk[r]; } \
        { v4u w_; w_.x = ske0[0]; w_.y = ske0[1]; w_.z = ske0[2]; w_.w = ske0[3]; *(LAS v4u*)(KET + (c0x * SK + 16 * rgx) * 2) = w_; w_.x = ske0[4]; w_.y = ske0[5]; w_.z = ske0[6]; w_.w = ske0[7]; *(LAS v4u*)(KET + (c0x * SK + 16 * rgx + 8) * 2) = w_; \
          w_.x = ske1[0]; w_.y = ske1[1]; w_.z = ske1[2]; w_.w = ske1[3]; *(LAS v4u*)(KET + ((c0x + 1) * SK + 16 * rgx) * 2) = w_; w_.x = ske1[4]; w_.y = ske1[5]; w_.z = ske1[6]; w_.w = ske1[7]; *(LAS v4u*)(KET + ((c0x + 1) * SK + 16 * rgx + 8) * 2) = w_; \
          _Pragma("unroll") for (int hh_ = 0; hh_ < 2; ++hh_) { \
            w_.x = (rv[8 * hh_ + 0] & 0xffffu) | (rv[8 * hh_ + 1] << 16); w_.y = (rv[8 * hh_ + 2] & 0xffffu) | (rv[8 * hh_ + 3] << 16); w_.z = (rv[8 * hh_ + 4] & 0xffffu) | (rv[8 * hh_ + 5] << 16); w_.w = (rv[8 * hh_ + 6] & 0xffffu) | (rv[8 * hh_ + 7] << 16); \
            *(LAS v4u*)(VT + (c0x * SK + 16 * rgx + 8 * hh_) * 2) = w_; \
            w_.x = (rv[8 * hh_ + 0] >> 16) | (rv[8 * hh_ + 1] & 0xffff0000u); w_.y = (rv[8 * hh_ + 2] >> 16) | (rv[8 * hh_ + 3] & 0xffff0000u); w_.z = (rv[8 * hh_ + 4] >> 16) | (rv[8 * hh_ + 5] & 0xffff0000u); w_.w = (rv[8 * hh_ + 6] >> 16) | (rv[8 * hh_ + 7] & 0xffff0000u); \
            *(LAS v4u*)(VT + ((c0x + 1) * SK + 16 * rgx + 8 * hh_) * 2) = w_; } } \
        if (rgx == 0) { f32x2 p_; p_.x = det0; p_.y = det1; *(LAS f32x2*)(DEC + c0x) = p_; } } while (0)
        f32x4 S[8][2];
#define WRITE_ST() do { _Pragma("unroll") for (int kt = 0; kt < 8; ++kt) _Pragma("unroll") for (int j = 0; j < 2; ++j) { v2u w_; w_.x = pkbf(S[kt][j][0], S[kt][j][1]); w_.y = pkbf(S[kt][j][2], S[kt][j][3]); \
        *(LAS v2u*)(ST + ((16 * (2 * wq + j) + i) * SQ + 16 * kt + 4 * g) * 2) = w_; } } while (0)
#pragma unroll
        for (int kt = 0; kt < 8; ++kt)
#pragma unroll
            for (int j = 0; j < 2; ++j) S[kt][j] = (f32x4){0.f, 0.f, 0.f, 0.f};
        LOAD_RAW(0); LOAD_V(0);
        WRITE_ST();
        { const int cpx = cp, rgx = rg, c0x = c0; PREP_REGS(nb == 0); (void)c0x; }
        if (nb > 0) {
            { const int nc_ = nb < nch ? nb : nch - 1; const bf16* qb_ = qp + (size_t)nc_ * 8192;
#pragma unroll
              for (int r = 0; r < 16; ++r) rq[r] = *(const unsigned*)(qb_ + r * 128); }
            for (int n = 0; n < nb; ++n) {
                int i_ = i, g_ = g; asm volatile("" : "+v"(i_), "+v"(g_));
                const int cpx = i_, rgx = g_, c0x = 32 * wq + 2 * i_;
                DUMP_REGS(false);
                __syncthreads();
                {
                    bf16x8 bv[2][2];
#pragma unroll
                    for (int j = 0; j < 2; ++j)
#pragma unroll
                        for (int c = 0; c < 2; ++c) bv[j][c] = *(const LAS bf16x8*)(VT + ((16 * (2 * wq + j) + i_) * SK + 32 * c + 8 * g_) * 2);
#pragma unroll
                    for (int kt = 0; kt < 8; ++kt) {
                        const f32x4 d = *(const LAS f32x4*)(DEC + 16 * kt + 4 * g_);
                        const bf16x8 a0 = *(const LAS bf16x8*)(KET + ((16 * kt + i_) * SK + 8 * g_) * 2), a1 = *(const LAS bf16x8*)(KET + ((16 * kt + i_) * SK + 32 + 8 * g_) * 2);
#pragma unroll
                        for (int j = 0; j < 2; ++j) { f32x4 acc = S[kt][j] * d; acc = MFMA16(a0, bv[j][0], acc); acc = MFMA16(a1, bv[j][1], acc); S[kt][j] = acc; }
                    }
                }
#pragma unroll
                for (int r = 0; r < 16; ++r) { rl[r] = *(const LAS unsigned*)(lds + ((16 * rgx + r) * 128 + c0x) * 2); rv[r] = *(const LAS unsigned*)(lds + 16384 + ((16 * rgx + r) * 128 + c0x) * 2); }
                PREP_REGS(n + 1 == nb);
                __syncthreads();
            }
            WRITE_ST();
            LOAD_RAW(nb + 1);
        } else { LOAD_RAW(1); }
        for (int n = nb; n < ne; ++n) {
            int i_ = i, g_ = g; asm volatile("" : "+v"(i_), "+v"(g_));
            const int cpx = i_, rgx = g_, c0x = 32 * wq + 2 * i_;
            DUMP_REGS(true);
            asm volatile("" ::: "memory");
            LOAD_V(n + 1);
            __syncthreads();
            {
                bf16x8 bv[2][2];
#pragma unroll
                for (int j = 0; j < 2; ++j)
#pragma unroll
                    for (int c = 0; c < 2; ++c) bv[j][c] = *(const LAS bf16x8*)(VT + ((16 * (2 * wq + j) + i_) * SK + 32 * c + 8 * g_) * 2);
#pragma unroll
                for (int kt = 0; kt < 8; ++kt) {
                    const f32x4 d = *(const LAS f32x4*)(DEC + 16 * kt + 4 * g_);
                    const bf16x8 a0 = *(const LAS bf16x8*)(KET + ((16 * kt + i_) * SK + 8 * g_) * 2), a1 = *(const LAS bf16x8*)(KET + ((16 * kt + i_) * SK + 32 + 8 * g_) * 2);
#pragma unroll
                    for (int j = 0; j < 2; ++j) { f32x4 acc = S[kt][j] * d; acc = MFMA16(a0, bv[j][0], acc); acc = MFMA16(a1, bv[j][1], acc); S[kt][j] = acc; }
                }
            }
            PREP_REGS(true);
            LOAD_RAW(n + 2);
            __syncthreads();
            WRITE_ST();
        }
        if (store_state) {
            float* op = s_out + (4 * g) * 128 + 32 * wq + i;
#pragma unroll
            for (int kt = 0; kt < 8; ++kt) {
#pragma unroll
                for (int j = 0; j < 2; ++j)
#pragma unroll
                    for (int r = 0; r < 4; ++r) __builtin_nontemporal_store(S[kt][j][r], op + r * 128 + 16 * j);
                op += 2048; asm volatile("" : "+v"(op));
            }
        }
#undef WRITE_ST
#undef DUMP_REGS
#undef PREP_REGS
#undef LOAD_RAW
#undef LOAD_V
    }
}

__device__ __forceinline__ void hgrn_sample_units(LAS unsigned char* lds, const bf16* Q, const bf16* LF, const bf16* V, const bf16* G, bf16* O, const float* gnorm,
                                                  const float* state, float* out_hs, int su0, int stride, int su_end) {
    int tid_ = threadIdx.x; asm volatile("" : "+v"(tid_));
    const int tid = tid_, lane = tid & 63, wid = tid >> 6, kr = tid >> 5, vc = tid & 31;
    LAS float* SQv = (LAS float*)lds; LAS float* SFv = SQv + 512; LAS float* SKv = SQv + 1024; LAS float* SVv = SQv + 1536; LAS float* RED = SQv + 2048;
    if (su0 >= su_end) return;
    f32x4 S[8], Sn[8]; unsigned short nq, nl, nv;
    const int tt = tid >> 7, tk = tid & 127;
#define SU_LOAD(su_) do { const int b_ = (su_) >> 4, h_ = (su_) & 15; const f32x4* sp_ = (const f32x4*)(state + (size_t)(su_) * 16384 + kr * 128 + 4 * vc); \
        _Pragma("unroll") for (int p = 0; p < 8; ++p) Sn[p] = __builtin_nontemporal_load(sp_ + p * 512); \
        const size_t idx_ = ((size_t)h_ * MT + (size_t)(MP + 4 * b_ + tt)) * 128 + tk; nq = Q[idx_]; nl = LF[idx_]; nv = V[idx_]; } while (0)
    SU_LOAD(su0);
    for (int su = su0; su < su_end; su += stride) {
        const int b = su >> 4, h = su & 15;
#pragma unroll
        for (int p = 0; p < 8; ++p) S[p] = Sn[p];
        { const float q = __builtin_bit_cast(float, (unsigned)nq << 16), v = __builtin_bit_cast(float, (unsigned)nv << 16);
          const float f = __expf((float)__builtin_bit_cast(_Float16, nl));
          SQv[tid] = q; SFv[tid] = f; SKv[tid] = 1.0f - f; SVv[tid] = v; }
        { const int sn = (su + stride) < su_end ? (su + stride) : su; SU_LOAD(sn); }
        __syncthreads();
        f32x4 o[4];
#pragma unroll
        for (int t = 0; t < 4; ++t) {
            const f32x4 vv = *(const LAS f32x4*)(SVv + t * 128 + 4 * vc); f32x4 acc = (f32x4){0.f, 0.f, 0.f, 0.f};
#pragma unroll
            for (int p = 0; p < 8; ++p) { const int k = t * 128 + kr + 16 * p; const float f = SFv[k], kn = SKv[k], q = SQv[k]; S[p] = S[p] * f + vv * kn; acc += S[p] * q; }
            o[t] = acc;
        }
        { f32x4* op = (f32x4*)(out_hs + (size_t)su * 16384 + kr * 128 + 4 * vc);
#pragma unroll
          for (int p = 0; p < 8; ++p) __builtin_nontemporal_store(S[p], op + p * 512); }
#pragma unroll
        for (int t = 0; t < 4; ++t) { o[t].x += __shfl_xor(o[t].x, 32); o[t].y += __shfl_xor(o[t].y, 32); o[t].z += __shfl_xor(o[t].z, 32); o[t].w += __shfl_xor(o[t].w, 32); }
        if (lane < 32) {
#pragma unroll
            for (int t = 0; t < 4; ++t) *(LAS f32x4*)(RED + (wid * 4 + t) * 128 + 4 * vc) = o[t];
        }
        __syncthreads();
        if (wid < 4) {
            const int t = wid; float a0 = 0.f, a1 = 0.f;
#pragma unroll
            for (int w2 = 0; w2 < 8; ++w2) { a0 += RED[(w2 * 4 + t) * 128 + lane]; a1 += RED[(w2 * 4 + t) * 128 + lane + 64]; }
            const float ss = wave_sum(a0 * a0 + a1 * a1); const float sc = __builtin_amdgcn_rsqf(ss * (1.0f / 128.0f) + LN_EPS);
            const int row = MP + 4 * b + t; const size_t gi = ((size_t)h * MT + (size_t)row) * 128;
            const float g0 = __builtin_bit_cast(float, (unsigned)G[gi + lane] << 16), g1 = __builtin_bit_cast(float, (unsigned)G[gi + lane + 64] << 16);
            bf16* orow = O + (size_t)row * 2048 + h * 128;
            orow[lane] = (bf16)(pkbf(a0 * sc * gnorm[h * 128 + lane] * g0, 0.f) & 0xffffu); orow[lane + 64] = (bf16)(pkbf(a1 * sc * gnorm[h * 128 + lane + 64] * g1, 0.f) & 0xffffu);
        }
        __syncthreads();
    }
#undef SU_LOAD
}

__device__ __forceinline__ void hgrn_phase(const Ptrs& P, LAS unsigned char* lds, int ctr_idx) {
    const bf16* Q = (const bf16*)(P.ws + WS_Q); const bf16* LF = (const bf16*)(P.ws + WS_LF); const bf16* V = (const bf16*)(P.ws + WS_V); const bf16* G = (const bf16*)(P.ws + WS_G);
    bf16* O = (bf16*)(P.ws + WS_O);
    const int Gd = (int)gridDim.x, bx = (int)blockIdx.x;
    if (Gd >= 256) {
        constexpr int SPLIT = 12; static_assert(SPLIT % 3 == 0, "the warm-up loader's register ring has three slots");
        if (bx < 256) { const int pu = bx & 127; const bool late = bx >= 128;
            hgrn_unit(lds, Q, LF, V, G, O, P.gnorm, (pu >> 4) * 2048, pu & 15, P.out + OUT_HP + (size_t)pu * 16384, late ? SPLIT : 0, late ? 32 : SPLIT, late); }
        if (bx < 128) hgrn_sample_units(lds, Q, LF, V, G, O, P.gnorm, P.state, P.out + OUT_HS, bx, 128, 2048);

    } else {
        const bool split = Gd > 128;
        if (!split || bx < 128) {
            for (int pu = bx; pu < 128; pu += (split ? 128 : Gd)) hgrn_unit(lds, Q, LF, V, G, O, P.gnorm, (pu >> 4) * 2048, pu & 15, P.out + OUT_HP + (size_t)pu * 16384, 0, 32, true);
        }
        if (!split || bx >= 128) { const int sid = split ? bx - 128 : bx, ns = split ? Gd - 128 : Gd; __syncthreads(); hgrn_sample_units(lds, Q, LF, V, G, O, P.gnorm, P.state, P.out + OUT_HS, sid, ns, 2048); }
    }
    (void)ctr_idx;
}

__device__ __forceinline__ void gate_phase(const Ptrs& P, LAS unsigned char* lds) {
    const int tid = threadIdx.x, lane = tid & 63, wid = __builtin_amdgcn_readfirstlane(tid >> 6);
    const int i = lane & 15, g = lane >> 4;
    constexpr int SW = 136;
    const bf16* U = (const bf16*)(P.ws + WS_U); const bf16* Vb = (const bf16*)(P.ws + WS_VB); bf16* GT = (bf16*)(P.ws + WS_O);
    const float* part = (const float*)(P.ws + WS_PART); const bf16* WSB = (const bf16*)(P.ws + WS_WSB);
    LAS unsigned char* WT = lds; LAS unsigned char* VNT = lds + 34816; LAS f32x2* STT = (LAS f32x2*)(lds + 69632); LAS unsigned char* OT = lds + 70656;
    int cur_grp = -1;
    for (int u = blockIdx.x; u < 2048; u += gridDim.x) {
        const int grp = u & 15, m0 = (u >> 4) * 128;
        float bq_[8]; v4u uzq[4];
#pragma unroll
        for (int tt = 0; tt < 8; ++tt) bq_[tt] = P.b_s[grp * 128 + 16 * tt + i];
#pragma unroll
        for (int it = 0; it < 4; ++it) { const int idx = tid + 512 * it, row = idx >> 4, c16 = idx & 15; uzq[it] = __builtin_nontemporal_load((const v4u*)(U + ((size_t)grp * MT + (size_t)(m0 + row)) * 128 + c16 * 8)); }
        __syncthreads();
        if (grp != cur_grp) {
#pragma unroll
            for (int it = 0; it < 4; ++it) { const int idx = tid + 512 * it, row = idx >> 4, c16 = idx & 15;
                *(LAS v4u*)(WT + (row * SW) * 2 + c16 * 16) = *(const v4u*)(WSB + (size_t)grp * 16384 + row * 128 + c16 * 8); }
            cur_grp = grp;
        }
        unsigned vraw[16];
#pragma unroll
        for (int r = 0; r < 16; ++r) vraw[r] = __builtin_nontemporal_load((const unsigned*)(Vb + ((size_t)grp * MT + (size_t)(m0 + 16 * wid + r)) * 128 + 2 * lane));
        if (tid < 128) { const f32x2* pr = (const f32x2*)(part + (size_t)(m0 + tid) * 64); float s = 0.f, ss = 0.f;
#pragma unroll
            for (int j = 0; j < 32; ++j) { const f32x2 p = pr[j]; s += p.x; ss += p.y; }
            const float mean = s * (1.0f / 2048.0f), var = ss * (1.0f / 2048.0f) - mean * mean; f32x2 o; o.x = mean; o.y = 1.0f / sqrtf(var + LN_EPS); STT[tid] = o; }
        __syncthreads();
        {
            const int c0 = grp * 128 + 2 * lane; const float g0 = P.lnv_g[c0], g1 = P.lnv_g[c0 + 1], b0 = P.lnv_b[c0], b1 = P.lnv_b[c0 + 1];
            float y0[16], y1[16];
#pragma unroll
            for (int r = 0; r < 16; ++r) { const int row = 16 * wid + r; const unsigned raw = vraw[r]; const f32x2 st = STT[row];
                y0[r] = (bf_lo(raw) - st.x) * st.y * g0 + b0; y1[r] = (bf_hi(raw) - st.x) * st.y * g1 + b1; }
#pragma unroll
            for (int hh = 0; hh < 2; ++hh) { v4u w0, w1;
                w0.x = pkbf(y0[8 * hh + 0], y0[8 * hh + 1]); w0.y = pkbf(y0[8 * hh + 2], y0[8 * hh + 3]); w0.z = pkbf(y0[8 * hh + 4], y0[8 * hh + 5]); w0.w = pkbf(y0[8 * hh + 6], y0[8 * hh + 7]);
                w1.x = pkbf(y1[8 * hh + 0], y1[8 * hh + 1]); w1.y = pkbf(y1[8 * hh + 2], y1[8 * hh + 3]); w1.z = pkbf(y1[8 * hh + 4], y1[8 * hh + 5]); w1.w = pkbf(y1[8 * hh + 6], y1[8 * hh + 7]);
                *(LAS v4u*)(VNT + ((2 * lane) * SW + 16 * wid + 8 * hh) * 2) = w0; *(LAS v4u*)(VNT + ((2 * lane + 1) * SW + 16 * wid + 8 * hh) * 2) = w1; }
        }
        __syncthreads();
        {
            bf16x8 av[4];
#pragma unroll
            for (int kk = 0; kk < 4; ++kk) av[kk] = *(const LAS bf16x8*)(VNT + ((16 * wid + i) * SW + 32 * kk + 8 * g) * 2);
#pragma unroll
            for (int tt = 0; tt < 8; ++tt) {
                f32x4 acc = (f32x4){0.f, 0.f, 0.f, 0.f};
#pragma unroll
                for (int kk = 0; kk < 4; ++kk) if (kk <= (tt >> 1)) { const bf16x8 b = *(const LAS bf16x8*)(WT + ((16 * tt + i) * SW + 32 * kk + 8 * g) * 2); acc = MFMA16(av[kk], b, acc); }
                const int t = 16 * tt + i; const float bias = bq_[tt];
                v2u w; w.x = pkbf(acc[0] + bias, acc[1] + bias); w.y = pkbf(acc[2] + bias, acc[3] + bias);
                *(LAS v2u*)(OT + (t * SW + 16 * wid + 4 * g) * 2) = w;
            }
        }
        __syncthreads();
#pragma unroll
        for (int it = 0; it < 4; ++it) { const int idx = tid + 512 * it, row = idx >> 4, c16 = idx & 15;
            const v4u mx = *(const LAS v4u*)(OT + (row * SW) * 2 + c16 * 16); const v4u uu = uzq[it]; v4u w;
            w.x = pkbf(bf_lo(uu.x) * bf_lo(mx.x), bf_hi(uu.x) * bf_hi(mx.x)); w.y = pkbf(bf_lo(uu.y) * bf_lo(mx.y), bf_hi(uu.y) * bf_hi(mx.y));
            w.z = pkbf(bf_lo(uu.z) * bf_lo(mx.z), bf_hi(uu.z) * bf_hi(mx.z)); w.w = pkbf(bf_lo(uu.w) * bf_lo(mx.w), bf_hi(uu.w) * bf_hi(mx.w));
            *(v4u*)(GT + (size_t)(m0 + row) * 2048 + grp * 128 + c16 * 8) = w; }
    }
    for (int sb = (int)gridDim.x - 1 - (int)blockIdx.x; sb < 128; sb += gridDim.x) {
        __syncthreads();
        const int mrow = MP + 4 * sb;
        if (tid < 4) { const f32x2* pr = (const f32x2*)(part + (size_t)(mrow + tid) * 64); float s = 0.f, ss = 0.f;
            for (int j = 0; j < 32; ++j) { const f32x2 p = pr[j]; s += p.x; ss += p.y; }
            const float mean = s * (1.0f / 2048.0f), var = ss * (1.0f / 2048.0f) - mean * mean; f32x2 o; o.x = mean; o.y = 1.0f / sqrtf(var + LN_EPS); STT[tid] = o; }
        __syncthreads();
        const int c = 4 * tid, grp = c >> 7;
        const f32x4 lg = *(const f32x4*)(P.lnv_g + c), lb = *(const f32x4*)(P.lnv_b + c);
        f32x4 vn[4];
#pragma unroll
        for (int t = 0; t < 4; ++t) { const v2u raw = *(const v2u*)(Vb + ((size_t)grp * MT + (size_t)(mrow + t)) * 128 + (c & 127)); const f32x2 st = STT[t];
            f32x4 x; x.x = bf_lo(raw.x); x.y = bf_hi(raw.x); x.z = bf_lo(raw.y); x.w = bf_hi(raw.y);
            vn[t] = (x - st.x) * st.y * lg + lb;
            __builtin_nontemporal_store(vn[t], (f32x4*)(P.out + OUT_CV + (size_t)(4 * sb + t) * 2048 + c)); }
#pragma unroll
        for (int t = 0; t < 4; ++t) { const float bias = P.b_s[grp * 128 + t]; f32x4 mx = (f32x4){bias, bias, bias, bias};
#pragma unroll
            for (int s = 0; s < 4; ++s) if (s <= t) mx += vn[s] * P.w_s[(size_t)grp * 16384 + t * 128 + s];
            const size_t off = (size_t)(mrow + t) * 2048 + c; const size_t offg = ((size_t)grp * MT + (size_t)(mrow + t)) * 128 + (c & 127); const v2u uu = *(const v2u*)(U + offg);
            v2u w; w.x = pkbf(bf_lo(uu.x) * mx.x, bf_hi(uu.x) * mx.y); w.y = pkbf(bf_lo(uu.y) * mx.z, bf_hi(uu.y) * mx.w);
            *(v2u*)(GT + off) = w; }
    }
}

struct Args { const float* in[15]; float* out; unsigned char* ws; int ph_lo, ph_hi; };
__global__ void __launch_bounds__(512, 2) mk_fwd(Args a) {
    extern __shared__ __attribute__((aligned(16))) unsigned char lds_raw[];
    LAS unsigned char* lds = (LAS unsigned char*)lds_raw;
    Ptrs P;
    P.xp = a.in[0]; P.xs = a.in[1]; P.state = a.in[2]; P.w_in_a = a.in[3]; P.lb_logits = a.in[4]; P.gnorm = a.in[5]; P.w_out_a = a.in[6]; P.w_in_b = a.in[7];
    P.lnv_g = a.in[8]; P.lnv_b = a.in[9]; P.w_s = a.in[10]; P.b_s = a.in[11]; P.w_out_b = a.in[12]; P.ln_g = a.in[13]; P.ln_b = a.in[14]; P.out = a.out; P.ws = a.ws;
    const int lo = a.ph_lo, hi = a.ph_hi;
    volatile LAS unsigned* bst = (volatile LAS unsigned*)(lds + 131072 + 64);
    if (threadIdx.x == 0) { bst[0] = 0u; bst[1] = 0u; }
    __syncthreads();
    XcdBarrier bar = xcd_barrier_post((unsigned*)(P.ws + WS_BAR), bst);
    if (lo < 0) cg::this_grid().sync();
#define IN(k) (lo <= (k) && (k) < hi)
#define SEAM(k) do { if (IN(k) && IN((k) + 1)) { xcd_barrier(bar); } } while (0)
#ifndef PROBE_REP
#define PROBE_REP -1
#endif
#define REP(k) for (int rep_ = 0; rep_ < ((PROBE_REP == (k)) ? 2 : 1); ++rep_, (void)((PROBE_REP == (k) && rep_ == 1) ? (cg::this_grid().sync(), 0) : 0))
    const int G = (int)gridDim.x, c = (int)blockIdx.x;
    if (IN(0)) REP(0) { p0_prologue(P, lds); }
    SEAM(0);
    if (IN(1)) REP(1) {
        pg8::Gemm g{(const bf16*)(P.ws + WS_XB), (const bf16*)(P.ws + WS_WINA), MT, 4 * EA, DM}; pg8::StaticOrder S; S.init(MT, 4 * EA, G, c);
        pg8::EpiHgrnIn E{(bf16*)(P.ws + WS_Q), (const float*)(P.ws + WS_LB)};
        pg8::gemm_phase<pg8::EpiHgrnIn, pg8::StaticOrder, true, true>(lds, g, S, E);
        if (G >= 128) {
            const int nfull = S.nwg / G, nlast = S.nwg - nfull * G;
            __syncthreads();
            if (nlast == 0 || nlast >= G) p0_late_weights(P, lds, c, G);
            else if (c >= nlast) p0_late_weights(P, lds, c - nlast, G - nlast);
        }
    }
    SEAM(1);
    if (IN(2)) REP(2) { hgrn_phase(P, lds, rep_); }
    SEAM(2);
    if (IN(3)) REP(3) {
        const int Mo = G > 32 ? MP : MT;
        pg8::Gemm g{(const bf16*)(P.ws + WS_O), (const bf16*)(P.ws + WS_WOUTA), Mo, DM, EA}; pg8::StaticOrder S; S.init(Mo, DM, G, c);
        pg8::EpiBf16Plain E{(bf16*)(P.ws + WS_D), DM};
        pg8::gemm_phase<pg8::EpiBf16Plain, pg8::StaticOrder, true, true>(lds, g, S, E);
    }
    SEAM(3);
    if (IN(4)) REP(4) { ln_phase<false>(P, lds, 0); }
    SEAM(4);
    if (IN(5)) REP(5) {
        pg8::Gemm g{(const bf16*)(P.ws + WS_XB), (const bf16*)(P.ws + WS_WINB), MT, 3 * EA, DM}; pg8::StaticOrder S; S.init(MT, 3 * EA, G, c);
        pg8::EpiGmlpIn E{(bf16*)(P.ws + WS_U), (float*)(P.ws + WS_PART)};
        pg8::gemm_phase<pg8::EpiGmlpIn, pg8::StaticOrder, true, true>(lds, g, S, E);
    }
    SEAM(5);
    if (IN(6)) REP(6) { gate_phase(P, lds); }
    SEAM(6);
    if (IN(7)) REP(7) {
        const int Mo = G > 32 ? MP : MT;
        pg8::Gemm g{(const bf16*)(P.ws + WS_O), (const bf16*)(P.ws + WS_WOUTB), Mo, DM, EA}; pg8::StaticOrder S; S.init(Mo, DM, G, c);
        pg8::EpiBf16Plain E{(bf16*)(P.ws + WS_D), DM};
        pg8::gemm_phase<pg8::EpiBf16Plain, pg8::StaticOrder, true, true>(lds, g, S, E);
    }
    SEAM(7);
    if (IN(8)) REP(8) { ln_phase<true>(P, lds, 1); }
#undef IN
#undef SEAM
}

extern "C" void kernel_launch(void* const* d_in, const int* in_sizes, int n_in, void* d_out, int out_size, void* d_ws, size_t ws_size, hipStream_t stream) {
    static int grid = 0;
    if (grid == 0) {
        if (n_in != 15 || ws_size < WS_END || out_size != 54001664) { fprintf(stderr, "kernel_launch: unexpected problem (n_in %d, out %d, ws %zu)\n", n_in, out_size, ws_size); grid = -1; return; }
        int dev = 0, cus = 0, per_cu = 0;
        if (hipGetDevice(&dev) != hipSuccess || hipDeviceGetAttribute(&cus, hipDeviceAttributeMultiprocessorCount, dev) != hipSuccess) { grid = -1; return; }
        if (hipFuncSetAttribute((const void*)mk_fwd, hipFuncAttributeMaxDynamicSharedMemorySize, LDS_BYTES) != hipSuccess) { fprintf(stderr, "kernel_launch: hipFuncSetAttribute failed\n"); grid = -1; return; }
        if (hipOccupancyMaxActiveBlocksPerMultiprocessor(&per_cu, (const void*)mk_fwd, 512, LDS_BYTES) != hipSuccess || per_cu < 1) { fprintf(stderr, "kernel_launch: occupancy query gave %d\n", per_cu); (void)hipGetLastError(); per_cu = 1; }
        grid = cus * 1;
        (void)in_sizes;
    }
    if (grid < 0) return;
    Args a{};
    for (int i = 0; i < 15; ++i) a.in[i] = (const float*)d_in[i];
    a.out = (float*)d_out; a.ws = (unsigned char*)d_ws;
#if MK_MULTI
    for (int p = 0; p < NPHASE; ++p) { a.ph_lo = p; a.ph_hi = p + 1; hipLaunchKernelGGL(mk_fwd, dim3(grid), dim3(512), LDS_BYTES, stream, a); }
#else
    a.ph_lo = 0; a.ph_hi = NPHASE;
    if (hipMemsetAsync((char*)d_ws + WS_BAR, 0, XCD_BAR_WORDS * 4, stream) != hipSuccess) { fprintf(stderr, "kernel_launch: memset of the barrier words failed\n"); return; }
    void* args[] = {&a};
    hipError_t e = hipLaunchCooperativeKernel((const void*)mk_fwd, dim3(grid), dim3(512), args, LDS_BYTES, stream);
    if (e != hipSuccess) fprintf(stderr, "kernel_launch: cooperative launch failed: %s (grid %d)\n", hipGetErrorString(e), grid);
#endif
}
```
